# Optimizing an MI355X kernel written in HIP

```python
import math
import jax, jax.numpy as jnp
from jax import lax
import numpy as np

D_MODEL = 1024
BATCH = 8
SEQ = 2048
DEPTH = 1

POOL_WIDTH = D_MODEL // 4
POOL_GROUPS = 4
POOL_GDIM = POOL_WIDTH // POOL_GROUPS
POOL_WINDOWS = (2, 4, 8, 16)
HEAD_DIM = 128
ATTN_WIDTH = D_MODEL - POOL_WIDTH
N_HEADS = ATTN_WIDTH // HEAD_DIM
N_KV_HEADS = 2
KV_WIDTH = N_KV_HEADS * HEAD_DIM
IDX_HEADS = 8
IDX_DIM = 64
TOPK_MAX = 256
QBLK = 128
ROPE_THETA = 500000.0
ROPE_DIM = HEAD_DIM // 4
IDX_ROPE_DIM = IDX_DIM // 4
N_EXPERTS = 32
TOP_K = 4
D_FF = D_MODEL
SWIGLU_LIMIT = 7.0
SWIGLU_ALPHA = 1.702
ALPHA_RES = (2.0 * DEPTH) ** 0.25
BETA_INIT = (8.0 * DEPTH) ** -0.25
LN_EPS = 1e-5
NEG_INF = -1e30
OFF_POOL = 0
OFF_Q = OFF_POOL + POOL_WIDTH
OFF_K = OFF_Q + ATTN_WIDTH
OFF_V = OFF_K + KV_WIDTH
OFF_IQ = OFF_V + KV_WIDTH
OFF_IK = OFF_IQ + IDX_HEADS * IDX_DIM
OFF_IW = OFF_IK + IDX_DIM
IN_WIDTH = OFF_IW + IDX_HEADS

kernel_name = "hymba_pool_dsa_moe_deepnorm"


def layer_norm(x, g, b):
    xf = x.astype(jnp.float32)
    mu = jnp.mean(xf, axis=-1, keepdims=True)
    var = jnp.mean(jnp.square(xf - mu), axis=-1, keepdims=True)
    y = (xf - mu) * lax.rsqrt(var + LN_EPS) * g.astype(jnp.float32) + b.astype(jnp.float32)
    return y.astype(x.dtype)


def apply_rope(x, positions, rd):
    inv_freq = ROPE_THETA ** (-jnp.arange(0, rd, 2, dtype=jnp.float32) / rd)
    ang = positions.astype(jnp.float32)[..., None] * inv_freq
    cos = jnp.cos(ang)[:, :, None, :]
    sin = jnp.sin(ang)[:, :, None, :]
    xr = x[..., :rd].astype(jnp.float32)
    x1, x2 = xr[..., : rd // 2], xr[..., rd // 2:]
    rot = jnp.concatenate([x1 * cos - x2 * sin, x2 * cos + x1 * sin], axis=-1)
    return jnp.concatenate([rot.astype(x.dtype), x[..., rd:]], axis=-1)


def pool_mixer(u, w_pool, pool_scale):
    B, L, C = u.shape
    uf = u.astype(jnp.float32)
    cs = jnp.concatenate([jnp.zeros((B, 1, C), jnp.float32), jnp.cumsum(uf, axis=1)], axis=1)
    t = jnp.arange(L)
    diffs = []
    for gi, w in enumerate(POOL_WINDOWS):
        sl = slice(gi * POOL_GDIM, (gi + 1) * POOL_GDIM)
        c = cs[..., sl]
        lo = jnp.maximum(t + 1 - w, 0)
        win_sum = c[:, t + 1] - c[:, lo]
        cnt = jnp.minimum(t + 1, w).astype(jnp.float32)[None, :, None]
        diffs.append(win_sum / cnt - uf[..., sl])
    d = jnp.stack(diffs, axis=2)
    y = jnp.einsum('blgc,gcd->blgd', d, w_pool.astype(jnp.float32)).reshape(B, L, C)
    return (y * pool_scale.astype(jnp.float32)).astype(u.dtype)


def sparse_attention(q, k, v, iq, ik, iw):
    B, L = q.shape[:2]
    n_sel = min(TOPK_MAX, L // 4)
    nb = L // QBLK
    key_pos = jnp.arange(L)
    ikf = ik.astype(jnp.float32)
    w_scale = (IDX_HEADS ** -0.5) * (IDX_DIM ** -0.5)

    def to_blocks(a):
        return a.reshape((B, nb, QBLK) + a.shape[2:]).swapaxes(0, 1)

    def block(args):
        qb, iqb, iwb, q_pos = args
        s = jnp.einsum('bqhd,bsd->bqhs', iqb.astype(jnp.float32), ikf)
        idx_score = jnp.einsum('bqhs,bqh->bqs', jax.nn.relu(s), iwb.astype(jnp.float32) * w_scale)
        causal = key_pos[None, :] <= q_pos[:, None]
        idx_score = jnp.where(causal[None], idx_score, NEG_INF)
        _, sel = lax.top_k(idx_score, n_sel)
        k_sel = jax.vmap(lambda kb, ib: kb[ib])(k, sel)
        v_sel = jax.vmap(lambda vb, ib: vb[ib])(v, sel)
        qg = qb.reshape(B, QBLK, N_KV_HEADS, N_HEADS // N_KV_HEADS, HEAD_DIM).astype(jnp.float32)
        logits = jnp.einsum('bqgrd,bqkgd->bqgrk', qg, k_sel.astype(jnp.float32)) * (HEAD_DIM ** -0.5)
        valid = sel <= q_pos[None, :, None]
        logits = jnp.where(valid[:, :, None, None, :], logits, NEG_INF)
        p = jax.nn.softmax(logits, axis=-1)
        o = jnp.einsum('bqgrk,bqkgd->bqgrd', p, v_sel.astype(jnp.float32))
        return o.reshape(B, QBLK, ATTN_WIDTH).astype(q.dtype)

    out = lax.map(block, (to_blocks(q), to_blocks(iq), to_blocks(iw), key_pos.reshape(nb, QBLK)))
    return out.swapaxes(0, 1).reshape(B, L, ATTN_WIDTH)


def moe(h, w_router, b_router, w_gate_up, b_gate_up, w_down, b_down):
    B, L, D = h.shape
    xf = h.reshape(-1, D)
    logits = xf.astype(jnp.float32) @ w_router.astype(jnp.float32) + b_router.astype(jnp.float32)
    top_logit, top_e = lax.top_k(logits, TOP_K)
    gates = jax.nn.softmax(top_logit, axis=-1)
    flat_e = top_e.reshape(-1)
    order = jnp.argsort(flat_e)
    e_sorted = flat_e[order]
    tok = order // TOP_K
    g_sorted = gates.reshape(-1)[order]
    group_sizes = jnp.bincount(flat_e, length=N_EXPERTS).astype(jnp.int32)
    xs = xf[tok]
    hu = lax.ragged_dot(xs, w_gate_up, group_sizes) + b_gate_up[e_sorted]
    gate = jnp.minimum(hu[:, :D_FF], SWIGLU_LIMIT)
    up = jnp.clip(hu[:, D_FF:], -SWIGLU_LIMIT, SWIGLU_LIMIT)
    act = (up + 1.0) * gate * jax.nn.sigmoid(SWIGLU_ALPHA * gate)
    y = lax.ragged_dot(act, w_down, group_sizes) + b_down[e_sorted]
    y = y * g_sorted[:, None].astype(y.dtype)
    out = jnp.zeros_like(xf).at[tok].add(y)
    return out.reshape(B, L, D)


def setup_inputs(seed: int = 0) -> dict:
    key = jax.random.key(seed)
    ks = jax.random.split(key, 20)
    f32 = jnp.float32
    nrm = lambda k, shape: jax.random.normal(k, shape, f32)
    x = nrm(ks[0], (BATCH, SEQ, D_MODEL))
    offs = jax.random.randint(ks[1], (BATCH, 1), 0, 4096, dtype=jnp.int32)
    positions = (offs + jnp.arange(SEQ, dtype=jnp.int32)[None, :]).astype(jnp.int32)
    ln_in_g = 1.0 + 0.02 * nrm(ks[2], (D_MODEL,))
    ln_in_b = 0.02 * nrm(ks[3], (D_MODEL,))
    col_scale = jnp.concatenate([
        jnp.ones((OFF_V,), f32),
        jnp.full((KV_WIDTH,), BETA_INIT, f32),
        jnp.ones((IN_WIDTH - OFF_IQ,), f32)])
    w_in = nrm(ks[4], (DEPTH, D_MODEL, IN_WIDTH)) * (D_MODEL ** -0.5) * col_scale
    w_pool = nrm(ks[5], (DEPTH, POOL_GROUPS, POOL_GDIM, POOL_GDIM)) * (POOL_GDIM ** -0.5)
    pool_scale = 1.0 + 0.02 * nrm(ks[6], (DEPTH, POOL_WIDTH))
    w_out = nrm(ks[7], (DEPTH, D_MODEL, D_MODEL)) * (D_MODEL ** -0.5) * BETA_INIT
    ln1_g = 1.0 + 0.02 * nrm(ks[8], (DEPTH, D_MODEL))
    ln1_b = 0.02 * nrm(ks[9], (DEPTH, D_MODEL))
    w_router = nrm(ks[10], (DEPTH, D_MODEL, N_EXPERTS)) * (D_MODEL ** -0.5)
    b_router = 0.01 * nrm(ks[11], (DEPTH, N_EXPERTS))
    w_gate_up = nrm(ks[12], (DEPTH, N_EXPERTS, D_MODEL, 2 * D_FF)) * (D_MODEL ** -0.5) * BETA_INIT
    b_gate_up = 0.01 * nrm(ks[13], (DEPTH, N_EXPERTS, 2 * D_FF))
    w_down = nrm(ks[14], (DEPTH, N_EXPERTS, D_FF, D_MODEL)) * (D_FF ** -0.5) * BETA_INIT
    b_down = 0.01 * nrm(ks[15], (DEPTH, N_EXPERTS, D_MODEL))
    ln2_g = 1.0 + 0.02 * nrm(ks[16], (DEPTH, D_MODEL))
    ln2_b = 0.02 * nrm(ks[17], (DEPTH, D_MODEL))
    return {"x": x, "positions": positions, "ln_in_g": ln_in_g, "ln_in_b": ln_in_b,
            "w_in": w_in, "w_pool": w_pool, "pool_scale": pool_scale, "w_out": w_out,
            "ln1_g": ln1_g, "ln1_b": ln1_b, "w_router": w_router, "b_router": b_router,
            "w_gate_up": w_gate_up, "b_gate_up": b_gate_up, "w_down": w_down, "b_down": b_down,
            "ln2_g": ln2_g, "ln2_b": ln2_b}


def reference(x, positions, ln_in_g, ln_in_b, w_in, w_pool, pool_scale, w_out, ln1_g, ln1_b,
              w_router, b_router, w_gate_up, b_gate_up, w_down, b_down, ln2_g, ln2_b):
    B, L, _ = x.shape
    h = layer_norm(x, ln_in_g, ln_in_b)
    for l in range(DEPTH):
        proj = jnp.einsum('bld,de->ble', h, w_in[l])
        u = proj[..., OFF_POOL:OFF_Q]
        q = proj[..., OFF_Q:OFF_K].reshape(B, L, N_HEADS, HEAD_DIM)
        k = proj[..., OFF_K:OFF_V].reshape(B, L, N_KV_HEADS, HEAD_DIM)
        v = proj[..., OFF_V:OFF_IQ].reshape(B, L, N_KV_HEADS, HEAD_DIM)
        iq = proj[..., OFF_IQ:OFF_IK].reshape(B, L, IDX_HEADS, IDX_DIM)
        ik = proj[..., OFF_IK:OFF_IW].reshape(B, L, 1, IDX_DIM)
        iw = proj[..., OFF_IW:IN_WIDTH]
        q = apply_rope(q, positions, ROPE_DIM)
        k = apply_rope(k, positions, ROPE_DIM)
        iq = apply_rope(iq, positions, IDX_ROPE_DIM)
        ik = apply_rope(ik, positions, IDX_ROPE_DIM)[:, :, 0, :]
        pool_out = pool_mixer(u, w_pool[l], pool_scale[l])
        attn_out = sparse_attention(q, k, v, iq, ik, iw)
        mix = jnp.einsum('ble,ed->bld', jnp.concatenate([pool_out, attn_out], axis=-1), w_out[l])
        h = layer_norm(ALPHA_RES * h + mix, ln1_g[l], ln1_b[l])
        ffn = moe(h, w_router[l], b_router[l], w_gate_up[l], b_gate_up[l], w_down[l], b_down[l])
        h = layer_norm(ALPHA_RES * h + ffn, ln2_g[l], ln2_b[l])
    return h
```

```cpp
#include <hip/hip_runtime.h>
#include <cstdio>
#include <cstdint>
#include <utility>

#define LAS __attribute__((address_space(3)))
typedef unsigned short bf16_t;
typedef short bf16x8 __attribute__((ext_vector_type(8)));
typedef short s16x4 __attribute__((ext_vector_type(4)));
typedef float f32x2 __attribute__((ext_vector_type(2)));
typedef float f32x4 __attribute__((ext_vector_type(4)));
typedef float f32x16 __attribute__((ext_vector_type(16)));
typedef unsigned u32x2 __attribute__((ext_vector_type(2)));
typedef unsigned u32x4 __attribute__((ext_vector_type(4)));

#ifndef MK_N_LAUNCHES
#define MK_N_LAUNCHES 1
#endif

constexpr int T = 16384, DM = 1024, SEQ = 2048, NBATCH = 8;
constexpr int INW = 2120, INP = 2304;
constexpr int NE = 32, CAP = 16384, MAXT = 288;
constexpr int NPH = 9;
constexpr float ALPHA = 1.189207115002721f;
constexpr float LN_EPS = 1e-5f;
constexpr float W_SCALE = 0.04419417382415922f;
constexpr int NTHREADS = 512;
constexpr int LDS_BYTES = 147456;
constexpr int MISC_OFF = 131072;

constexpr size_t al256(size_t x) { return (x + 255) / 256 * 256; }
constexpr size_t WS_CTL = 0;
constexpr size_t CTL_BYTES = 65536;
constexpr size_t WS_BTIN = WS_CTL + CTL_BYTES;
constexpr size_t WS_BTOUT = WS_BTIN + al256((size_t)INP * 1024 * 2);
constexpr size_t WS_BTGU = WS_BTOUT + al256((size_t)1024 * 1024 * 2);
constexpr size_t WS_BTDN = WS_BTGU + al256((size_t)NE * 2048 * 1024 * 2);
constexpr size_t WS_WPT = WS_BTDN + al256((size_t)NE * 1024 * 1024 * 2);
constexpr size_t WS_WRA = WS_WPT + al256((size_t)4 * 64 * 64 * 2);
constexpr size_t WS_HA = WS_WRA + al256((size_t)1024 * 32 * 4);
constexpr size_t WS_STATS = WS_HA + al256((size_t)T * 1024 * 2);
constexpr size_t WS_ROPEQK = WS_STATS + al256((size_t)T * 2 * 4);
constexpr size_t WS_ROPEIX = WS_ROPEQK + al256((size_t)T * 32 * 4);
constexpr size_t WS_U = WS_ROPEIX + al256((size_t)T * 16 * 4);
constexpr size_t WS_Q = WS_U + al256((size_t)T * 256 * 2);
constexpr size_t WS_K = WS_Q + al256((size_t)T * 768 * 2);
constexpr size_t WS_V = WS_K + al256((size_t)T * 256 * 2);
constexpr size_t WS_IQ = WS_V + al256((size_t)T * 256 * 2);
constexpr size_t WS_IK = WS_IQ + al256((size_t)T * 512 * 2);
constexpr size_t WS_IW = WS_IK + al256((size_t)T * 64 * 2);
constexpr size_t WS_MASK = WS_IW + al256((size_t)T * 8 * 4);
constexpr size_t WS_CAT = WS_MASK + al256((size_t)T * 64 * 4);
constexpr size_t WS_H1F = WS_CAT + al256((size_t)T * 1024 * 2);
constexpr size_t WS_H1B = WS_H1F + al256((size_t)T * 1024 * 4);
constexpr size_t WS_INV = WS_H1B + al256((size_t)T * 1024 * 2);
constexpr size_t WS_TOKEP = WS_INV + al256((size_t)NE * CAP * 4);
constexpr size_t WS_TOKG = WS_TOKEP + al256((size_t)T * 4 * 4);
constexpr size_t WS_ACT = WS_TOKG + al256((size_t)T * 4 * 4);
constexpr size_t WS_Y = WS_ACT + al256((size_t)MAXT * 256 * 1024 * 2);
constexpr size_t WS_MIX = WS_Y + al256((size_t)MAXT * 256 * 1024 * 2);
constexpr size_t WS_HA8 = WS_MIX + al256((size_t)T * 1024 * 2);
constexpr size_t WS_BTIN8 = WS_HA8 + al256((size_t)T * 1024);
constexpr size_t WS_END = WS_BTIN8 + al256((size_t)1536 * 1024);
constexpr int CW_CNT = 4096;
constexpr int CW_ATTQ = 4224;
constexpr int CW_CVQ1 = 4288, CW_CVQ3 = 4352, CW_ACTRDY = 4608;
constexpr int CW_TMO2 = 4480;
constexpr int CV_PAIRS1 = 3072, CV_PAIRS3 = 5120, CV_HIDDEN = 2 * (CV_PAIRS1 + CV_PAIRS3);

#define XB_TMO      128
#define XB_XCNT(j)  (256  + 64 * (j))
#define XB_XSUB(j)  (1280 + 64 * (j))
#define XB_XGEN(j)  (2304 + 64 * (j))
#define XB_TOP      3328
#define XB_TOPGEN   3392
#define XCD_BAR_WORDS 3456
#define XB_SPIN_CAP (1u << 18)
__device__ __forceinline__ unsigned xb_ld(unsigned* p)              { return __hip_atomic_load(p, __ATOMIC_RELAXED, __HIP_MEMORY_SCOPE_AGENT); }
__device__ __forceinline__ unsigned xb_add(unsigned* p, unsigned v) { return __hip_atomic_fetch_add(p, v, __ATOMIC_RELAXED, __HIP_MEMORY_SCOPE_AGENT); }
__device__ __forceinline__ unsigned xb_xcc_id() { return (unsigned)__builtin_amdgcn_s_getreg((3 << 11) | 20) & 0xFu; }
#define XB_SPIN(cond, bar) do { unsigned _sp = 0; while (cond) { __builtin_amdgcn_s_sleep(1); \
    if ((++_sp & 255u) == 0u) { if (xb_ld(&(bar)[XB_TMO])) break; if (_sp > XB_SPIN_CAP) { atomicAdd(&(bar)[XB_TMO], 1u); break; } } } } while (0)
struct XcdBarrier { unsigned* bar; unsigned x; volatile LAS unsigned* st; };
__device__ __forceinline__ XcdBarrier xcd_barrier_post(unsigned* bar, volatile LAS unsigned* st) {
    XcdBarrier b; b.bar = bar; b.x = xb_xcc_id(); b.st = st;
    if (threadIdx.x == 0) (void)xb_add(&bar[XB_XCNT(b.x)], 1u);
    return b;
}
__device__ __forceinline__ void xcd_barrier_complete(unsigned* bar, unsigned x, unsigned& nloc, unsigned& nx) {
    const unsigned G = gridDim.x * gridDim.y * gridDim.z;
    unsigned sum, cnt, mine, sp = 0u;
    for (;;) {
        sum = 0u; cnt = 0u; mine = 0u;
#pragma unroll
        for (unsigned j = 0; j < 16; ++j) { const unsigned c = xb_ld(&bar[XB_XCNT(j)]); sum += c; cnt += (c > 0u) ? 1u : 0u; mine = (j == x) ? c : mine; }
        if (sum == G) break;
        __builtin_amdgcn_s_sleep(1);
        if ((++sp & 255u) == 0u) { if (xb_ld(&bar[XB_TMO])) break; if (sp > XB_SPIN_CAP) { atomicAdd(&bar[XB_TMO], 1u); break; } }
    }
    nloc = mine > 0u ? mine : 1u; nx = cnt > 0u ? cnt : 1u;
}
__device__ __forceinline__ void xcd_barrier(const XcdBarrier& b) {
    asm volatile("s_waitcnt vmcnt(0)" ::: "memory");
    __syncthreads();
    if (threadIdx.x == 0) {
        unsigned* bar = b.bar;
        __builtin_amdgcn_s_waitcnt(0);
        unsigned nloc = b.st[0], nx = b.st[1];
        if (nloc == 0u) { xcd_barrier_complete(bar, b.x, nloc, nx); b.st[0] = nloc; b.st[1] = nx; }
        const unsigned old = xb_add(&bar[XB_XSUB(b.x)], 1u);
        const unsigned gen = old / nloc;
        if (old + 1u == (gen + 1u) * nloc) {
            __builtin_amdgcn_fence(__ATOMIC_RELEASE, "agent");
            asm volatile("s_waitcnt vmcnt(0)" ::: "memory");
            const unsigned og = xb_add(&bar[XB_TOP], 1u);
            const unsigned tg = og / nx;
            if (og + 1u == (tg + 1u) * nx) xb_add(&bar[XB_TOPGEN], 1u);
            else XB_SPIN(xb_ld(&bar[XB_TOPGEN]) == tg, bar);
            __builtin_amdgcn_fence(__ATOMIC_ACQUIRE, "agent");
            xb_add(&bar[XB_XGEN(b.x)], 1u);
            asm volatile("s_waitcnt vmcnt(0)" ::: "memory");
        } else {
            XB_SPIN(xb_ld(&bar[XB_XGEN(b.x)]) == gen, bar);
            __builtin_amdgcn_fence(__ATOMIC_ACQUIRE, "agent");
            asm volatile("s_waitcnt vmcnt(0)" ::: "memory");
        }
    }
    __syncthreads();
}

__device__ __forceinline__ unsigned cvt_pk_bf16(float lo, float hi) { unsigned r; asm volatile("v_cvt_pk_bf16_f32 %0, %1, %2" : "=v"(r) : "v"(lo), "v"(hi)); return r; }
__device__ __forceinline__ unsigned pk4_fp8(float a, float b, float c, float d) { int w = __builtin_amdgcn_cvt_pk_fp8_f32(a, b, 0, false); w = __builtin_amdgcn_cvt_pk_fp8_f32(c, d, w, true); return (unsigned)w; }
__device__ __forceinline__ float bf16_lo(unsigned w) { return __uint_as_float(w << 16); }
__device__ __forceinline__ float bf16_hi(unsigned w) { return __uint_as_float(w & 0xffff0000u); }
template <int CTRL> __device__ __forceinline__ float dpp_f(float v) { return __builtin_bit_cast(float, __builtin_amdgcn_update_dpp(0, __builtin_bit_cast(int, v), CTRL, 0xf, 0xf, true)); }
__device__ __forceinline__ float wave_sum(float v) {
    v += dpp_f<0xB1>(v);
    v += dpp_f<0x4E>(v);
    v += dpp_f<0x141>(v);
    v += dpp_f<0x140>(v);
    const int vi = __builtin_bit_cast(int, v);
    const float r0 = __builtin_bit_cast(float, __builtin_amdgcn_readlane(vi, 0)), r1 = __builtin_bit_cast(float, __builtin_amdgcn_readlane(vi, 16));
    const float r2 = __builtin_bit_cast(float, __builtin_amdgcn_readlane(vi, 32)), r3 = __builtin_bit_cast(float, __builtin_amdgcn_readlane(vi, 48));
    return (r0 + r1) + (r2 + r3);
}
#define LDS_WAIT() asm volatile("s_waitcnt lgkmcnt(0)" ::: "memory")
#define VM_WAIT()  asm volatile("s_waitcnt vmcnt(0)" ::: "memory")
__device__ __forceinline__ int crow(int r, int hi) { return (r & 3) + 8 * (r >> 2) + 4 * hi; }

namespace pg8 {
constexpr int BM = 256, BK = 64, HALF = 128, HTB = HALF * BK * 2, STAGE_BYTES = 8 * HTB, NXCD = 8, WGM = 8, KD = 1024;
__device__ __forceinline__ int lds_byte(int r, int c) { const int st = (r >> 4) * 2 + (c >> 5), rr = r & 15, cc = c & 31, ob = rr * 64 + cc * 2; return st * 1024 + (ob ^ (((ob >> 9) & 1) << 5)); }
__device__ __forceinline__ void stage_rc(int b, int& R, int& C) { const int st = b / 1024, sb = b % 1024, swz = sb ^ (((sb >> 9) & 1) << 5); R = (st >> 1) * 16 + swz / 64; C = (st & 1) * 32 + (swz % 64) / 2; }
__device__ __forceinline__ int perm32(int rho) { const int n = rho >> 4, i = rho & 15; return 8 * (i >> 2) + 4 * n + (i & 3); }

struct Unit { int pm, pn, e, idx; };

__device__ __forceinline__ void order_decode(int wgid, int nM, int nN, int& pm, int& pn) {
    const int nig = WGM * nN, gid = wgid / nig, fm = gid * WGM, gsz = (nM - fm) < WGM ? (nM - fm) : WGM;
    pm = fm + ((wgid % nig) % gsz); pn = (wgid % nig) / gsz;
}
__device__ __forceinline__ bool order_next(int i, int G, int c, int nM, int nN, int& pm, int& pn, int woff = 0) {
    const int nwg = nM * nN - woff; const long L = (long)i * G + c; if (L >= nwg) return false;
    int wgid = (int)L; { const int q = nwg / NXCD, r = nwg % NXCD, xcd = wgid % NXCD, off = wgid / NXCD; wgid = (xcd < r ? xcd * (q + 1) : r * (q + 1) + (xcd - r) * q) + off; }
    order_decode(wgid + woff, nM, nN, pm, pn); return true;
}
struct StaticSched {
    int nM, nN, G, c, t0, toff;
    __device__ __forceinline__ bool next(int i, Unit& u) const { u.idx = i; const bool ok = order_next(i, G, c, nM, nN, u.pm, u.pn); u.e = (u.pn == 0) ? t0 : u.pn + toff; return ok; }
    __device__ __forceinline__ int a_row(const Unit& u, int h, int R) const { return u.pm * BM + h * HALF + R; }
    __device__ __forceinline__ int b_row(const Unit& u) const { return u.e * BM; }
};
template <bool GATHER> struct MoeSched {
    int nM, nN, G, c; int brows;
    const LAS int* tstart; const LAS int* toktab; int woff;
    __device__ __forceinline__ bool next(int i, Unit& u) const {
        u.idx = i;
        if (!order_next(i, G, c, nM, nN, u.pm, u.pn, woff)) return false;
        int e = 0;
#pragma unroll
        for (int k = 1; k < NE; ++k) e += (u.pm >= tstart[k]) ? 1 : 0;
        u.e = e; return true;
    }
    __device__ __forceinline__ int a_row(const Unit& u, int h, int R) const { if constexpr (GATHER) return toktab[u.idx * 256 + h * HALF + R]; else return u.pm * BM + h * HALF + R; }
    __device__ __forceinline__ int b_row(const Unit& u) const { return u.e * brows + u.pn * BM; }
};

typedef int v8i32 __attribute__((ext_vector_type(8)));
typedef int v4i32 __attribute__((ext_vector_type(4)));
__device__ __forceinline__ v8i32 cat8(bf16x8 a, bf16x8 b) { const v4i32 x = __builtin_bit_cast(v4i32, a), y = __builtin_bit_cast(v4i32, b); return __builtin_shufflevector(x, y, 0, 1, 2, 3, 4, 5, 6, 7); }
template <class Epi, class Sched, bool FP8 = false, int SW = 0x7f7f7f7f, int SA = 0x7f7f7f7f>
__device__ __forceinline__ void gemm_phase(LAS unsigned char* lds, const char* Abase, const char* Bbase, const Sched& S, const Epi& E) {
    const int tid = threadIdx.x, wid = __builtin_amdgcn_readfirstlane(tid >> 6), lane = tid & 63, wr = wid >> 2, wc = wid & 3, fr = lane & 15, fq = lane >> 4;
    constexpr int ROWB = FP8 ? KD : 2 * KD, nt = ROWB / 128;
    int RA[2], CA[2]; unsigned voffB[2];
#pragma unroll
    for (int i = 0; i < 2; ++i) { int R, C; stage_rc(tid * 16 + i * 8192, R, C); const int Rb = Epi::PERM ? ((R & ~31) + perm32(R & 31)) : R;
        RA[i] = R; CA[i] = C * 2; voffB[i] = (unsigned)(Rb * ROWB + C * 2); }
    const size_t kstep = (size_t)(BK * 2);
    const size_t hstep = (size_t)HALF * ROWB;
    const unsigned ldsw = (unsigned)wid * 1024u;
    const int aoff = lds_byte(wr * 64 + fr, fq * 8), boff = lds_byte(wc * 32 + fr, fq * 8);
#define PG8_SA(b, h) (((b) * 2 + (h)) * HTB)
#define PG8_SB(b, h) ((4 + (b) * 2 + (h)) * HTB)
#define PG8_STAGE(bufoff, gbase, voff) do { _Pragma("unroll") for (int _i = 0; _i < 2; ++_i) \
        __builtin_amdgcn_global_load_lds((const unsigned*)((const char*)(gbase) + (voff)[_i]), (LAS unsigned*)(lds + (bufoff) + ldsw + _i * 8192), 16, 0, 0); } while (0)
#define PG8_LDA(dst, b, h) do { _Pragma("unroll") for (int m = 0; m < 4; ++m) _Pragma("unroll") for (int k = 0; k < 2; ++k) dst[m][k] = *(const LAS bf16x8*)(lds + PG8_SA(b, h) + aoff + m * 2048 + k * 1024); } while (0)
#define PG8_LDB(dst, b, h) do { _Pragma("unroll") for (int n = 0; n < 2; ++n) _Pragma("unroll") for (int k = 0; k < 2; ++k) dst[n][k] = *(const LAS bf16x8*)(lds + PG8_SB(b, h) + boff + n * 2048 + k * 1024); } while (0)
#define PG8_MMA(ai, bj, At, Bt) do { __builtin_amdgcn_s_setprio(1); if constexpr (FP8) { _Pragma("unroll") for (int m = 0; m < 4; ++m) _Pragma("unroll") for (int n = 0; n < 2; ++n) \
        acc[ai][bj][m][n] = __builtin_amdgcn_mfma_scale_f32_16x16x128_f8f6f4(cat8(Bt[n][0], Bt[n][1]), cat8(At[m][0], At[m][1]), acc[ai][bj][m][n], 0, 0, 0, SW, 0, SA); } \
        else { _Pragma("unroll") for (int m = 0; m < 4; ++m) _Pragma("unroll") for (int n = 0; n < 2; ++n) _Pragma("unroll") for (int k = 0; k < 2; ++k) \
        acc[ai][bj][m][n] = __builtin_amdgcn_mfma_f32_16x16x32_bf16(Bt[n][k], At[m][k], acc[ai][bj][m][n], 0, 0, 0); } __builtin_amdgcn_s_setprio(0); } while (0)
#define PG8_WAIT_V(n) asm volatile("s_waitcnt vmcnt(" #n ")" ::: "memory")
#define PG8_WAIT_L(n) asm volatile("s_waitcnt lgkmcnt(" #n ")" ::: "memory")
#define PG8_BAR __builtin_amdgcn_s_barrier()
#define PG8_SCHED __builtin_amdgcn_sched_barrier(0)
    Unit cur, nxt; int ui = 0;
    if (!S.next(0, cur)) return;
    f32x4 acc[2][2][4][2]; f32x4 bini[2][2];
#pragma unroll
    for (int b = 0; b < 2; ++b)
#pragma unroll
        for (int n = 0; n < 2; ++n) bini[b][n] = Epi::BIAS_INIT ? E.bias4(cur, b, n, wc, fq) : (f32x4){0.f, 0.f, 0.f, 0.f};
#pragma unroll
    for (int a = 0; a < 2; ++a)
#pragma unroll
        for (int b = 0; b < 2; ++b)
#pragma unroll
            for (int m = 0; m < 4; ++m)
#pragma unroll
                for (int n = 0; n < 2; ++n) acc[a][b][m][n] = bini[b][n];
    bf16x8 At[4][2], B0[2][2], B1[2][2];
    unsigned oA[2][2];
#pragma unroll
    for (int h = 0; h < 2; ++h)
#pragma unroll
        for (int i = 0; i < 2; ++i) oA[h][i] = (unsigned)(S.a_row(cur, h, RA[i]) * ROWB + CA[i]);
    const char* cB = Bbase + (size_t)S.b_row(cur) * ROWB;
    const char* cA = Abase;
    PG8_STAGE(PG8_SB(0, 0), cB, voffB); PG8_STAGE(PG8_SA(0, 0), cA, oA[0]); PG8_STAGE(PG8_SB(0, 1), cB + hstep, voffB); PG8_STAGE(PG8_SA(0, 1), cA, oA[1]);
    if (wr == 1) PG8_BAR;
    PG8_WAIT_V(4); PG8_BAR;
    PG8_STAGE(PG8_SB(1, 0), cB + kstep, voffB); PG8_STAGE(PG8_SA(1, 0), cA + kstep, oA[0]); PG8_STAGE(PG8_SB(1, 1), cB + hstep + kstep, voffB);
    PG8_WAIT_V(6); PG8_BAR;
    for (;;) {
        const bool has_next = S.next(ui + 1, nxt);
        const char* nB = has_next ? Bbase + (size_t)S.b_row(nxt) * ROWB : cB;
        for (int t = 0; t < nt; t += 2) {
            const bool last = (t == nt - 2);
            const char* a1 = cA + (size_t)(t + 1) * kstep;
            const char* a2 = last ? cA : cA + (size_t)(t + 2) * kstep; const char* b2 = last ? nB : cB + (size_t)(t + 2) * kstep;
            const char* a3 = a2 + kstep; const char* b3 = b2 + kstep;
            PG8_LDB(B0, 0, 0); PG8_SCHED; PG8_LDA(At, 0, 0); PG8_STAGE(PG8_SA(1, 1), a1, oA[1]);
            if (last && has_next) {
#pragma unroll
                for (int h = 0; h < 2; ++h)
#pragma unroll
                    for (int i = 0; i < 2; ++i) oA[h][i] = (unsigned)(S.a_row(nxt, h, RA[i]) * ROWB + CA[i]);
            }
            PG8_WAIT_L(8); PG8_BAR; PG8_WAIT_L(0); PG8_MMA(0, 0, At, B0); PG8_BAR; PG8_SCHED;
            PG8_LDB(B1, 0, 1); PG8_STAGE(PG8_SB(0, 0), b2, voffB);
            PG8_BAR; PG8_WAIT_L(0); PG8_MMA(0, 1, At, B1); PG8_BAR;
            PG8_LDA(At, 0, 1); PG8_STAGE(PG8_SA(0, 0), a2, oA[0]);
            PG8_BAR; PG8_WAIT_L(0); PG8_MMA(1, 0, At, B0); PG8_BAR; PG8_SCHED;
            PG8_STAGE(PG8_SB(0, 1), b2 + hstep, voffB);
            PG8_WAIT_V(6); PG8_BAR; PG8_MMA(1, 1, At, B1); PG8_BAR;
            PG8_LDB(B0, 1, 0); PG8_SCHED; PG8_LDA(At, 1, 0); PG8_STAGE(PG8_SA(0, 1), a2, oA[1]);
            PG8_WAIT_L(8); PG8_BAR; PG8_WAIT_L(0); PG8_MMA(0, 0, At, B0); PG8_BAR; PG8_SCHED;
            PG8_LDB(B1, 1, 1); PG8_STAGE(PG8_SB(1, 0), b3, voffB);
            PG8_BAR; PG8_WAIT_L(0); PG8_MMA(0, 1, At, B1); PG8_BAR;
            PG8_LDA(At, 1, 1); PG8_STAGE(PG8_SA(1, 0), a3, oA[0]);
            PG8_BAR; PG8_WAIT_L(0); PG8_MMA(1, 0, At, B0); PG8_BAR; PG8_SCHED;
            PG8_STAGE(PG8_SB(1, 1), b3 + hstep, voffB);
            PG8_WAIT_V(6); PG8_BAR; PG8_MMA(1, 1, At, B1); PG8_BAR;
        }
        int l2 = threadIdx.x & 63; asm volatile("" : "+v"(l2));
        const int fr2 = l2 & 15, fq2 = l2 >> 4;
        if (Epi::BIAS_INIT && has_next) {
#pragma unroll
            for (int b = 0; b < 2; ++b)
#pragma unroll
                for (int n = 0; n < 2; ++n) bini[b][n] = E.bias4(nxt, b, n, wc, fq2);
        }
        E(acc, cur, wr, wc, fr2, fq2);
        if (!has_next) break;
#pragma unroll
        for (int a = 0; a < 2; ++a)
#pragma unroll
            for (int b = 0; b < 2; ++b)
#pragma unroll
                for (int m = 0; m < 4; ++m)
#pragma unroll
                    for (int n = 0; n < 2; ++n) acc[a][b][m][n] = bini[b][n];
        cur = nxt; cB = nB; ++ui;
    }
    PG8_WAIT_V(0);
    if (wr == 0) PG8_BAR;
    PG8_BAR;
#undef PG8_SA
#undef PG8_SB
#undef PG8_STAGE
#undef PG8_LDA
#undef PG8_LDB
#undef PG8_MMA
#undef PG8_WAIT_V
#undef PG8_WAIT_L
#undef PG8_BAR
#undef PG8_SCHED
}
}

struct EpiInProj {
    static constexpr bool PERM = true, BIAS_INIT = false;
    bf16_t *u, *q, *k, *v, *iq, *ik; float* iw; const float* ropeQK; const float* ropeIX;
    __device__ __forceinline__ f32x4 bias4(const pg8::Unit&, int, int, int, int) const { return (f32x4){0.f, 0.f, 0.f, 0.f}; }
    __device__ __forceinline__ void operator()(f32x4 (&acc)[2][2][4][2], const pg8::Unit& un, int wr, int wc, int fr, int fq) const {
        const int lane = threadIdx.x & 63;
#pragma unroll
        for (int bj = 0; bj < 2; ++bj) {
            const int gc = un.e * 256 + bj * 128;
            bf16_t* dst; int ld; int kind = 0;
            const int cin = wc * 32 + 8 * fq;
            if (gc < 256) { dst = u + gc + cin; ld = 256; }
            else if (gc < 1024) { dst = q + (gc - 256) + cin; ld = 768; kind = (wc == 0) ? 1 : 0; }
            else if (gc < 1280) { dst = k + (gc - 1024) + cin; ld = 256; kind = (wc == 0) ? 1 : 0; }
            else if (gc < 1536) { dst = v + (gc - 1280) + cin; ld = 256; }
            else if (gc < 2048) { dst = iq + (gc - 1536) + cin; ld = 512; kind = ((wc & 1) == 0) ? 2 : 0; }
            else if (gc == 2048) { if (wc >= 2) { if (wc == 2 && fq == 0) {
#pragma unroll
                        for (int ai = 0; ai < 2; ++ai)
#pragma unroll
                            for (int m = 0; m < 4; ++m) { const int row = un.pm * 256 + ai * 128 + wr * 64 + m * 16 + fr;
                                *(f32x4*)(iw + (size_t)row * 8) = acc[ai][bj][m][0]; *(f32x4*)(iw + (size_t)row * 8 + 4) = acc[ai][bj][m][1]; } }
                    continue; }
                dst = ik + cin; ld = 64; kind = (wc == 0) ? 2 : 0; }
            else continue;
#pragma unroll
            for (int ai = 0; ai < 2; ++ai)
#pragma unroll
                for (int m = 0; m < 4; ++m) {
                    const int row = un.pm * 256 + ai * 128 + wr * 64 + m * 16 + fr;
                    f32x4 v0 = acc[ai][bj][m][0], v1 = acc[ai][bj][m][1];
                    if (kind == 1) {
                        const float* rp = ropeQK + (size_t)row * 32 + 8 * (fq & 1);
                        const f32x4 c0 = *(const f32x4*)rp, c1 = *(const f32x4*)(rp + 4), s0 = *(const f32x4*)(rp + 16), s1 = *(const f32x4*)(rp + 20);
                        f32x4 p0, p1;
#pragma unroll
                        for (int j = 0; j < 4; ++j) { p0[j] = __shfl_xor(v0[j], 32); p1[j] = __shfl_xor(v1[j], 32); }
                        const float sg = (fq < 2) ? -1.f : 1.f;
                        v0 = v0 * c0 + sg * (p0 * s0); v1 = v1 * c1 + sg * (p1 * s1);
                    } else if (kind == 2) {
                        const float* rp = ropeIX + (size_t)row * 16;
                        const f32x4 c0 = *(const f32x4*)rp, c1 = *(const f32x4*)(rp + 4), s0 = *(const f32x4*)(rp + 8), s1 = *(const f32x4*)(rp + 12);
                        f32x4 p0, p1;
#pragma unroll
                        for (int j = 0; j < 4; ++j) { p0[j] = __shfl_xor(v0[j], 16); p1[j] = __shfl_xor(v1[j], 16); }
                        if (fq < 2) { const float sg = (fq == 0) ? -1.f : 1.f; v0 = v0 * c0 + sg * (p0 * s0); v1 = v1 * c1 + sg * (p1 * s1); }
                    }
                    u32x4 w; w.x = cvt_pk_bf16(v0[0], v0[1]); w.y = cvt_pk_bf16(v0[2], v0[3]); w.z = cvt_pk_bf16(v1[0], v1[1]); w.w = cvt_pk_bf16(v1[2], v1[3]);
                    *(u32x4*)(dst + (size_t)row * ld) = w;
                }
        }
        (void)lane;
    }
};
struct EpiMix {
    static constexpr bool PERM = true, BIAS_INIT = false;
    bf16_t* mix;
    __device__ __forceinline__ f32x4 bias4(const pg8::Unit&, int, int, int, int) const { return (f32x4){0.f, 0.f, 0.f, 0.f}; }
    __device__ __forceinline__ void operator()(f32x4 (&acc)[2][2][4][2], const pg8::Unit& un, int wr, int wc, int fr, int fq) const {
        const int row0 = un.pm * 256 + wr * 64 + fr, col0 = un.pn * 256 + wc * 32 + 8 * fq;
#pragma unroll
        for (int bj = 0; bj < 2; ++bj)
#pragma unroll
            for (int ai = 0; ai < 2; ++ai)
#pragma unroll
                for (int m = 0; m < 4; ++m) {
                    const f32x4 v0 = acc[ai][bj][m][0], v1 = acc[ai][bj][m][1];
                    u32x4 w; w.x = cvt_pk_bf16(v0[0], v0[1]); w.y = cvt_pk_bf16(v0[2], v0[3]); w.z = cvt_pk_bf16(v1[0], v1[1]); w.w = cvt_pk_bf16(v1[2], v1[3]);
                    *(u32x4*)(mix + (size_t)(row0 + ai * 128 + m * 16) * 1024 + col0 + bj * 128) = w;
                }
    }
};
struct EpiGateUp {
    static constexpr bool PERM = true, BIAS_INIT = true;
    unsigned char* act; const float* bias; unsigned* rdy;
    __device__ __forceinline__ f32x4 bias4(const pg8::Unit& un, int bj, int n, int wc, int fq) const { return *(const f32x4*)(bias + (size_t)un.e * 2048 + bj * 1024 + un.pn * 128 + wc * 32 + 8 * fq + 4 * n); }
    __device__ __forceinline__ void operator()(f32x4 (&acc)[2][2][4][2], const pg8::Unit& un, int wr, int wc, int fr, int fq) const {
        const int row0 = un.pm * 256 + wr * 64 + fr, col0 = un.pn * 128 + wc * 32 + 8 * fq;
#pragma unroll
        for (int ai = 0; ai < 2; ++ai)
#pragma unroll
            for (int m = 0; m < 4; ++m) {
                float o[8];
#pragma unroll
                for (int n = 0; n < 2; ++n) {
                    const f32x4 gt = acc[ai][0][m][n], up = acc[ai][1][m][n];
#pragma unroll
                    for (int j = 0; j < 4; ++j) {
                        const float gg = fminf(gt[j], 7.0f), uu = fminf(fmaxf(up[j], -7.0f), 7.0f);
                        const float sig = __builtin_amdgcn_rcpf(1.0f + __builtin_amdgcn_exp2f(-1.702f * 1.4426950408889634f * gg));
                        o[4 * n + j] = (uu * 8.0f + 8.0f) * gg * sig;
                    }
                }
                u32x2 w; w.x = pk4_fp8(o[0], o[1], o[2], o[3]); w.y = pk4_fp8(o[4], o[5], o[6], o[7]);
                const unsigned dofs = (unsigned)((row0 + ai * 128 + m * 16) * 1024 + col0);
                if (un.pm < 32) asm volatile("global_store_dwordx2 %0, %1, %2 sc1" :: "v"(dofs), "v"(w), "s"(act) : "memory");
                else *(u32x2*)(act + dofs) = w;
            }
        if (un.pm < 32) {
            asm volatile("s_waitcnt vmcnt(0)" ::: "memory");
            if ((threadIdx.x & 63) == 0) __hip_atomic_fetch_add(rdy + un.pm, 1u, __ATOMIC_RELAXED, __HIP_MEMORY_SCOPE_AGENT);
        }
    }
};
struct EpiDown {
    static constexpr bool PERM = true, BIAS_INIT = false;
    unsigned char* y; const float* bias;
    __device__ __forceinline__ f32x4 bias4(const pg8::Unit& un, int bj, int n, int wc, int fq) const { return *(const f32x4*)(bias + (size_t)un.e * 1024 + un.pn * 256 + bj * 128 + wc * 32 + 8 * fq + 4 * n); }
    __device__ __forceinline__ void operator()(f32x4 (&acc)[2][2][4][2], const pg8::Unit& un, int wr, int wc, int fr, int fq) const {
        const int row0 = un.pm * 256 + wr * 64 + fr, col0 = un.pn * 256 + wc * 32 + 8 * fq;
        const float* bp = bias + (size_t)un.e * 1024 + col0;
#pragma unroll
        for (int bj = 0; bj < 2; ++bj) {
            const f32x4 b0 = *(const f32x4*)(bp + bj * 128) * 64.0f, b1 = *(const f32x4*)(bp + bj * 128 + 4) * 64.0f;
#pragma unroll
            for (int ai = 0; ai < 2; ++ai)
#pragma unroll
                for (int m = 0; m < 4; ++m) {
                    const f32x4 v0 = acc[ai][bj][m][0] * 64.0f + b0, v1 = acc[ai][bj][m][1] * 64.0f + b1;
#define CL8(x) __builtin_amdgcn_fmed3f((x), -448.f, 448.f)
                    u32x2 w; w.x = pk4_fp8(CL8(v0[0]), CL8(v0[1]), CL8(v0[2]), CL8(v0[3])); w.y = pk4_fp8(CL8(v1[0]), CL8(v1[1]), CL8(v1[2]), CL8(v1[3]));
#undef CL8
                    *(u32x2*)(y + (size_t)(row0 + ai * 128 + m * 16) * 1024 + col0 + bj * 128) = w;
                }
        }
    }
};

struct Args { const void* in[18]; float* out; unsigned char* ws; int ph_lo, ph_hi; };
struct Frame {
    LAS unsigned char* lds; int tid, lane, wave, G, bid;
    const float *x, *ln_in_g, *ln_in_b, *w_in, *w_pool, *pool_scale, *w_out, *ln1_g, *ln1_b, *w_router, *b_router, *w_gu, *b_gu, *w_dn, *b_dn, *ln2_g, *ln2_b;
    const int* positions; float* out; unsigned char* ws; unsigned* ctl;
};

typedef const Args __attribute__((address_space(4))) * KArgP;
__device__ __forceinline__ void frame_refresh(Frame& F) {
    KArgP ap = (KArgP)__builtin_amdgcn_kernarg_segment_ptr(); asm volatile("" : "+s"(ap));
    int t_ = threadIdx.x; asm volatile("" : "+v"(t_)); F.tid = t_; F.lane = t_ & 63;
    F.x = (const float*)ap->in[0]; F.positions = (const int*)ap->in[1]; F.ln_in_g = (const float*)ap->in[2]; F.ln_in_b = (const float*)ap->in[3];
    F.w_in = (const float*)ap->in[4]; F.w_pool = (const float*)ap->in[5]; F.pool_scale = (const float*)ap->in[6]; F.w_out = (const float*)ap->in[7];
    F.ln1_g = (const float*)ap->in[8]; F.ln1_b = (const float*)ap->in[9]; F.w_router = (const float*)ap->in[10]; F.b_router = (const float*)ap->in[11];
    F.w_gu = (const float*)ap->in[12]; F.b_gu = (const float*)ap->in[13]; F.w_dn = (const float*)ap->in[14]; F.b_dn = (const float*)ap->in[15];
    F.ln2_g = (const float*)ap->in[16]; F.ln2_b = (const float*)ap->in[17];
    F.out = ap->out; F.ws = ap->ws; F.ctl = (unsigned*)(ap->ws + WS_CTL);
}
struct TrItem { const float* src; unsigned char* dst; int ldw, ldt, fp8; };
__device__ __forceinline__ TrItem mk_item(const float* W, unsigned char* WT, int ldw, int k0, int n0, int ldt, int drow0, int fp8) {
    TrItem t; t.src = W + (size_t)k0 * ldw + n0; t.dst = WT + ((size_t)drow0 * ldt + k0) * (fp8 ? 1 : 2); t.ldw = ldw; t.ldt = ldt; t.fp8 = fp8; return t;
}
__device__ __forceinline__ void tr_load(const TrItem& t, float (&tmp)[32], int lane) {
    const float* p = t.src + (size_t)(lane >> 5) * t.ldw + (lane & 31);
#pragma unroll
    for (int i = 0; i < 32; ++i) tmp[i] = __builtin_nontemporal_load(p + (size_t)(2 * i) * t.ldw);
}
__device__ __forceinline__ void tr_store(const TrItem& t, const float (&tmp)[32], LAS float* scr, int lane) {
#pragma unroll
    for (int i = 0; i < 32; ++i) { const int kk = 2 * i + (lane >> 5); scr[kk * 33 + (lane & 31)] = tmp[i]; }
    LDS_WAIT();
    if (t.fp8) {
        const int n = lane >> 1, kb = 32 * (lane & 1); const LAS float* sp = scr + kb * 33 + n;
        unsigned o[8];
#pragma unroll
        for (int q = 0; q < 8; ++q) { float v[4];
#pragma unroll
            for (int j = 0; j < 4; ++j) v[j] = __builtin_amdgcn_fmed3f(sp[(4 * q + j) * 33] * 64.0f, -448.f, 448.f);
            o[q] = pk4_fp8(v[0], v[1], v[2], v[3]); }
        unsigned char* dp = t.dst + (size_t)n * 1024 + kb;
        *(u32x4*)dp = (u32x4){o[0], o[1], o[2], o[3]}; *(u32x4*)(dp + 16) = (u32x4){o[4], o[5], o[6], o[7]};
    } else {
        const int c = lane & 7;
#pragma unroll
        for (int j = 0; j < 4; ++j) { const int n = (lane >> 3) + 8 * j; const LAS float* sp = scr + (8 * c) * 33 + n;
            u32x4 o; o.x = cvt_pk_bf16(sp[0 * 33], sp[1 * 33]); o.y = cvt_pk_bf16(sp[2 * 33], sp[3 * 33]); o.z = cvt_pk_bf16(sp[4 * 33], sp[5 * 33]); o.w = cvt_pk_bf16(sp[6 * 33], sp[7 * 33]);
            *(u32x4*)(t.dst + ((size_t)n * t.ldt + 8 * c) * 2) = o; }
    }
    LDS_WAIT();
}
__device__ __forceinline__ TrItem moe_item(Frame& F, int r) {
    constexpr int I_GU = NE * 16 * 64;
    if (r < I_GU) { const int e = r / 1024, rr = r % 1024, kb = rr / 64, nb = rr % 64, n0 = 32 * nb, bj = n0 / 1024, rem = n0 % 1024, pn = rem / 128, j0 = rem % 128;
        return mk_item(F.w_gu + (size_t)e * 1024 * 2048, F.ws + WS_BTGU + (size_t)e * 2048 * 1024, 2048, 64 * kb, n0, 1024, pn * 256 + bj * 128 + j0, 1); }
    r -= I_GU; const int e = r / 512, rr = r % 512, kb = rr / 32, nb = rr % 32;
    return mk_item(F.w_dn + (size_t)e * 1024 * 1024, F.ws + WS_BTDN + (size_t)e * 1024 * 1024, 1024, 64 * kb, 32 * nb, 1024, 32 * nb, 1);
}
__device__ __forceinline__ void convert_range(Frame& F, int first, int n, int widx, int nw) {
    LAS float* scr = (LAS float*)(F.lds + F.wave * 16384);
    int base = 2 * widx; if (base >= n) return;
    float va[32], vb[32], vc[32], vd[32];
    TrItem ta = moe_item(F, first + base), tb = moe_item(F, first + base + 1);
    tr_load(ta, va, F.lane); tr_load(tb, vb, F.lane);
    for (;;) {
        const int nb = base + 2 * nw; const bool more = nb < n;
        const TrItem tc = moe_item(F, first + (more ? nb : base)), td = moe_item(F, first + (more ? nb : base) + 1);
        if (more) { tr_load(tc, vc, F.lane); tr_load(td, vd, F.lane); }
        tr_store(ta, va, scr, F.lane); tr_store(tb, vb, scr, F.lane);
        if (!more) break;
        const int nb2 = nb + 2 * nw; const bool more2 = nb2 < n;
        ta = moe_item(F, first + (more2 ? nb2 : nb)); tb = moe_item(F, first + (more2 ? nb2 : nb) + 1);
        if (more2) { tr_load(ta, va, F.lane); tr_load(tb, vb, F.lane); }
        tr_store(tc, vc, scr, F.lane); tr_store(td, vd, scr, F.lane);
        if (!more2) break;
        base = nb2;
    }
}
__device__ __forceinline__ void cvq_pull(Frame& F, unsigned* head, int first, int npairs) {
    LAS float* scr = (LAS float*)(F.lds + F.wave * 16384);
    for (;;) {
        unsigned c = 0; if (F.lane == 0) c = __hip_atomic_fetch_add(head, 1u, __ATOMIC_RELAXED, __HIP_MEMORY_SCOPE_AGENT);
        c = (unsigned)__builtin_amdgcn_readfirstlane((int)c);
        if (c >= (unsigned)npairs) break;
        const int r = 2 * (first + (int)c);
        const TrItem ta = moe_item(F, r), tb = moe_item(F, r + 1);
        float va[32], vb[32];
        tr_load(ta, va, F.lane); tr_load(tb, vb, F.lane);
        tr_store(ta, va, scr, F.lane); tr_store(tb, vb, scr, F.lane);
    }
}
__constant__ double ROPE_QK_FREQ[16] = {1.0, 0.44036660267178046, 0.19392274474868576, 0.08539710028576561, 0.03760603093086393, 0.016560440080994446, 0.007292664737217109, 0.003211445994752591,
    0.001414213562373095, 0.000622772421914596, 0.0002742481756762073, 0.00012076973741146504, 5.318295896944988e-05, 2.341999896140934e-05, 1.031338537721246e-05, 4.5416704806078695e-06};
__constant__ double ROPE_IX_FREQ[8] = {1.0, 0.19392274474868576, 0.03760603093086393, 0.007292664737217109, 0.001414213562373095, 0.0002742481756762073, 5.318295896944988e-05, 1.031338537721246e-05};

__device__ __forceinline__ void p0_prologue(Frame& F) {
    LAS float* scr = (LAS float*)(F.lds + F.wave * 16384);
    const int gw = F.bid * 8 + F.wave, NGW = F.G * 8;
    const int gt = F.bid * NTHREADS + F.tid, NGT = F.G * NTHREADS;
    bf16_t* BtIn = (bf16_t*)(F.ws + WS_BTIN); bf16_t* BtOut = (bf16_t*)(F.ws + WS_BTOUT);
    bf16_t* WpT = (bf16_t*)(F.ws + WS_WPT);
    constexpr int I_IN = 16 * 66, I_OUT = 16 * 32, I_POOL = 8, I_MOE = NE * 16 * 64 + NE * 16 * 32;
    constexpr int NSMALL = I_IN + I_OUT + I_POOL, NITEMS = NSMALL + (I_MOE - CV_HIDDEN);
    auto decode = [&](int it) -> TrItem {
        int r = it;
        if (r < I_IN) { const int kb = r / 66, nb = r % 66;
            if (nb >= 8 && nb < 48) return mk_item(F.w_in, F.ws + WS_BTIN8, INW, 64 * kb, 32 * nb, 1024, 32 * nb, 1);
            return mk_item(F.w_in, (unsigned char*)BtIn, INW, 64 * kb, 32 * nb, 1024, 32 * nb, 0); } r -= I_IN;
        if (r < I_OUT) { const int kb = r / 32, nb = r % 32; return mk_item(F.w_out, (unsigned char*)BtOut, 1024, 64 * kb, 32 * nb, 1024, 32 * nb, 0); } r -= I_OUT;
        if (r < I_POOL) { const int g = r / 2, nb = r % 2; return mk_item(F.w_pool + g * 4096, (unsigned char*)(WpT + g * 4096), 64, 0, 32 * nb, 64, 32 * nb, 0); } r -= I_POOL;
        return moe_item(F, CV_HIDDEN + r);
    };
    for (int it = gw; it < NITEMS; it += 2 * NGW) {
        const bool two = (it + NGW < NITEMS);
        const TrItem ta = decode(it), tb = decode(two ? it + NGW : it);
        float va[32], vb[32];
        tr_load(ta, va, F.lane); if (two) tr_load(tb, vb, F.lane);
        tr_store(ta, va, scr, F.lane); if (two) tr_store(tb, vb, scr, F.lane);
    }
    for (int i = gt; i < 192 * 1024; i += NGT) { const int n = 2112 + i / 1024, k = i % 1024; const float v = (n < INW) ? F.w_in[(size_t)k * INW + n] : 0.f;
        BtIn[(size_t)n * 1024 + k] = (bf16_t)(cvt_pk_bf16(v, 0.f) & 0xffffu); }
    { float* wrA = (float*)(F.ws + WS_WRA);
      for (int i = gt; i < 32768; i += NGT) { const int ii = i & 3, e = (i >> 2) & 31, kh = (i >> 7) & 1, c = i >> 8; wrA[i] = F.w_router[(8 * c + 4 * kh + ii) * 32 + e]; } }
    { float* rq = (float*)(F.ws + WS_ROPEQK); float* ri = (float*)(F.ws + WS_ROPEIX);
      for (int i = gt; i < T * 24; i += NGT) { const int tok = i / 24, j = i % 24; const double pos = (double)F.positions[tok];
          const double inv = (j < 16) ? ROPE_QK_FREQ[j] : ROPE_IX_FREQ[j - 16];
          double rev = pos * inv * 0.15915494309189535; rev -= __builtin_floor(rev);
          const float c = __builtin_amdgcn_cosf((float)rev), s = __builtin_amdgcn_sinf((float)rev);
          if (j < 16) { rq[(size_t)tok * 32 + j] = c; rq[(size_t)tok * 32 + 16 + j] = s; } else { ri[(size_t)tok * 16 + (j - 16)] = c; ri[(size_t)tok * 16 + 8 + (j - 16)] = s; } } }
    if (F.bid == 0 && F.tid < 64) { F.ctl[CW_CNT + F.tid] = 0u; if (F.tid == 0) F.ctl[CW_ATTQ] = 0u; }
    { bf16_t* hA = (bf16_t*)(F.ws + WS_HA); float* stats = (float*)(F.ws + WS_STATS);
      f32x4 gv[4], bv[4];
#pragma unroll
      for (int j = 0; j < 4; ++j) { gv[j] = ((const f32x4*)F.ln_in_g)[F.lane + 64 * j]; bv[j] = ((const f32x4*)F.ln_in_b)[F.lane + 64 * j]; }
      f32x4 nx[4];
      if (gw < T) { const f32x4* xr = (const f32x4*)(F.x + (size_t)gw * 1024) + F.lane;
#pragma unroll
          for (int j = 0; j < 4; ++j) nx[j] = __builtin_nontemporal_load(xr + 64 * j); }
      for (int m = gw; m < T; m += NGW) {
          f32x4 v[4]; float s = 0.f;
#pragma unroll
          for (int j = 0; j < 4; ++j) { v[j] = nx[j]; s += (v[j].x + v[j].y) + (v[j].z + v[j].w); }
          if (m + NGW < T) { const f32x4* xr = (const f32x4*)(F.x + (size_t)(m + NGW) * 1024) + F.lane;
#pragma unroll
              for (int j = 0; j < 4; ++j) nx[j] = __builtin_nontemporal_load(xr + 64 * j); }
          const float mean = wave_sum(s) * (1.f / 1024.f); float s2 = 0.f;
#pragma unroll
          for (int j = 0; j < 4; ++j) { v[j] = v[j] - mean; s2 += (v[j].x * v[j].x + v[j].y * v[j].y) + (v[j].z * v[j].z + v[j].w * v[j].w); }
          const float rstd = 1.f / sqrtf(wave_sum(s2) * (1.f / 1024.f) + LN_EPS);
          u32x2* o8 = (u32x2*)(hA + (size_t)m * 1024) + F.lane; unsigned* q8 = (unsigned*)(F.ws + WS_HA8 + (size_t)m * 1024) + F.lane;
#pragma unroll
          for (int j = 0; j < 4; ++j) { const f32x4 h = v[j] * rstd * gv[j] + bv[j]; u32x2 w; w.x = cvt_pk_bf16(h.x, h.y); w.y = cvt_pk_bf16(h.z, h.w); o8[64 * j] = w; q8[64 * j] = pk4_fp8(h.x, h.y, h.z, h.w); }
          if (F.lane == 0) { stats[(size_t)m * 2] = mean; stats[(size_t)m * 2 + 1] = rstd; }
      } }
}

__device__ __forceinline__ void p2_pool(Frame& F) {
    const bf16_t* U = (const bf16_t*)(F.ws + WS_U); const bf16_t* WpT = (const bf16_t*)(F.ws + WS_WPT); bf16_t* cat = (bf16_t*)(F.ws + WS_CAT);
    LAS bf16_t* dl = (LAS bf16_t*)F.lds;
    LAS bf16_t* ul = (LAS bf16_t*)(F.lds + 33792);
    for (int tile = F.bid; tile < T / 64; tile += F.G) {
        const int t0 = tile * 64, pos0 = t0 % SEQ;
        __syncthreads();
        for (int i = F.tid; i < 79 * 32; i += NTHREADS) { const int r = i >> 5, c8 = i & 31; u32x4 v = {0u, 0u, 0u, 0u};
            if (pos0 + r - 15 >= 0) v = *(const u32x4*)(U + (size_t)(t0 + r - 15) * 256 + c8 * 8);
            *(LAS u32x4*)(ul + r * 256 + c8 * 8) = v; }
        __syncthreads();
        { const int c = F.tid & 255, half = F.tid >> 8, w = 2 << (c >> 6);
          const int ts = half * 32; float sum = 0.f;
          for (int d = 1; d < w; ++d) sum += __uint_as_float((unsigned)ul[(15 + ts - d) * 256 + c] << 16);
#pragma unroll 4
          for (int tt = 0; tt < 32; ++tt) { const int tl = ts + tt, p = pos0 + tl; const float cur = __uint_as_float((unsigned)ul[(15 + tl) * 256 + c] << 16);
              sum += cur; const int cnt = (p + 1 < w) ? (p + 1) : w;
              const float diff = sum / (float)cnt - cur;
              dl[tl * 264 + c] = (bf16_t)(cvt_pk_bf16(diff, 0.f) & 0xffffu);
              sum -= __uint_as_float((unsigned)ul[(15 + tl - (w - 1)) * 256 + c] << 16); } }
        __syncthreads();
        { const int g = F.wave & 3, th = F.wave >> 2, r32 = F.lane & 31, hi = F.lane >> 5;
          f32x16 c0 = {}, c1 = {};
#pragma unroll
          for (int s = 0; s < 4; ++s) {
              const bf16x8 a = *(const LAS bf16x8*)(dl + (th * 32 + r32) * 264 + g * 64 + 16 * s + 8 * hi);
              const bf16x8 b0 = *(const bf16x8*)(WpT + (size_t)g * 4096 + (size_t)r32 * 64 + 16 * s + 8 * hi);
              const bf16x8 b1 = *(const bf16x8*)(WpT + (size_t)g * 4096 + (size_t)(32 + r32) * 64 + 16 * s + 8 * hi);
              c0 = __builtin_amdgcn_mfma_f32_32x32x16_bf16(a, b0, c0, 0, 0, 0);
              c1 = __builtin_amdgcn_mfma_f32_32x32x16_bf16(a, b1, c1, 0, 0, 0); }
          const float ps0 = F.pool_scale[g * 64 + r32], ps1 = F.pool_scale[g * 64 + 32 + r32];
#pragma unroll
          for (int r = 0; r < 16; ++r) { const int tok = t0 + th * 32 + crow(r, hi);
              cat[(size_t)tok * 1024 + g * 64 + r32] = (bf16_t)(cvt_pk_bf16(c0[r] * ps0, 0.f) & 0xffffu);
              cat[(size_t)tok * 1024 + g * 64 + 32 + r32] = (bf16_t)(cvt_pk_bf16(c1[r] * ps1, 0.f) & 0xffffu); } }
    }
    __syncthreads();
}

constexpr int IDX_RING_OFF = 0, IDX_SLOT = 32768;
constexpr int IDX_HIST_OFF = 3 * IDX_SLOT;
constexpr int IDX_RES_OFF = IDX_HIST_OFF + 24576;
__device__ __forceinline__ void hist_find16(const LAS unsigned* hist, int li, unsigned need, unsigned& bsel, unsigned& above) {
    const u32x4 h0 = *(const LAS u32x4*)(hist + 4 * li);
    const unsigned c[8] = {h0.x & 0xffffu, h0.x >> 16, h0.y & 0xffffu, h0.y >> 16, h0.z & 0xffffu, h0.z >> 16, h0.w & 0xffffu, h0.w >> 16};
    unsigned s = 0;
#pragma unroll
    for (int k = 0; k < 8; ++k) s += c[k];
    unsigned S = s;
#pragma unroll
    for (int d = 1; d < 32; d <<= 1) { const unsigned o = __shfl_down(S, d, 32); if (li + d < 32) S += o; }
    const unsigned excl = S - s;
    unsigned b = 0xffffffffu, ab = 0;
    if (excl < need && need <= S) { unsigned cum = excl; bool found = false;
#pragma unroll
        for (int k = 7; k >= 0; --k) { if (!found && cum + c[k] >= need) { b = 8 * li + k; ab = cum; found = true; } if (!found) cum += c[k]; } }
    const unsigned long long bal = __ballot(b != 0xffffffffu);
    const unsigned halfmask = (unsigned)((threadIdx.x & 32) ? (bal >> 32) : (bal & 0xffffffffull));
    const int src = (halfmask ? (__ffs(halfmask) - 1) : 0) + (threadIdx.x & 32);
    bsel = __shfl(b, src, 64); above = __shfl(ab, src, 64);
    if (!halfmask) { bsel = 0; above = 0; }
}
template <int J> __device__ __forceinline__ void wlane(unsigned& m, unsigned v) { asm volatile("v_writelane_b32 %0, %1, %2" : "+v"(m) : "s"(v), "n"(J)); }
template <int J> __device__ __forceinline__ void mask_emit_step(const unsigned (&k0)[32], const unsigned (&k1)[32], unsigned T0, unsigned T1, int kh, int ntiles, unsigned& m0, unsigned& m1, unsigned& m2, unsigned& m3) {
    if (2 * J + kh < ntiles) {
        const unsigned long long ba = __ballot(k0[J] >= T0), bc = __ballot(k1[J] >= T1);
        wlane<J>(m0, (unsigned)ba); wlane<J>(m2, (unsigned)(ba >> 32)); wlane<J>(m1, (unsigned)bc); wlane<J>(m3, (unsigned)(bc >> 32));
    }
}
template <int... Js> __device__ __forceinline__ void mask_emit(std::integer_sequence<int, Js...>, const unsigned (&k0)[32], const unsigned (&k1)[32], unsigned T0, unsigned T1, int kh, int ntiles, unsigned& m0, unsigned& m1, unsigned& m2, unsigned& m3) {
    (mask_emit_step<Js>(k0, k1, T0, T1, kh, ntiles, m0, m1, m2, m3), ...);
}
__device__ __forceinline__ void p2_indexer_unit(Frame& F, int b, int qb) {
    const bf16_t* IQ = (const bf16_t*)(F.ws + WS_IQ); const bf16_t* IK = (const bf16_t*)(F.ws + WS_IK); const float* IW = (const float*)(F.ws + WS_IW);
    unsigned* MASK = (unsigned*)(F.ws + WS_MASK);
    const int qg = F.wave & 3, kh = F.wave >> 2;
    LAS unsigned* hist = (LAS unsigned*)(F.lds + IDX_HIST_OFF) + qg * 4 * 384;
    LAS float* mm = (LAS float*)(F.lds + IDX_RES_OFF);
    const int lane = F.lane, r32 = lane & 31, hi = lane >> 5;
    const int p0 = qb * 16 + qg * 4;
    const int tq0 = b * SEQ + p0;
    const int ntiles = (qb >> 1) + 1;
    const int nch = (ntiles + 7) >> 3;
    const char* ikb = (const char*)(IK + (size_t)b * SEQ * 64);
    unsigned dsrc[4];
#pragma unroll
    for (int i = 0; i < 4; ++i) { const int row = F.wave * 32 + i * 8 + (lane >> 3), pos = lane & 7; dsrc[i] = (unsigned)(row * 128 + ((pos ^ ((row >> 1) & 7)) << 4)); }
#define IDX_ISSUE(ch) do { _Pragma("unroll") for (int i_ = 0; i_ < 4; ++i_) \
        __builtin_amdgcn_global_load_lds((const unsigned*)(ikb + (size_t)(ch) * 32768 + dsrc[i_]), (LAS unsigned*)(F.lds + IDX_RING_OFF + ((ch) % 3) * IDX_SLOT + F.wave * 4096 + i_ * 1024), 16, 0, 0); } while (0)
    bf16x8 af[4];
    { const int i = r32, qi = 2 * ((i >> 2) & 1) + (i >> 4), hd = (i & 3) + 4 * ((i >> 3) & 1);
#pragma unroll
      for (int s = 0; s < 4; ++s) af[s] = *(const bf16x8*)(IQ + (size_t)(tq0 + qi) * 512 + hd * 64 + 16 * s + 8 * hi); }
    float wA[8], wB[8];
#pragma unroll
    for (int r = 0; r < 8; ++r) { const int hd = (r & 3) + 4 * (r >> 2); wA[r] = IW[(size_t)(tq0 + 2 * hi) * 8 + hd] * W_SCALE; wB[r] = IW[(size_t)(tq0 + 2 * hi + 1) * 8 + hd] * W_SCALE; }
    __builtin_amdgcn_s_barrier();
    asm volatile("" ::: "memory");
    IDX_ISSUE(0); if (nch > 1) IDX_ISSUE(1);
#pragma unroll
    for (int i = 0; i < 3; ++i) *(LAS u32x4*)(F.lds + IDX_HIST_OFF + (i * 512 + F.tid) * 16) = (u32x4){0u, 0u, 0u, 0u};
    const int limA = p0 + 2 * hi - 32 * (ntiles - 1), limB = limA + 1;
    float sc0[32], sc1[32];
#pragma unroll
    for (int j = 0; j < 32; ++j) { sc0[j] = -INFINITY; sc1[j] = -INFINITY; }
    float mx0 = -INFINITY, mn0 = INFINITY, mx1 = -INFINITY, mn1 = INFINITY;
    const int frag_off = r32 * 128;
    const int fx = (r32 >> 1) & 7;
#pragma unroll
    for (int ch = 0; ch < 8; ++ch) {
        if (ch < nch) {
            if (ch + 1 < nch) asm volatile("s_waitcnt vmcnt(4)" ::: "memory"); else asm volatile("s_waitcnt vmcnt(0)" ::: "memory");
            __builtin_amdgcn_s_barrier();
            asm volatile("" ::: "memory");
            if (ch + 2 < nch) IDX_ISSUE(ch + 2);
            const LAS char* slot = (const LAS char*)(F.lds + IDX_RING_OFF + (ch % 3) * IDX_SLOT);
#pragma unroll
            for (int j4 = 0; j4 < 4; ++j4) {
                const int jl = 2 * j4 + kh, j = ch * 8 + jl, idx = ch * 4 + j4;
                if (j < ntiles) {
                    f32x16 acc = {};
#pragma unroll
                    for (int s = 0; s < 4; ++s) { const bf16x8 bfr = *(const LAS bf16x8*)(slot + jl * 4096 + frag_off + (((2 * s + hi) ^ fx) << 4));
                        acc = __builtin_amdgcn_mfma_f32_32x32x16_bf16(af[s], bfr, acc, 0, 0, 0); }
                    float s0 = 0.f, s1 = 0.f;
#pragma unroll
                    for (int r = 0; r < 8; ++r) {
                        const int ia = __float_as_int(acc[r]), ib = __float_as_int(acc[8 + r]);
                        s0 = fmaf(wA[r], __int_as_float(ia > 0 ? ia : 0), s0); s1 = fmaf(wB[r], __int_as_float(ib > 0 ? ib : 0), s1); }
                    if (j == ntiles - 1) {
                        mn0 = fminf(mn0, (r32 > limA) ? INFINITY : s0); mn1 = fminf(mn1, (r32 > limB) ? INFINITY : s1);
                        s0 = (r32 > limA) ? -INFINITY : s0; s1 = (r32 > limB) ? -INFINITY : s1;
                    } else { mn0 = fminf(mn0, s0); mn1 = fminf(mn1, s1); }
                    mx0 = fmaxf(mx0, s0); mx1 = fmaxf(mx1, s1);
                    sc0[idx] = s0; sc1[idx] = s1;
                }
            }
        }
    }
#undef IDX_ISSUE
#pragma unroll
    for (int d = 1; d < 32; d <<= 1) { mx0 = fmaxf(mx0, __shfl_xor(mx0, d)); mx1 = fmaxf(mx1, __shfl_xor(mx1, d)); mn0 = fminf(mn0, __shfl_xor(mn0, d)); mn1 = fminf(mn1, __shfl_xor(mn1, d)); }
    if (r32 == 0) { LAS float* w = mm + ((qg * 2 + kh) * 4 + 2 * hi) * 2; w[0] = mx0; w[1] = mn0; w[2] = mx1; w[3] = mn1; }
    __syncthreads();
    { const LAS float* w = mm + ((qg * 2 + (kh ^ 1)) * 4 + 2 * hi) * 2; mx0 = fmaxf(mx0, w[0]); mn0 = fminf(mn0, w[1]); mx1 = fmaxf(mx1, w[2]); mn1 = fminf(mn1, w[3]); }
    const float scl0 = (mx0 > mn0) ? (16777212.0f / (mx0 - mn0)) : 0.f, scl1 = (mx1 > mn1) ? (16777212.0f / (mx1 - mn1)) : 0.f;
    const float off0 = 1.5f - mn0 * scl0, off1 = 1.5f - mn1 * scl1;
    unsigned k0[32], k1[32];
#pragma unroll
    for (int j = 0; j < 32; ++j) { k0[j] = (unsigned)fmaf(sc0[j], scl0, off0); k1[j] = (unsigned)fmaf(sc1[j], scl1, off1); }
    unsigned T0 = 1u, T1 = 1u;
#ifndef NO_SELECT
    if (qb >= 16) {
        LAS unsigned* hA = hist + (2 * hi) * 384; LAS unsigned* hB = hist + (2 * hi + 1) * 384;
        unsigned pre0 = 0, pre1 = 0, need0 = 256, need1 = 256;
#pragma unroll
        for (int lvl = 0; lvl < 3; ++lvl) {
            const int sh = 16 - 8 * lvl;
#pragma unroll
            for (int j = 0; j < 32; ++j) {
                if (2 * j + kh < ntiles) {
                    const unsigned ka = k0[j], kc = k1[j];
                    if (lvl == 0 || (ka >> (sh + 8)) == pre0) { const unsigned bn = (ka >> sh) & 255u; (void)__hip_atomic_fetch_add(hA + lvl * 128 + (bn >> 1), 1u << ((bn & 1u) << 4), __ATOMIC_RELAXED, __HIP_MEMORY_SCOPE_WORKGROUP); }
                    if (lvl == 0 || (kc >> (sh + 8)) == pre1) { const unsigned bn = (kc >> sh) & 255u; (void)__hip_atomic_fetch_add(hB + lvl * 128 + (bn >> 1), 1u << ((bn & 1u) << 4), __ATOMIC_RELAXED, __HIP_MEMORY_SCOPE_WORKGROUP); }
                }
            }
            __syncthreads();
            unsigned b0, a0, b1, a1;
            hist_find16(hA + lvl * 128, r32, need0, b0, a0);
            hist_find16(hB + lvl * 128, r32, need1, b1, a1);
            pre0 = (pre0 << 8) | b0; need0 -= a0;
            pre1 = (pre1 << 8) | b1; need1 -= a1;
        }
        T0 = pre0 > 1u ? pre0 : 1u; T1 = pre1 > 1u ? pre1 : 1u;
    }
#endif
    unsigned m0 = 0, m1 = 0, m2 = 0, m3 = 0;
    mask_emit(std::make_integer_sequence<int, 32>{}, k0, k1, T0, T1, kh, ntiles, m0, m1, m2, m3);
    if (lane < 32) { const int w = 2 * lane + kh;
        MASK[(size_t)(tq0 + 0) * 64 + w] = m0; MASK[(size_t)(tq0 + 1) * 64 + w] = m1; MASK[(size_t)(tq0 + 2) * 64 + w] = m2; MASK[(size_t)(tq0 + 3) * 64 + w] = m3; }
}
__device__ __forceinline__ void p2_indexer(Frame& F) {
    for (int pi = F.bid; pi < 512; pi += F.G) { const int b = pi >> 6, x = pi & 63;
        p2_indexer_unit(F, b, 127 - x);
        p2_indexer_unit(F, b, x); }
    __syncthreads();
}

namespace att {
constexpr int D = 128, NW = 8, QBLK = 32, KVBLK = 64;
constexpr float SCALE = 0.088388347648318440f;
constexpr float THR = 8.f;
constexpr int LDQ = 768, LDK = 256, LDO = 1024;
constexpr size_t SHM_V = KVBLK * D * 2, SHM_K = KVBLK * D * 2, SHM_ATTN = 2 * SHM_V + 2 * SHM_K + NW * 64 * 4;
#define KSWZ(row, colB) ((row) * 256 + ((colB) ^ (((row) & 7) << 4)))
#define SBAR() __builtin_amdgcn_sched_barrier(0)
__device__ __forceinline__ void apply_mask(f32x16& p0, f32x16& p1, u32x2 mk, int hi) {
    const int ml = (int)(mk.x >> (4 * hi)), mh = (int)(mk.y >> (4 * hi));
#pragma unroll
    for (int r = 0; r < 16; ++r) { const int cr = (r & 3) + 8 * (r >> 2);
        const unsigned t0 = (unsigned)__builtin_amdgcn_sbfe(ml, cr, 1), t1 = (unsigned)__builtin_amdgcn_sbfe(mh, cr, 1);
        p0[r] = __uint_as_float((__float_as_uint(p0[r]) & t0) | (0xff800000u & ~t0));
        p1[r] = __uint_as_float((__float_as_uint(p1[r]) & t1) | (0xff800000u & ~t1)); }
}
__device__ __forceinline__ void partialSM(f32x16& p0, f32x16& p1, float& m_reg, float& mn, float& alpha) {
    constexpr float C = SCALE * 1.4426950408889634f;
    float pmax = p0[0];
#pragma unroll
    for (int r = 1; r < 16; ++r) pmax = fmaxf(pmax, p0[r]);
#pragma unroll
    for (int r = 0; r < 16; ++r) pmax = fmaxf(pmax, p1[r]);
    { auto rr = __builtin_amdgcn_permlane32_swap(__float_as_uint(pmax), __float_as_uint(pmax), false, false);
      pmax = fmaxf(__uint_as_float(rr[0]), __uint_as_float(rr[1])); }
    if (__builtin_expect(__all(pmax - m_reg <= THR / SCALE), 1)) { mn = m_reg; alpha = 1.f; }
    else { mn = fmaxf(m_reg, pmax); alpha = __builtin_amdgcn_exp2f((m_reg - mn) * C); m_reg = mn; }
    const float mnC = -mn * C;
#pragma unroll
    for (int r = 0; r < 16; ++r) p0[r] = fmaf(p0[r], C, mnC);
#pragma unroll
    for (int r = 0; r < 16; ++r) p1[r] = fmaf(p1[r], C, mnC);
#pragma unroll
    for (int r = 0; r < 16; ++r) p0[r] = __builtin_amdgcn_exp2f(p0[r]);
}
__device__ __forceinline__ void finishSM(f32x16& p0, f32x16& p1, float alpha, float& l_reg, bf16x8& pa0, bf16x8& pa1, bf16x8& pa2, bf16x8& pa3) {
#pragma unroll
    for (int r = 0; r < 16; ++r) p1[r] = __builtin_amdgcn_exp2f(p1[r]);
    float ps = 0;
#pragma unroll
    for (int r = 0; r < 16; ++r) ps += p0[r];
#pragma unroll
    for (int r = 0; r < 16; ++r) ps += p1[r];
    { auto rr = __builtin_amdgcn_permlane32_swap(__float_as_uint(ps), __float_as_uint(ps), false, false);
      ps = __uint_as_float(rr[0]) + __uint_as_float(rr[1]); }
    l_reg = l_reg * alpha + ps;
#define PK4(P, BASE, OUT) do { unsigned a0 = cvt_pk_bf16(P[BASE + 0], P[BASE + 1]), a1 = cvt_pk_bf16(P[BASE + 2], P[BASE + 3]);   \
    unsigned b0 = cvt_pk_bf16(P[BASE + 4], P[BASE + 5]), b1 = cvt_pk_bf16(P[BASE + 6], P[BASE + 7]);                              \
    auto r0 = __builtin_amdgcn_permlane32_swap(a0, b0, false, false); auto r1 = __builtin_amdgcn_permlane32_swap(a1, b1, false, false); \
    u32x4 w = {r0[0], r1[0], r0[1], r1[1]}; OUT = *reinterpret_cast<bf16x8*>(&w); } while (0)
    PK4(p0, 0, pa0); PK4(p0, 8, pa1); PK4(p1, 0, pa2); PK4(p1, 8, pa3);
#undef PK4
}
__device__ __forceinline__ void qkt(f32x16& p0, f32x16& p1, const LAS char* Ks, const bf16x8* qr, int r32, int hi) {
    p0 = f32x16{}; p1 = f32x16{};
#pragma unroll
    for (int d0 = 0; d0 < 8; ++d0) { const int cb = (d0 * 16 + hi * 8) * 2;
        const bf16x8 b0 = *reinterpret_cast<const LAS bf16x8*>(Ks + KSWZ(r32, cb));
        const bf16x8 b1 = *reinterpret_cast<const LAS bf16x8*>(Ks + KSWZ(32 + r32, cb));
        p0 = __builtin_amdgcn_mfma_f32_32x32x16_bf16(b0, qr[d0], p0, 0, 0, 0);
        p1 = __builtin_amdgcn_mfma_f32_32x32x16_bf16(b1, qr[d0], p1, 0, 0, 0); }
}
__device__ __forceinline__ int v_st(int k, int c) { const int kk = (k & ~0xC) | ((k & 4) << 1) | ((k & 8) >> 1); return ((kk >> 3) * 4 + (c >> 5)) * 512 + ((kk & 7) * 32 + (c & 31)) * 2; }
__device__ __forceinline__ int v_rd_base(int lane) { return ((lane & 3) << 3) | (((lane >> 2) & 3) << 6) | (((lane >> 4) & 1) << 5) | (((lane >> 5) & 1) << 8); }
constexpr int v_rd_off(int d0, int ks, int half) { return d0 * 512 + ks * 4096 + half * 2048; }
template <int OFF> __device__ __forceinline__ s16x4 tr_read(int vb) {
    s16x4 r; asm volatile("ds_read_b64_tr_b16 %0, %1 offset:%2" : "=&v"(r) : "v"(vb), "i"(OFF) : "memory"); return r;
}
template <int D0> __device__ __forceinline__ void pv_one(f32x16& od, int vb, bf16x8 pa0, bf16x8 pa1, bf16x8 pa2, bf16x8 pa3) {
    const s16x4 l0 = tr_read<v_rd_off(D0, 0, 0)>(vb), h0 = tr_read<v_rd_off(D0, 0, 1)>(vb), l1 = tr_read<v_rd_off(D0, 1, 0)>(vb), h1 = tr_read<v_rd_off(D0, 1, 1)>(vb);
    const s16x4 l2 = tr_read<v_rd_off(D0, 2, 0)>(vb), h2 = tr_read<v_rd_off(D0, 2, 1)>(vb), l3 = tr_read<v_rd_off(D0, 3, 0)>(vb), h3 = tr_read<v_rd_off(D0, 3, 1)>(vb);
    asm volatile("s_waitcnt lgkmcnt(0)" ::: "memory"); SBAR();
#define PK(L, H) (bf16x8){L[0], L[1], L[2], L[3], H[0], H[1], H[2], H[3]}
    od = __builtin_amdgcn_mfma_f32_32x32x16_bf16(pa0, PK(l0, h0), od, 0, 0, 0);
    od = __builtin_amdgcn_mfma_f32_32x32x16_bf16(pa1, PK(l1, h1), od, 0, 0, 0);
    od = __builtin_amdgcn_mfma_f32_32x32x16_bf16(pa2, PK(l2, h2), od, 0, 0, 0);
    od = __builtin_amdgcn_mfma_f32_32x32x16_bf16(pa3, PK(l3, h3), od, 0, 0, 0);
#undef PK
}
__device__ __forceinline__ void pv_d0(f32x16* o, int vb, bf16x8 pa0, bf16x8 pa1, bf16x8 pa2, bf16x8 pa3) {
    pv_one<0>(o[0], vb, pa0, pa1, pa2, pa3); pv_one<1>(o[1], vb, pa0, pa1, pa2, pa3); pv_one<2>(o[2], vb, pa0, pa1, pa2, pa3); pv_one<3>(o[3], vb, pa0, pa1, pa2, pa3);
}
__device__ __forceinline__ void attn_body(const bf16_t* __restrict__ Qb, const bf16_t* __restrict__ Kh, const bf16_t* __restrict__ Vh, bf16_t* __restrict__ Ob, const unsigned* __restrict__ Mb, int NT, LAS char* lds) {
    const int tid = threadIdx.x, wid = tid >> 6, lane = tid & 63, r32 = lane & 31, hi = lane >> 5;
    LAS char* V_lds = lds; LAS char* K_lds = lds + 2 * SHM_V;
    LAS float* ws = (LAS float*)(lds + 2 * SHM_V + 2 * SHM_K) + wid * 64; LAS float* li_l = ws; LAS float* al_l = ws + 32;
    float m_reg = -1e30f, l_reg = 0; f32x16 o[4] = {}; bf16x8 qr[8];
    const bf16_t* Qw = Qb + (long)(wid * QBLK + r32) * LDQ + hi * 8;
#pragma unroll
    for (int d0 = 0; d0 < 8; ++d0) qr[d0] = *reinterpret_cast<const bf16x8*>(Qw + d0 * 16);
    const unsigned mofs = (unsigned)(wid * QBLK + r32) * 256u;
#define Mw_(j) (*(const u32x2*)((const char*)Mb + (mofs + 8u * (unsigned)(j))))
    const int sr = tid >> 4, sc = (tid & 15) * 8, vst0 = v_st(sr, sc), vst1 = v_st(32 + sr, sc);
    const int vb0 = (int)(uintptr_t)V_lds + v_rd_base(lane);
    struct { bf16x8 vs0, vs1, ks0, ks1; } sr_[2];
#define SLOAD(i, k0) do { sr_[i].vs0 = *(const bf16x8*)(&Vh[(long)((k0) + sr) * LDK + sc]); sr_[i].vs1 = *(const bf16x8*)(&Vh[(long)((k0) + 32 + sr) * LDK + sc]); \
    sr_[i].ks0 = *(const bf16x8*)(&Kh[(long)((k0) + sr) * LDK + sc]); sr_[i].ks1 = *(const bf16x8*)(&Kh[(long)((k0) + 32 + sr) * LDK + sc]); } while (0)
#define SWRITE(b, i) do { *(LAS bf16x8*)(V_lds + (b) * SHM_V + vst0) = sr_[i].vs0;          \
    *(LAS bf16x8*)(V_lds + (b) * SHM_V + vst1) = sr_[i].vs1; int kc = sc * 2;               \
    *(LAS bf16x8*)(K_lds + (b) * SHM_K + KSWZ(sr, kc)) = sr_[i].ks0;                       \
    *(LAS bf16x8*)(K_lds + (b) * SHM_K + KSWZ(32 + sr, kc)) = sr_[i].ks1; } while (0)
#define SWAIT() asm volatile("s_waitcnt vmcnt(5)" ::: "memory")
#define RESC(a) do { if (__any((a) < 1.f)) { if (hi == 0) al_l[r32] = (a); asm volatile("s_waitcnt lgkmcnt(0)" ::: "memory"); \
    _Pragma("unroll") for (int d = 0; d < 4; ++d) _Pragma("unroll") for (int r = 0; r < 16; ++r) o[d][r] *= al_l[crow(r, hi)]; } } while (0)
    f32x16 pA0, pA1, pB0, pB1; float mnA, mnB, alA, alB; bf16x8 pa0, pa1, pa2, pa3;
    u32x2 mkA = Mw_(0), mkB = Mw_(1);
    constexpr int SE = 0, SO = 1;
    SLOAD(SE, 0); asm volatile("s_waitcnt vmcnt(0)" ::: "memory"); SWRITE(0, SE); __syncthreads();
    qkt(pA0, pA1, K_lds, qr, r32, hi); apply_mask(pA0, pA1, mkA, hi); partialSM(pA0, pA1, m_reg, mnA, alA); mkA = Mw_(2);
    SLOAD(SO, KVBLK); if (2 < NT) SLOAD(SE, 2 * KVBLK);
    SWAIT(); SWRITE(1, SO); __syncthreads();
    for (int j = 1; j + 1 < NT; j += 2) {
        SBAR(); qkt(pB0, pB1, K_lds + SHM_K, qr, r32, hi);
        finishSM(pA0, pA1, alA, l_reg, pa0, pa1, pa2, pa3); SBAR();
        SLOAD(SO, (j + 2) * KVBLK); SBAR();
        pv_d0(o, vb0, pa0, pa1, pa2, pa3); apply_mask(pB0, pB1, mkB, hi); partialSM(pB0, pB1, m_reg, mnB, alB); mkB = Mw_((j + 2 < NT) ? (j + 2) : j);
        __syncthreads(); SWAIT(); SWRITE(0, SE);
        RESC(alB); __syncthreads();
        SBAR(); qkt(pA0, pA1, K_lds, qr, r32, hi);
        finishSM(pB0, pB1, alB, l_reg, pa0, pa1, pa2, pa3); SBAR();
        if (j + 3 < NT) SLOAD(SE, (j + 3) * KVBLK); SBAR();
        pv_d0(o, vb0 + (int)SHM_V, pa0, pa1, pa2, pa3); apply_mask(pA0, pA1, mkA, hi); partialSM(pA0, pA1, m_reg, mnA, alA); mkA = Mw_((j + 3 < NT) ? (j + 3) : (j + 1));
        __syncthreads(); SWAIT(); SWRITE(1, SO);
        RESC(alA); __syncthreads();
    }
    SBAR(); qkt(pB0, pB1, K_lds + SHM_K, qr, r32, hi);
    finishSM(pA0, pA1, alA, l_reg, pa0, pa1, pa2, pa3); SBAR();
    pv_d0(o, vb0, pa0, pa1, pa2, pa3); apply_mask(pB0, pB1, mkB, hi); partialSM(pB0, pB1, m_reg, mnB, alB);
    __syncthreads(); RESC(alB);
    finishSM(pB0, pB1, alB, l_reg, pa0, pa1, pa2, pa3); SBAR();
    pv_d0(o, vb0 + (int)SHM_V, pa0, pa1, pa2, pa3);
    if (hi == 0) li_l[r32] = l_reg; asm volatile("s_waitcnt lgkmcnt(0)" ::: "memory");
    float rli[16];
#pragma unroll
    for (int r = 0; r < 16; ++r) rli[r] = __builtin_amdgcn_rcpf(li_l[crow(r, hi)]);
    bf16_t* Ow = Ob + (long)(wid * QBLK) * LDO;
#pragma unroll
    for (int r = 0; r < 16; ++r) { const int orow = crow(r, hi);
#pragma unroll
        for (int d0 = 0; d0 < 4; ++d0) Ow[(long)orow * LDO + d0 * 32 + r32] = (bf16_t)(cvt_pk_bf16(o[d0][r] * rli[r], 0.f) & 0xffffu); }
#undef SLOAD
#undef SWRITE
#undef SWAIT
#undef RESC
#undef Mw_
}
}

__device__ __forceinline__ void p3_attention(Frame& F) {
    const bf16_t* Q = (const bf16_t*)(F.ws + WS_Q); const bf16_t* K = (const bf16_t*)(F.ws + WS_K); const bf16_t* V = (const bf16_t*)(F.ws + WS_V);
    bf16_t* cat = (bf16_t*)(F.ws + WS_CAT); const unsigned* MASK = (const unsigned*)(F.ws + WS_MASK);
    const int j = F.bid;
    if (F.G == 256 && j >= 216) {
        convert_range(F, 2 * CV_PAIRS1, 2 * CV_PAIRS3, (j - 216) * 8 + F.wave, 40 * 8);
        return;
    }
    int qbs[2], phs[2], nu = 2;
    if (F.G != 256) { nu = 0; }
    else if (j < 48) { qbs[0] = 7; phs[0] = j; nu = 1; qbs[1] = 0; phs[1] = 0; }
    else if (j < 96) { qbs[0] = 6; phs[0] = j - 48; qbs[1] = 0; phs[1] = j - 48; }
    else if (j < 144) { qbs[0] = 5; phs[0] = j - 96; qbs[1] = 1; phs[1] = j - 96; }
    else if (j < 192) { qbs[0] = 4; phs[0] = j - 144; qbs[1] = 2; phs[1] = j - 144; }
    else { qbs[0] = 3; phs[0] = 2 * (j - 192); qbs[1] = 3; phs[1] = 2 * (j - 192) + 1; }
    for (int ui = 0; ui < nu; ++ui) {
        __syncthreads();
        const int qb = qbs[ui], b = phs[ui] / 6, h = phs[ui] % 6, g = h / 3;
        const size_t row0 = (size_t)b * SEQ + (size_t)qb * 256;
        att::attn_body(Q + row0 * 768 + h * 128, K + (size_t)b * SEQ * 256 + g * 128, V + (size_t)b * SEQ * 256 + g * 128, cat + row0 * 1024 + 256 + h * 128, MASK + row0 * 64, 4 * (qb + 1), (LAS char*)F.lds);
    }
    __syncthreads();
}

__device__ __forceinline__ void p5_ln1_router(Frame& F) {
    const bf16_t* MIX = (const bf16_t*)(F.ws + WS_MIX); const bf16_t* HA = (const bf16_t*)(F.ws + WS_HA);
    bf16_t* H1R = (bf16_t*)(F.ws + WS_H1F); unsigned char* H1Q = F.ws + WS_H1B; const float* wrA = (const float*)(F.ws + WS_WRA);
    unsigned* INV = (unsigned*)(F.ws + WS_INV); unsigned* TOKEP = (unsigned*)(F.ws + WS_TOKEP); float* TOKG = (float*)(F.ws + WS_TOKG);
    LAS float* tile = (LAS float*)F.lds;
    LAS float* part = (LAS float*)F.lds;
    LAS float* logit = (LAS float*)(F.lds + 36864);
    LAS int* sel_e = (LAS int*)(F.lds + MISC_OFF + 2048);
    LAS float* sel_g = (LAS float*)(F.lds + MISC_OFF + 3072);
    LAS int* sel_p = (LAS int*)(F.lds + MISC_OFF + 4096);
    LAS unsigned* lcnt = (LAS unsigned*)(F.lds + MISC_OFF + 5120);
    LAS int* ebase = (LAS int*)(F.lds + MISC_OFF + 5376);
    const int lane = F.lane, r32 = lane & 31, hi = lane >> 5;
    for (int blk = F.bid; blk < T / 64; blk += F.G) {
        const int t0 = blk * 64;
        if (F.tid < 32) lcnt[F.tid] = 0u;
        for (int pass = 0; pass < 2; ++pass) {
            __syncthreads();
            { f32x4 g1[4], b1[4];
#pragma unroll
              for (int j = 0; j < 4; ++j) { g1[j] = ((const f32x4*)F.ln1_g)[lane + 64 * j]; b1[j] = ((const f32x4*)F.ln1_b)[lane + 64 * j]; }
#pragma unroll
              for (int rb = 0; rb < 4; rb += 2) {
              u32x2 xv[2][4]; u32x2 mv[2][4];
#pragma unroll
              for (int rr = 0; rr < 2; ++rr) { const int m = t0 + pass * 32 + F.wave * 4 + rb + rr;
#pragma unroll
                  for (int j = 0; j < 4; ++j) { xv[rr][j] = ((const u32x2*)(HA + (size_t)m * 1024))[lane + 64 * j]; mv[rr][j] = ((const u32x2*)(MIX + (size_t)m * 1024))[lane + 64 * j]; } }
#pragma unroll
              for (int rr = 0; rr < 2; ++rr) { const int tl = F.wave * 4 + rb + rr, m = t0 + pass * 32 + tl;
                  f32x4 v[4]; float s = 0.f;
#pragma unroll
                  for (int j = 0; j < 4; ++j) { const u32x2 hw = xv[rr][j]; const f32x4 h = {bf16_lo(hw.x), bf16_hi(hw.x), bf16_lo(hw.y), bf16_hi(hw.y)};
                      const u32x2 w = mv[rr][j]; const f32x4 mx = {bf16_lo(w.x), bf16_hi(w.x), bf16_lo(w.y), bf16_hi(w.y)};
                      v[j] = ALPHA * h + mx; s += (v[j].x + v[j].y) + (v[j].z + v[j].w); }
                  const float mean = wave_sum(s) * (1.f / 1024.f); float s2 = 0.f;
#pragma unroll
                  for (int j = 0; j < 4; ++j) { v[j] = v[j] - mean; s2 += (v[j].x * v[j].x + v[j].y * v[j].y) + (v[j].z * v[j].z + v[j].w * v[j].w); }
                  const float rstd = 1.f / sqrtf(wave_sum(s2) * (1.f / 1024.f) + LN_EPS);
                  u32x2* of = (u32x2*)(H1R + (size_t)m * 1024) + lane; unsigned* ob = (unsigned*)(H1Q + (size_t)m * 1024) + lane;
#pragma unroll
                  for (int j = 0; j < 4; ++j) { const f32x4 h = v[j] * rstd * g1[j] + b1[j]; { u32x2 hw; hw.x = cvt_pk_bf16(h.x, h.y); hw.y = cvt_pk_bf16(h.z, h.w); of[64 * j] = hw; } ob[64 * j] = pk4_fp8(h.x, h.y, h.z, h.w);
                      *(LAS f32x4*)(tile + tl * 1024 + (((lane + 64 * j) ^ (tl & 15)) << 2)) = h; } } } }
            f32x4 a4[16];
#pragma unroll
            for (int i = 0; i < 16; ++i) a4[i] = *(const f32x4*)(wrA + (size_t)(((F.wave * 16 + i) * 2 + hi) * 32 + r32) * 4);
            __syncthreads();
            f32x16 acc = {};
#pragma unroll
            for (int i = 0; i < 16; ++i) { const int c = F.wave * 16 + i;
                const f32x4 b4 = *(const LAS f32x4*)(tile + r32 * 1024 + (((2 * c + hi) ^ (r32 & 15)) << 2));
                acc = __builtin_amdgcn_mfma_f32_32x32x2f32(a4[i].x, b4.x, acc, 0, 0, 0);
                acc = __builtin_amdgcn_mfma_f32_32x32x2f32(a4[i].y, b4.y, acc, 0, 0, 0);
                acc = __builtin_amdgcn_mfma_f32_32x32x2f32(a4[i].z, b4.z, acc, 0, 0, 0);
                acc = __builtin_amdgcn_mfma_f32_32x32x2f32(a4[i].w, b4.w, acc, 0, 0, 0); }
            __syncthreads();
#pragma unroll
            for (int r = 0; r < 16; ++r) part[(F.wave * 32 + r32) * 33 + crow(r, hi)] = acc[r];
            __syncthreads();
#pragma unroll
            for (int q = 0; q < 2; ++q) { const int o = F.tid * 2 + q, tok = o >> 5, e = o & 31; float sm = F.b_router[e];
#pragma unroll
                for (int kq = 0; kq < 8; ++kq) sm += part[(kq * 32 + tok) * 33 + e];
                logit[tok * 33 + e] = sm; }
            __syncthreads();
            if (F.tid < 32) {
                float bv_[4] = {-INFINITY, -INFINITY, -INFINITY, -INFINITY}; int bi[4] = {0, 0, 0, 0};
#pragma unroll
                for (int e = 0; e < 32; ++e) { const float v = logit[F.tid * 33 + e];
                    if (v > bv_[3]) { bv_[3] = v; bi[3] = e;
                        if (bv_[3] > bv_[2]) { float tv = bv_[2]; bv_[2] = bv_[3]; bv_[3] = tv; int ti = bi[2]; bi[2] = bi[3]; bi[3] = ti;
                            if (bv_[2] > bv_[1]) { tv = bv_[1]; bv_[1] = bv_[2]; bv_[2] = tv; ti = bi[1]; bi[1] = bi[2]; bi[2] = ti;
                                if (bv_[1] > bv_[0]) { tv = bv_[0]; bv_[0] = bv_[1]; bv_[1] = tv; ti = bi[0]; bi[0] = bi[1]; bi[1] = ti; } } } } }
                float ex[4], se = 0.f;
#pragma unroll
                for (int j = 0; j < 4; ++j) { ex[j] = __expf(bv_[j] - bv_[0]); se += ex[j]; }
#pragma unroll
                for (int j = 0; j < 4; ++j) { sel_g[(pass * 32 + F.tid) * 4 + j] = ex[j] / se; sel_e[(pass * 32 + F.tid) * 4 + j] = bi[j]; }
            }
        }
        __syncthreads();
        if (F.tid < 256) sel_p[F.tid] = (int)__hip_atomic_fetch_add(lcnt + sel_e[F.tid], 1u, __ATOMIC_RELAXED, __HIP_MEMORY_SCOPE_WORKGROUP);
        __syncthreads();
        if (F.tid < 32) { const unsigned c = lcnt[F.tid]; int base = 0; if (c > 0) base = (int)__hip_atomic_fetch_add(F.ctl + CW_CNT + F.tid, c, __ATOMIC_RELAXED, __HIP_MEMORY_SCOPE_AGENT); ebase[F.tid] = base; }
        __syncthreads();
        if (F.tid < 256) { const int tok = t0 + (F.tid >> 2), e = sel_e[F.tid], p = ebase[e] + sel_p[F.tid];
            INV[(size_t)e * CAP + p] = (unsigned)tok; TOKEP[(size_t)tok * 4 + (F.tid & 3)] = ((unsigned)e << 16) | (unsigned)p; TOKG[(size_t)tok * 4 + (F.tid & 3)] = sel_g[F.tid]; }
        __syncthreads();
    }
}

__device__ __forceinline__ void moe_tables(Frame& F, LAS int* tstart) {
    __syncthreads();
    if (F.tid < 64) {
        const unsigned c = (F.tid < NE) ? __hip_atomic_load(F.ctl + CW_CNT + (F.tid & 31), __ATOMIC_RELAXED, __HIP_MEMORY_SCOPE_AGENT) : 0u;
        const int nt = (int)((c + 255u) >> 8); int incl = nt;
#pragma unroll
        for (int d = 1; d < 32; d <<= 1) { const int o = __shfl_up(incl, d, 64); if ((int)F.tid >= d) incl += o; }
        if (F.tid < NE) { tstart[F.tid] = incl - nt; tstart[40 + F.tid] = (int)c; }
        if (F.tid == NE - 1) tstart[NE] = incl; }
    __syncthreads();
}

__device__ __forceinline__ float fp8_to_f32(unsigned w, int byte) {
    if (byte == 0) return __builtin_amdgcn_cvt_f32_fp8(w, 0); if (byte == 1) return __builtin_amdgcn_cvt_f32_fp8(w, 1); if (byte == 2) return __builtin_amdgcn_cvt_f32_fp8(w, 2); return __builtin_amdgcn_cvt_f32_fp8(w, 3);
}
__device__ __forceinline__ void p8_final(Frame& F, LAS int* tstart) {
    const bf16_t* H1R = (const bf16_t*)(F.ws + WS_H1F); const unsigned* TOKEP = (const unsigned*)(F.ws + WS_TOKEP); const float* TOKG = (const float*)(F.ws + WS_TOKG);
    const unsigned char* Y = F.ws + WS_Y;
    const int gw = F.bid * 8 + F.wave, NGW = F.G * 8;
    f32x4 gv[4], bv[4];
#pragma unroll
    for (int j = 0; j < 4; ++j) { gv[j] = ((const f32x4*)F.ln2_g)[F.lane + 64 * j]; bv[j] = ((const f32x4*)F.ln2_b)[F.lane + 64 * j]; }
    unsigned tk = 0; float tg = 0.f;
    { const int m = gw + (F.lane >> 2) * NGW; if (F.lane < 32 && m < T) { tk = TOKEP[(size_t)m * 4 + (F.lane & 3)]; tg = TOKG[(size_t)m * 4 + (F.lane & 3)] * (1.0f / 64.0f); } }
    u32x2 hwA[4], hwB[4]; unsigned ywA[4][4], ywB[4][4];
#define P8_LOAD(k, hw, yw) do { const int m_ = gw + (k) * NGW; if (m_ < T) { const u32x2* xr_ = (const u32x2*)(H1R + (size_t)m_ * 1024) + F.lane; \
        _Pragma("unroll") for (int j = 0; j < 4; ++j) hw[j] = xr_[64 * j]; \
        _Pragma("unroll") for (int q = 0; q < 4; ++q) { const unsigned ep_ = (unsigned)__builtin_amdgcn_readlane((int)tk, (k) * 4 + q); \
            const size_t slot_ = (size_t)tstart[ep_ >> 16] * 256 + (ep_ & 0xffffu); const unsigned* yr_ = (const unsigned*)(Y + slot_ * 1024) + F.lane; \
            _Pragma("unroll") for (int j = 0; j < 4; ++j) yw[q][j] = yr_[64 * j]; } } } while (0)
#define P8_ROW(k, hw, yw) do { const int m_ = gw + (k) * NGW; if (m_ < T) { f32x4 v[4]; float gt[4]; \
        _Pragma("unroll") for (int q = 0; q < 4; ++q) gt[q] = __builtin_bit_cast(float, __builtin_amdgcn_readlane(__builtin_bit_cast(int, tg), (k) * 4 + q)); \
        _Pragma("unroll") for (int j = 0; j < 4; ++j) { v[j] = (f32x4){ALPHA * bf16_lo(hw[j].x), ALPHA * bf16_hi(hw[j].x), ALPHA * bf16_lo(hw[j].y), ALPHA * bf16_hi(hw[j].y)}; \
            _Pragma("unroll") for (int q = 0; q < 4; ++q) { const unsigned w = yw[q][j]; \
                v[j].x += gt[q] * fp8_to_f32(w, 0); v[j].y += gt[q] * fp8_to_f32(w, 1); v[j].z += gt[q] * fp8_to_f32(w, 2); v[j].w += gt[q] * fp8_to_f32(w, 3); } } \
        float s_ = 0.f; _Pragma("unroll") for (int j = 0; j < 4; ++j) s_ += (v[j].x + v[j].y) + (v[j].z + v[j].w); \
        const float mean_ = wave_sum(s_) * (1.f / 1024.f); float s2_ = 0.f; \
        _Pragma("unroll") for (int j = 0; j < 4; ++j) { v[j] = v[j] - mean_; s2_ += (v[j].x * v[j].x + v[j].y * v[j].y) + (v[j].z * v[j].z + v[j].w * v[j].w); } \
        const float rstd_ = 1.f / sqrtf(wave_sum(s2_) * (1.f / 1024.f) + LN_EPS); \
        f32x4* orow_ = (f32x4*)(F.out + (size_t)m_ * 1024) + F.lane; \
        _Pragma("unroll") for (int j = 0; j < 4; ++j) orow_[64 * j] = v[j] * rstd_ * gv[j] + bv[j]; } } while (0)
    P8_LOAD(0, hwA, ywA);
    P8_LOAD(1, hwB, ywB); P8_ROW(0, hwA, ywA);
    P8_LOAD(2, hwA, ywA); P8_ROW(1, hwB, ywB);
    P8_LOAD(3, hwB, ywB); P8_ROW(2, hwA, ywA);
    P8_LOAD(4, hwA, ywA); P8_ROW(3, hwB, ywB);
    P8_LOAD(5, hwB, ywB); P8_ROW(4, hwA, ywA);
    P8_LOAD(6, hwA, ywA); P8_ROW(5, hwB, ywB);
    P8_LOAD(7, hwB, ywB); P8_ROW(6, hwA, ywA);
    P8_ROW(7, hwB, ywB);
#undef P8_LOAD
#undef P8_ROW
}

__global__ void __launch_bounds__(NTHREADS, 2) mk_fwd(Args args) {
    extern __shared__ __attribute__((aligned(16))) unsigned char lds_raw[];
    Frame F;
    F.lds = (LAS unsigned char*)lds_raw;
    F.tid = threadIdx.x; F.lane = F.tid & 63; F.wave = __builtin_amdgcn_readfirstlane(F.tid >> 6); F.G = gridDim.x; F.bid = blockIdx.x;
    frame_refresh(F);
    volatile LAS unsigned* misc = (volatile LAS unsigned*)(F.lds + MISC_OFF);
    LAS int* tstart = (LAS int*)(F.lds + MISC_OFF + 256);
    LAS int* toktab = (LAS int*)(F.lds + MISC_OFF + 1024);
    if (F.tid < 4) misc[F.tid] = 0u;
    __syncthreads();
    const int lo = args.ph_lo, hi = args.ph_hi;
    XcdBarrier bar; bar.bar = F.ctl; bar.x = 0; bar.st = misc;
    if (hi - lo > 1) bar = xcd_barrier_post(F.ctl, misc);
#define IN(k) (lo <= (k) && (k) < hi)
#ifdef ONLY
#define PH_ON(k) ((k) == ONLY)
#else
#define PH_ON(k) true
#endif
#define SEAM(k) do { if (IN(k) && IN((k) + 1)) xcd_barrier(bar); frame_refresh(F); } while (0)

    if (PH_ON(0) && IN(0)) { p0_prologue(F); } SEAM(0);
    if (PH_ON(1) && IN(1)) {
        EpiInProj E{(bf16_t*)(F.ws + WS_U), (bf16_t*)(F.ws + WS_Q), (bf16_t*)(F.ws + WS_K), (bf16_t*)(F.ws + WS_V), (bf16_t*)(F.ws + WS_IQ), (bf16_t*)(F.ws + WS_IK), (float*)(F.ws + WS_IW),
                    (const float*)(F.ws + WS_ROPEQK), (const float*)(F.ws + WS_ROPEIX)};
        { pg8::StaticSched S{T / 256, 5, F.G, F.bid, 1, 1};
          pg8::gemm_phase<EpiInProj, pg8::StaticSched, true, 0x79797979, 0x7f7f7f7f>(F.lds, (const char*)(F.ws + WS_HA8), (const char*)(F.ws + WS_BTIN8), S, E); }
        { pg8::StaticSched S{T / 256, 4, F.G, F.bid, 0, 5};
          pg8::gemm_phase<EpiInProj, pg8::StaticSched>(F.lds, (const char*)(F.ws + WS_HA), (const char*)(F.ws + WS_BTIN), S, E); }
        if (F.bid >= 64) {
            convert_range(F, 0, 2 * CV_PAIRS1, (F.bid - 64) * 8 + F.wave, (F.G - 64) * 8); }
    } SEAM(1);
    if (PH_ON(2) && IN(2)) {
#ifndef NO_POOL
 p2_pool(F);
#endif
 p2_indexer(F); } SEAM(2);
    if (PH_ON(3) && IN(3)) { p3_attention(F); } SEAM(3);
    if (PH_ON(4) && IN(4)) {
        pg8::StaticSched S{T / 256, 4, F.G, F.bid, 0, 0};
        EpiMix E{(bf16_t*)(F.ws + WS_MIX)};
        pg8::gemm_phase<EpiMix, pg8::StaticSched>(F.lds, (const char*)(F.ws + WS_CAT), (const char*)(F.ws + WS_BTOUT), S, E);
    } SEAM(4);
    if (PH_ON(5) && IN(5)) { p5_ln1_router(F); } SEAM(5);
    if (PH_ON(6) && IN(6)) {
        moe_tables(F, tstart);
        const int ntl = tstart[NE];
        pg8::MoeSched<true> S{ntl, 8, F.G, F.bid, 2048, tstart, toktab, 0};
        { const unsigned* INV = (const unsigned*)(F.ws + WS_INV); pg8::Unit u; unsigned tk[10];
#pragma unroll
          for (int i = 0; i < 10; ++i) { tk[i] = 0u; if (S.next(i, u) && F.tid < 256) { const int p = (u.pm - tstart[u.e]) * 256 + F.tid; const int cnt = tstart[40 + u.e];
                  tk[i] = INV[(size_t)u.e * CAP + (p < cnt ? p : 0)]; } }
#pragma unroll
          for (int i = 0; i < 10; ++i) if (F.tid < 256) toktab[i * 256 + F.tid] = (int)tk[i];
          __syncthreads(); }
        EpiGateUp E{F.ws + WS_ACT, F.b_gu, F.ctl + CW_ACTRDY};
#ifndef NO_GU
        pg8::gemm_phase<EpiGateUp, pg8::MoeSched<true>, true, 0x79797979, 0x7f7f7f7f>(F.lds, (const char*)(F.ws + WS_H1B), (const char*)(F.ws + WS_BTGU), S, E);
#endif
        { const int nwg6 = 8 * ntl, rounds6 = (nwg6 + F.G - 1) / F.G, nidle = rounds6 * F.G - nwg6, cfirst = nwg6 - (rounds6 - 1) * F.G;
          int early = ((nidle < 128 ? nidle : 128) / 32) * 32; if (rounds6 < 9 || ntl < 32) early = 0;
          const int rank = F.bid - cfirst;
#ifndef NO_EARLY
          if (rank >= 0 && rank < early) {
              pg8::MoeSched<false> S7{early / 4, 4, F.G, rank, 1024, tstart, toktab, 0};
              pg8::Unit u; S7.next(0, u);
              if (F.tid < 64) {
                  unsigned* cp = F.ctl + CW_ACTRDY + u.pm; unsigned sp = 0;
                  while ((unsigned)__builtin_amdgcn_readfirstlane((int)__hip_atomic_load(cp, __ATOMIC_RELAXED, __HIP_MEMORY_SCOPE_AGENT)) < 64u) {
                      __builtin_amdgcn_s_sleep(2); if (++sp > (1u << 20)) { if (F.tid == 0) __hip_atomic_store(F.ctl + CW_TMO2, 1u, __ATOMIC_RELAXED, __HIP_MEMORY_SCOPE_AGENT); break; } }
                  __builtin_amdgcn_fence(__ATOMIC_ACQUIRE, "agent");
                  asm volatile("s_waitcnt vmcnt(0)" ::: "memory"); }
              __syncthreads();
              EpiDown E7{F.ws + WS_Y, F.b_dn};
              pg8::gemm_phase<EpiDown, pg8::MoeSched<false>, true, 0x79797979, 0x7c7c7c7c>(F.lds, (const char*)(F.ws + WS_ACT), (const char*)(F.ws + WS_BTDN), S7, E7);
          }
#endif
          (void)rank; (void)early; }
    } SEAM(6);
    if (PH_ON(7) && IN(7)) {
        moe_tables(F, tstart);
        const int ntl = tstart[NE];
        const int nwg6 = 8 * ntl, rounds6 = (nwg6 + F.G - 1) / F.G, nidle = rounds6 * F.G - nwg6;
        int early = ((nidle < 128 ? nidle : 128) / 32) * 32; if (rounds6 < 9 || ntl < 32) early = 0;
        pg8::MoeSched<false> S{ntl, 4, F.G, F.bid, 1024, tstart, toktab, early};
        EpiDown E{F.ws + WS_Y, F.b_dn};
        pg8::gemm_phase<EpiDown, pg8::MoeSched<false>, true, 0x79797979, 0x7c7c7c7c>(F.lds, (const char*)(F.ws + WS_ACT), (const char*)(F.ws + WS_BTDN), S, E);
    } SEAM(7);
    if (PH_ON(8) && IN(8)) { moe_tables(F, tstart); p8_final(F, tstart); }
#undef IN
#undef SEAM
}

extern "C" void kernel_launch(void* const* d_in, const int* in_sizes, int n_in, void* d_out, int out_size, void* d_ws, size_t ws_size, hipStream_t stream) {
    static int grid = 0;
    if (grid == 0) {
        if (n_in != 18 || in_sizes[0] != T * DM || out_size != T * DM || ws_size < WS_END) {
            fprintf(stderr, "kernel_launch: shape mismatch (n_in %d, in0 %d, out %d, ws %zu, need %zu)\n", n_in, n_in > 0 ? in_sizes[0] : -1, out_size, ws_size, (size_t)WS_END); grid = -1; return; }
        int dev = 0, cus = 0, per_cu = 0;
        if (hipGetDevice(&dev) != hipSuccess || hipDeviceGetAttribute(&cus, hipDeviceAttributeMultiprocessorCount, dev) != hipSuccess) { grid = -1; return; }
        if (hipFuncSetAttribute((const void*)mk_fwd, hipFuncAttributeMaxDynamicSharedMemorySize, LDS_BYTES) != hipSuccess) { fprintf(stderr, "kernel_launch: hipFuncSetAttribute failed\n"); grid = -1; return; }
        if (hipOccupancyMaxActiveBlocksPerMultiprocessor(&per_cu, (const void*)mk_fwd, NTHREADS, LDS_BYTES) != hipSuccess || per_cu < 1) {
            fprintf(stderr, "kernel_launch: occupancy query reports %d workgroups per CU\n", per_cu); }
        (void)hipGetLastError();
        grid = cus;
        if (grid != 256) { fprintf(stderr, "kernel_launch: built for a 256-CU device (static work deals), found %d CUs\n", cus); grid = -1; return; }
    }
    if (grid < 0) return;
    (void)hipMemsetAsync((char*)d_ws + WS_CTL, 0, CTL_BYTES, stream);
    Args a{};
    for (int i = 0; i < 18; ++i) a.in[i] = d_in[i];
    a.out = (float*)d_out; a.ws = (unsigned char*)d_ws;
#if MK_N_LAUNCHES == 1
    a.ph_lo = 0; a.ph_hi = NPH;
    hipLaunchKernelGGL(mk_fwd, dim3(grid), dim3(NTHREADS), LDS_BYTES, stream, a);
#else
    for (int p = 0; p < NPH; ++p) { a.ph_lo = p; a.ph_hi = p + 1; hipLaunchKernelGGL(mk_fwd, dim3(grid), dim3(NTHREADS), LDS_BYTES, stream, a);
#ifdef PROBE_DUP
        if (p == PROBE_DUP) { if (p == 3 || p == 5) (void)hipMemsetAsync((char*)d_ws + WS_CTL + 4096 * 4, 0, 1024, stream); hipLaunchKernelGGL(mk_fwd, dim3(grid), dim3(NTHREADS), LDS_BYTES, stream, a); }
#endif
    }
#endif
    const hipError_t le = hipPeekAtLastError();
    if (le != hipSuccess) fprintf(stderr, "kernel_launch: launch failed: %s\n", hipGetErrorName(le));
}
```

```cpp
#include <hip/hip_runtime.h>
#include <cstdio>
#include <cstdint>
#include <utility>

#define LAS __attribute__((address_space(3)))
typedef unsigned short bf16_t;
typedef short bf16x8 __attribute__((ext_vector_type(8)));
typedef short s16x4 __attribute__((ext_vector_type(4)));
typedef float f32x2 __attribute__((ext_vector_type(2)));
typedef float f32x4 __attribute__((ext_vector_type(4)));
typedef float f32x16 __attribute__((ext_vector_type(16)));
typedef unsigned u32x2 __attribute__((ext_vector_type(2)));
typedef unsigned u32x4 __attribute__((ext_vector_type(4)));

#ifndef MK_N_LAUNCHES
#define MK_N_LAUNCHES 1
#endif

constexpr int T = 16384, DM = 1024, SEQ = 2048, NBATCH = 8;
constexpr int INW = 2120, INP = 2304;
constexpr int NE = 32, CAP = 16384, MAXT = 288;
constexpr int NPH = 9;
constexpr float ALPHA = 1.189207115002721f;
constexpr float LN_EPS = 1e-5f;
constexpr float W_SCALE = 0.04419417382415922f;
constexpr int NTHREADS = 512;
constexpr int LDS_BYTES = 147456;
constexpr int MISC_OFF = 131072;

constexpr size_t al256(size_t x) { return (x + 255) / 256 * 256; }
constexpr size_t WS_CTL = 0;
constexpr size_t CTL_BYTES = 65536;
constexpr size_t WS_BTIN = WS_CTL + CTL_BYTES;
constexpr size_t WS_BTOUT = WS_BTIN + al256((size_t)INP * 1024 * 2);
constexpr size_t WS_BTGU = WS_BTOUT + al256((size_t)1024 * 1024 * 2);
constexpr size_t WS_BTDN = WS_BTGU + al256((size_t)NE * 2048 * 1024 * 2);
constexpr size_t WS_WPT = WS_BTDN + al256((size_t)NE * 1024 * 1024 * 2);
constexpr size_t WS_WRA = WS_WPT + al256((size_t)4 * 64 * 64 * 2);
constexpr size_t WS_HA = WS_WRA + al256((size_t)1024 * 32 * 4);
constexpr size_t WS_STATS = WS_HA + al256((size_t)T * 1024 * 2);
constexpr size_t WS_ROPEQK = WS_STATS + al256((size_t)T * 2 * 4);
constexpr size_t WS_ROPEIX = WS_ROPEQK + al256((size_t)T * 32 * 4);
constexpr size_t WS_U = WS_ROPEIX + al256((size_t)T * 16 * 4);
constexpr size_t WS_Q = WS_U + al256((size_t)T * 256 * 2);
constexpr size_t WS_K = WS_Q + al256((size_t)T * 768 * 2);
constexpr size_t WS_V = WS_K + al256((size_t)T * 256 * 2);
constexpr size_t WS_IQ = WS_V + al256((size_t)T * 256 * 2);
constexpr size_t WS_IK = WS_IQ + al256((size_t)T * 512 * 2);
constexpr size_t WS_IW = WS_IK + al256((size_t)T * 64 * 2);
constexpr size_t WS_MASK = WS_IW + al256((size_t)T * 8 * 4);
constexpr size_t WS_CAT = WS_MASK + al256((size_t)T * 64 * 4);
constexpr size_t WS_H1F = WS_CAT + al256((size_t)T * 1024 * 2);
constexpr size_t WS_H1B = WS_H1F + al256((size_t)T * 1024 * 4);
constexpr size_t WS_INV = WS_H1B + al256((size_t)T * 1024 * 2);
constexpr size_t WS_TOKEP = WS_INV + al256((size_t)NE * CAP * 4);
constexpr size_t WS_TOKG = WS_TOKEP + al256((size_t)T * 4 * 4);
constexpr size_t WS_ACT = WS_TOKG + al256((size_t)T * 4 * 4);
constexpr size_t WS_Y = WS_ACT + al256((size_t)MAXT * 256 * 1024 * 2);
constexpr size_t WS_MIX = WS_Y + al256((size_t)MAXT * 256 * 1024 * 2);
constexpr size_t WS_HA8 = WS_MIX + al256((size_t)T * 1024 * 2);
constexpr size_t WS_BTIN8 = WS_HA8 + al256((size_t)T * 1024);
constexpr size_t WS_END = WS_BTIN8 + al256((size_t)1536 * 1024);
constexpr int CW_CNT = 4096;
constexpr int CW_ATTQ = 4224;
constexpr int CW_CVQ1 = 4288, CW_CVQ3 = 4352, CW_ACTRDY = 4608;
constexpr int CW_TMO2 = 4480;
constexpr int CV_PAIRS1 = 3072, CV_PAIRS3 = 5120, CV_HIDDEN = 2 * (CV_PAIRS1 + CV_PAIRS3);

#define XB_TMO      128
#define XB_XCNT(j)  (256  + 64 * (j))
#define XB_XSUB(j)  (1280 + 64 * (j))
#define XB_XGEN(j)  (2304 + 64 * (j))
#define XB_TOP      3328
#define XB_TOPGEN   3392
#define XCD_BAR_WORDS 3456
#define XB_SPIN_CAP (1u << 18)
__device__ __forceinline__ unsigned xb_ld(unsigned* p)              { return __hip_atomic_load(p, __ATOMIC_RELAXED, __HIP_MEMORY_SCOPE_AGENT); }
__device__ __forceinline__ unsigned xb_add(unsigned* p, unsigned v) { return __hip_atomic_fetch_add(p, v, __ATOMIC_RELAXED, __HIP_MEMORY_SCOPE_AGENT); }
__device__ __forceinline__ unsigned xb_xcc_id() { return (unsigned)__builtin_amdgcn_s_getreg((3 << 11) | 20) & 0xFu; }
#define XB_SPIN(cond, bar) do { unsigned _sp = 0; while (cond) { __builtin_amdgcn_s_sleep(1); \
    if ((++_sp & 255u) == 0u) { if (xb_ld(&(bar)[XB_TMO])) break; if (_sp > XB_SPIN_CAP) { atomicAdd(&(bar)[XB_TMO], 1u); break; } } } } while (0)
struct XcdBarrier { unsigned* bar; unsigned x; volatile LAS unsigned* st; };
__device__ __forceinline__ XcdBarrier xcd_barrier_post(unsigned* bar, volatile LAS unsigned* st) {
    XcdBarrier b; b.bar = bar; b.x = xb_xcc_id(); b.st = st;
    if (threadIdx.x == 0) (void)xb_add(&bar[XB_XCNT(b.x)], 1u);
    return b;
}
__device__ __forceinline__ void xcd_barrier_complete(unsigned* bar, unsigned x, unsigned& nloc, unsigned& nx) {
    const unsigned G = gridDim.x * gridDim.y * gridDim.z;
    unsigned sum, cnt, mine, sp = 0u;
    for (;;) {
        sum = 0u; cnt = 0u; mine = 0u;
#pragma unroll
        for (unsigned j = 0; j < 16; ++j) { const unsigned c = xb_ld(&bar[XB_XCNT(j)]); sum += c; cnt += (c > 0u) ? 1u : 0u; mine = (j == x) ? c : mine; }
        if (sum == G) break;
        __builtin_amdgcn_s_sleep(1);
        if ((++sp & 255u) == 0u) { if (xb_ld(&bar[XB_TMO])) break; if (sp > XB_SPIN_CAP) { atomicAdd(&bar[XB_TMO], 1u); break; } }
    }
    nloc = mine > 0u ? mine : 1u; nx = cnt > 0u ? cnt : 1u;
}
__device__ __forceinline__ void xcd_barrier(const XcdBarrier& b) {
    asm volatile("s_waitcnt vmcnt(0)" ::: "memory");
    __syncthreads();
    if (threadIdx.x == 0) {
        unsigned* bar = b.bar;
        __builtin_amdgcn_s_waitcnt(0);
        unsigned nloc = b.st[0], nx = b.st[1];
        if (nloc == 0u) { xcd_barrier_complete(bar, b.x, nloc, nx); b.st[0] = nloc; b.st[1] = nx; }
        const unsigned old = xb_add(&bar[XB_XSUB(b.x)], 1u);
        const unsigned gen = old / nloc;
        if (old + 1u == (gen + 1u) * nloc) {
            __builtin_amdgcn_fence(__ATOMIC_RELEASE, "agent");
            asm volatile("s_waitcnt vmcnt(0)" ::: "memory");
            const unsigned og = xb_add(&bar[XB_TOP], 1u);
            const unsigned tg = og / nx;
            if (og + 1u == (tg + 1u) * nx) xb_add(&bar[XB_TOPGEN], 1u);
            else XB_SPIN(xb_ld(&bar[XB_TOPGEN]) == tg, bar);
            __builtin_amdgcn_fence(__ATOMIC_ACQUIRE, "agent");
            xb_add(&bar[XB_XGEN(b.x)], 1u);
            asm volatile("s_waitcnt vmcnt(0)" ::: "memory");
        } else {
            XB_SPIN(xb_ld(&bar[XB_XGEN(b.x)]) == gen, bar);
            __builtin_amdgcn_fence(__ATOMIC_ACQUIRE, "agent");
            asm volatile("s_waitcnt vmcnt(0)" ::: "memory");
        }
    }
    __syncthreads();
}

__device__ __forceinline__ unsigned cvt_pk_bf16(float lo, float hi) { unsigned r; asm volatile("v_cvt_pk_bf16_f32 %0, %1, %2" : "=v"(r) : "v"(lo), "v"(hi)); return r; }
__device__ __forceinline__ unsigned pk4_fp8(float a, float b, float c, float d) { int w = __builtin_amdgcn_cvt_pk_fp8_f32(a, b, 0, false); w = __builtin_amdgcn_cvt_pk_fp8_f32(c, d, w, true); return (unsigned)w; }
__device__ __forceinline__ float bf16_lo(unsigned w) { return __uint_as_float(w << 16); }
__device__ __forceinline__ float bf16_hi(unsigned w) { return __uint_as_float(w & 0xffff0000u); }
template <int CTRL> __device__ __forceinline__ float dpp_f(float v) { return __builtin_bit_cast(float, __builtin_amdgcn_update_dpp(0, __builtin_bit_cast(int, v), CTRL, 0xf, 0xf, true)); }
__device__ __forceinline__ float wave_sum(float v) {
    v += dpp_f<0xB1>(v);
    v += dpp_f<0x4E>(v);
    v += dpp_f<0x141>(v);
    v += dpp_f<0x140>(v);
    const int vi = __builtin_bit_cast(int, v);
    const float r0 = __builtin_bit_cast(float, __builtin_amdgcn_readlane(vi, 0)), r1 = __builtin_bit_cast(float, __builtin_amdgcn_readlane(vi, 16));
    const float r2 = __builtin_bit_cast(float, __builtin_amdgcn_readlane(vi, 32)), r3 = __builtin_bit_cast(float, __builtin_amdgcn_readlane(vi, 48));
    return (r0 + r1) + (r2 + r3);
}
#define LDS_WAIT() asm volatile("s_waitcnt lgkmcnt(0)" ::: "memory")
#define VM_WAIT()  asm volatile("s_waitcnt vmcnt(0)" ::: "memory")
__device__ __forceinline__ int crow(int r, int hi) { return (r & 3) + 8 * (r >> 2) + 4 * hi; }

namespace pg8 {
constexpr int BM = 256, BK = 64, HALF = 128, HTB = HALF * BK * 2, STAGE_BYTES = 8 * HTB, NXCD = 8, WGM = 4, KD = 1024;
__device__ __forceinline__ int lds_byte(int r, int c) { const int st = (r >> 4) * 2 + (c >> 5), rr = r & 15, cc = c & 31, ob = rr * 64 + cc * 2; return st * 1024 + (ob ^ (((ob >> 9) & 1) << 5)); }
__device__ __forceinline__ void stage_rc(int b, int& R, int& C) { const int st = b / 1024, sb = b % 1024, swz = sb ^ (((sb >> 9) & 1) << 5); R = (st >> 1) * 16 + swz / 64; C = (st & 1) * 32 + (swz % 64) / 2; }
__device__ __forceinline__ int perm32(int rho) { const int n = rho >> 4, i = rho & 15; return 8 * (i >> 2) + 4 * n + (i & 3); }

struct Unit { int pm, pn, e, idx; };

__device__ __forceinline__ void order_decode(int wgid, int nM, int nN, int& pm, int& pn) {
    const int nig = WGM * nN, gid = wgid / nig, fm = gid * WGM, gsz = (nM - fm) < WGM ? (nM - fm) : WGM;
    pm = fm + ((wgid % nig) % gsz); pn = (wgid % nig) / gsz;
}
__device__ __forceinline__ bool order_next(int i, int G, int c, int nM, int nN, int& pm, int& pn, int woff = 0) {
    const int nwg = nM * nN - woff; const long L = (long)i * G + c; if (L >= nwg) return false;
    int wgid = (int)L; { const int q = nwg / NXCD, r = nwg % NXCD, xcd = wgid % NXCD, off = wgid / NXCD; wgid = (xcd < r ? xcd * (q + 1) : r * (q + 1) + (xcd - r) * q) + off; }
    order_decode(wgid + woff, nM, nN, pm, pn); return true;
}
struct StaticSched {
    int nM, nN, G, c, t0, toff;
    __device__ __forceinline__ bool next(int i, Unit& u) const { u.idx = i; const bool ok = order_next(i, G, c, nM, nN, u.pm, u.pn); u.e = (u.pn == 0) ? t0 : u.pn + toff; return ok; }
    __device__ __forceinline__ int a_row(const Unit& u, int h, int R) const { return u.pm * BM + h * HALF + R; }
    __device__ __forceinline__ int b_row(const Unit& u) const { return u.e * BM; }
};
template <bool GATHER> struct MoeSched {
    int nM, nN, G, c; int brows;
    const LAS int* tstart; const LAS int* toktab; int woff;
    __device__ __forceinline__ bool next(int i, Unit& u) const {
        u.idx = i;
        if (!order_next(i, G, c, nM, nN, u.pm, u.pn, woff)) return false;
        int e = 0;
#pragma unroll
        for (int k = 1; k < NE; ++k) e += (u.pm >= tstart[k]) ? 1 : 0;
        u.e = e; return true;
    }
    __device__ __forceinline__ int a_row(const Unit& u, int h, int R) const { if constexpr (GATHER) return toktab[u.idx * 256 + h * HALF + R]; else return u.pm * BM + h * HALF + R; }
    __device__ __forceinline__ int b_row(const Unit& u) const { return u.e * brows + u.pn * BM; }
};

typedef int v8i32 __attribute__((ext_vector_type(8)));
typedef int v4i32 __attribute__((ext_vector_type(4)));
__device__ __forceinline__ v8i32 cat8(bf16x8 a, bf16x8 b) { const v4i32 x = __builtin_bit_cast(v4i32, a), y = __builtin_bit_cast(v4i32, b); return __builtin_shufflevector(x, y, 0, 1, 2, 3, 4, 5, 6, 7); }
template <class Epi, class Sched, bool FP8 = false, int SW = 0x7f7f7f7f, int SA = 0x7f7f7f7f>
__device__ __forceinline__ void gemm_phase(LAS unsigned char* lds, const char* Abase, const char* Bbase, const Sched& S, const Epi& E) {
    const int tid = threadIdx.x, wid = __builtin_amdgcn_readfirstlane(tid >> 6), lane = tid & 63, wr = wid >> 2, wc = wid & 3, fr = lane & 15, fq = lane >> 4;
    constexpr int ROWB = FP8 ? KD : 2 * KD, nt = ROWB / 128;
    int RA[2], CA[2]; unsigned voffB[2];
#pragma unroll
    for (int i = 0; i < 2; ++i) { int R, C; stage_rc(tid * 16 + i * 8192, R, C); const int Rb = Epi::PERM ? ((R & ~31) + perm32(R & 31)) : R;
        RA[i] = R; CA[i] = C * 2; voffB[i] = (unsigned)(Rb * ROWB + C * 2); }
    const size_t kstep = (size_t)(BK * 2);
    const size_t hstep = (size_t)HALF * ROWB;
    const unsigned ldsw = (unsigned)wid * 1024u;
    const int aoff = lds_byte(wr * 64 + fr, fq * 8), boff = lds_byte(wc * 32 + fr, fq * 8);
#define PG8_SA(b, h) (((b) * 2 + (h)) * HTB)
#define PG8_SB(b, h) ((4 + (b) * 2 + (h)) * HTB)
#define PG8_STAGE(bufoff, gbase, voff) do { _Pragma("unroll") for (int _i = 0; _i < 2; ++_i) \
        __builtin_amdgcn_global_load_lds((const unsigned*)((const char*)(gbase) + (voff)[_i]), (LAS unsigned*)(lds + (bufoff) + ldsw + _i * 8192), 16, 0, 0); } while (0)
#define PG8_LDA(dst, b, h) do { _Pragma("unroll") for (int m = 0; m < 4; ++m) _Pragma("unroll") for (int k = 0; k < 2; ++k) dst[m][k] = *(const LAS bf16x8*)(lds + PG8_SA(b, h) + aoff + m * 2048 + k * 1024); } while (0)
#define PG8_LDB(dst, b, h) do { _Pragma("unroll") for (int n = 0; n < 2; ++n) _Pragma("unroll") for (int k = 0; k < 2; ++k) dst[n][k] = *(const LAS bf16x8*)(lds + PG8_SB(b, h) + boff + n * 2048 + k * 1024); } while (0)
#define PG8_MMA(ai, bj, At, Bt) do { __builtin_amdgcn_s_setprio(1); if constexpr (FP8) { _Pragma("unroll") for (int m = 0; m < 4; ++m) _Pragma("unroll") for (int n = 0; n < 2; ++n) \
        acc[ai][bj][m][n] = __builtin_amdgcn_mfma_scale_f32_16x16x128_f8f6f4(cat8(Bt[n][0], Bt[n][1]), cat8(At[m][0], At[m][1]), acc[ai][bj][m][n], 0, 0, 0, SW, 0, SA); } \
        else { _Pragma("unroll") for (int m = 0; m < 4; ++m) _Pragma("unroll") for (int n = 0; n < 2; ++n) _Pragma("unroll") for (int k = 0; k < 2; ++k) \
        acc[ai][bj][m][n] = __builtin_amdgcn_mfma_f32_16x16x32_bf16(Bt[n][k], At[m][k], acc[ai][bj][m][n], 0, 0, 0); } __builtin_amdgcn_s_setprio(0); } while (0)
#define PG8_WAIT_V(n) asm volatile("s_waitcnt vmcnt(" #n ")" ::: "memory")
#define PG8_WAIT_L(n) asm volatile("s_waitcnt lgkmcnt(" #n ")" ::: "memory")
#define PG8_BAR __builtin_amdgcn_s_barrier()
#define PG8_SCHED __builtin_amdgcn_sched_barrier(0)
    Unit cur, nxt; int ui = 0;
    if (!S.next(0, cur)) return;
    f32x4 acc[2][2][4][2]; f32x4 bini[2][2];
#pragma unroll
    for (int b = 0; b < 2; ++b)
#pragma unroll
        for (int n = 0; n < 2; ++n) bini[b][n] = Epi::BIAS_INIT ? E.bias4(cur, b, n, wc, fq) : (f32x4){0.f, 0.f, 0.f, 0.f};
#pragma unroll
    for (int a = 0; a < 2; ++a)
#pragma unroll
        for (int b = 0; b < 2; ++b)
#pragma unroll
            for (int m = 0; m < 4; ++m)
#pragma unroll
                for (int n = 0; n < 2; ++n) acc[a][b][m][n] = bini[b][n];
    bf16x8 At[4][2], B0[2][2], B1[2][2];
    unsigned oA[2][2];
#pragma unroll
    for (int h = 0; h < 2; ++h)
#pragma unroll
        for (int i = 0; i < 2; ++i) oA[h][i] = (unsigned)(S.a_row(cur, h, RA[i]) * ROWB + CA[i]);
    const char* cB = Bbase + (size_t)S.b_row(cur) * ROWB;
    const char* cA = Abase;
    PG8_STAGE(PG8_SB(0, 0), cB, voffB); PG8_STAGE(PG8_SA(0, 0), cA, oA[0]); PG8_STAGE(PG8_SB(0, 1), cB + hstep, voffB); PG8_STAGE(PG8_SA(0, 1), cA, oA[1]);
    if (wr == 1) PG8_BAR;
    PG8_WAIT_V(4); PG8_BAR;
    PG8_STAGE(PG8_SB(1, 0), cB + kstep, voffB); PG8_STAGE(PG8_SA(1, 0), cA + kstep, oA[0]); PG8_STAGE(PG8_SB(1, 1), cB + hstep + kstep, voffB);
    PG8_WAIT_V(6); PG8_BAR;
    for (;;) {
        const bool has_next = S.next(ui + 1, nxt);
        const char* nB = has_next ? Bbase + (size_t)S.b_row(nxt) * ROWB : cB;
        for (int t = 0; t < nt; t += 2) {
            const bool last = (t == nt - 2);
            const char* a1 = cA + (size_t)(t + 1) * kstep;
            const char* a2 = last ? cA : cA + (size_t)(t + 2) * kstep; const char* b2 = last ? nB : cB + (size_t)(t + 2) * kstep;
            const char* a3 = a2 + kstep; const char* b3 = b2 + kstep;
            PG8_LDB(B0, 0, 0); PG8_SCHED; PG8_LDA(At, 0, 0); PG8_STAGE(PG8_SA(1, 1), a1, oA[1]);
            if (last && has_next) {
#pragma unroll
                for (int h = 0; h < 2; ++h)
#pragma unroll
                    for (int i = 0; i < 2; ++i) oA[h][i] = (unsigned)(S.a_row(nxt, h, RA[i]) * ROWB + CA[i]);
            }
            PG8_WAIT_L(8); PG8_BAR; PG8_WAIT_L(0); PG8_MMA(0, 0, At, B0); PG8_BAR; PG8_SCHED;
            PG8_LDB(B1, 0, 1); PG8_STAGE(PG8_SB(0, 0), b2, voffB);
            PG8_BAR; PG8_WAIT_L(0); PG8_MMA(0, 1, At, B1); PG8_BAR;
            PG8_LDA(At, 0, 1); PG8_STAGE(PG8_SA(0, 0), a2, oA[0]);
            PG8_BAR; PG8_WAIT_L(0); PG8_MMA(1, 0, At, B0); PG8_BAR; PG8_SCHED;
            PG8_STAGE(PG8_SB(0, 1), b2 + hstep, voffB);
            PG8_WAIT_V(6); PG8_BAR; PG8_MMA(1, 1, At, B1); PG8_BAR;
            PG8_LDB(B0, 1, 0); PG8_SCHED; PG8_LDA(At, 1, 0); PG8_STAGE(PG8_SA(0, 1), a2, oA[1]);
            PG8_WAIT_L(8); PG8_BAR; PG8_WAIT_L(0); PG8_MMA(0, 0, At, B0); PG8_BAR; PG8_SCHED;
            PG8_LDB(B1, 1, 1); PG8_STAGE(PG8_SB(1, 0), b3, voffB);
            PG8_BAR; PG8_WAIT_L(0); PG8_MMA(0, 1, At, B1); PG8_BAR;
            PG8_LDA(At, 1, 1); PG8_STAGE(PG8_SA(1, 0), a3, oA[0]);
            PG8_BAR; PG8_WAIT_L(0); PG8_MMA(1, 0, At, B0); PG8_BAR; PG8_SCHED;
            PG8_STAGE(PG8_SB(1, 1), b3 + hstep, voffB);
            PG8_WAIT_V(6); PG8_BAR; PG8_MMA(1, 1, At, B1); PG8_BAR;
        }
        int l2 = threadIdx.x & 63; asm volatile("" : "+v"(l2));
        const int fr2 = l2 & 15, fq2 = l2 >> 4;
        if (Epi::BIAS_INIT && has_next) {
#pragma unroll
            for (int b = 0; b < 2; ++b)
#pragma unroll
                for (int n = 0; n < 2; ++n) bini[b][n] = E.bias4(nxt, b, n, wc, fq2);
        }
        E(acc, cur, wr, wc, fr2, fq2);
        if (!has_next) break;
#pragma unroll
        for (int a = 0; a < 2; ++a)
#pragma unroll
            for (int b = 0; b < 2; ++b)
#pragma unroll
                for (int m = 0; m < 4; ++m)
#pragma unroll
                    for (int n = 0; n < 2; ++n) acc[a][b][m][n] = bini[b][n];
        cur = nxt; cB = nB; ++ui;
    }
    PG8_WAIT_V(0);
    if (wr == 0) PG8_BAR;
    PG8_BAR;
#undef PG8_SA
#undef PG8_SB
#undef PG8_STAGE
#undef PG8_LDA
#undef PG8_LDB
#undef PG8_MMA
#undef PG8_WAIT_V
#undef PG8_WAIT_L
#undef PG8_BAR
#undef PG8_SCHED
}
}

struct EpiInProj {
    static constexpr bool PERM = true, BIAS_INIT = false;
    bf16_t *u, *q, *k, *v, *iq, *ik; float* iw; const float* ropeQK; const float* ropeIX;
    __device__ __forceinline__ f32x4 bias4(const pg8::Unit&, int, int, int, int) const { return (f32x4){0.f, 0.f, 0.f, 0.f}; }
    __device__ __forceinline__ void operator()(f32x4 (&acc)[2][2][4][2], const pg8::Unit& un, int wr, int wc, int fr, int fq) const {
        const int lane = threadIdx.x & 63;
#pragma unroll
        for (int bj = 0; bj < 2; ++bj) {
            const int gc = un.e * 256 + bj * 128;
            bf16_t* dst; int ld; int kind = 0;
            const int cin = wc * 32 + 8 * fq;
            if (gc < 256) { dst = u + gc + cin; ld = 256; }
            else if (gc < 1024) { dst = q + (gc - 256) + cin; ld = 768; kind = (wc == 0) ? 1 : 0; }
            else if (gc < 1280) { dst = k + (gc - 1024) + cin; ld = 256; kind = (wc == 0) ? 1 : 0; }
            else if (gc < 1536) { dst = v + (gc - 1280) + cin; ld = 256; }
            else if (gc < 2048) { dst = iq + (gc - 1536) + cin; ld = 512; kind = ((wc & 1) == 0) ? 2 : 0; }
            else if (gc == 2048) { if (wc >= 2) { if (wc == 2 && fq == 0) {
#pragma unroll
                        for (int ai = 0; ai < 2; ++ai)
#pragma unroll
                            for (int m = 0; m < 4; ++m) { const int row = un.pm * 256 + ai * 128 + wr * 64 + m * 16 + fr;
                                *(f32x4*)(iw + (size_t)row * 8) = acc[ai][bj][m][0]; *(f32x4*)(iw + (size_t)row * 8 + 4) = acc[ai][bj][m][1]; } }
                    continue; }
                dst = ik + cin; ld = 64; kind = (wc == 0) ? 2 : 0; }
            else continue;
#pragma unroll
            for (int ai = 0; ai < 2; ++ai)
#pragma unroll
                for (int m = 0; m < 4; ++m) {
                    const int row = un.pm * 256 + ai * 128 + wr * 64 + m * 16 + fr;
                    f32x4 v0 = acc[ai][bj][m][0], v1 = acc[ai][bj][m][1];
                    if (kind == 1) {
                        const float* rp = ropeQK + (size_t)row * 32 + 8 * (fq & 1);
                        const f32x4 c0 = *(const f32x4*)rp, c1 = *(const f32x4*)(rp + 4), s0 = *(const f32x4*)(rp + 16), s1 = *(const f32x4*)(rp + 20);
                        f32x4 p0, p1;
#pragma unroll
                        for (int j = 0; j < 4; ++j) { p0[j] = __shfl_xor(v0[j], 32); p1[j] = __shfl_xor(v1[j], 32); }
                        const float sg = (fq < 2) ? -1.f : 1.f;
                        v0 = v0 * c0 + sg * (p0 * s0); v1 = v1 * c1 + sg * (p1 * s1);
                    } else if (kind == 2) {
                        const float* rp = ropeIX + (size_t)row * 16;
                        const f32x4 c0 = *(const f32x4*)rp, c1 = *(const f32x4*)(rp + 4), s0 = *(const f32x4*)(rp + 8), s1 = *(const f32x4*)(rp + 12);
                        f32x4 p0, p1;
#pragma unroll
                        for (int j = 0; j < 4; ++j) { p0[j] = __shfl_xor(v0[j], 16); p1[j] = __shfl_xor(v1[j], 16); }
                        if (fq < 2) { const float sg = (fq == 0) ? -1.f : 1.f; v0 = v0 * c0 + sg * (p0 * s0); v1 = v1 * c1 + sg * (p1 * s1); }
                    }
                    u32x4 w; w.x = cvt_pk_bf16(v0[0], v0[1]); w.y = cvt_pk_bf16(v0[2], v0[3]); w.z = cvt_pk_bf16(v1[0], v1[1]); w.w = cvt_pk_bf16(v1[2], v1[3]);
                    *(u32x4*)(dst + (size_t)row * ld) = w;
                }
        }
        (void)lane;
    }
};
struct EpiMix {
    static constexpr bool PERM = true, BIAS_INIT = false;
    bf16_t* mix;
    __device__ __forceinline__ f32x4 bias4(const pg8::Unit&, int, int, int, int) const { return (f32x4){0.f, 0.f, 0.f, 0.f}; }
    __device__ __forceinline__ void operator()(f32x4 (&acc)[2][2][4][2], const pg8::Unit& un, int wr, int wc, int fr, int fq) const {
        const int row0 = un.pm * 256 + wr * 64 + fr, col0 = un.pn * 256 + wc * 32 + 8 * fq;
#pragma unroll
        for (int bj = 0; bj < 2; ++bj)
#pragma unroll
            for (int ai = 0; ai < 2; ++ai)
#pragma unroll
                for (int m = 0; m < 4; ++m) {
                    const f32x4 v0 = acc[ai][bj][m][0], v1 = acc[ai][bj][m][1];
                    u32x4 w; w.x = cvt_pk_bf16(v0[0], v0[1]); w.y = cvt_pk_bf16(v0[2], v0[3]); w.z = cvt_pk_bf16(v1[0], v1[1]); w.w = cvt_pk_bf16(v1[2], v1[3]);
                    *(u32x4*)(mix + (size_t)(row0 + ai * 128 + m * 16) * 1024 + col0 + bj * 128) = w;
                }
    }
};
struct EpiGateUp {
    static constexpr bool PERM = true, BIAS_INIT = true;
    unsigned char* act; const float* bias; unsigned* rdy;
    __device__ __forceinline__ f32x4 bias4(const pg8::Unit& un, int bj, int n, int wc, int fq) const { return *(const f32x4*)(bias + (size_t)un.e * 2048 + bj * 1024 + un.pn * 128 + wc * 32 + 8 * fq + 4 * n); }
    __device__ __forceinline__ void operator()(f32x4 (&acc)[2][2][4][2], const pg8::Unit& un, int wr, int wc, int fr, int fq) const {
        const int row0 = un.pm * 256 + wr * 64 + fr, col0 = un.pn * 128 + wc * 32 + 8 * fq;
#pragma unroll
        for (int ai = 0; ai < 2; ++ai)
#pragma unroll
            for (int m = 0; m < 4; ++m) {
                float o[8];
#pragma unroll
                for (int n = 0; n < 2; ++n) {
                    const f32x4 gt = acc[ai][0][m][n], up = acc[ai][1][m][n];
#pragma unroll
                    for (int j = 0; j < 4; ++j) {
                        const float gg = fminf(gt[j], 7.0f), uu = fminf(fmaxf(up[j], -7.0f), 7.0f);
                        const float sig = __builtin_amdgcn_rcpf(1.0f + __builtin_amdgcn_exp2f(-1.702f * 1.4426950408889634f * gg));
                        o[4 * n + j] = (uu * 8.0f + 8.0f) * gg * sig;
                    }
                }
                u32x2 w; w.x = pk4_fp8(o[0], o[1], o[2], o[3]); w.y = pk4_fp8(o[4], o[5], o[6], o[7]);
                const unsigned dofs = (unsigned)((row0 + ai * 128 + m * 16) * 1024 + col0);
                if (un.pm < 32) asm volatile("global_store_dwordx2 %0, %1, %2 sc1" :: "v"(dofs), "v"(w), "s"(act) : "memory");
                else *(u32x2*)(act + dofs) = w;
            }
        if (un.pm < 32) {
            asm volatile("s_waitcnt vmcnt(0)" ::: "memory");
            if ((threadIdx.x & 63) == 0) __hip_atomic_fetch_add(rdy + un.pm, 1u, __ATOMIC_RELAXED, __HIP_MEMORY_SCOPE_AGENT);
        }
    }
};
struct EpiDown {
    static constexpr bool PERM = true, BIAS_INIT = false;
    unsigned char* y; const float* bias;
    __device__ __forceinline__ f32x4 bias4(const pg8::Unit& un, int bj, int n, int wc, int fq) const { return *(const f32x4*)(bias + (size_t)un.e * 1024 + un.pn * 256 + bj * 128 + wc * 32 + 8 * fq + 4 * n); }
    __device__ __forceinline__ void operator()(f32x4 (&acc)[2][2][4][2], const pg8::Unit& un, int wr, int wc, int fr, int fq) const {
        const int row0 = un.pm * 256 + wr * 64 + fr, col0 = un.pn * 256 + wc * 32 + 8 * fq;
        const float* bp = bias + (size_t)un.e * 1024 + col0;
#pragma unroll
        for (int bj = 0; bj < 2; ++bj) {
            const f32x4 b0 = *(const f32x4*)(bp + bj * 128) * 64.0f, b1 = *(const f32x4*)(bp + bj * 128 + 4) * 64.0f;
#pragma unroll
            for (int ai = 0; ai < 2; ++ai)
#pragma unroll
                for (int m = 0; m < 4; ++m) {
                    const f32x4 v0 = acc[ai][bj][m][0] * 64.0f + b0, v1 = acc[ai][bj][m][1] * 64.0f + b1;
#define CL8(x) __builtin_amdgcn_fmed3f((x), -448.f, 448.f)
                    u32x2 w; w.x = pk4_fp8(CL8(v0[0]), CL8(v0[1]), CL8(v0[2]), CL8(v0[3])); w.y = pk4_fp8(CL8(v1[0]), CL8(v1[1]), CL8(v1[2]), CL8(v1[3]));
#undef CL8
                    *(u32x2*)(y + (size_t)(row0 + ai * 128 + m * 16) * 1024 + col0 + bj * 128) = w;
                }
        }
    }
};

struct Args { const void* in[18]; float* out; unsigned char* ws; int ph_lo, ph_hi; };
struct Frame {
    LAS unsigned char* lds; int tid, lane, wave, G, bid;
    const float *x, *ln_in_g, *ln_in_b, *w_in, *w_pool, *pool_scale, *w_out, *ln1_g, *ln1_b, *w_router, *b_router, *w_gu, *b_gu, *w_dn, *b_dn, *ln2_g, *ln2_b;
    const int* positions; float* out; unsigned char* ws; unsigned* ctl;
};

typedef const Args __attribute__((address_space(4))) * KArgP;
__device__ __forceinline__ void frame_refresh(Frame& F) {
    KArgP ap = (KArgP)__builtin_amdgcn_kernarg_segment_ptr(); asm volatile("" : "+s"(ap));
    int t_ = threadIdx.x; asm volatile("" : "+v"(t_)); F.tid = t_; F.lane = t_ & 63;
    F.x = (const float*)ap->in[0]; F.positions = (const int*)ap->in[1]; F.ln_in_g = (const float*)ap->in[2]; F.ln_in_b = (const float*)ap->in[3];
    F.w_in = (const float*)ap->in[4]; F.w_pool = (const float*)ap->in[5]; F.pool_scale = (const float*)ap->in[6]; F.w_out = (const float*)ap->in[7];
    F.ln1_g = (const float*)ap->in[8]; F.ln1_b = (const float*)ap->in[9]; F.w_router = (const float*)ap->in[10]; F.b_router = (const float*)ap->in[11];
    F.w_gu = (const float*)ap->in[12]; F.b_gu = (const float*)ap->in[13]; F.w_dn = (const float*)ap->in[14]; F.b_dn = (const float*)ap->in[15];
    F.ln2_g = (const float*)ap->in[16]; F.ln2_b = (const float*)ap->in[17];
    F.out = ap->out; F.ws = ap->ws; F.ctl = (unsigned*)(ap->ws + WS_CTL);
}
struct TrItem { const float* src; unsigned char* dst; int ldw, ldt, fp8; };
__device__ __forceinline__ TrItem mk_item(const float* W, unsigned char* WT, int ldw, int k0, int n0, int ldt, int drow0, int fp8) {
    TrItem t; t.src = W + (size_t)k0 * ldw + n0; t.dst = WT + ((size_t)drow0 * ldt + k0) * (fp8 ? 1 : 2); t.ldw = ldw; t.ldt = ldt; t.fp8 = fp8; return t;
}
__device__ __forceinline__ void tr_load(const TrItem& t, float (&tmp)[32], int lane) {
    const float* p = t.src + (size_t)(lane >> 5) * t.ldw + (lane & 31);
#pragma unroll
    for (int i = 0; i < 32; ++i) tmp[i] = __builtin_nontemporal_load(p + (size_t)(2 * i) * t.ldw);
}
__device__ __forceinline__ void tr_store(const TrItem& t, const float (&tmp)[32], LAS float* scr, int lane) {
#pragma unroll
    for (int i = 0; i < 32; ++i) { const int kk = 2 * i + (lane >> 5); scr[kk * 33 + (lane & 31)] = tmp[i]; }
    LDS_WAIT();
    if (t.fp8) {
        const int n = lane >> 1, kb = 32 * (lane & 1); const LAS float* sp = scr + kb * 33 + n;
        unsigned o[8];
#pragma unroll
        for (int q = 0; q < 8; ++q) { float v[4];
#pragma unroll
            for (int j = 0; j < 4; ++j) v[j] = __builtin_amdgcn_fmed3f(sp[(4 * q + j) * 33] * 64.0f, -448.f, 448.f);
            o[q] = pk4_fp8(v[0], v[1], v[2], v[3]); }
        unsigned char* dp = t.dst + (size_t)n * 1024 + kb;
        *(u32x4*)dp = (u32x4){o[0], o[1], o[2], o[3]}; *(u32x4*)(dp + 16) = (u32x4){o[4], o[5], o[6], o[7]};
    } else {
        const int c = lane & 7;
#pragma unroll
        for (int j = 0; j < 4; ++j) { const int n = (lane >> 3) + 8 * j; const LAS float* sp = scr + (8 * c) * 33 + n;
            u32x4 o; o.x = cvt_pk_bf16(sp[0 * 33], sp[1 * 33]); o.y = cvt_pk_bf16(sp[2 * 33], sp[3 * 33]); o.z = cvt_pk_bf16(sp[4 * 33], sp[5 * 33]); o.w = cvt_pk_bf16(sp[6 * 33], sp[7 * 33]);
            *(u32x4*)(t.dst + ((size_t)n * t.ldt + 8 * c) * 2) = o; }
    }
    LDS_WAIT();
}
__device__ __forceinline__ TrItem moe_item(Frame& F, int r) {
    constexpr int I_GU = NE * 16 * 64;
    if (r < I_GU) { const int e = r / 1024, rr = r % 1024, kb = rr / 64, nb = rr % 64, n0 = 32 * nb, bj = n0 / 1024, rem = n0 % 1024, pn = rem / 128, j0 = rem % 128;
        return mk_item(F.w_gu + (size_t)e * 1024 * 2048, F.ws + WS_BTGU + (size_t)e * 2048 * 1024, 2048, 64 * kb, n0, 1024, pn * 256 + bj * 128 + j0, 1); }
    r -= I_GU; const int e = r / 512, rr = r % 512, kb = rr / 32, nb = rr % 32;
    return mk_item(F.w_dn + (size_t)e * 1024 * 1024, F.ws + WS_BTDN + (size_t)e * 1024 * 1024, 1024, 64 * kb, 32 * nb, 1024, 32 * nb, 1);
}
__device__ __forceinline__ void convert_range(Frame& F, int first, int n, int widx, int nw) {
    LAS float* scr = (LAS float*)(F.lds + F.wave * 16384);
    int base = 2 * widx; if (base >= n) return;
    float va[32], vb[32], vc[32], vd[32];
    TrItem ta = moe_item(F, first + base), tb = moe_item(F, first + base + 1);
    tr_load(ta, va, F.lane); tr_load(tb, vb, F.lane);
    for (;;) {
        const int nb = base + 2 * nw; const bool more = nb < n;
        const TrItem tc = moe_item(F, first + (more ? nb : base)), td = moe_item(F, first + (more ? nb : base) + 1);
        if (more) { tr_load(tc, vc, F.lane); tr_load(td, vd, F.lane); }
        tr_store(ta, va, scr, F.lane); tr_store(tb, vb, scr, F.lane);
        if (!more) break;
        const int nb2 = nb + 2 * nw; const bool more2 = nb2 < n;
        ta = moe_item(F, first + (more2 ? nb2 : nb)); tb = moe_item(F, first + (more2 ? nb2 : nb) + 1);
        if (more2) { tr_load(ta, va, F.lane); tr_load(tb, vb, F.lane); }
        tr_store(tc, vc, scr, F.lane); tr_store(td, vd, scr, F.lane);
        if (!more2) break;
        base = nb2;
    }
}
__device__ __forceinline__ void cvq_pull(Frame& F, unsigned* head, int first, int npairs) {
    LAS float* scr = (LAS float*)(F.lds + F.wave * 16384);
    for (;;) {
        unsigned c = 0; if (F.lane == 0) c = __hip_atomic_fetch_add(head, 1u, __ATOMIC_RELAXED, __HIP_MEMORY_SCOPE_AGENT);
        c = (unsigned)__builtin_amdgcn_readfirstlane((int)c);
        if (c >= (unsigned)npairs) break;
        const int r = 2 * (first + (int)c);
        const TrItem ta = moe_item(F, r), tb = moe_item(F, r + 1);
        float va[32], vb[32];
        tr_load(ta, va, F.lane); tr_load(tb, vb, F.lane);
        tr_store(ta, va, scr, F.lane); tr_store(tb, vb, scr, F.lane);
    }
}
__constant__ double ROPE_QK_FREQ[16] = {1.0, 0.44036660267178046, 0.19392274474868576, 0.08539710028576561, 0.03760603093086393, 0.016560440080994446, 0.007292664737217109, 0.003211445994752591,
    0.001414213562373095, 0.000622772421914596, 0.0002742481756762073, 0.00012076973741146504, 5.318295896944988e-05, 2.341999896140934e-05, 1.031338537721246e-05, 4.5416704806078695e-06};
__constant__ double ROPE_IX_FREQ[8] = {1.0, 0.19392274474868576, 0.03760603093086393, 0.007292664737217109, 0.001414213562373095, 0.0002742481756762073, 5.318295896944988e-05, 1.031338537721246e-05};

__device__ __forceinline__ void p0_prologue(Frame& F) {
    LAS float* scr = (LAS float*)(F.lds + F.wave * 16384);
    const int gw = F.bid * 8 + F.wave, NGW = F.G * 8;
    const int gt = F.bid * NTHREADS + F.tid, NGT = F.G * NTHREADS;
    bf16_t* BtIn = (bf16_t*)(F.ws + WS_BTIN); bf16_t* BtOut = (bf16_t*)(F.ws + WS_BTOUT);
    bf16_t* WpT = (bf16_t*)(F.ws + WS_WPT);
    constexpr int I_IN = 16 * 66, I_OUT = 16 * 32, I_POOL = 8, I_MOE = NE * 16 * 64 + NE * 16 * 32;
    constexpr int NSMALL = I_IN + I_OUT + I_POOL, NITEMS = NSMALL + (I_MOE - CV_HIDDEN);
    auto decode = [&](int it) -> TrItem {
        int r = it;
        if (r < I_IN) { const int kb = r / 66, nb = r % 66;
            if (nb >= 8 && nb < 48) return mk_item(F.w_in, F.ws + WS_BTIN8, INW, 64 * kb, 32 * nb, 1024, 32 * nb, 1);
            return mk_item(F.w_in, (unsigned char*)BtIn, INW, 64 * kb, 32 * nb, 1024, 32 * nb, 0); } r -= I_IN;
        if (r < I_OUT) { const int kb = r / 32, nb = r % 32; return mk_item(F.w_out, (unsigned char*)BtOut, 1024, 64 * kb, 32 * nb, 1024, 32 * nb, 0); } r -= I_OUT;
        if (r < I_POOL) { const int g = r / 2, nb = r % 2; return mk_item(F.w_pool + g * 4096, (unsigned char*)(WpT + g * 4096), 64, 0, 32 * nb, 64, 32 * nb, 0); } r -= I_POOL;
        return moe_item(F, CV_HIDDEN + r);
    };
    for (int it = gw; it < NITEMS; it += 2 * NGW) {
        const bool two = (it + NGW < NITEMS);
        const TrItem ta = decode(it), tb = decode(two ? it + NGW : it);
        float va[32], vb[32];
        tr_load(ta, va, F.lane); if (two) tr_load(tb, vb, F.lane);
        tr_store(ta, va, scr, F.lane); if (two) tr_store(tb, vb, scr, F.lane);
    }
    for (int i = gt; i < 192 * 1024; i += NGT) { const int n = 2112 + i / 1024, k = i % 1024; const float v = (n < INW) ? F.w_in[(size_t)k * INW + n] : 0.f;
        BtIn[(size_t)n * 1024 + k] = (bf16_t)(cvt_pk_bf16(v, 0.f) & 0xffffu); }
    { float* wrA = (float*)(F.ws + WS_WRA);
      for (int i = gt; i < 32768; i += NGT) { const int ii = i & 3, e = (i >> 2) & 31, kh = (i >> 7) & 1, c = i >> 8; wrA[i] = F.w_router[(8 * c + 4 * kh + ii) * 32 + e]; } }
    { float* rq = (float*)(F.ws + WS_ROPEQK); float* ri = (float*)(F.ws + WS_ROPEIX);
      for (int i = gt; i < T * 24; i += NGT) { const int tok = i / 24, j = i % 24; const double pos = (double)F.positions[tok];
          const double inv = (j < 16) ? ROPE_QK_FREQ[j] : ROPE_IX_FREQ[j - 16];
          double rev = pos * inv * 0.15915494309189535; rev -= __builtin_floor(rev);
          const float c = __builtin_amdgcn_cosf((float)rev), s = __builtin_amdgcn_sinf((float)rev);
          if (j < 16) { rq[(size_t)tok * 32 + j] = c; rq[(size_t)tok * 32 + 16 + j] = s; } else { ri[(size_t)tok * 16 + (j - 16)] = c; ri[(size_t)tok * 16 + 8 + (j - 16)] = s; } } }
    if (F.bid == 0 && F.tid < 64) { F.ctl[CW_CNT + F.tid] = 0u; if (F.tid == 0) F.ctl[CW_ATTQ] = 0u; }
    { bf16_t* hA = (bf16_t*)(F.ws + WS_HA); float* stats = (float*)(F.ws + WS_STATS);
      f32x4 gv[4], bv[4];
#pragma unroll
      for (int j = 0; j < 4; ++j) { gv[j] = ((const f32x4*)F.ln_in_g)[F.lane + 64 * j]; bv[j] = ((const f32x4*)F.ln_in_b)[F.lane + 64 * j]; }
      f32x4 nx[4];
      if (gw < T) { const f32x4* xr = (const f32x4*)(F.x + (size_t)gw * 1024) + F.lane;
#pragma unroll
          for (int j = 0; j < 4; ++j) nx[j] = __builtin_nontemporal_load(xr + 64 * j); }
      for (int m = gw; m < T; m += NGW) {
          f32x4 v[4]; float s = 0.f;
#pragma unroll
          for (int j = 0; j < 4; ++j) { v[j] = nx[j]; s += (v[j].x + v[j].y) + (v[j].z + v[j].w); }
          if (m + NGW < T) { const f32x4* xr = (const f32x4*)(F.x + (size_t)(m + NGW) * 1024) + F.lane;
#pragma unroll
              for (int j = 0; j < 4; ++j) nx[j] = __builtin_nontemporal_load(xr + 64 * j); }
          const float mean = wave_sum(s) * (1.f / 1024.f); float s2 = 0.f;
#pragma unroll
          for (int j = 0; j < 4; ++j) { v[j] = v[j] - mean; s2 += (v[j].x * v[j].x + v[j].y * v[j].y) + (v[j].z * v[j].z + v[j].w * v[j].w); }
          const float rstd = 1.f / sqrtf(wave_sum(s2) * (1.f / 1024.f) + LN_EPS);
          u32x2* o8 = (u32x2*)(hA + (size_t)m * 1024) + F.lane; unsigned* q8 = (unsigned*)(F.ws + WS_HA8 + (size_t)m * 1024) + F.lane;
#pragma unroll
          for (int j = 0; j < 4; ++j) { const f32x4 h = v[j] * rstd * gv[j] + bv[j]; u32x2 w; w.x = cvt_pk_bf16(h.x, h.y); w.y = cvt_pk_bf16(h.z, h.w); o8[64 * j] = w; q8[64 * j] = pk4_fp8(h.x, h.y, h.z, h.w); }
          if (F.lane == 0) { stats[(size_t)m * 2] = mean; stats[(size_t)m * 2 + 1] = rstd; }
      } }
}

__device__ __forceinline__ void p2_pool(Frame& F) {
    const bf16_t* U = (const bf16_t*)(F.ws + WS_U); const bf16_t* WpT = (const bf16_t*)(F.ws + WS_WPT); bf16_t* cat = (bf16_t*)(F.ws + WS_CAT);
    LAS bf16_t* dl = (LAS bf16_t*)F.lds;
    LAS bf16_t* ul = (LAS bf16_t*)(F.lds + 33792);
    for (int tile = F.bid; tile < T / 64; tile += F.G) {
        const int t0 = tile * 64, pos0 = t0 % SEQ;
        __syncthreads();
        for (int i = F.tid; i < 79 * 32; i += NTHREADS) { const int r = i >> 5, c8 = i & 31; u32x4 v = {0u, 0u, 0u, 0u};
            if (pos0 + r - 15 >= 0) v = *(const u32x4*)(U + (size_t)(t0 + r - 15) * 256 + c8 * 8);
            *(LAS u32x4*)(ul + r * 256 + c8 * 8) = v; }
        __syncthreads();
        { const int c = F.tid & 255, half = F.tid >> 8, w = 2 << (c >> 6);
          const int ts = half * 32; float sum = 0.f;
          for (int d = 1; d < w; ++d) sum += __uint_as_float((unsigned)ul[(15 + ts - d) * 256 + c] << 16);
#pragma unroll 4
          for (int tt = 0; tt < 32; ++tt) { const int tl = ts + tt, p = pos0 + tl; const float cur = __uint_as_float((unsigned)ul[(15 + tl) * 256 + c] << 16);
              sum += cur; const int cnt = (p + 1 < w) ? (p + 1) : w;
              const float diff = sum / (float)cnt - cur;
              dl[tl * 264 + c] = (bf16_t)(cvt_pk_bf16(diff, 0.f) & 0xffffu);
              sum -= __uint_as_float((unsigned)ul[(15 + tl - (w - 1)) * 256 + c] << 16); } }
        __syncthreads();
        { const int g = F.wave & 3, th = F.wave >> 2, r32 = F.lane & 31, hi = F.lane >> 5;
          f32x16 c0 = {}, c1 = {};
#pragma unroll
          for (int s = 0; s < 4; ++s) {
              const bf16x8 a = *(const LAS bf16x8*)(dl + (th * 32 + r32) * 264 + g * 64 + 16 * s + 8 * hi);
              const bf16x8 b0 = *(const bf16x8*)(WpT + (size_t)g * 4096 + (size_t)r32 * 64 + 16 * s + 8 * hi);
              const bf16x8 b1 = *(const bf16x8*)(WpT + (size_t)g * 4096 + (size_t)(32 + r32) * 64 + 16 * s + 8 * hi);
              c0 = __builtin_amdgcn_mfma_f32_32x32x16_bf16(a, b0, c0, 0, 0, 0);
              c1 = __builtin_amdgcn_mfma_f32_32x32x16_bf16(a, b1, c1, 0, 0, 0); }
          const float ps0 = F.pool_scale[g * 64 + r32], ps1 = F.pool_scale[g * 64 + 32 + r32];
#pragma unroll
          for (int r = 0; r < 16; ++r) { const int tok = t0 + th * 32 + crow(r, hi);
              cat[(size_t)tok * 1024 + g * 64 + r32] = (bf16_t)(cvt_pk_bf16(c0[r] * ps0, 0.f) & 0xffffu);
              cat[(size_t)tok * 1024 + g * 64 + 32 + r32] = (bf16_t)(cvt_pk_bf16(c1[r] * ps1, 0.f) & 0xffffu); } }
    }
    __syncthreads();
}

constexpr int IDX_RING_OFF = 0, IDX_SLOT = 32768;
constexpr int IDX_HIST_OFF = 3 * IDX_SLOT;
constexpr int IDX_RES_OFF = IDX_HIST_OFF + 24576;
__device__ __forceinline__ void hist_find16(const LAS unsigned* hist, int li, unsigned need, unsigned& bsel, unsigned& above) {
    const u32x4 h0 = *(const LAS u32x4*)(hist + 4 * li);
    const unsigned c[8] = {h0.x & 0xffffu, h0.x >> 16, h0.y & 0xffffu, h0.y >> 16, h0.z & 0xffffu, h0.z >> 16, h0.w & 0xffffu, h0.w >> 16};
    unsigned s = 0;
#pragma unroll
    for (int k = 0; k < 8; ++k) s += c[k];
    unsigned S = s;
#pragma unroll
    for (int d = 1; d < 32; d <<= 1) { const unsigned o = __shfl_down(S, d, 32); if (li + d < 32) S += o; }
    const unsigned excl = S - s;
    unsigned b = 0xffffffffu, ab = 0;
    if (excl < need && need <= S) { unsigned cum = excl; bool found = false;
#pragma unroll
        for (int k = 7; k >= 0; --k) { if (!found && cum + c[k] >= need) { b = 8 * li + k; ab = cum; found = true; } if (!found) cum += c[k]; } }
    const unsigned long long bal = __ballot(b != 0xffffffffu);
    const unsigned halfmask = (unsigned)((threadIdx.x & 32) ? (bal >> 32) : (bal & 0xffffffffull));
    const int src = (halfmask ? (__ffs(halfmask) - 1) : 0) + (threadIdx.x & 32);
    bsel = __shfl(b, src, 64); above = __shfl(ab, src, 64);
    if (!halfmask) { bsel = 0; above = 0; }
}
template <int J> __device__ __forceinline__ void wlane(unsigned& m, unsigned v) { asm volatile("v_writelane_b32 %0, %1, %2" : "+v"(m) : "s"(v), "n"(J)); }
template <int J> __device__ __forceinline__ void mask_emit_step(const unsigned (&k0)[32], const unsigned (&k1)[32], unsigned T0, unsigned T1, int kh, int ntiles, unsigned& m0, unsigned& m1, unsigned& m2, unsigned& m3) {
    if (2 * J + kh < ntiles) {
        const unsigned long long ba = __ballot(k0[J] >= T0), bc = __ballot(k1[J] >= T1);
        wlane<J>(m0, (unsigned)ba); wlane<J>(m2, (unsigned)(ba >> 32)); wlane<J>(m1, (unsigned)bc); wlane<J>(m3, (unsigned)(bc >> 32));
    }
}
template <int... Js> __device__ __forceinline__ void mask_emit(std::integer_sequence<int, Js...>, const unsigned (&k0)[32], const unsigned (&k1)[32], unsigned T0, unsigned T1, int kh, int ntiles, unsigned& m0, unsigned& m1, unsigned& m2, unsigned& m3) {
    (mask_emit_step<Js>(k0, k1, T0, T1, kh, ntiles, m0, m1, m2, m3), ...);
}
__device__ __forceinline__ void p2_indexer_unit(Frame& F, int b, int qb) {
    const bf16_t* IQ = (const bf16_t*)(F.ws + WS_IQ); const bf16_t* IK = (const bf16_t*)(F.ws + WS_IK); const float* IW = (const float*)(F.ws + WS_IW);
    unsigned* MASK = (unsigned*)(F.ws + WS_MASK);
    const int qg = F.wave & 3, kh = F.wave >> 2;
    LAS unsigned* hist = (LAS unsigned*)(F.lds + IDX_HIST_OFF) + qg * 4 * 384;
    LAS float* mm = (LAS float*)(F.lds + IDX_RES_OFF);
    const int lane = F.lane, r32 = lane & 31, hi = lane >> 5;
    const int p0 = qb * 16 + qg * 4;
    const int tq0 = b * SEQ + p0;
    const int ntiles = (qb >> 1) + 1;
    const int nch = (ntiles + 7) >> 3;
    const char* ikb = (const char*)(IK + (size_t)b * SEQ * 64);
    unsigned dsrc[4];
#pragma unroll
    for (int i = 0; i < 4; ++i) { const int row = F.wave * 32 + i * 8 + (lane >> 3), pos = lane & 7; dsrc[i] = (unsigned)(row * 128 + ((pos ^ ((row >> 1) & 7)) << 4)); }
#define IDX_ISSUE(ch) do { _Pragma("unroll") for (int i_ = 0; i_ < 4; ++i_) \
        __builtin_amdgcn_global_load_lds((const unsigned*)(ikb + (size_t)(ch) * 32768 + dsrc[i_]), (LAS unsigned*)(F.lds + IDX_RING_OFF + ((ch) % 3) * IDX_SLOT + F.wave * 4096 + i_ * 1024), 16, 0, 0); } while (0)
    bf16x8 af[4];
    { const int i = r32, qi = 2 * ((i >> 2) & 1) + (i >> 4), hd = (i & 3) + 4 * ((i >> 3) & 1);
#pragma unroll
      for (int s = 0; s < 4; ++s) af[s] = *(const bf16x8*)(IQ + (size_t)(tq0 + qi) * 512 + hd * 64 + 16 * s + 8 * hi); }
    float wA[8], wB[8];
#pragma unroll
    for (int r = 0; r < 8; ++r) { const int hd = (r & 3) + 4 * (r >> 2); wA[r] = IW[(size_t)(tq0 + 2 * hi) * 8 + hd] * W_SCALE; wB[r] = IW[(size_t)(tq0 + 2 * hi + 1) * 8 + hd] * W_SCALE; }
    __builtin_amdgcn_s_barrier();
    asm volatile("" ::: "memory");
    IDX_ISSUE(0); if (nch > 1) IDX_ISSUE(1);
#pragma unroll
    for (int i = 0; i < 3; ++i) *(LAS u32x4*)(F.lds + IDX_HIST_OFF + (i * 512 + F.tid) * 16) = (u32x4){0u, 0u, 0u, 0u};
    const int limA = p0 + 2 * hi - 32 * (ntiles - 1), limB = limA + 1;
    float sc0[32], sc1[32];
#pragma unroll
    for (int j = 0; j < 32; ++j) { sc0[j] = -INFINITY; sc1[j] = -INFINITY; }
    float mx0 = -INFINITY, mn0 = INFINITY, mx1 = -INFINITY, mn1 = INFINITY;
    const int frag_off = r32 * 128;
    const int fx = (r32 >> 1) & 7;
#pragma unroll
    for (int ch = 0; ch < 8; ++ch) {
        if (ch < nch) {
            if (ch + 1 < nch) asm volatile("s_waitcnt vmcnt(4)" ::: "memory"); else asm volatile("s_waitcnt vmcnt(0)" ::: "memory");
            __builtin_amdgcn_s_barrier();
            asm volatile("" ::: "memory");
            if (ch + 2 < nch) IDX_ISSUE(ch + 2);
            const LAS char* slot = (const LAS char*)(F.lds + IDX_RING_OFF + (ch % 3) * IDX_SLOT);
#pragma unroll
            for (int j4 = 0; j4 < 4; ++j4) {
                const int jl = 2 * j4 + kh, j = ch * 8 + jl, idx = ch * 4 + j4;
                if (j < ntiles) {
                    f32x16 acc = {};
#pragma unroll
                    for (int s = 0; s < 4; ++s) { const bf16x8 bfr = *(const LAS bf16x8*)(slot + jl * 4096 + frag_off + (((2 * s + hi) ^ fx) << 4));
                        acc = __builtin_amdgcn_mfma_f32_32x32x16_bf16(af[s], bfr, acc, 0, 0, 0); }
                    float s0 = 0.f, s1 = 0.f;
#pragma unroll
                    for (int r = 0; r < 8; ++r) {
                        const int ia = __float_as_int(acc[r]), ib = __float_as_int(acc[8 + r]);
                        s0 = fmaf(wA[r], __int_as_float(ia > 0 ? ia : 0), s0); s1 = fmaf(wB[r], __int_as_float(ib > 0 ? ib : 0), s1); }
                    if (j == ntiles - 1) {
                        mn0 = fminf(mn0, (r32 > limA) ? INFINITY : s0); mn1 = fminf(mn1, (r32 > limB) ? INFINITY : s1);
                        s0 = (r32 > limA) ? -INFINITY : s0; s1 = (r32 > limB) ? -INFINITY : s1;
                    } else { mn0 = fminf(mn0, s0); mn1 = fminf(mn1, s1); }
                    mx0 = fmaxf(mx0, s0); mx1 = fmaxf(mx1, s1);
                    sc0[idx] = s0; sc1[idx] = s1;
                }
            }
        }
    }
#undef IDX_ISSUE
#pragma unroll
    for (int d = 1; d < 32; d <<= 1) { mx0 = fmaxf(mx0, __shfl_xor(mx0, d)); mx1 = fmaxf(mx1, __shfl_xor(mx1, d)); mn0 = fminf(mn0, __shfl_xor(mn0, d)); mn1 = fminf(mn1, __shfl_xor(mn1, d)); }
    if (r32 == 0) { LAS float* w = mm + ((qg * 2 + kh) * 4 + 2 * hi) * 2; w[0] = mx0; w[1] = mn0; w[2] = mx1; w[3] = mn1; }
    __syncthreads();
    { const LAS float* w = mm + ((qg * 2 + (kh ^ 1)) * 4 + 2 * hi) * 2; mx0 = fmaxf(mx0, w[0]); mn0 = fminf(mn0, w[1]); mx1 = fmaxf(mx1, w[2]); mn1 = fminf(mn1, w[3]); }
    const float scl0 = (mx0 > mn0) ? (16777212.0f / (mx0 - mn0)) : 0.f, scl1 = (mx1 > mn1) ? (16777212.0f / (mx1 - mn1)) : 0.f;
    const float off0 = 1.5f - mn0 * scl0, off1 = 1.5f - mn1 * scl1;
    unsigned k0[32], k1[32];
#pragma unroll
    for (int j = 0; j < 32; ++j) { k0[j] = (unsigned)fmaf(sc0[j], scl0, off0); k1[j] = (unsigned)fmaf(sc1[j], scl1, off1); }
    unsigned T0 = 1u, T1 = 1u;
#ifndef NO_SELECT
    if (qb >= 16) {
        LAS unsigned* hA = hist + (2 * hi) * 384; LAS unsigned* hB = hist + (2 * hi + 1) * 384;
        unsigned pre0 = 0, pre1 = 0, need0 = 256, need1 = 256;
#pragma unroll
        for (int lvl = 0; lvl < 3; ++lvl) {
            const int sh = 16 - 8 * lvl;
#pragma unroll
            for (int j = 0; j < 32; ++j) {
                if (2 * j + kh < ntiles) {
                    const unsigned ka = k0[j], kc = k1[j];
                    if (lvl == 0 || (ka >> (sh + 8)) == pre0) { const unsigned bn = (ka >> sh) & 255u; (void)__hip_atomic_fetch_add(hA + lvl * 128 + (bn >> 1), 1u << ((bn & 1u) << 4), __ATOMIC_RELAXED, __HIP_MEMORY_SCOPE_WORKGROUP); }
                    if (lvl == 0 || (kc >> (sh + 8)) == pre1) { const unsigned bn = (kc >> sh) & 255u; (void)__hip_atomic_fetch_add(hB + lvl * 128 + (bn >> 1), 1u << ((bn & 1u) << 4), __ATOMIC_RELAXED, __HIP_MEMORY_SCOPE_WORKGROUP); }
                }
            }
            __syncthreads();
            unsigned b0, a0, b1, a1;
            hist_find16(hA + lvl * 128, r32, need0, b0, a0);
            hist_find16(hB + lvl * 128, r32, need1, b1, a1);
            pre0 = (pre0 << 8) | b0; need0 -= a0;
            pre1 = (pre1 << 8) | b1; need1 -= a1;
        }
        T0 = pre0 > 1u ? pre0 : 1u; T1 = pre1 > 1u ? pre1 : 1u;
    }
#endif
    unsigned m0 = 0, m1 = 0, m2 = 0, m3 = 0;
    mask_emit(std::make_integer_sequence<int, 32>{}, k0, k1, T0, T1, kh, ntiles, m0, m1, m2, m3);
    if (lane < 32) { const int w = 2 * lane + kh;
        MASK[(size_t)(tq0 + 0) * 64 + w] = m0; MASK[(size_t)(tq0 + 1) * 64 + w] = m1; MASK[(size_t)(tq0 + 2) * 64 + w] = m2; MASK[(size_t)(tq0 + 3) * 64 + w] = m3; }
}
__device__ __forceinline__ void p2_indexer(Frame& F) {
    for (int pi = F.bid; pi < 512; pi += F.G) { const int b = pi >> 6, x = pi & 63;
        p2_indexer_unit(F, b, 127 - x);
        p2_indexer_unit(F, b, x); }
    __syncthreads();
}

namespace att {
constexpr int D = 128, NW = 8, QBLK = 32, KVBLK = 64;
constexpr float SCALE = 0.088388347648318440f;
constexpr float THR = 8.f;
constexpr int LDQ = 768, LDK = 256, LDO = 1024;
constexpr size_t SHM_V = KVBLK * D * 2, SHM_K = KVBLK * D * 2, SHM_ATTN = 2 * SHM_V + 2 * SHM_K + NW * 64 * 4;
#define KSWZ(row, colB) ((row) * 256 + ((colB) ^ (((row) & 7) << 4)))
#define SBAR() __builtin_amdgcn_sched_barrier(0)
__device__ __forceinline__ void apply_mask(f32x16& p0, f32x16& p1, u32x2 mk, int hi) {
    const int ml = (int)(mk.x >> (4 * hi)), mh = (int)(mk.y >> (4 * hi));
#pragma unroll
    for (int r = 0; r < 16; ++r) { const int cr = (r & 3) + 8 * (r >> 2);
        const unsigned t0 = (unsigned)__builtin_amdgcn_sbfe(ml, cr, 1), t1 = (unsigned)__builtin_amdgcn_sbfe(mh, cr, 1);
        p0[r] = __uint_as_float((__float_as_uint(p0[r]) & t0) | (0xff800000u & ~t0));
        p1[r] = __uint_as_float((__float_as_uint(p1[r]) & t1) | (0xff800000u & ~t1)); }
}
__device__ __forceinline__ void partialSM(f32x16& p0, f32x16& p1, float& m_reg, float& mn, float& alpha) {
    constexpr float C = SCALE * 1.4426950408889634f;
    float pmax = p0[0];
#pragma unroll
    for (int r = 1; r < 16; ++r) pmax = fmaxf(pmax, p0[r]);
#pragma unroll
    for (int r = 0; r < 16; ++r) pmax = fmaxf(pmax, p1[r]);
    { auto rr = __builtin_amdgcn_permlane32_swap(__float_as_uint(pmax), __float_as_uint(pmax), false, false);
      pmax = fmaxf(__uint_as_float(rr[0]), __uint_as_float(rr[1])); }
    if (__builtin_expect(__all(pmax - m_reg <= THR / SCALE), 1)) { mn = m_reg; alpha = 1.f; }
    else { mn = fmaxf(m_reg, pmax); alpha = __builtin_amdgcn_exp2f((m_reg - mn) * C); m_reg = mn; }
    const float mnC = -mn * C;
#pragma unroll
    for (int r = 0; r < 16; ++r) p0[r] = fmaf(p0[r], C, mnC);
#pragma unroll
    for (int r = 0; r < 16; ++r) p1[r] = fmaf(p1[r], C, mnC);
#pragma unroll
    for (int r = 0; r < 16; ++r) p0[r] = __builtin_amdgcn_exp2f(p0[r]);
}
__device__ __forceinline__ void finishSM(f32x16& p0, f32x16& p1, float alpha, float& l_reg, bf16x8& pa0, bf16x8& pa1, bf16x8& pa2, bf16x8& pa3) {
#pragma unroll
    for (int r = 0; r < 16; ++r) p1[r] = __builtin_amdgcn_exp2f(p1[r]);
    float ps = 0;
#pragma unroll
    for (int r = 0; r < 16; ++r) ps += p0[r];
#pragma unroll
    for (int r = 0; r < 16; ++r) ps += p1[r];
    { auto rr = __builtin_amdgcn_permlane32_swap(__float_as_uint(ps), __float_as_uint(ps), false, false);
      ps = __uint_as_float(rr[0]) + __uint_as_float(rr[1]); }
    l_reg = l_reg * alpha + ps;
#define PK4(P, BASE, OUT) do { unsigned a0 = cvt_pk_bf16(P[BASE + 0], P[BASE + 1]), a1 = cvt_pk_bf16(P[BASE + 2], P[BASE + 3]);   \
    unsigned b0 = cvt_pk_bf16(P[BASE + 4], P[BASE + 5]), b1 = cvt_pk_bf16(P[BASE + 6], P[BASE + 7]);                              \
    auto r0 = __builtin_amdgcn_permlane32_swap(a0, b0, false, false); auto r1 = __builtin_amdgcn_permlane32_swap(a1, b1, false, false); \
    u32x4 w = {r0[0], r1[0], r0[1], r1[1]}; OUT = *reinterpret_cast<bf16x8*>(&w); } while (0)
    PK4(p0, 0, pa0); PK4(p0, 8, pa1); PK4(p1, 0, pa2); PK4(p1, 8, pa3);
#undef PK4
}
__device__ __forceinline__ void qkt(f32x16& p0, f32x16& p1, const LAS char* Ks, const bf16x8* qr, int r32, int hi) {
    p0 = f32x16{}; p1 = f32x16{};
#pragma unroll
    for (int d0 = 0; d0 < 8; ++d0) { const int cb = (d0 * 16 + hi * 8) * 2;
        const bf16x8 b0 = *reinterpret_cast<const LAS bf16x8*>(Ks + KSWZ(r32, cb));
        const bf16x8 b1 = *reinterpret_cast<const LAS bf16x8*>(Ks + KSWZ(32 + r32, cb));
        p0 = __builtin_amdgcn_mfma_f32_32x32x16_bf16(b0, qr[d0], p0, 0, 0, 0);
        p1 = __builtin_amdgcn_mfma_f32_32x32x16_bf16(b1, qr[d0], p1, 0, 0, 0); }
}
__device__ __forceinline__ int v_st(int k, int c) { const int kk = (k & ~0xC) | ((k & 4) << 1) | ((k & 8) >> 1); return ((kk >> 3) * 4 + (c >> 5)) * 512 + ((kk & 7) * 32 + (c & 31)) * 2; }
__device__ __forceinline__ int v_rd_base(int lane) { return ((lane & 3) << 3) | (((lane >> 2) & 3) << 6) | (((lane >> 4) & 1) << 5) | (((lane >> 5) & 1) << 8); }
constexpr int v_rd_off(int d0, int ks, int half) { return d0 * 512 + ks * 4096 + half * 2048; }
template <int OFF> __device__ __forceinline__ s16x4 tr_read(int vb) {
    s16x4 r; asm volatile("ds_read_b64_tr_b16 %0, %1 offset:%2" : "=&v"(r) : "v"(vb), "i"(OFF) : "memory"); return r;
}
template <int D0> __device__ __forceinline__ void pv_one(f32x16& od, int vb, bf16x8 pa0, bf16x8 pa1, bf16x8 pa2, bf16x8 pa3) {
    const s16x4 l0 = tr_read<v_rd_off(D0, 0, 0)>(vb), h0 = tr_read<v_rd_off(D0, 0, 1)>(vb), l1 = tr_read<v_rd_off(D0, 1, 0)>(vb), h1 = tr_read<v_rd_off(D0, 1, 1)>(vb);
    const s16x4 l2 = tr_read<v_rd_off(D0, 2, 0)>(vb), h2 = tr_read<v_rd_off(D0, 2, 1)>(vb), l3 = tr_read<v_rd_off(D0, 3, 0)>(vb), h3 = tr_read<v_rd_off(D0, 3, 1)>(vb);
    asm volatile("s_waitcnt lgkmcnt(0)" ::: "memory"); SBAR();
#define PK(L, H) (bf16x8){L[0], L[1], L[2], L[3], H[0], H[1], H[2], H[3]}
    od = __builtin_amdgcn_mfma_f32_32x32x16_bf16(pa0, PK(l0, h0), od, 0, 0, 0);
    od = __builtin_amdgcn_mfma_f32_32x32x16_bf16(pa1, PK(l1, h1), od, 0, 0, 0);
    od = __builtin_amdgcn_mfma_f32_32x32x16_bf16(pa2, PK(l2, h2), od, 0, 0, 0);
    od = __builtin_amdgcn_mfma_f32_32x32x16_bf16(pa3, PK(l3, h3), od, 0, 0, 0);
#undef PK
}
__device__ __forceinline__ void pv_d0(f32x16* o, int vb, bf16x8 pa0, bf16x8 pa1, bf16x8 pa2, bf16x8 pa3) {
    pv_one<0>(o[0], vb, pa0, pa1, pa2, pa3); pv_one<1>(o[1], vb, pa0, pa1, pa2, pa3); pv_one<2>(o[2], vb, pa0, pa1, pa2, pa3); pv_one<3>(o[3], vb, pa0, pa1, pa2, pa3);
}
__device__ __forceinline__ void attn_body(const bf16_t* __restrict__ Qb, const bf16_t* __restrict__ Kh, const bf16_t* __restrict__ Vh, bf16_t* __restrict__ Ob, const unsigned* __restrict__ Mb, int NT, LAS char* lds) {
    const int tid = threadIdx.x, wid = tid >> 6, lane = tid & 63, r32 = lane & 31, hi = lane >> 5;
    LAS char* V_lds = lds; LAS char* K_lds = lds + 2 * SHM_V;
    LAS float* ws = (LAS float*)(lds + 2 * SHM_V + 2 * SHM_K) + wid * 64; LAS float* li_l = ws; LAS float* al_l = ws + 32;
    float m_reg = -1e30f, l_reg = 0; f32x16 o[4] = {}; bf16x8 qr[8];
    const bf16_t* Qw = Qb + (long)(wid * QBLK + r32) * LDQ + hi * 8;
#pragma unroll
    for (int d0 = 0; d0 < 8; ++d0) qr[d0] = *reinterpret_cast<const bf16x8*>(Qw + d0 * 16);
    const unsigned mofs = (unsigned)(wid * QBLK + r32) * 256u;
#define Mw_(j) (*(const u32x2*)((const char*)Mb + (mofs + 8u * (unsigned)(j))))
    const int sr = tid >> 4, sc = (tid & 15) * 8, vst0 = v_st(sr, sc), vst1 = v_st(32 + sr, sc);
    const int vb0 = (int)(uintptr_t)V_lds + v_rd_base(lane);
    struct { bf16x8 vs0, vs1, ks0, ks1; } sr_[2];
#define SLOAD(i, k0) do { sr_[i].vs0 = *(const bf16x8*)(&Vh[(long)((k0) + sr) * LDK + sc]); sr_[i].vs1 = *(const bf16x8*)(&Vh[(long)((k0) + 32 + sr) * LDK + sc]); \
    sr_[i].ks0 = *(const bf16x8*)(&Kh[(long)((k0) + sr) * LDK + sc]); sr_[i].ks1 = *(const bf16x8*)(&Kh[(long)((k0) + 32 + sr) * LDK + sc]); } while (0)
#define SWRITE(b, i) do { *(LAS bf16x8*)(V_lds + (b) * SHM_V + vst0) = sr_[i].vs0;          \
    *(LAS bf16x8*)(V_lds + (b) * SHM_V + vst1) = sr_[i].vs1; int kc = sc * 2;               \
    *(LAS bf16x8*)(K_lds + (b) * SHM_K + KSWZ(sr, kc)) = sr_[i].ks0;                       \
    *(LAS bf16x8*)(K_lds + (b) * SHM_K + KSWZ(32 + sr, kc)) = sr_[i].ks1; } while (0)
#define SWAIT() asm volatile("s_waitcnt vmcnt(5)" ::: "memory")
#define RESC(a) do { if (__any((a) < 1.f)) { if (hi == 0) al_l[r32] = (a); asm volatile("s_waitcnt lgkmcnt(0)" ::: "memory"); \
    _Pragma("unroll") for (int d = 0; d < 4; ++d) _Pragma("unroll") for (int r = 0; r < 16; ++r) o[d][r] *= al_l[crow(r, hi)]; } } while (0)
    f32x16 pA0, pA1, pB0, pB1; float mnA, mnB, alA, alB; bf16x8 pa0, pa1, pa2, pa3;
    u32x2 mkA = Mw_(0), mkB = Mw_(1);
    constexpr int SE = 0, SO = 1;
    SLOAD(SE, 0); asm volatile("s_waitcnt vmcnt(0)" ::: "memory"); SWRITE(0, SE); __syncthreads();
    qkt(pA0, pA1, K_lds, qr, r32, hi); apply_mask(pA0, pA1, mkA, hi); partialSM(pA0, pA1, m_reg, mnA, alA); mkA = Mw_(2);
    SLOAD(SO, KVBLK); if (2 < NT) SLOAD(SE, 2 * KVBLK);
    SWAIT(); SWRITE(1, SO); __syncthreads();
    for (int j = 1; j + 1 < NT; j += 2) {
        SBAR(); qkt(pB0, pB1, K_lds + SHM_K, qr, r32, hi);
        finishSM(pA0, pA1, alA, l_reg, pa0, pa1, pa2, pa3); SBAR();
        SLOAD(SO, (j + 2) * KVBLK); SBAR();
        pv_d0(o, vb0, pa0, pa1, pa2, pa3); apply_mask(pB0, pB1, mkB, hi); partialSM(pB0, pB1, m_reg, mnB, alB); mkB = Mw_((j + 2 < NT) ? (j + 2) : j);
        __syncthreads(); SWAIT(); SWRITE(0, SE);
        RESC(alB); __syncthreads();
        SBAR(); qkt(pA0, pA1, K_lds, qr, r32, hi);
        finishSM(pB0, pB1, alB, l_reg, pa0, pa1, pa2, pa3); SBAR();
        if (j + 3 < NT) SLOAD(SE, (j + 3) * KVBLK); SBAR();
        pv_d0(o, vb0 + (int)SHM_V, pa0, pa1, pa2, pa3); apply_mask(pA0, pA1, mkA, hi); partialSM(pA0, pA1, m_reg, mnA, alA); mkA = Mw_((j + 3 < NT) ? (j + 3) : (j + 1));
        __syncthreads(); SWAIT(); SWRITE(1, SO);
        RESC(alA); __syncthreads();
    }
    SBAR(); qkt(pB0, pB1, K_lds + SHM_K, qr, r32, hi);
    finishSM(pA0, pA1, alA, l_reg, pa0, pa1, pa2, pa3); SBAR();
    pv_d0(o, vb0, pa0, pa1, pa2, pa3); apply_mask(pB0, pB1, mkB, hi); partialSM(pB0, pB1, m_reg, mnB, alB);
    __syncthreads(); RESC(alB);
    finishSM(pB0, pB1, alB, l_reg, pa0, pa1, pa2, pa3); SBAR();
    pv_d0(o, vb0 + (int)SHM_V, pa0, pa1, pa2, pa3);
    if (hi == 0) li_l[r32] = l_reg; asm volatile("s_waitcnt lgkmcnt(0)" ::: "memory");
    float rli[16];
#pragma unroll
    for (int r = 0; r < 16; ++r) rli[r] = __builtin_amdgcn_rcpf(li_l[crow(r, hi)]);
    bf16_t* Ow = Ob + (long)(wid * QBLK) * LDO;
#pragma unroll
    for (int r = 0; r < 16; ++r) { const int orow = crow(r, hi);
#pragma unroll
        for (int d0 = 0; d0 < 4; ++d0) Ow[(long)orow * LDO + d0 * 32 + r32] = (bf16_t)(cvt_pk_bf16(o[d0][r] * rli[r], 0.f) & 0xffffu); }
#undef SLOAD
#undef SWRITE
#undef SWAIT
#undef RESC
#undef Mw_
}
}

__device__ __forceinline__ void p3_attention(Frame& F) {
    const bf16_t* Q = (const bf16_t*)(F.ws + WS_Q); const bf16_t* K = (const bf16_t*)(F.ws + WS_K); const bf16_t* V = (const bf16_t*)(F.ws + WS_V);
    bf16_t* cat = (bf16_t*)(F.ws + WS_CAT); const unsigned* MASK = (const unsigned*)(F.ws + WS_MASK);
    const int j = F.bid;
    if (F.G == 256 && j >= 216) {
        convert_range(F, 2 * CV_PAIRS1, 2 * CV_PAIRS3, (j - 216) * 8 + F.wave, 40 * 8);
        return;
    }
    int qbs[2], phs[2], nu = 2;
    if (F.G != 256) { nu = 0; }
    else if (j < 48) { qbs[0] = 7; phs[0] = j; nu = 1; qbs[1] = 0; phs[1] = 0; }
    else if (j < 96) { qbs[0] = 6; phs[0] = j - 48; qbs[1] = 0; phs[1] = j - 48; }
    else if (j < 144) { qbs[0] = 5; phs[0] = j - 96; qbs[1] = 1; phs[1] = j - 96; }
    else if (j < 192) { qbs[0] = 4; phs[0] = j - 144; qbs[1] = 2; phs[1] = j - 144; }
    else { qbs[0] = 3; phs[0] = 2 * (j - 192); qbs[1] = 3; phs[1] = 2 * (j - 192) + 1; }
    for (int ui = 0; ui < nu; ++ui) {
        __syncthreads();
        const int qb = qbs[ui], b = phs[ui] / 6, h = phs[ui] % 6, g = h / 3;
        const size_t row0 = (size_t)b * SEQ + (size_t)qb * 256;
        att::attn_body(Q + row0 * 768 + h * 128, K + (size_t)b * SEQ * 256 + g * 128, V + (size_t)b * SEQ * 256 + g * 128, cat + row0 * 1024 + 256 + h * 128, MASK + row0 * 64, 4 * (qb + 1), (LAS char*)F.lds);
    }
    __syncthreads();
}

__device__ __forceinline__ void p5_ln1_router(Frame& F) {
    const bf16_t* MIX = (const bf16_t*)(F.ws + WS_MIX); const bf16_t* HA = (const bf16_t*)(F.ws + WS_HA);
    bf16_t* H1R = (bf16_t*)(F.ws + WS_H1F); unsigned char* H1Q = F.ws + WS_H1B; const float* wrA = (const float*)(F.ws + WS_WRA);
    unsigned* INV = (unsigned*)(F.ws + WS_INV); unsigned* TOKEP = (unsigned*)(F.ws + WS_TOKEP); float* TOKG = (float*)(F.ws + WS_TOKG);
    LAS float* tile = (LAS float*)F.lds;
    LAS float* part = (LAS float*)F.lds;
    LAS float* logit = (LAS float*)(F.lds + 36864);
    LAS int* sel_e = (LAS int*)(F.lds + MISC_OFF + 2048);
    LAS float* sel_g = (LAS float*)(F.lds + MISC_OFF + 3072);
    LAS int* sel_p = (LAS int*)(F.lds + MISC_OFF + 4096);
    LAS unsigned* lcnt = (LAS unsigned*)(F.lds + MISC_OFF + 5120);
    LAS int* ebase = (LAS int*)(F.lds + MISC_OFF + 5376);
    const int lane = F.lane, r32 = lane & 31, hi = lane >> 5;
    for (int blk = F.bid; blk < T / 64; blk += F.G) {
        const int t0 = blk * 64;
        if (F.tid < 32) lcnt[F.tid] = 0u;
        for (int pass = 0; pass < 2; ++pass) {
            __syncthreads();
            { f32x4 g1[4], b1[4];
#pragma unroll
              for (int j = 0; j < 4; ++j) { g1[j] = ((const f32x4*)F.ln1_g)[lane + 64 * j]; b1[j] = ((const f32x4*)F.ln1_b)[lane + 64 * j]; }
#pragma unroll
              for (int rb = 0; rb < 4; rb += 2) {
              u32x2 xv[2][4]; u32x2 mv[2][4];
#pragma unroll
              for (int rr = 0; rr < 2; ++rr) { const int m = t0 + pass * 32 + F.wave * 4 + rb + rr;
#pragma unroll
                  for (int j = 0; j < 4; ++j) { xv[rr][j] = ((const u32x2*)(HA + (size_t)m * 1024))[lane + 64 * j]; mv[rr][j] = ((const u32x2*)(MIX + (size_t)m * 1024))[lane + 64 * j]; } }
#pragma unroll
              for (int rr = 0; rr < 2; ++rr) { const int tl = F.wave * 4 + rb + rr, m = t0 + pass * 32 + tl;
                  f32x4 v[4]; float s = 0.f;
#pragma unroll
                  for (int j = 0; j < 4; ++j) { const u32x2 hw = xv[rr][j]; const f32x4 h = {bf16_lo(hw.x), bf16_hi(hw.x), bf16_lo(hw.y), bf16_hi(hw.y)};
                      const u32x2 w = mv[rr][j]; const f32x4 mx = {bf16_lo(w.x), bf16_hi(w.x), bf16_lo(w.y), bf16_hi(w.y)};
                      v[j] = ALPHA * h + mx; s += (v[j].x + v[j].y) + (v[j].z + v[j].w); }
                  const float mean = wave_sum(s) * (1.f / 1024.f); float s2 = 0.f;
#pragma unroll
                  for (int j = 0; j < 4; ++j) { v[j] = v[j] - mean; s2 += (v[j].x * v[j].x + v[j].y * v[j].y) + (v[j].z * v[j].z + v[j].w * v[j].w); }
                  const float rstd = 1.f / sqrtf(wave_sum(s2) * (1.f / 1024.f) + LN_EPS);
                  u32x2* of = (u32x2*)(H1R + (size_t)m * 1024) + lane; unsigned* ob = (unsigned*)(H1Q + (size_t)m * 1024) + lane;
#pragma unroll
                  for (int j = 0; j < 4; ++j) { const f32x4 h = v[j] * rstd * g1[j] + b1[j]; { u32x2 hw; hw.x = cvt_pk_bf16(h.x, h.y); hw.y = cvt_pk_bf16(h.z, h.w); of[64 * j] = hw; } ob[64 * j] = pk4_fp8(h.x, h.y, h.z, h.w);
                      *(LAS f32x4*)(tile + tl * 1024 + (((lane + 64 * j) ^ (tl & 15)) << 2)) = h; } } } }
            f32x4 a4[16];
#pragma unroll
            for (int i = 0; i < 16; ++i) a4[i] = *(const f32x4*)(wrA + (size_t)(((F.wave * 16 + i) * 2 + hi) * 32 + r32) * 4);
            __syncthreads();
            f32x16 acc = {};
#pragma unroll
            for (int i = 0; i < 16; ++i) { const int c = F.wave * 16 + i;
                const f32x4 b4 = *(const LAS f32x4*)(tile + r32 * 1024 + (((2 * c + hi) ^ (r32 & 15)) << 2));
                acc = __builtin_amdgcn_mfma_f32_32x32x2f32(a4[i].x, b4.x, acc, 0, 0, 0);
                acc = __builtin_amdgcn_mfma_f32_32x32x2f32(a4[i].y, b4.y, acc, 0, 0, 0);
                acc = __builtin_amdgcn_mfma_f32_32x32x2f32(a4[i].z, b4.z, acc, 0, 0, 0);
                acc = __builtin_amdgcn_mfma_f32_32x32x2f32(a4[i].w, b4.w, acc, 0, 0, 0); }
            __syncthreads();
#pragma unroll
            for (int r = 0; r < 16; ++r) part[(F.wave * 32 + r32) * 33 + crow(r, hi)] = acc[r];
            __syncthreads();
#pragma unroll
            for (int q = 0; q < 2; ++q) { const int o = F.tid * 2 + q, tok = o >> 5, e = o & 31; float sm = F.b_router[e];
#pragma unroll
                for (int kq = 0; kq < 8; ++kq) sm += part[(kq * 32 + tok) * 33 + e];
                logit[tok * 33 + e] = sm; }
            __syncthreads();
            if (F.tid < 32) {
                float bv_[4] = {-INFINITY, -INFINITY, -INFINITY, -INFINITY}; int bi[4] = {0, 0, 0, 0};
#pragma unroll
                for (int e = 0; e < 32; ++e) { const float v = logit[F.tid * 33 + e];
                    if (v > bv_[3]) { bv_[3] = v; bi[3] = e;
                        if (bv_[3] > bv_[2]) { float tv = bv_[2]; bv_[2] = bv_[3]; bv_[3] = tv; int ti = bi[2]; bi[2] = bi[3]; bi[3] = ti;
                            if (bv_[2] > bv_[1]) { tv = bv_[1]; bv_[1] = bv_[2]; bv_[2] = tv; ti = bi[1]; bi[1] = bi[2]; bi[2] = ti;
                                if (bv_[1] > bv_[0]) { tv = bv_[0]; bv_[0] = bv_[1]; bv_[1] = tv; ti = bi[0]; bi[0] = bi[1]; bi[1] = ti; } } } } }
                float ex[4], se = 0.f;
#pragma unroll
                for (int j = 0; j < 4; ++j) { ex[j] = __expf(bv_[j] - bv_[0]); se += ex[j]; }
#pragma unroll
                for (int j = 0; j < 4; ++j) { sel_g[(pass * 32 + F.tid) * 4 + j] = ex[j] / se; sel_e[(pass * 32 + F.tid) * 4 + j] = bi[j]; }
            }
        }
        __syncthreads();
        if (F.tid < 256) sel_p[F.tid] = (int)__hip_atomic_fetch_add(lcnt + sel_e[F.tid], 1u, __ATOMIC_RELAXED, __HIP_MEMORY_SCOPE_WORKGROUP);
        __syncthreads();
        if (F.tid < 32) { const unsigned c = lcnt[F.tid]; int base = 0; if (c > 0) base = (int)__hip_atomic_fetch_add(F.ctl + CW_CNT + F.tid, c, __ATOMIC_RELAXED, __HIP_MEMORY_SCOPE_AGENT); ebase[F.tid] = base; }
        __syncthreads();
        if (F.tid < 256) { const int tok = t0 + (F.tid >> 2), e = sel_e[F.tid], p = ebase[e] + sel_p[F.tid];
            INV[(size_t)e * CAP + p] = (unsigned)tok; TOKEP[(size_t)tok * 4 + (F.tid & 3)] = ((unsigned)e << 16) | (unsigned)p; TOKG[(size_t)tok * 4 + (F.tid & 3)] = sel_g[F.tid]; }
        __syncthreads();
    }
}

__device__ __forceinline__ void moe_tables(Frame& F, LAS int* tstart) {
    __syncthreads();
    if (F.tid < 64) {
        const unsigned c = (F.tid < NE) ? __hip_atomic_load(F.ctl + CW_CNT + (F.tid & 31), __ATOMIC_RELAXED, __HIP_MEMORY_SCOPE_AGENT) : 0u;
        const int nt = (int)((c + 255u) >> 8); int incl = nt;
#pragma unroll
        for (int d = 1; d < 32; d <<= 1) { const int o = __shfl_up(incl, d, 64); if ((int)F.tid >= d) incl += o; }
        if (F.tid < NE) { tstart[F.tid] = incl - nt; tstart[40 + F.tid] = (int)c; }
        if (F.tid == NE - 1) tstart[NE] = incl; }
    __syncthreads();
}

__device__ __forceinline__ float fp8_to_f32(unsigned w, int byte) {
    if (byte == 0) return __builtin_amdgcn_cvt_f32_fp8(w, 0); if (byte == 1) return __builtin_amdgcn_cvt_f32_fp8(w, 1); if (byte == 2) return __builtin_amdgcn_cvt_f32_fp8(w, 2); return __builtin_amdgcn_cvt_f32_fp8(w, 3);
}
__device__ __forceinline__ void p8_final(Frame& F, LAS int* tstart) {
    const bf16_t* H1R = (const bf16_t*)(F.ws + WS_H1F); const unsigned* TOKEP = (const unsigned*)(F.ws + WS_TOKEP); const float* TOKG = (const float*)(F.ws + WS_TOKG);
    const unsigned char* Y = F.ws + WS_Y;
    const int gw = F.bid * 8 + F.wave, NGW = F.G * 8;
    f32x4 gv[4], bv[4];
#pragma unroll
    for (int j = 0; j < 4; ++j) { gv[j] = ((const f32x4*)F.ln2_g)[F.lane + 64 * j]; bv[j] = ((const f32x4*)F.ln2_b)[F.lane + 64 * j]; }
    unsigned tk = 0; float tg = 0.f;
    { const int m = gw + (F.lane >> 2) * NGW; if (F.lane < 32 && m < T) { tk = TOKEP[(size_t)m * 4 + (F.lane & 3)]; tg = TOKG[(size_t)m * 4 + (F.lane & 3)] * (1.0f / 64.0f); } }
    u32x2 hwA[4], hwB[4]; unsigned ywA[4][4], ywB[4][4];
#define P8_LOAD(k, hw, yw) do { const int m_ = gw + (k) * NGW; if (m_ < T) { const u32x2* xr_ = (const u32x2*)(H1R + (size_t)m_ * 1024) + F.lane; \
        _Pragma("unroll") for (int j = 0; j < 4; ++j) hw[j] = xr_[64 * j]; \
        _Pragma("unroll") for (int q = 0; q < 4; ++q) { const unsigned ep_ = (unsigned)__builtin_amdgcn_readlane((int)tk, (k) * 4 + q); \
            const size_t slot_ = (size_t)tstart[ep_ >> 16] * 256 + (ep_ & 0xffffu); const unsigned* yr_ = (const unsigned*)(Y + slot_ * 1024) + F.lane; \
            _Pragma("unroll") for (int j = 0; j < 4; ++j) yw[q][j] = yr_[64 * j]; } } } while (0)
#define P8_ROW(k, hw, yw) do { const int m_ = gw + (k) * NGW; if (m_ < T) { f32x4 v[4]; float gt[4]; \
        _Pragma("unroll") for (int q = 0; q < 4; ++q) gt[q] = __builtin_bit_cast(float, __builtin_amdgcn_readlane(__builtin_bit_cast(int, tg), (k) * 4 + q)); \
        _Pragma("unroll") for (int j = 0; j < 4; ++j) { v[j] = (f32x4){ALPHA * bf16_lo(hw[j].x), ALPHA * bf16_hi(hw[j].x), ALPHA * bf16_lo(hw[j].y), ALPHA * bf16_hi(hw[j].y)}; \
            _Pragma("unroll") for (int q = 0; q < 4; ++q) { const unsigned w = yw[q][j]; \
                v[j].x += gt[q] * fp8_to_f32(w, 0); v[j].y += gt[q] * fp8_to_f32(w, 1); v[j].z += gt[q] * fp8_to_f32(w, 2); v[j].w += gt[q] * fp8_to_f32(w, 3); } } \
        float s_ = 0.f; _Pragma("unroll") for (int j = 0; j < 4; ++j) s_ += (v[j].x + v[j].y) + (v[j].z + v[j].w); \
        const float mean_ = wave_sum(s_) * (1.f / 1024.f); float s2_ = 0.f; \
        _Pragma("unroll") for (int j = 0; j < 4; ++j) { v[j] = v[j] - mean_; s2_ += (v[j].x * v[j].x + v[j].y * v[j].y) + (v[j].z * v[j].z + v[j].w * v[j].w); } \
        const float rstd_ = 1.f / sqrtf(wave_sum(s2_) * (1.f / 1024.f) + LN_EPS); \
        f32x4* orow_ = (f32x4*)(F.out + (size_t)m_ * 1024) + F.lane; \
        _Pragma("unroll") for (int j = 0; j < 4; ++j) orow_[64 * j] = v[j] * rstd_ * gv[j] + bv[j]; } } while (0)
    P8_LOAD(0, hwA, ywA);
    P8_LOAD(1, hwB, ywB); P8_ROW(0, hwA, ywA);
    P8_LOAD(2, hwA, ywA); P8_ROW(1, hwB, ywB);
    P8_LOAD(3, hwB, ywB); P8_ROW(2, hwA, ywA);
    P8_LOAD(4, hwA, ywA); P8_ROW(3, hwB, ywB);
    P8_LOAD(5, hwB, ywB); P8_ROW(4, hwA, ywA);
    P8_LOAD(6, hwA, ywA); P8_ROW(5, hwB, ywB);
    P8_LOAD(7, hwB, ywB); P8_ROW(6, hwA, ywA);
    P8_ROW(7, hwB, ywB);
#undef P8_LOAD
#undef P8_ROW
}

__global__ void __launch_bounds__(NTHREADS, 2) mk_fwd(Args args) {
    extern __shared__ __attribute__((aligned(16))) unsigned char lds_raw[];
    Frame F;
    F.lds = (LAS unsigned char*)lds_raw;
    F.tid = threadIdx.x; F.lane = F.tid & 63; F.wave = __builtin_amdgcn_readfirstlane(F.tid >> 6); F.G = gridDim.x; F.bid = blockIdx.x;
    frame_refresh(F);
    volatile LAS unsigned* misc = (volatile LAS unsigned*)(F.lds + MISC_OFF);
    LAS int* tstart = (LAS int*)(F.lds + MISC_OFF + 256);
    LAS int* toktab = (LAS int*)(F.lds + MISC_OFF + 1024);
    if (F.tid < 4) misc[F.tid] = 0u;
    __syncthreads();
    const int lo = args.ph_lo, hi = args.ph_hi;
    XcdBarrier bar; bar.bar = F.ctl; bar.x = 0; bar.st = misc;
    if (hi - lo > 1) bar = xcd_barrier_post(F.ctl, misc);
#define IN(k) (lo <= (k) && (k) < hi)
#ifdef ONLY
#define PH_ON(k) ((k) == ONLY)
#else
#define PH_ON(k) true
#endif
#define SEAM(k) do { if (IN(k) && IN((k) + 1)) xcd_barrier(bar); frame_refresh(F); } while (0)

    if (PH_ON(0) && IN(0)) { p0_prologue(F); } SEAM(0);
    if (PH_ON(1) && IN(1)) {
        EpiInProj E{(bf16_t*)(F.ws + WS_U), (bf16_t*)(F.ws + WS_Q), (bf16_t*)(F.ws + WS_K), (bf16_t*)(F.ws + WS_V), (bf16_t*)(F.ws + WS_IQ), (bf16_t*)(F.ws + WS_IK), (float*)(F.ws + WS_IW),
                    (const float*)(F.ws + WS_ROPEQK), (const float*)(F.ws + WS_ROPEIX)};
        { pg8::StaticSched S{T / 256, 5, F.G, F.bid, 1, 1};
          pg8::gemm_phase<EpiInProj, pg8::StaticSched, true, 0x79797979, 0x7f7f7f7f>(F.lds, (const char*)(F.ws + WS_HA8), (const char*)(F.ws + WS_BTIN8), S, E); }
        { pg8::StaticSched S{T / 256, 4, F.G, F.bid, 0, 5};
          pg8::gemm_phase<EpiInProj, pg8::StaticSched>(F.lds, (const char*)(F.ws + WS_HA), (const char*)(F.ws + WS_BTIN), S, E); }
        if (F.bid >= 64) {
            convert_range(F, 0, 2 * CV_PAIRS1, (F.bid - 64) * 8 + F.wave, (F.G - 64) * 8); }
    } SEAM(1);
    if (PH_ON(2) && IN(2)) {
#ifndef NO_POOL
 p2_pool(F);
#endif
 p2_indexer(F); } SEAM(2);
    if (PH_ON(3) && IN(3)) { p3_attention(F); } SEAM(3);
    if (PH_ON(4) && IN(4)) {
        pg8::StaticSched S{T / 256, 4, F.G, F.bid, 0, 0};
        EpiMix E{(bf16_t*)(F.ws + WS_MIX)};
        pg8::gemm_phase<EpiMix, pg8::StaticSched>(F.lds, (const char*)(F.ws + WS_CAT), (const char*)(F.ws + WS_BTOUT), S, E);
    } SEAM(4);
    if (PH_ON(5) && IN(5)) { p5_ln1_router(F); } SEAM(5);
    if (PH_ON(6) && IN(6)) {
        moe_tables(F, tstart);
        const int ntl = tstart[NE];
        pg8::MoeSched<true> S{ntl, 8, F.G, F.bid, 2048, tstart, toktab, 0};
        { const unsigned* INV = (const unsigned*)(F.ws + WS_INV); pg8::Unit u; unsigned tk[10];
#pragma unroll
          for (int i = 0; i < 10; ++i) { tk[i] = 0u; if (S.next(i, u) && F.tid < 256) { const int p = (u.pm - tstart[u.e]) * 256 + F.tid; const int cnt = tstart[40 + u.e];
                  tk[i] = INV[(size_t)u.e * CAP + (p < cnt ? p : 0)]; } }
#pragma unroll
          for (int i = 0; i < 10; ++i) if (F.tid < 256) toktab[i * 256 + F.tid] = (int)tk[i];
          __syncthreads(); }
        EpiGateUp E{F.ws + WS_ACT, F.b_gu, F.ctl + CW_ACTRDY};
#ifndef NO_GU
        pg8::gemm_phase<EpiGateUp, pg8::MoeSched<true>, true, 0x79797979, 0x7f7f7f7f>(F.lds, (const char*)(F.ws + WS_H1B), (const char*)(F.ws + WS_BTGU), S, E);
#endif
        { const int nwg6 = 8 * ntl, rounds6 = (nwg6 + F.G - 1) / F.G, nidle = rounds6 * F.G - nwg6, cfirst = nwg6 - (rounds6 - 1) * F.G;
          int early = ((nidle < 128 ? nidle : 128) / 32) * 32; if (rounds6 < 9 || ntl < 32) early = 0;
          const int rank = F.bid - cfirst;
#ifndef NO_EARLY
          if (rank >= 0 && rank < early) {
              pg8::MoeSched<false> S7{early / 4, 4, F.G, rank, 1024, tstart, toktab, 0};
              pg8::Unit u; S7.next(0, u);
              if (F.tid < 64) {
                  unsigned* cp = F.ctl + CW_ACTRDY + u.pm; unsigned sp = 0;
                  while ((unsigned)__builtin_amdgcn_readfirstlane((int)__hip_atomic_load(cp, __ATOMIC_RELAXED, __HIP_MEMORY_SCOPE_AGENT)) < 64u) {
                      __builtin_amdgcn_s_sleep(2); if (++sp > (1u << 20)) { if (F.tid == 0) __hip_atomic_store(F.ctl + CW_TMO2, 1u, __ATOMIC_RELAXED, __HIP_MEMORY_SCOPE_AGENT); break; } }
                  __builtin_amdgcn_fence(__ATOMIC_ACQUIRE, "agent");
                  asm volatile("s_waitcnt vmcnt(0)" ::: "memory"); }
              __syncthreads();
              EpiDown E7{F.ws + WS_Y, F.b_dn};
              pg8::gemm_phase<EpiDown, pg8::MoeSched<false>, true, 0x79797979, 0x7c7c7c7c>(F.lds, (const char*)(F.ws + WS_ACT), (const char*)(F.ws + WS_BTDN), S7, E7);
          }
#endif
          (void)rank; (void)early; }
    } SEAM(6);
    if (PH_ON(7) && IN(7)) {
        moe_tables(F, tstart);
        const int ntl = tstart[NE];
        const int nwg6 = 8 * ntl, rounds6 = (nwg6 + F.G - 1) / F.G, nidle = rounds6 * F.G - nwg6;
        int early = ((nidle < 128 ? nidle : 128) / 32) * 32; if (rounds6 < 9 || ntl < 32) early = 0;
        pg8::MoeSched<false> S{ntl, 4, F.G, F.bid, 1024, tstart, toktab, early};
        EpiDown E{F.ws + WS_Y, F.b_dn};
        pg8::gemm_phase<EpiDown, pg8::MoeSched<false>, true, 0x79797979, 0x7c7c7c7c>(F.lds, (const char*)(F.ws + WS_ACT), (const char*)(F.ws + WS_BTDN), S, E);
    } SEAM(7);
    if (PH_ON(8) && IN(8)) { moe_tables(F, tstart); p8_final(F, tstart); }
#undef IN
#undef SEAM
}

extern "C" void kernel_launch(void* const* d_in, const int* in_sizes, int n_in, void* d_out, int out_size, void* d_ws, size_t ws_size, hipStream_t stream) {
    static int grid = 0;
    if (grid == 0) {
        if (n_in != 18 || in_sizes[0] != T * DM || out_size != T * DM || ws_size < WS_END) {
            fprintf(stderr, "kernel_launch: shape mismatch (n_in %d, in0 %d, out %d, ws %zu, need %zu)\n", n_in, n_in > 0 ? in_sizes[0] : -1, out_size, ws_size, (size_t)WS_END); grid = -1; return; }
        int dev = 0, cus = 0, per_cu = 0;
        if (hipGetDevice(&dev) != hipSuccess || hipDeviceGetAttribute(&cus, hipDeviceAttributeMultiprocessorCount, dev) != hipSuccess) { grid = -1; return; }
        if (hipFuncSetAttribute((const void*)mk_fwd, hipFuncAttributeMaxDynamicSharedMemorySize, LDS_BYTES) != hipSuccess) { fprintf(stderr, "kernel_launch: hipFuncSetAttribute failed\n"); grid = -1; return; }
        if (hipOccupancyMaxActiveBlocksPerMultiprocessor(&per_cu, (const void*)mk_fwd, NTHREADS, LDS_BYTES) != hipSuccess || per_cu < 1) {
            fprintf(stderr, "kernel_launch: occupancy query reports %d workgroups per CU\n", per_cu); }
        (void)hipGetLastError();
        grid = cus;
        if (grid != 256) { fprintf(stderr, "kernel_launch: built for a 256-CU device (static work deals), found %d CUs\n", cus); grid = -1; return; }
    }
    if (grid < 0) return;
    (void)hipMemsetAsync((char*)d_ws + WS_CTL, 0, CTL_BYTES, stream);
    Args a{};
    for (int i = 0; i < 18; ++i) a.in[i] = d_in[i];
    a.out = (float*)d_out; a.ws = (unsigned char*)d_ws;
#if MK_N_LAUNCHES == 1
    a.ph_lo = 0; a.ph_hi = NPH;
    hipLaunchKernelGGL(mk_fwd, dim3(grid), dim3(NTHREADS), LDS_BYTES, stream, a);
#else
    for (int p = 0; p < NPH; ++p) { a.ph_lo = p; a.ph_hi = p + 1; hipLaunchKernelGGL(mk_fwd, dim3(grid), dim3(NTHREADS), LDS_BYTES, stream, a);
#ifdef PROBE_DUP
        if (p == PROBE_DUP) { if (p == 3 || p == 5) (void)hipMemsetAsync((char*)d_ws + WS_CTL + 4096 * 4, 0, 1024, stream); hipLaunchKernelGGL(mk_fwd, dim3(grid), dim3(NTHREADS), LDS_BYTES, stream, a); }
#endif
    }
#endif
    const hipError_t le = hipPeekAtLastError();
    if (le != hipSuccess) fprintf(stderr, "kernel_launch: launch failed: %s\n", hipGetErrorName(le));
}
```

```cpp
#include <hip/hip_runtime.h>
#include <cstdio>
#include <cstdint>
#include <utility>

#define LAS __attribute__((address_space(3)))
typedef unsigned short bf16_t;
typedef short bf16x8 __attribute__((ext_vector_type(8)));
typedef short s16x4 __attribute__((ext_vector_type(4)));
typedef float f32x2 __attribute__((ext_vector_type(2)));
typedef float f32x4 __attribute__((ext_vector_type(4)));
typedef float f32x16 __attribute__((ext_vector_type(16)));
typedef unsigned u32x2 __attribute__((ext_vector_type(2)));
typedef unsigned u32x4 __attribute__((ext_vector_type(4)));

#ifndef MK_N_LAUNCHES
#define MK_N_LAUNCHES 1
#endif

constexpr int T = 16384, DM = 1024, SEQ = 2048, NBATCH = 8;
constexpr int INW = 2120, INP = 2304;
constexpr int NE = 32, CAP = 16384, MAXT = 288;
constexpr int NPH = 9;
constexpr float ALPHA = 1.189207115002721f;
constexpr float LN_EPS = 1e-5f;
constexpr float W_SCALE = 0.04419417382415922f;
constexpr int NTHREADS = 512;
constexpr int LDS_BYTES = 147456;
constexpr int MISC_OFF = 131072;

constexpr size_t al256(size_t x) { return (x + 255) / 256 * 256; }
constexpr size_t WS_CTL = 0;
constexpr size_t CTL_BYTES = 65536;
constexpr size_t WS_BTIN = WS_CTL + CTL_BYTES;
constexpr size_t WS_BTOUT = WS_BTIN + al256((size_t)INP * 1024 * 2);
constexpr size_t WS_BTGU = WS_BTOUT + al256((size_t)1024 * 1024 * 2);
constexpr size_t WS_BTDN = WS_BTGU + al256((size_t)NE * 2048 * 1024 * 2);
constexpr size_t WS_WPT = WS_BTDN + al256((size_t)NE * 1024 * 1024 * 2);
constexpr size_t WS_WRA = WS_WPT + al256((size_t)4 * 64 * 64 * 2);
constexpr size_t WS_HA = WS_WRA + al256((size_t)1024 * 32 * 4);
constexpr size_t WS_STATS = WS_HA + al256((size_t)T * 1024 * 2);
constexpr size_t WS_ROPEQK = WS_STATS + al256((size_t)T * 2 * 4);
constexpr size_t WS_ROPEIX = WS_ROPEQK + al256((size_t)T * 32 * 4);
constexpr size_t WS_U = WS_ROPEIX + al256((size_t)T * 16 * 4);
constexpr size_t WS_Q = WS_U + al256((size_t)T * 256 * 2);
constexpr size_t WS_K = WS_Q + al256((size_t)T * 768 * 2);
constexpr size_t WS_V = WS_K + al256((size_t)T * 256 * 2);
constexpr size_t WS_IQ = WS_V + al256((size_t)T * 256 * 2);
constexpr size_t WS_IK = WS_IQ + al256((size_t)T * 512 * 2);
constexpr size_t WS_IW = WS_IK + al256((size_t)T * 64 * 2);
constexpr size_t WS_MASK = WS_IW + al256((size_t)T * 8 * 4);
constexpr size_t WS_CAT = WS_MASK + al256((size_t)T * 64 * 4);
constexpr size_t WS_H1F = WS_CAT + al256((size_t)T * 1024 * 2);
constexpr size_t WS_H1B = WS_H1F + al256((size_t)T * 1024 * 4);
constexpr size_t WS_INV = WS_H1B + al256((size_t)T * 1024 * 2);
constexpr size_t WS_TOKEP = WS_INV + al256((size_t)NE * CAP * 4);
constexpr size_t WS_TOKG = WS_TOKEP + al256((size_t)T * 4 * 4);
constexpr size_t WS_ACT = WS_TOKG + al256((size_t)T * 4 * 4);
constexpr size_t WS_Y = WS_ACT + al256((size_t)MAXT * 256 * 1024 * 2);
constexpr size_t WS_MIX = WS_Y + al256((size_t)MAXT * 256 * 1024 * 2);
constexpr size_t WS_HA8 = WS_MIX + al256((size_t)T * 1024 * 2);
constexpr size_t WS_BTIN8 = WS_HA8 + al256((size_t)T * 1024);
constexpr size_t WS_END = WS_BTIN8 + al256((size_t)1536 * 1024);
constexpr int CW_CNT = 4096;
constexpr int CW_ATTQ = 4224;
constexpr int CW_CVQ1 = 4288, CW_CVQ3 = 4352, CW_ACTRDY = 4608;
constexpr int CW_TMO2 = 4480;
constexpr int CV_PAIRS1 = 3072, CV_PAIRS3 = 5120, CV_HIDDEN = 2 * (CV_PAIRS1 + CV_PAIRS3);

#define XB_TMO      128
#define XB_XCNT(j)  (256  + 64 * (j))
#define XB_XSUB(j)  (1280 + 64 * (j))
#define XB_XGEN(j)  (2304 + 64 * (j))
#define XB_TOP      3328
#define XB_TOPGEN   3392
#define XCD_BAR_WORDS 3456
#define XB_SPIN_CAP (1u << 18)
__device__ __forceinline__ unsigned xb_ld(unsigned* p)              { return __hip_atomic_load(p, __ATOMIC_RELAXED, __HIP_MEMORY_SCOPE_AGENT); }
__device__ __forceinline__ unsigned xb_add(unsigned* p, unsigned v) { return __hip_atomic_fetch_add(p, v, __ATOMIC_RELAXED, __HIP_MEMORY_SCOPE_AGENT); }
__device__ __forceinline__ unsigned xb_xcc_id() { return (unsigned)__builtin_amdgcn_s_getreg((3 << 11) | 20) & 0xFu; }
#define XB_SPIN(cond, bar) do { unsigned _sp = 0; while (cond) { __builtin_amdgcn_s_sleep(1); \
    if ((++_sp & 255u) == 0u) { if (xb_ld(&(bar)[XB_TMO])) break; if (_sp > XB_SPIN_CAP) { atomicAdd(&(bar)[XB_TMO], 1u); break; } } } } while (0)
struct XcdBarrier { unsigned* bar; unsigned x; volatile LAS unsigned* st; };
__device__ __forceinline__ XcdBarrier xcd_barrier_post(unsigned* bar, volatile LAS unsigned* st) {
    XcdBarrier b; b.bar = bar; b.x = xb_xcc_id(); b.st = st;
    if (threadIdx.x == 0) (void)xb_add(&bar[XB_XCNT(b.x)], 1u);
    return b;
}
__device__ __forceinline__ void xcd_barrier_complete(unsigned* bar, unsigned x, unsigned& nloc, unsigned& nx) {
    const unsigned G = gridDim.x * gridDim.y * gridDim.z;
    unsigned sum, cnt, mine, sp = 0u;
    for (;;) {
        sum = 0u; cnt = 0u; mine = 0u;
#pragma unroll
        for (unsigned j = 0; j < 16; ++j) { const unsigned c = xb_ld(&bar[XB_XCNT(j)]); sum += c; cnt += (c > 0u) ? 1u : 0u; mine = (j == x) ? c : mine; }
        if (sum == G) break;
        __builtin_amdgcn_s_sleep(1);
        if ((++sp & 255u) == 0u) { if (xb_ld(&bar[XB_TMO])) break; if (sp > XB_SPIN_CAP) { atomicAdd(&bar[XB_TMO], 1u); break; } }
    }
    nloc = mine > 0u ? mine : 1u; nx = cnt > 0u ? cnt : 1u;
}
__device__ __forceinline__ void xcd_barrier(const XcdBarrier& b) {
    asm volatile("s_waitcnt vmcnt(0)" ::: "memory");
    __syncthreads();
    if (threadIdx.x == 0) {
        unsigned* bar = b.bar;
        __builtin_amdgcn_s_waitcnt(0);
        unsigned nloc = b.st[0], nx = b.st[1];
        if (nloc == 0u) { xcd_barrier_complete(bar, b.x, nloc, nx); b.st[0] = nloc; b.st[1] = nx; }
        const unsigned old = xb_add(&bar[XB_XSUB(b.x)], 1u);
        const unsigned gen = old / nloc;
        if (old + 1u == (gen + 1u) * nloc) {
            __builtin_amdgcn_fence(__ATOMIC_RELEASE, "agent");
            asm volatile("s_waitcnt vmcnt(0)" ::: "memory");
            const unsigned og = xb_add(&bar[XB_TOP], 1u);
            const unsigned tg = og / nx;
            if (og + 1u == (tg + 1u) * nx) xb_add(&bar[XB_TOPGEN], 1u);
            else XB_SPIN(xb_ld(&bar[XB_TOPGEN]) == tg, bar);
            __builtin_amdgcn_fence(__ATOMIC_ACQUIRE, "agent");
            xb_add(&bar[XB_XGEN(b.x)], 1u);
            asm volatile("s_waitcnt vmcnt(0)" ::: "memory");
        } else {
            XB_SPIN(xb_ld(&bar[XB_XGEN(b.x)]) == gen, bar);
            __builtin_amdgcn_fence(__ATOMIC_ACQUIRE, "agent");
            asm volatile("s_waitcnt vmcnt(0)" ::: "memory");
        }
    }
    __syncthreads();
}

__device__ __forceinline__ unsigned cvt_pk_bf16(float lo, float hi) { unsigned r; asm volatile("v_cvt_pk_bf16_f32 %0, %1, %2" : "=v"(r) : "v"(lo), "v"(hi)); return r; }
__device__ __forceinline__ unsigned pk4_fp8(float a, float b, float c, float d) { int w = __builtin_amdgcn_cvt_pk_fp8_f32(a, b, 0, false); w = __builtin_amdgcn_cvt_pk_fp8_f32(c, d, w, true); return (unsigned)w; }
__device__ __forceinline__ float bf16_lo(unsigned w) { return __uint_as_float(w << 16); }
__device__ __forceinline__ float bf16_hi(unsigned w) { return __uint_as_float(w & 0xffff0000u); }
template <int CTRL> __device__ __forceinline__ float dpp_f(float v) { return __builtin_bit_cast(float, __builtin_amdgcn_update_dpp(0, __builtin_bit_cast(int, v), CTRL, 0xf, 0xf, true)); }
__device__ __forceinline__ float wave_sum(float v) {
    v += dpp_f<0xB1>(v);
    v += dpp_f<0x4E>(v);
    v += dpp_f<0x141>(v);
    v += dpp_f<0x140>(v);
    const int vi = __builtin_bit_cast(int, v);
    const float r0 = __builtin_bit_cast(float, __builtin_amdgcn_readlane(vi, 0)), r1 = __builtin_bit_cast(float, __builtin_amdgcn_readlane(vi, 16));
    const float r2 = __builtin_bit_cast(float, __builtin_amdgcn_readlane(vi, 32)), r3 = __builtin_bit_cast(float, __builtin_amdgcn_readlane(vi, 48));
    return (r0 + r1) + (r2 + r3);
}
#define LDS_WAIT() asm volatile("s_waitcnt lgkmcnt(0)" ::: "memory")
#define VM_WAIT()  asm volatile("s_waitcnt vmcnt(0)" ::: "memory")
__device__ __forceinline__ int crow(int r, int hi) { return (r & 3) + 8 * (r >> 2) + 4 * hi; }

namespace pg8 {
constexpr int BM = 256, BK = 64, HALF = 128, HTB = HALF * BK * 2, STAGE_BYTES = 8 * HTB, NXCD = 8, WGM = 4, KD = 1024;
__device__ __forceinline__ int lds_byte(int r, int c) { const int st = (r >> 4) * 2 + (c >> 5), rr = r & 15, cc = c & 31, ob = rr * 64 + cc * 2; return st * 1024 + (ob ^ (((ob >> 9) & 1) << 5)); }
__device__ __forceinline__ void stage_rc(int b, int& R, int& C) { const int st = b / 1024, sb = b % 1024, swz = sb ^ (((sb >> 9) & 1) << 5); R = (st >> 1) * 16 + swz / 64; C = (st & 1) * 32 + (swz % 64) / 2; }
__device__ __forceinline__ int perm32(int rho) { const int n = rho >> 4, i = rho & 15; return 8 * (i >> 2) + 4 * n + (i & 3); }

struct Unit { int pm, pn, e, idx; };

__device__ __forceinline__ void order_decode(int wgid, int nM, int nN, int& pm, int& pn) {
    const int nig = WGM * nN, gid = wgid / nig, fm = gid * WGM, gsz = (nM - fm) < WGM ? (nM - fm) : WGM;
    pm = fm + ((wgid % nig) % gsz); pn = (wgid % nig) / gsz;
}
__device__ __forceinline__ bool order_next(int i, int G, int c, int nM, int nN, int& pm, int& pn, int woff = 0) {
    const int nwg = nM * nN - woff; const long L = (long)i * G + c; if (L >= nwg) return false;
    int wgid = (int)L; { const int q = nwg / NXCD, r = nwg % NXCD, xcd = wgid % NXCD, off = wgid / NXCD; wgid = (xcd < r ? xcd * (q + 1) : r * (q + 1) + (xcd - r) * q) + off; }
    order_decode(wgid + woff, nM, nN, pm, pn); return true;
}
struct StaticSched {
    int nM, nN, G, c, t0, toff;
    __device__ __forceinline__ bool next(int i, Unit& u) const { u.idx = i; const bool ok = order_next(i, G, c, nM, nN, u.pm, u.pn); u.e = (u.pn == 0) ? t0 : u.pn + toff; return ok; }
    __device__ __forceinline__ int a_row(const Unit& u, int h, int R) const { return u.pm * BM + h * HALF + R; }
    __device__ __forceinline__ int b_row(const Unit& u) const { return u.e * BM; }
};
template <bool GATHER> struct MoeSched {
    int nM, nN, G, c; int brows;
    const LAS int* tstart; const LAS int* toktab; int woff;
    __device__ __forceinline__ bool next(int i, Unit& u) const {
        u.idx = i;
        if (!order_next(i, G, c, nM, nN, u.pm, u.pn, woff)) return false;
        int e = 0;
#pragma unroll
        for (int k = 1; k < NE; ++k) e += (u.pm >= tstart[k]) ? 1 : 0;
        u.e = e; return true;
    }
    __device__ __forceinline__ int a_row(const Unit& u, int h, int R) const { if constexpr (GATHER) return toktab[u.idx * 256 + h * HALF + R]; else return u.pm * BM + h * HALF + R; }
    __device__ __forceinline__ int b_row(const Unit& u) const { return u.e * brows + u.pn * BM; }
};

typedef int v8i32 __attribute__((ext_vector_type(8)));
typedef int v4i32 __attribute__((ext_vector_type(4)));
__device__ __forceinline__ v8i32 cat8(bf16x8 a, bf16x8 b) { const v4i32 x = __builtin_bit_cast(v4i32, a), y = __builtin_bit_cast(v4i32, b); return __builtin_shufflevector(x, y, 0, 1, 2, 3, 4, 5, 6, 7); }
template <class Epi, class Sched, bool FP8 = false, int SW = 0x7f7f7f7f, int SA = 0x7f7f7f7f>
__device__ __forceinline__ void gemm_phase(LAS unsigned char* lds, const char* Abase, const char* Bbase, const Sched& S, const Epi& E) {
    const int tid = threadIdx.x, wid = __builtin_amdgcn_readfirstlane(tid >> 6), lane = tid & 63, wr = wid >> 2, wc = wid & 3, fr = lane & 15, fq = lane >> 4;
    constexpr int ROWB = FP8 ? KD : 2 * KD, nt = ROWB / 128;
    int RA[2], CA[2]; unsigned voffB[2];
#pragma unroll
    for (int i = 0; i < 2; ++i) { int R, C; stage_rc(tid * 16 + i * 8192, R, C); const int Rb = Epi::PERM ? ((R & ~31) + perm32(R & 31)) : R;
        RA[i] = R; CA[i] = C * 2; voffB[i] = (unsigned)(Rb * ROWB + C * 2); }
    const size_t kstep = (size_t)(BK * 2);
    const size_t hstep = (size_t)HALF * ROWB;
    const unsigned ldsw = (unsigned)wid * 1024u;
    const int aoff = lds_byte(wr * 64 + fr, fq * 8), boff = lds_byte(wc * 32 + fr, fq * 8);
#define PG8_SA(b, h) (((b) * 2 + (h)) * HTB)
#define PG8_SB(b, h) ((4 + (b) * 2 + (h)) * HTB)
#define PG8_STAGE(bufoff, gbase, voff) do { _Pragma("unroll") for (int _i = 0; _i < 2; ++_i) \
        __builtin_amdgcn_global_load_lds((const unsigned*)((const char*)(gbase) + (voff)[_i]), (LAS unsigned*)(lds + (bufoff) + ldsw + _i * 8192), 16, 0, 0); } while (0)
#define PG8_LDA(dst, b, h) do { _Pragma("unroll") for (int m = 0; m < 4; ++m) _Pragma("unroll") for (int k = 0; k < 2; ++k) dst[m][k] = *(const LAS bf16x8*)(lds + PG8_SA(b, h) + aoff + m * 2048 + k * 1024); } while (0)
#define PG8_LDB(dst, b, h) do { _Pragma("unroll") for (int n = 0; n < 2; ++n) _Pragma("unroll") for (int k = 0; k < 2; ++k) dst[n][k] = *(const LAS bf16x8*)(lds + PG8_SB(b, h) + boff + n * 2048 + k * 1024); } while (0)
#define PG8_MMA(ai, bj, At, Bt) do { __builtin_amdgcn_s_setprio(1); if constexpr (FP8) { _Pragma("unroll") for (int m = 0; m < 4; ++m) _Pragma("unroll") for (int n = 0; n < 2; ++n) \
        acc[ai][bj][m][n] = __builtin_amdgcn_mfma_scale_f32_16x16x128_f8f6f4(cat8(Bt[n][0], Bt[n][1]), cat8(At[m][0], At[m][1]), acc[ai][bj][m][n], 0, 0, 0, SW, 0, SA); } \
        else { _Pragma("unroll") for (int m = 0; m < 4; ++m) _Pragma("unroll") for (int n = 0; n < 2; ++n) _Pragma("unroll") for (int k = 0; k < 2; ++k) \
        acc[ai][bj][m][n] = __builtin_amdgcn_mfma_f32_16x16x32_bf16(Bt[n][k], At[m][k], acc[ai][bj][m][n], 0, 0, 0); } __builtin_amdgcn_s_setprio(0); } while (0)
#define PG8_WAIT_V(n) asm volatile("s_waitcnt vmcnt(" #n ")" ::: "memory")
#define PG8_WAIT_L(n) asm volatile("s_waitcnt lgkmcnt(" #n ")" ::: "memory")
#define PG8_BAR __builtin_amdgcn_s_barrier()
#define PG8_SCHED __builtin_amdgcn_sched_barrier(0)
    Unit cur, nxt; int ui = 0;
    if (!S.next(0, cur)) return;
    f32x4 acc[2][2][4][2]; f32x4 bini[2][2];
#pragma unroll
    for (int b = 0; b < 2; ++b)
#pragma unroll
        for (int n = 0; n < 2; ++n) bini[b][n] = Epi::BIAS_INIT ? E.bias4(cur, b, n, wc, fq) : (f32x4){0.f, 0.f, 0.f, 0.f};
#pragma unroll
    for (int a = 0; a < 2; ++a)
#pragma unroll
        for (int b = 0; b < 2; ++b)
#pragma unroll
            for (int m = 0; m < 4; ++m)
#pragma unroll
                for (int n = 0; n < 2; ++n) acc[a][b][m][n] = bini[b][n];
    bf16x8 At[4][2], B0[2][2], B1[2][2];
    unsigned oA[2][2];
#pragma unroll
    for (int h = 0; h < 2; ++h)
#pragma unroll
        for (int i = 0; i < 2; ++i) oA[h][i] = (unsigned)(S.a_row(cur, h, RA[i]) * ROWB + CA[i]);
    const char* cB = Bbase + (size_t)S.b_row(cur) * ROWB;
    const char* cA = Abase;
    PG8_STAGE(PG8_SB(0, 0), cB, voffB); PG8_STAGE(PG8_SA(0, 0), cA, oA[0]); PG8_STAGE(PG8_SB(0, 1), cB + hstep, voffB); PG8_STAGE(PG8_SA(0, 1), cA, oA[1]);
    if (wr == 1) PG8_BAR;
    PG8_WAIT_V(4); PG8_BAR;
    PG8_STAGE(PG8_SB(1, 0), cB + kstep, voffB); PG8_STAGE(PG8_SA(1, 0), cA + kstep, oA[0]); PG8_STAGE(PG8_SB(1, 1), cB + hstep + kstep, voffB);
    PG8_WAIT_V(6); PG8_BAR;
    for (;;) {
        const bool has_next = S.next(ui + 1, nxt);
        const char* nB = has_next ? Bbase + (size_t)S.b_row(nxt) * ROWB : cB;
        for (int t = 0; t < nt; t += 2) {
            const bool last = (t == nt - 2);
            const char* a1 = cA + (size_t)(t + 1) * kstep;
            const char* a2 = last ? cA : cA + (size_t)(t + 2) * kstep; const char* b2 = last ? nB : cB + (size_t)(t + 2) * kstep;
            const char* a3 = a2 + kstep; const char* b3 = b2 + kstep;
            PG8_LDB(B0, 0, 0); PG8_SCHED; PG8_LDA(At, 0, 0); PG8_STAGE(PG8_SA(1, 1), a1, oA[1]);
            if (last && has_next) {
#pragma unroll
                for (int h = 0; h < 2; ++h)
#pragma unroll
                    for (int i = 0; i < 2; ++i) oA[h][i] = (unsigned)(S.a_row(nxt, h, RA[i]) * ROWB + CA[i]);
            }
            PG8_WAIT_L(8); PG8_BAR; PG8_WAIT_L(0); PG8_MMA(0, 0, At, B0); PG8_BAR; PG8_SCHED;
            PG8_LDB(B1, 0, 1); PG8_STAGE(PG8_SB(0, 0), b2, voffB);
            PG8_BAR; PG8_WAIT_L(0); PG8_MMA(0, 1, At, B1); PG8_BAR;
            PG8_LDA(At, 0, 1); PG8_STAGE(PG8_SA(0, 0), a2, oA[0]);
            PG8_BAR; PG8_WAIT_L(0); PG8_MMA(1, 0, At, B0); PG8_BAR; PG8_SCHED;
            PG8_STAGE(PG8_SB(0, 1), b2 + hstep, voffB);
            PG8_WAIT_V(6); PG8_BAR; PG8_MMA(1, 1, At, B1); PG8_BAR;
            PG8_LDB(B0, 1, 0); PG8_SCHED; PG8_LDA(At, 1, 0); PG8_STAGE(PG8_SA(0, 1), a2, oA[1]);
            PG8_WAIT_L(8); PG8_BAR; PG8_WAIT_L(0); PG8_MMA(0, 0, At, B0); PG8_BAR; PG8_SCHED;
            PG8_LDB(B1, 1, 1); PG8_STAGE(PG8_SB(1, 0), b3, voffB);
            PG8_BAR; PG8_WAIT_L(0); PG8_MMA(0, 1, At, B1); PG8_BAR;
            PG8_LDA(At, 1, 1); PG8_STAGE(PG8_SA(1, 0), a3, oA[0]);
            PG8_BAR; PG8_WAIT_L(0); PG8_MMA(1, 0, At, B0); PG8_BAR; PG8_SCHED;
            PG8_STAGE(PG8_SB(1, 1), b3 + hstep, voffB);
            PG8_WAIT_V(6); PG8_BAR; PG8_MMA(1, 1, At, B1); PG8_BAR;
        }
        int l2 = threadIdx.x & 63; asm volatile("" : "+v"(l2));
        const int fr2 = l2 & 15, fq2 = l2 >> 4;
        if (Epi::BIAS_INIT && has_next) {
#pragma unroll
            for (int b = 0; b < 2; ++b)
#pragma unroll
                for (int n = 0; n < 2; ++n) bini[b][n] = E.bias4(nxt, b, n, wc, fq2);
        }
        E(acc, cur, wr, wc, fr2, fq2);
        if (!has_next) break;
#pragma unroll
        for (int a = 0; a < 2; ++a)
#pragma unroll
            for (int b = 0; b < 2; ++b)
#pragma unroll
                for (int m = 0; m < 4; ++m)
#pragma unroll
                    for (int n = 0; n < 2; ++n) acc[a][b][m][n] = bini[b][n];
        cur = nxt; cB = nB; ++ui;
    }
    PG8_WAIT_V(0);
    if (wr == 0) PG8_BAR;
    PG8_BAR;
#undef PG8_SA
#undef PG8_SB
#undef PG8_STAGE
#undef PG8_LDA
#undef PG8_LDB
#undef PG8_MMA
#undef PG8_WAIT_V
#undef PG8_WAIT_L
#undef PG8_BAR
#undef PG8_SCHED
}
}

struct EpiInProj {
    static constexpr bool PERM = true, BIAS_INIT = false;
    bf16_t *u, *q, *k, *v, *iq, *ik; float* iw; const float* ropeQK; const float* ropeIX;
    __device__ __forceinline__ f32x4 bias4(const pg8::Unit&, int, int, int, int) const { return (f32x4){0.f, 0.f, 0.f, 0.f}; }
    __device__ __forceinline__ void operator()(f32x4 (&acc)[2][2][4][2], const pg8::Unit& un, int wr, int wc, int fr, int fq) const {
        const int lane = threadIdx.x & 63;
#pragma unroll
        for (int bj = 0; bj < 2; ++bj) {
            const int gc = un.e * 256 + bj * 128;
            bf16_t* dst; int ld; int kind = 0;
            const int cin = wc * 32 + 8 * fq;
            if (gc < 256) { dst = u + gc + cin; ld = 256; }
            else if (gc < 1024) { dst = q + (gc - 256) + cin; ld = 768; kind = (wc == 0) ? 1 : 0; }
            else if (gc < 1280) { dst = k + (gc - 1024) + cin; ld = 256; kind = (wc == 0) ? 1 : 0; }
            else if (gc < 1536) { dst = v + (gc - 1280) + cin; ld = 256; }
            else if (gc < 2048) { dst = iq + (gc - 1536) + cin; ld = 512; kind = ((wc & 1) == 0) ? 2 : 0; }
            else if (gc == 2048) { if (wc >= 2) { if (wc == 2 && fq == 0) {
#pragma unroll
                        for (int ai = 0; ai < 2; ++ai)
#pragma unroll
                            for (int m = 0; m < 4; ++m) { const int row = un.pm * 256 + ai * 128 + wr * 64 + m * 16 + fr;
                                *(f32x4*)(iw + (size_t)row * 8) = acc[ai][bj][m][0]; *(f32x4*)(iw + (size_t)row * 8 + 4) = acc[ai][bj][m][1]; } }
                    continue; }
                dst = ik + cin; ld = 64; kind = (wc == 0) ? 2 : 0; }
            else continue;
#pragma unroll
            for (int ai = 0; ai < 2; ++ai)
#pragma unroll
                for (int m = 0; m < 4; ++m) {
                    const int row = un.pm * 256 + ai * 128 + wr * 64 + m * 16 + fr;
                    f32x4 v0 = acc[ai][bj][m][0], v1 = acc[ai][bj][m][1];
                    if (kind == 1) {
                        const float* rp = ropeQK + (size_t)row * 32 + 8 * (fq & 1);
                        const f32x4 c0 = *(const f32x4*)rp, c1 = *(const f32x4*)(rp + 4), s0 = *(const f32x4*)(rp + 16), s1 = *(const f32x4*)(rp + 20);
                        f32x4 p0, p1;
#pragma unroll
                        for (int j = 0; j < 4; ++j) { p0[j] = __shfl_xor(v0[j], 32); p1[j] = __shfl_xor(v1[j], 32); }
                        const float sg = (fq < 2) ? -1.f : 1.f;
                        v0 = v0 * c0 + sg * (p0 * s0); v1 = v1 * c1 + sg * (p1 * s1);
                    } else if (kind == 2) {
                        const float* rp = ropeIX + (size_t)row * 16;
                        const f32x4 c0 = *(const f32x4*)rp, c1 = *(const f32x4*)(rp + 4), s0 = *(const f32x4*)(rp + 8), s1 = *(const f32x4*)(rp + 12);
                        f32x4 p0, p1;
#pragma unroll
                        for (int j = 0; j < 4; ++j) { p0[j] = __shfl_xor(v0[j], 16); p1[j] = __shfl_xor(v1[j], 16); }
                        if (fq < 2) { const float sg = (fq == 0) ? -1.f : 1.f; v0 = v0 * c0 + sg * (p0 * s0); v1 = v1 * c1 + sg * (p1 * s1); }
                    }
                    u32x4 w; w.x = cvt_pk_bf16(v0[0], v0[1]); w.y = cvt_pk_bf16(v0[2], v0[3]); w.z = cvt_pk_bf16(v1[0], v1[1]); w.w = cvt_pk_bf16(v1[2], v1[3]);
                    *(u32x4*)(dst + (size_t)row * ld) = w;
                }
        }
        (void)lane;
    }
};
struct EpiMix {
    static constexpr bool PERM = true, BIAS_INIT = false;
    bf16_t* mix;
    __device__ __forceinline__ f32x4 bias4(const pg8::Unit&, int, int, int, int) const { return (f32x4){0.f, 0.f, 0.f, 0.f}; }
    __device__ __forceinline__ void operator()(f32x4 (&acc)[2][2][4][2], const pg8::Unit& un, int wr, int wc, int fr, int fq) const {
        const int row0 = un.pm * 256 + wr * 64 + fr, col0 = un.pn * 256 + wc * 32 + 8 * fq;
#pragma unroll
        for (int bj = 0; bj < 2; ++bj)
#pragma unroll
            for (int ai = 0; ai < 2; ++ai)
#pragma unroll
                for (int m = 0; m < 4; ++m) {
                    const f32x4 v0 = acc[ai][bj][m][0], v1 = acc[ai][bj][m][1];
                    u32x4 w; w.x = cvt_pk_bf16(v0[0], v0[1]); w.y = cvt_pk_bf16(v0[2], v0[3]); w.z = cvt_pk_bf16(v1[0], v1[1]); w.w = cvt_pk_bf16(v1[2], v1[3]);
                    *(u32x4*)(mix + (size_t)(row0 + ai * 128 + m * 16) * 1024 + col0 + bj * 128) = w;
                }
    }
};
struct EpiGateUp {
    static constexpr bool PERM = true, BIAS_INIT = true;
    unsigned char* act; const float* bias; unsigned* rdy;
    __device__ __forceinline__ f32x4 bias4(const pg8::Unit& un, int bj, int n, int wc, int fq) const { return *(const f32x4*)(bias + (size_t)un.e * 2048 + bj * 1024 + un.pn * 128 + wc * 32 + 8 * fq + 4 * n); }
    __device__ __forceinline__ void operator()(f32x4 (&acc)[2][2][4][2], const pg8::Unit& un, int wr, int wc, int fr, int fq) const {
        const int row0 = un.pm * 256 + wr * 64 + fr, col0 = un.pn * 128 + wc * 32 + 8 * fq;
#pragma unroll
        for (int ai = 0; ai < 2; ++ai)
#pragma unroll
            for (int m = 0; m < 4; ++m) {
                float o[8];
#pragma unroll
                for (int n = 0; n < 2; ++n) {
                    const f32x4 gt = acc[ai][0][m][n], up = acc[ai][1][m][n];
#pragma unroll
                    for (int j = 0; j < 4; ++j) {
                        const float gg = fminf(gt[j], 7.0f), uu = fminf(fmaxf(up[j], -7.0f), 7.0f);
                        const float sig = __builtin_amdgcn_rcpf(1.0f + __builtin_amdgcn_exp2f(-1.702f * 1.4426950408889634f * gg));
                        o[4 * n + j] = (uu * 8.0f + 8.0f) * gg * sig;
                    }
                }
                u32x2 w; w.x = pk4_fp8(o[0], o[1], o[2], o[3]); w.y = pk4_fp8(o[4], o[5], o[6], o[7]);
                const unsigned dofs = (unsigned)((row0 + ai * 128 + m * 16) * 1024 + col0);
                if (un.pm < 32) asm volatile("global_store_dwordx2 %0, %1, %2 sc1" :: "v"(dofs), "v"(w), "s"(act) : "memory");
                else *(u32x2*)(act + dofs) = w;
            }
        if (un.pm < 32) {
            asm volatile("s_waitcnt vmcnt(0)" ::: "memory");
            if ((threadIdx.x & 63) == 0) __hip_atomic_fetch_add(rdy + un.pm, 1u, __ATOMIC_RELAXED, __HIP_MEMORY_SCOPE_AGENT);
        }
    }
};
struct EpiDown {
    static constexpr bool PERM = true, BIAS_INIT = false;
    unsigned char* y; const float* bias;
    __device__ __forceinline__ f32x4 bias4(const pg8::Unit& un, int bj, int n, int wc, int fq) const { return *(const f32x4*)(bias + (size_t)un.e * 1024 + un.pn * 256 + bj * 128 + wc * 32 + 8 * fq + 4 * n); }
    __device__ __forceinline__ void operator()(f32x4 (&acc)[2][2][4][2], const pg8::Unit& un, int wr, int wc, int fr, int fq) const {
        const int row0 = un.pm * 256 + wr * 64 + fr, col0 = un.pn * 256 + wc * 32 + 8 * fq;
        const float* bp = bias + (size_t)un.e * 1024 + col0;
#pragma unroll
        for (int bj = 0; bj < 2; ++bj) {
            const f32x4 b0 = *(const f32x4*)(bp + bj * 128) * 64.0f, b1 = *(const f32x4*)(bp + bj * 128 + 4) * 64.0f;
#pragma unroll
            for (int ai = 0; ai < 2; ++ai)
#pragma unroll
                for (int m = 0; m < 4; ++m) {
                    const f32x4 v0 = acc[ai][bj][m][0] * 64.0f + b0, v1 = acc[ai][bj][m][1] * 64.0f + b1;
#define CL8(x) __builtin_amdgcn_fmed3f((x), -448.f, 448.f)
                    u32x2 w; w.x = pk4_fp8(CL8(v0[0]), CL8(v0[1]), CL8(v0[2]), CL8(v0[3])); w.y = pk4_fp8(CL8(v1[0]), CL8(v1[1]), CL8(v1[2]), CL8(v1[3]));
#undef CL8
                    *(u32x2*)(y + (size_t)(row0 + ai * 128 + m * 16) * 1024 + col0 + bj * 128) = w;
                }
        }
    }
};

struct Args { const void* in[18]; float* out; unsigned char* ws; int ph_lo, ph_hi; };
struct Frame {
    LAS unsigned char* lds; int tid, lane, wave, G, bid;
    const float *x, *ln_in_g, *ln_in_b, *w_in, *w_pool, *pool_scale, *w_out, *ln1_g, *ln1_b, *w_router, *b_router, *w_gu, *b_gu, *w_dn, *b_dn, *ln2_g, *ln2_b;
    const int* positions; float* out; unsigned char* ws; unsigned* ctl;
};

typedef const Args __attribute__((address_space(4))) * KArgP;
__device__ __forceinline__ void frame_refresh(Frame& F) {
    KArgP ap = (KArgP)__builtin_amdgcn_kernarg_segment_ptr(); asm volatile("" : "+s"(ap));
    int t_ = threadIdx.x; asm volatile("" : "+v"(t_)); F.tid = t_; F.lane = t_ & 63;
    F.x = (const float*)ap->in[0]; F.positions = (const int*)ap->in[1]; F.ln_in_g = (const float*)ap->in[2]; F.ln_in_b = (const float*)ap->in[3];
    F.w_in = (const float*)ap->in[4]; F.w_pool = (const float*)ap->in[5]; F.pool_scale = (const float*)ap->in[6]; F.w_out = (const float*)ap->in[7];
    F.ln1_g = (const float*)ap->in[8]; F.ln1_b = (const float*)ap->in[9]; F.w_router = (const float*)ap->in[10]; F.b_router = (const float*)ap->in[11];
    F.w_gu = (const float*)ap->in[12]; F.b_gu = (const float*)ap->in[13]; F.w_dn = (const float*)ap->in[14]; F.b_dn = (const float*)ap->in[15];
    F.ln2_g = (const float*)ap->in[16]; F.ln2_b = (const float*)ap->in[17];
    F.out = ap->out; F.ws = ap->ws; F.ctl = (unsigned*)(ap->ws + WS_CTL);
}
struct TrItem { const float* src; unsigned char* dst; int ldw, ldt, fp8; };
__device__ __forceinline__ TrItem mk_item(const float* W, unsigned char* WT, int ldw, int k0, int n0, int ldt, int drow0, int fp8) {
    TrItem t; t.src = W + (size_t)k0 * ldw + n0; t.dst = WT + ((size_t)drow0 * ldt + k0) * (fp8 ? 1 : 2); t.ldw = ldw; t.ldt = ldt; t.fp8 = fp8; return t;
}
__device__ __forceinline__ void tr_load(const TrItem& t, float (&tmp)[32], int lane) {
    const float* p = t.src + (size_t)(lane >> 5) * t.ldw + (lane & 31);
#pragma unroll
    for (int i = 0; i < 32; ++i) tmp[i] = __builtin_nontemporal_load(p + (size_t)(2 * i) * t.ldw);
}
__device__ __forceinline__ void tr_store(const TrItem& t, const float (&tmp)[32], LAS float* scr, int lane) {
#pragma unroll
    for (int i = 0; i < 32; ++i) { const int kk = 2 * i + (lane >> 5); scr[kk * 33 + (lane & 31)] = tmp[i]; }
    LDS_WAIT();
    if (t.fp8) {
        const int n = lane >> 1, kb = 32 * (lane & 1); const LAS float* sp = scr + kb * 33 + n;
        unsigned o[8];
#pragma unroll
        for (int q = 0; q < 8; ++q) { float v[4];
#pragma unroll
            for (int j = 0; j < 4; ++j) v[j] = __builtin_amdgcn_fmed3f(sp[(4 * q + j) * 33] * 64.0f, -448.f, 448.f);
            o[q] = pk4_fp8(v[0], v[1], v[2], v[3]); }
        unsigned char* dp = t.dst + (size_t)n * 1024 + kb;
        *(u32x4*)dp = (u32x4){o[0], o[1], o[2], o[3]}; *(u32x4*)(dp + 16) = (u32x4){o[4], o[5], o[6], o[7]};
    } else {
        const int c = lane & 7;
#pragma unroll
        for (int j = 0; j < 4; ++j) { const int n = (lane >> 3) + 8 * j; const LAS float* sp = scr + (8 * c) * 33 + n;
            u32x4 o; o.x = cvt_pk_bf16(sp[0 * 33], sp[1 * 33]); o.y = cvt_pk_bf16(sp[2 * 33], sp[3 * 33]); o.z = cvt_pk_bf16(sp[4 * 33], sp[5 * 33]); o.w = cvt_pk_bf16(sp[6 * 33], sp[7 * 33]);
            *(u32x4*)(t.dst + ((size_t)n * t.ldt + 8 * c) * 2) = o; }
    }
    LDS_WAIT();
}
__device__ __forceinline__ TrItem moe_item(Frame& F, int r) {
    constexpr int I_GU = NE * 16 * 64;
    if (r < I_GU) { const int e = r / 1024, rr = r % 1024, kb = rr / 64, nb = rr % 64, n0 = 32 * nb, bj = n0 / 1024, rem = n0 % 1024, pn = rem / 128, j0 = rem % 128;
        return mk_item(F.w_gu + (size_t)e * 1024 * 2048, F.ws + WS_BTGU + (size_t)e * 2048 * 1024, 2048, 64 * kb, n0, 1024, pn * 256 + bj * 128 + j0, 1); }
    r -= I_GU; const int e = r / 512, rr = r % 512, kb = rr / 32, nb = rr % 32;
    return mk_item(F.w_dn + (size_t)e * 1024 * 1024, F.ws + WS_BTDN + (size_t)e * 1024 * 1024, 1024, 64 * kb, 32 * nb, 1024, 32 * nb, 1);
}
__device__ __forceinline__ void convert_range(Frame& F, int first, int n, int widx, int nw) {
    LAS float* scr = (LAS float*)(F.lds + F.wave * 16384);
    int base = 2 * widx; if (base >= n) return;
    float va[32], vb[32], vc[32], vd[32];
    TrItem ta = moe_item(F, first + base), tb = moe_item(F, first + base + 1);
    tr_load(ta, va, F.lane); tr_load(tb, vb, F.lane);
    for (;;) {
        const int nb = base + 2 * nw; const bool more = nb < n;
        const TrItem tc = moe_item(F, first + (more ? nb : base)), td = moe_item(F, first + (more ? nb : base) + 1);
        if (more) { tr_load(tc, vc, F.lane); tr_load(td, vd, F.lane); }
        tr_store(ta, va, scr, F.lane); tr_store(tb, vb, scr, F.lane);
        if (!more) break;
        const int nb2 = nb + 2 * nw; const bool more2 = nb2 < n;
        ta = moe_item(F, first + (more2 ? nb2 : nb)); tb = moe_item(F, first + (more2 ? nb2 : nb) + 1);
        if (more2) { tr_load(ta, va, F.lane); tr_load(tb, vb, F.lane); }
        tr_store(tc, vc, scr, F.lane); tr_store(td, vd, scr, F.lane);
        if (!more2) break;
        base = nb2;
    }
}
__device__ __forceinline__ void cvq_pull(Frame& F, unsigned* head, int first, int npairs) {
    LAS float* scr = (LAS float*)(F.lds + F.wave * 16384);
    for (;;) {
        unsigned c = 0; if (F.lane == 0) c = __hip_atomic_fetch_add(head, 1u, __ATOMIC_RELAXED, __HIP_MEMORY_SCOPE_AGENT);
        c = (unsigned)__builtin_amdgcn_readfirstlane((int)c);
        if (c >= (unsigned)npairs) break;
        const int r = 2 * (first + (int)c);
        const TrItem ta = moe_item(F, r), tb = moe_item(F, r + 1);
        float va[32], vb[32];
        tr_load(ta, va, F.lane); tr_load(tb, vb, F.lane);
        tr_store(ta, va, scr, F.lane); tr_store(tb, vb, scr, F.lane);
    }
}
__constant__ double ROPE_QK_FREQ[16] = {1.0, 0.44036660267178046, 0.19392274474868576, 0.08539710028576561, 0.03760603093086393, 0.016560440080994446, 0.007292664737217109, 0.003211445994752591,
    0.001414213562373095, 0.000622772421914596, 0.0002742481756762073, 0.00012076973741146504, 5.318295896944988e-05, 2.341999896140934e-05, 1.031338537721246e-05, 4.5416704806078695e-06};
__constant__ double ROPE_IX_FREQ[8] = {1.0, 0.19392274474868576, 0.03760603093086393, 0.007292664737217109, 0.001414213562373095, 0.0002742481756762073, 5.318295896944988e-05, 1.031338537721246e-05};

__device__ __forceinline__ void p0_prologue(Frame& F) {
    LAS float* scr = (LAS float*)(F.lds + F.wave * 16384);
    const int gw = F.bid * 8 + F.wave, NGW = F.G * 8;
    const int gt = F.bid * NTHREADS + F.tid, NGT = F.G * NTHREADS;
    bf16_t* BtIn = (bf16_t*)(F.ws + WS_BTIN); bf16_t* BtOut = (bf16_t*)(F.ws + WS_BTOUT);
    bf16_t* WpT = (bf16_t*)(F.ws + WS_WPT);
    constexpr int I_IN = 16 * 66, I_OUT = 16 * 32, I_POOL = 8, I_MOE = NE * 16 * 64 + NE * 16 * 32;
    constexpr int NSMALL = I_IN + I_OUT + I_POOL, NITEMS = NSMALL + (I_MOE - CV_HIDDEN);
    auto decode = [&](int it) -> TrItem {
        int r = it;
        if (r < I_IN) { const int kb = r / 66, nb = r % 66;
            if (nb >= 8 && nb < 48) return mk_item(F.w_in, F.ws + WS_BTIN8, INW, 64 * kb, 32 * nb, 1024, 32 * nb, 1);
            return mk_item(F.w_in, (unsigned char*)BtIn, INW, 64 * kb, 32 * nb, 1024, 32 * nb, 0); } r -= I_IN;
        if (r < I_OUT) { const int kb = r / 32, nb = r % 32; return mk_item(F.w_out, (unsigned char*)BtOut, 1024, 64 * kb, 32 * nb, 1024, 32 * nb, 0); } r -= I_OUT;
        if (r < I_POOL) { const int g = r / 2, nb = r % 2; return mk_item(F.w_pool + g * 4096, (unsigned char*)(WpT + g * 4096), 64, 0, 32 * nb, 64, 32 * nb, 0); } r -= I_POOL;
        return moe_item(F, CV_HIDDEN + r);
    };
    for (int it = gw; it < NITEMS; it += 2 * NGW) {
        const bool two = (it + NGW < NITEMS);
        const TrItem ta = decode(it), tb = decode(two ? it + NGW : it);
        float va[32], vb[32];
        tr_load(ta, va, F.lane); if (two) tr_load(tb, vb, F.lane);
        tr_store(ta, va, scr, F.lane); if (two) tr_store(tb, vb, scr, F.lane);
    }
    for (int i = gt; i < 192 * 1024; i += NGT) { const int n = 2112 + i / 1024, k = i % 1024; const float v = (n < INW) ? F.w_in[(size_t)k * INW + n] : 0.f;
        BtIn[(size_t)n * 1024 + k] = (bf16_t)(cvt_pk_bf16(v, 0.f) & 0xffffu); }
    { float* wrA = (float*)(F.ws + WS_WRA);
      for (int i = gt; i < 32768; i += NGT) { const int ii = i & 3, e = (i >> 2) & 31, kh = (i >> 7) & 1, c = i >> 8; wrA[i] = F.w_router[(8 * c + 4 * kh + ii) * 32 + e]; } }
    { float* rq = (float*)(F.ws + WS_ROPEQK); float* ri = (float*)(F.ws + WS_ROPEIX);
      for (int i = gt; i < T * 24; i += NGT) { const int tok = i / 24, j = i % 24; const double pos = (double)F.positions[tok];
          const double inv = (j < 16) ? ROPE_QK_FREQ[j] : ROPE_IX_FREQ[j - 16];
          double rev = pos * inv * 0.15915494309189535; rev -= __builtin_floor(rev);
          const float c = __builtin_amdgcn_cosf((float)rev), s = __builtin_amdgcn_sinf((float)rev);
          if (j < 16) { rq[(size_t)tok * 32 + j] = c; rq[(size_t)tok * 32 + 16 + j] = s; } else { ri[(size_t)tok * 16 + (j - 16)] = c; ri[(size_t)tok * 16 + 8 + (j - 16)] = s; } } }
    if (F.bid == 0 && F.tid < 64) { F.ctl[CW_CNT + F.tid] = 0u; if (F.tid == 0) F.ctl[CW_ATTQ] = 0u; }
    { bf16_t* hA = (bf16_t*)(F.ws + WS_HA); float* stats = (float*)(F.ws + WS_STATS);
      f32x4 gv[4], bv[4];
#pragma unroll
      for (int j = 0; j < 4; ++j) { gv[j] = ((const f32x4*)F.ln_in_g)[F.lane + 64 * j]; bv[j] = ((const f32x4*)F.ln_in_b)[F.lane + 64 * j]; }
      f32x4 nx[4];
      if (gw < T) { const f32x4* xr = (const f32x4*)(F.x + (size_t)gw * 1024) + F.lane;
#pragma unroll
          for (int j = 0; j < 4; ++j) nx[j] = __builtin_nontemporal_load(xr + 64 * j); }
      for (int m = gw; m < T; m += NGW) {
          f32x4 v[4]; float s = 0.f;
#pragma unroll
          for (int j = 0; j < 4; ++j) { v[j] = nx[j]; s += (v[j].x + v[j].y) + (v[j].z + v[j].w); }
          if (m + NGW < T) { const f32x4* xr = (const f32x4*)(F.x + (size_t)(m + NGW) * 1024) + F.lane;
#pragma unroll
              for (int j = 0; j < 4; ++j) nx[j] = __builtin_nontemporal_load(xr + 64 * j); }
          const float mean = wave_sum(s) * (1.f / 1024.f); float s2 = 0.f;
#pragma unroll
          for (int j = 0; j < 4; ++j) { v[j] = v[j] - mean; s2 += (v[j].x * v[j].x + v[j].y * v[j].y) + (v[j].z * v[j].z + v[j].w * v[j].w); }
          const float rstd = 1.f / sqrtf(wave_sum(s2) * (1.f / 1024.f) + LN_EPS);
          u32x2* o8 = (u32x2*)(hA + (size_t)m * 1024) + F.lane; unsigned* q8 = (unsigned*)(F.ws + WS_HA8 + (size_t)m * 1024) + F.lane;
#pragma unroll
          for (int j = 0; j < 4; ++j) { const f32x4 h = v[j] * rstd * gv[j] + bv[j]; u32x2 w; w.x = cvt_pk_bf16(h.x, h.y); w.y = cvt_pk_bf16(h.z, h.w); o8[64 * j] = w; q8[64 * j] = pk4_fp8(h.x, h.y, h.z, h.w); }
          if (F.lane == 0) { stats[(size_t)m * 2] = mean; stats[(size_t)m * 2 + 1] = rstd; }
      } }
}

__device__ __forceinline__ void p2_pool(Frame& F) {
    const bf16_t* U = (const bf16_t*)(F.ws + WS_U); const bf16_t* WpT = (const bf16_t*)(F.ws + WS_WPT); bf16_t* cat = (bf16_t*)(F.ws + WS_CAT);
    LAS bf16_t* dl = (LAS bf16_t*)F.lds;
    LAS bf16_t* ul = (LAS bf16_t*)(F.lds + 33792);
    for (int tile = F.bid; tile < T / 64; tile += F.G) {
        const int t0 = tile * 64, pos0 = t0 % SEQ;
        __syncthreads();
        for (int i = F.tid; i < 79 * 32; i += NTHREADS) { const int r = i >> 5, c8 = i & 31; u32x4 v = {0u, 0u, 0u, 0u};
            if (pos0 + r - 15 >= 0) v = *(const u32x4*)(U + (size_t)(t0 + r - 15) * 256 + c8 * 8);
            *(LAS u32x4*)(ul + r * 256 + c8 * 8) = v; }
        __syncthreads();
        { const int c = F.tid & 255, half = F.tid >> 8, w = 2 << (c >> 6);
          const int ts = half * 32; float sum = 0.f;
          for (int d = 1; d < w; ++d) sum += __uint_as_float((unsigned)ul[(15 + ts - d) * 256 + c] << 16);
#pragma unroll 4
          for (int tt = 0; tt < 32; ++tt) { const int tl = ts + tt, p = pos0 + tl; const float cur = __uint_as_float((unsigned)ul[(15 + tl) * 256 + c] << 16);
              sum += cur; const int cnt = (p + 1 < w) ? (p + 1) : w;
              const float diff = sum / (float)cnt - cur;
              dl[tl * 264 + c] = (bf16_t)(cvt_pk_bf16(diff, 0.f) & 0xffffu);
              sum -= __uint_as_float((unsigned)ul[(15 + tl - (w - 1)) * 256 + c] << 16); } }
        __syncthreads();
        { const int g = F.wave & 3, th = F.wave >> 2, r32 = F.lane & 31, hi = F.lane >> 5;
          f32x16 c0 = {}, c1 = {};
#pragma unroll
          for (int s = 0; s < 4; ++s) {
              const bf16x8 a = *(const LAS bf16x8*)(dl + (th * 32 + r32) * 264 + g * 64 + 16 * s + 8 * hi);
              const bf16x8 b0 = *(const bf16x8*)(WpT + (size_t)g * 4096 + (size_t)r32 * 64 + 16 * s + 8 * hi);
              const bf16x8 b1 = *(const bf16x8*)(WpT + (size_t)g * 4096 + (size_t)(32 + r32) * 64 + 16 * s + 8 * hi);
              c0 = __builtin_amdgcn_mfma_f32_32x32x16_bf16(a, b0, c0, 0, 0, 0);
              c1 = __builtin_amdgcn_mfma_f32_32x32x16_bf16(a, b1, c1, 0, 0, 0); }
          const float ps0 = F.pool_scale[g * 64 + r32], ps1 = F.pool_scale[g * 64 + 32 + r32];
#pragma unroll
          for (int r = 0; r < 16; ++r) { const int tok = t0 + th * 32 + crow(r, hi);
              cat[(size_t)tok * 1024 + g * 64 + r32] = (bf16_t)(cvt_pk_bf16(c0[r] * ps0, 0.f) & 0xffffu);
              cat[(size_t)tok * 1024 + g * 64 + 32 + r32] = (bf16_t)(cvt_pk_bf16(c1[r] * ps1, 0.f) & 0xffffu); } }
    }
    __syncthreads();
}

constexpr int IDX_RING_OFF = 0, IDX_SLOT = 32768;
constexpr int IDX_HIST_OFF = 3 * IDX_SLOT;
constexpr int IDX_RES_OFF = IDX_HIST_OFF + 24576;
__device__ __forceinline__ void hist_find16(const LAS unsigned* hist, int li, unsigned need, unsigned& bsel, unsigned& above) {
    const u32x4 h0 = *(const LAS u32x4*)(hist + 4 * li);
    const unsigned c[8] = {h0.x & 0xffffu, h0.x >> 16, h0.y & 0xffffu, h0.y >> 16, h0.z & 0xffffu, h0.z >> 16, h0.w & 0xffffu, h0.w >> 16};
    unsigned s = 0;
#pragma unroll
    for (int k = 0; k < 8; ++k) s += c[k];
    unsigned S = s;
#pragma unroll
    for (int d = 1; d < 32; d <<= 1) { const unsigned o = __shfl_down(S, d, 32); if (li + d < 32) S += o; }
    const unsigned excl = S - s;
    unsigned b = 0xffffffffu, ab = 0;
    if (excl < need && need <= S) { unsigned cum = excl; bool found = false;
#pragma unroll
        for (int k = 7; k >= 0; --k) { if (!found && cum + c[k] >= need) { b = 8 * li + k; ab = cum; found = true; } if (!found) cum += c[k]; } }
    const unsigned long long bal = __ballot(b != 0xffffffffu);
    const unsigned halfmask = (unsigned)((threadIdx.x & 32) ? (bal >> 32) : (bal & 0xffffffffull));
    const int src = (halfmask ? (__ffs(halfmask) - 1) : 0) + (threadIdx.x & 32);
    bsel = __shfl(b, src, 64); above = __shfl(ab, src, 64);
    if (!halfmask) { bsel = 0; above = 0; }
}
template <int J> __device__ __forceinline__ void wlane(unsigned& m, unsigned v) { asm volatile("v_writelane_b32 %0, %1, %2" : "+v"(m) : "s"(v), "n"(J)); }
template <int J> __device__ __forceinline__ void mask_emit_step(const unsigned (&k0)[32], const unsigned (&k1)[32], unsigned T0, unsigned T1, int kh, int ntiles, unsigned& m0, unsigned& m1, unsigned& m2, unsigned& m3) {
    if (2 * J + kh < ntiles) {
        const unsigned long long ba = __ballot(k0[J] >= T0), bc = __ballot(k1[J] >= T1);
        wlane<J>(m0, (unsigned)ba); wlane<J>(m2, (unsigned)(ba >> 32)); wlane<J>(m1, (unsigned)bc); wlane<J>(m3, (unsigned)(bc >> 32));
    }
}
template <int... Js> __device__ __forceinline__ void mask_emit(std::integer_sequence<int, Js...>, const unsigned (&k0)[32], const unsigned (&k1)[32], unsigned T0, unsigned T1, int kh, int ntiles, unsigned& m0, unsigned& m1, unsigned& m2, unsigned& m3) {
    (mask_emit_step<Js>(k0, k1, T0, T1, kh, ntiles, m0, m1, m2, m3), ...);
}
__device__ __forceinline__ void p2_indexer_unit(Frame& F, int b, int qb) {
    const bf16_t* IQ = (const bf16_t*)(F.ws + WS_IQ); const bf16_t* IK = (const bf16_t*)(F.ws + WS_IK); const float* IW = (const float*)(F.ws + WS_IW);
    unsigned* MASK = (unsigned*)(F.ws + WS_MASK);
    const int qg = F.wave & 3, kh = F.wave >> 2;
    LAS unsigned* hist = (LAS unsigned*)(F.lds + IDX_HIST_OFF) + qg * 4 * 384;
    LAS float* mm = (LAS float*)(F.lds + IDX_RES_OFF);
    const int lane = F.lane, r32 = lane & 31, hi = lane >> 5;
    const int p0 = qb * 16 + qg * 4;
    const int tq0 = b * SEQ + p0;
    const int ntiles = (qb >> 1) + 1;
    const int nch = (ntiles + 7) >> 3;
    const char* ikb = (const char*)(IK + (size_t)b * SEQ * 64);
    unsigned dsrc[4];
#pragma unroll
    for (int i = 0; i < 4; ++i) { const int row = F.wave * 32 + i * 8 + (lane >> 3), pos = lane & 7; dsrc[i] = (unsigned)(row * 128 + ((pos ^ ((row >> 1) & 7)) << 4)); }
#define IDX_ISSUE(ch) do { _Pragma("unroll") for (int i_ = 0; i_ < 4; ++i_) \
        __builtin_amdgcn_global_load_lds((const unsigned*)(ikb + (size_t)(ch) * 32768 + dsrc[i_]), (LAS unsigned*)(F.lds + IDX_RING_OFF + ((ch) % 3) * IDX_SLOT + F.wave * 4096 + i_ * 1024), 16, 0, 0); } while (0)
    bf16x8 af[4];
    { const int i = r32, qi = 2 * ((i >> 2) & 1) + (i >> 4), hd = (i & 3) + 4 * ((i >> 3) & 1);
#pragma unroll
      for (int s = 0; s < 4; ++s) af[s] = *(const bf16x8*)(IQ + (size_t)(tq0 + qi) * 512 + hd * 64 + 16 * s + 8 * hi); }
    float wA[8], wB[8];
#pragma unroll
    for (int r = 0; r < 8; ++r) { const int hd = (r & 3) + 4 * (r >> 2); wA[r] = IW[(size_t)(tq0 + 2 * hi) * 8 + hd] * W_SCALE; wB[r] = IW[(size_t)(tq0 + 2 * hi + 1) * 8 + hd] * W_SCALE; }
    __builtin_amdgcn_s_barrier();
    asm volatile("" ::: "memory");
    IDX_ISSUE(0); if (nch > 1) IDX_ISSUE(1);
#pragma unroll
    for (int i = 0; i < 3; ++i) *(LAS u32x4*)(F.lds + IDX_HIST_OFF + (i * 512 + F.tid) * 16) = (u32x4){0u, 0u, 0u, 0u};
    const int limA = p0 + 2 * hi - 32 * (ntiles - 1), limB = limA + 1;
    float sc0[32], sc1[32];
#pragma unroll
    for (int j = 0; j < 32; ++j) { sc0[j] = -INFINITY; sc1[j] = -INFINITY; }
    float mx0 = -INFINITY, mn0 = INFINITY, mx1 = -INFINITY, mn1 = INFINITY;
    const int frag_off = r32 * 128;
    const int fx = (r32 >> 1) & 7;
#pragma unroll
    for (int ch = 0; ch < 8; ++ch) {
        if (ch < nch) {
            if (ch + 1 < nch) asm volatile("s_waitcnt vmcnt(4)" ::: "memory"); else asm volatile("s_waitcnt vmcnt(0)" ::: "memory");
            __builtin_amdgcn_s_barrier();
            asm volatile("" ::: "memory");
            if (ch + 2 < nch) IDX_ISSUE(ch + 2);
            const LAS char* slot = (const LAS char*)(F.lds + IDX_RING_OFF + (ch % 3) * IDX_SLOT);
#pragma unroll
            for (int j4 = 0; j4 < 4; ++j4) {
                const int jl = 2 * j4 + kh, j = ch * 8 + jl, idx = ch * 4 + j4;
                if (j < ntiles) {
                    f32x16 acc = {};
#pragma unroll
                    for (int s = 0; s < 4; ++s) { const bf16x8 bfr = *(const LAS bf16x8*)(slot + jl * 4096 + frag_off + (((2 * s + hi) ^ fx) << 4));
                        acc = __builtin_amdgcn_mfma_f32_32x32x16_bf16(af[s], bfr, acc, 0, 0, 0); }
                    float s0 = 0.f, s1 = 0.f;
#pragma unroll
                    for (int r = 0; r < 8; ++r) {
                        const int ia = __float_as_int(acc[r]), ib = __float_as_int(acc[8 + r]);
                        s0 = fmaf(wA[r], __int_as_float(ia > 0 ? ia : 0), s0); s1 = fmaf(wB[r], __int_as_float(ib > 0 ? ib : 0), s1); }
                    if (j == ntiles - 1) {
                        mn0 = fminf(mn0, (r32 > limA) ? INFINITY : s0); mn1 = fminf(mn1, (r32 > limB) ? INFINITY : s1);
                        s0 = (r32 > limA) ? -INFINITY : s0; s1 = (r32 > limB) ? -INFINITY : s1;
                    } else { mn0 = fminf(mn0, s0); mn1 = fminf(mn1, s1); }
                    mx0 = fmaxf(mx0, s0); mx1 = fmaxf(mx1, s1);
                    sc0[idx] = s0; sc1[idx] = s1;
                }
            }
        }
    }
#undef IDX_ISSUE
#pragma unroll
    for (int d = 1; d < 32; d <<= 1) { mx0 = fmaxf(mx0, __shfl_xor(mx0, d)); mx1 = fmaxf(mx1, __shfl_xor(mx1, d)); mn0 = fminf(mn0, __shfl_xor(mn0, d)); mn1 = fminf(mn1, __shfl_xor(mn1, d)); }
    if (r32 == 0) { LAS float* w = mm + ((qg * 2 + kh) * 4 + 2 * hi) * 2; w[0] = mx0; w[1] = mn0; w[2] = mx1; w[3] = mn1; }
    __syncthreads();
    { const LAS float* w = mm + ((qg * 2 + (kh ^ 1)) * 4 + 2 * hi) * 2; mx0 = fmaxf(mx0, w[0]); mn0 = fminf(mn0, w[1]); mx1 = fmaxf(mx1, w[2]); mn1 = fminf(mn1, w[3]); }
    const float scl0 = (mx0 > mn0) ? (16777212.0f / (mx0 - mn0)) : 0.f, scl1 = (mx1 > mn1) ? (16777212.0f / (mx1 - mn1)) : 0.f;
    const float off0 = 1.5f - mn0 * scl0, off1 = 1.5f - mn1 * scl1;
    unsigned k0[32], k1[32];
#pragma unroll
    for (int j = 0; j < 32; ++j) { k0[j] = (unsigned)fmaf(sc0[j], scl0, off0); k1[j] = (unsigned)fmaf(sc1[j], scl1, off1); }
    unsigned T0 = 1u, T1 = 1u;
#ifndef NO_SELECT
    if (qb >= 16) {
        LAS unsigned* hA = hist + (2 * hi) * 384; LAS unsigned* hB = hist + (2 * hi + 1) * 384;
        unsigned pre0 = 0, pre1 = 0, need0 = 256, need1 = 256;
#pragma unroll
        for (int lvl = 0; lvl < 3; ++lvl) {
            const int sh = 16 - 8 * lvl;
#pragma unroll
            for (int j = 0; j < 32; ++j) {
                if (2 * j + kh < ntiles) {
                    const unsigned ka = k0[j], kc = k1[j];
                    if (lvl == 0 || (ka >> (sh + 8)) == pre0) { const unsigned bn = (ka >> sh) & 255u; (void)__hip_atomic_fetch_add(hA + lvl * 128 + (bn >> 1), 1u << ((bn & 1u) << 4), __ATOMIC_RELAXED, __HIP_MEMORY_SCOPE_WORKGROUP); }
                    if (lvl == 0 || (kc >> (sh + 8)) == pre1) { const unsigned bn = (kc >> sh) & 255u; (void)__hip_atomic_fetch_add(hB + lvl * 128 + (bn >> 1), 1u << ((bn & 1u) << 4), __ATOMIC_RELAXED, __HIP_MEMORY_SCOPE_WORKGROUP); }
                }
            }
            __syncthreads();
            unsigned b0, a0, b1, a1;
            hist_find16(hA + lvl * 128, r32, need0, b0, a0);
            hist_find16(hB + lvl * 128, r32, need1, b1, a1);
            pre0 = (pre0 << 8) | b0; need0 -= a0;
            pre1 = (pre1 << 8) | b1; need1 -= a1;
        }
        T0 = pre0 > 1u ? pre0 : 1u; T1 = pre1 > 1u ? pre1 : 1u;
    }
#endif
    unsigned m0 = 0, m1 = 0, m2 = 0, m3 = 0;
    mask_emit(std::make_integer_sequence<int, 32>{}, k0, k1, T0, T1, kh, ntiles, m0, m1, m2, m3);
    if (lane < 32) { const int w = 2 * lane + kh;
        MASK[(size_t)(tq0 + 0) * 64 + w] = m0; MASK[(size_t)(tq0 + 1) * 64 + w] = m1; MASK[(size_t)(tq0 + 2) * 64 + w] = m2; MASK[(size_t)(tq0 + 3) * 64 + w] = m3; }
}
__device__ __forceinline__ void p2_indexer(Frame& F) {
    for (int pi = F.bid; pi < 512; pi += F.G) { const int b = pi >> 6, x = pi & 63;
        p2_indexer_unit(F, b, 127 - x);
        p2_indexer_unit(F, b, x); }
    __syncthreads();
}

namespace att {
constexpr int D = 128, NW = 8, QBLK = 32, KVBLK = 64;
constexpr float SCALE = 0.088388347648318440f;
constexpr float THR = 8.f;
constexpr int LDQ = 768, LDK = 256, LDO = 1024;
constexpr size_t SHM_V = KVBLK * D * 2, SHM_K = KVBLK * D * 2, SHM_ATTN = 2 * SHM_V + 2 * SHM_K + NW * 64 * 4;
#define KSWZ(row, colB) ((row) * 256 + ((colB) ^ (((row) & 7) << 4)))
#define SBAR() __builtin_amdgcn_sched_barrier(0)
__device__ __forceinline__ void apply_mask(f32x16& p0, f32x16& p1, u32x2 mk, int hi) {
    const int ml = (int)(mk.x >> (4 * hi)), mh = (int)(mk.y >> (4 * hi));
#pragma unroll
    for (int r = 0; r < 16; ++r) { const int cr = (r & 3) + 8 * (r >> 2);
        const unsigned t0 = (unsigned)__builtin_amdgcn_sbfe(ml, cr, 1), t1 = (unsigned)__builtin_amdgcn_sbfe(mh, cr, 1);
        p0[r] = __uint_as_float((__float_as_uint(p0[r]) & t0) | (0xff800000u & ~t0));
        p1[r] = __uint_as_float((__float_as_uint(p1[r]) & t1) | (0xff800000u & ~t1)); }
}
__device__ __forceinline__ void partialSM(f32x16& p0, f32x16& p1, float& m_reg, float& mn, float& alpha) {
    constexpr float C = SCALE * 1.4426950408889634f;
    float pmax = p0[0];
#pragma unroll
    for (int r = 1; r < 16; ++r) pmax = fmaxf(pmax, p0[r]);
#pragma unroll
    for (int r = 0; r < 16; ++r) pmax = fmaxf(pmax, p1[r]);
    { auto rr = __builtin_amdgcn_permlane32_swap(__float_as_uint(pmax), __float_as_uint(pmax), false, false);
      pmax = fmaxf(__uint_as_float(rr[0]), __uint_as_float(rr[1])); }
    if (__builtin_expect(__all(pmax - m_reg <= THR / SCALE), 1)) { mn = m_reg; alpha = 1.f; }
    else { mn = fmaxf(m_reg, pmax); alpha = __builtin_amdgcn_exp2f((m_reg - mn) * C); m_reg = mn; }
    const float mnC = -mn * C;
#pragma unroll
    for (int r = 0; r < 16; ++r) p0[r] = fmaf(p0[r], C, mnC);
#pragma unroll
    for (int r = 0; r < 16; ++r) p1[r] = fmaf(p1[r], C, mnC);
#pragma unroll
    for (int r = 0; r < 16; ++r) p0[r] = __builtin_amdgcn_exp2f(p0[r]);
}
__device__ __forceinline__ void finishSM(f32x16& p0, f32x16& p1, float alpha, float& l_reg, bf16x8& pa0, bf16x8& pa1, bf16x8& pa2, bf16x8& pa3) {
#pragma unroll
    for (int r = 0; r < 16; ++r) p1[r] = __builtin_amdgcn_exp2f(p1[r]);
    float ps = 0;
#pragma unroll
    for (int r = 0; r < 16; ++r) ps += p0[r];
#pragma unroll
    for (int r = 0; r < 16; ++r) ps += p1[r];
    { auto rr = __builtin_amdgcn_permlane32_swap(__float_as_uint(ps), __float_as_uint(ps), false, false);
      ps = __uint_as_float(rr[0]) + __uint_as_float(rr[1]); }
    l_reg = l_reg * alpha + ps;
#define PK4(P, BASE, OUT) do { unsigned a0 = cvt_pk_bf16(P[BASE + 0], P[BASE + 1]), a1 = cvt_pk_bf16(P[BASE + 2], P[BASE + 3]);   \
    unsigned b0 = cvt_pk_bf16(P[BASE + 4], P[BASE + 5]), b1 = cvt_pk_bf16(P[BASE + 6], P[BASE + 7]);                              \
    auto r0 = __builtin_amdgcn_permlane32_swap(a0, b0, false, false); auto r1 = __builtin_amdgcn_permlane32_swap(a1, b1, false, false); \
    u32x4 w = {r0[0], r1[0], r0[1], r1[1]}; OUT = *reinterpret_cast<bf16x8*>(&w); } while (0)
    PK4(p0, 0, pa0); PK4(p0, 8, pa1); PK4(p1, 0, pa2); PK4(p1, 8, pa3);
#undef PK4
}
__device__ __forceinline__ void qkt(f32x16& p0, f32x16& p1, const LAS char* Ks, const bf16x8* qr, int r32, int hi) {
    p0 = f32x16{}; p1 = f32x16{};
#pragma unroll
    for (int d0 = 0; d0 < 8; ++d0) { const int cb = (d0 * 16 + hi * 8) * 2;
        const bf16x8 b0 = *reinterpret_cast<const LAS bf16x8*>(Ks + KSWZ(r32, cb));
        const bf16x8 b1 = *reinterpret_cast<const LAS bf16x8*>(Ks + KSWZ(32 + r32, cb));
        p0 = __builtin_amdgcn_mfma_f32_32x32x16_bf16(b0, qr[d0], p0, 0, 0, 0);
        p1 = __builtin_amdgcn_mfma_f32_32x32x16_bf16(b1, qr[d0], p1, 0, 0, 0); }
}
__device__ __forceinline__ int v_st(int k, int c) { const int kk = (k & ~0xC) | ((k & 4) << 1) | ((k & 8) >> 1); return ((kk >> 3) * 4 + (c >> 5)) * 512 + ((kk & 7) * 32 + (c & 31)) * 2; }
__device__ __forceinline__ int v_rd_base(int lane) { return ((lane & 3) << 3) | (((lane >> 2) & 3) << 6) | (((lane >> 4) & 1) << 5) | (((lane >> 5) & 1) << 8); }
constexpr int v_rd_off(int d0, int ks, int half) { return d0 * 512 + ks * 4096 + half * 2048; }
template <int OFF> __device__ __forceinline__ s16x4 tr_read(int vb) {
    s16x4 r; asm volatile("ds_read_b64_tr_b16 %0, %1 offset:%2" : "=&v"(r) : "v"(vb), "i"(OFF) : "memory"); return r;
}
template <int D0> __device__ __forceinline__ void pv_one(f32x16& od, int vb, bf16x8 pa0, bf16x8 pa1, bf16x8 pa2, bf16x8 pa3) {
    const s16x4 l0 = tr_read<v_rd_off(D0, 0, 0)>(vb), h0 = tr_read<v_rd_off(D0, 0, 1)>(vb), l1 = tr_read<v_rd_off(D0, 1, 0)>(vb), h1 = tr_read<v_rd_off(D0, 1, 1)>(vb);
    const s16x4 l2 = tr_read<v_rd_off(D0, 2, 0)>(vb), h2 = tr_read<v_rd_off(D0, 2, 1)>(vb), l3 = tr_read<v_rd_off(D0, 3, 0)>(vb), h3 = tr_read<v_rd_off(D0, 3, 1)>(vb);
    asm volatile("s_waitcnt lgkmcnt(0)" ::: "memory"); SBAR();
#define PK(L, H) (bf16x8){L[0], L[1], L[2], L[3], H[0], H[1], H[2], H[3]}
    od = __builtin_amdgcn_mfma_f32_32x32x16_bf16(pa0, PK(l0, h0), od, 0, 0, 0);
    od = __builtin_amdgcn_mfma_f32_32x32x16_bf16(pa1, PK(l1, h1), od, 0, 0, 0);
    od = __builtin_amdgcn_mfma_f32_32x32x16_bf16(pa2, PK(l2, h2), od, 0, 0, 0);
    od = __builtin_amdgcn_mfma_f32_32x32x16_bf16(pa3, PK(l3, h3), od, 0, 0, 0);
#undef PK
}
__device__ __forceinline__ void pv_d0(f32x16* o, int vb, bf16x8 pa0, bf16x8 pa1, bf16x8 pa2, bf16x8 pa3) {
    pv_one<0>(o[0], vb, pa0, pa1, pa2, pa3); pv_one<1>(o[1], vb, pa0, pa1, pa2, pa3); pv_one<2>(o[2], vb, pa0, pa1, pa2, pa3); pv_one<3>(o[3], vb, pa0, pa1, pa2, pa3);
}
__device__ __forceinline__ void attn_body(const bf16_t* __restrict__ Qb, const bf16_t* __restrict__ Kh, const bf16_t* __restrict__ Vh, bf16_t* __restrict__ Ob, const unsigned* __restrict__ Mb, int NT, LAS char* lds) {
    const int tid = threadIdx.x, wid = tid >> 6, lane = tid & 63, r32 = lane & 31, hi = lane >> 5;
    LAS char* V_lds = lds; LAS char* K_lds = lds + 2 * SHM_V;
    LAS float* ws = (LAS float*)(lds + 2 * SHM_V + 2 * SHM_K) + wid * 64; LAS float* li_l = ws; LAS float* al_l = ws + 32;
    float m_reg = -1e30f, l_reg = 0; f32x16 o[4] = {}; bf16x8 qr[8];
    const bf16_t* Qw = Qb + (long)(wid * QBLK + r32) * LDQ + hi * 8;
#pragma unroll
    for (int d0 = 0; d0 < 8; ++d0) qr[d0] = *reinterpret_cast<const bf16x8*>(Qw + d0 * 16);
    const unsigned mofs = (unsigned)(wid * QBLK + r32) * 256u;
#define Mw_(j) (*(const u32x2*)((const char*)Mb + (mofs + 8u * (unsigned)(j))))
    const int sr = tid >> 4, sc = (tid & 15) * 8, vst0 = v_st(sr, sc), vst1 = v_st(32 + sr, sc);
    const int vb0 = (int)(uintptr_t)V_lds + v_rd_base(lane);
    struct { bf16x8 vs0, vs1, ks0, ks1; } sr_[2];
#define SLOAD(i, k0) do { sr_[i].vs0 = *(const bf16x8*)(&Vh[(long)((k0) + sr) * LDK + sc]); sr_[i].vs1 = *(const bf16x8*)(&Vh[(long)((k0) + 32 + sr) * LDK + sc]); \
    sr_[i].ks0 = *(const bf16x8*)(&Kh[(long)((k0) + sr) * LDK + sc]); sr_[i].ks1 = *(const bf16x8*)(&Kh[(long)((k0) + 32 + sr) * LDK + sc]); } while (0)
#define SWRITE(b, i) do { *(LAS bf16x8*)(V_lds + (b) * SHM_V + vst0) = sr_[i].vs0;          \
    *(LAS bf16x8*)(V_lds + (b) * SHM_V + vst1) = sr_[i].vs1; int kc = sc * 2;               \
    *(LAS bf16x8*)(K_lds + (b) * SHM_K + KSWZ(sr, kc)) = sr_[i].ks0;                       \
    *(LAS bf16x8*)(K_lds + (b) * SHM_K + KSWZ(32 + sr, kc)) = sr_[i].ks1; } while (0)
#define SWAIT() asm volatile("s_waitcnt vmcnt(5)" ::: "memory")
#define RESC(a) do { if (__any((a) < 1.f)) { if (hi == 0) al_l[r32] = (a); asm volatile("s_waitcnt lgkmcnt(0)" ::: "memory"); \
    _Pragma("unroll") for (int d = 0; d < 4; ++d) _Pragma("unroll") for (int r = 0; r < 16; ++r) o[d][r] *= al_l[crow(r, hi)]; } } while (0)
    f32x16 pA0, pA1, pB0, pB1; float mnA, mnB, alA, alB; bf16x8 pa0, pa1, pa2, pa3;
    u32x2 mkA = Mw_(0), mkB = Mw_(1);
    constexpr int SE = 0, SO = 1;
    SLOAD(SE, 0); asm volatile("s_waitcnt vmcnt(0)" ::: "memory"); SWRITE(0, SE); __syncthreads();
    qkt(pA0, pA1, K_lds, qr, r32, hi); apply_mask(pA0, pA1, mkA, hi); partialSM(pA0, pA1, m_reg, mnA, alA); mkA = Mw_(2);
    SLOAD(SO, KVBLK); if (2 < NT) SLOAD(SE, 2 * KVBLK);
    SWAIT(); SWRITE(1, SO); __syncthreads();
    for (int j = 1; j + 1 < NT; j += 2) {
        SBAR(); qkt(pB0, pB1, K_lds + SHM_K, qr, r32, hi);
        finishSM(pA0, pA1, alA, l_reg, pa0, pa1, pa2, pa3); SBAR();
        SLOAD(SO, (j + 2) * KVBLK); SBAR();
        pv_d0(o, vb0, pa0, pa1, pa2, pa3); apply_mask(pB0, pB1, mkB, hi); partialSM(pB0, pB1, m_reg, mnB, alB); mkB = Mw_((j + 2 < NT) ? (j + 2) : j);
        __syncthreads(); SWAIT(); SWRITE(0, SE);
        RESC(alB); __syncthreads();
        SBAR(); qkt(pA0, pA1, K_lds, qr, r32, hi);
        finishSM(pB0, pB1, alB, l_reg, pa0, pa1, pa2, pa3); SBAR();
        if (j + 3 < NT) SLOAD(SE, (j + 3) * KVBLK); SBAR();
        pv_d0(o, vb0 + (int)SHM_V, pa0, pa1, pa2, pa3); apply_mask(pA0, pA1, mkA, hi); partialSM(pA0, pA1, m_reg, mnA, alA); mkA = Mw_((j + 3 < NT) ? (j + 3) : (j + 1));
        __syncthreads(); SWAIT(); SWRITE(1, SO);
        RESC(alA); __syncthreads();
    }
    SBAR(); qkt(pB0, pB1, K_lds + SHM_K, qr, r32, hi);
    finishSM(pA0, pA1, alA, l_reg, pa0, pa1, pa2, pa3); SBAR();
    pv_d0(o, vb0, pa0, pa1, pa2, pa3); apply_mask(pB0, pB1, mkB, hi); partialSM(pB0, pB1, m_reg, mnB, alB);
    __syncthreads(); RESC(alB);
    finishSM(pB0, pB1, alB, l_reg, pa0, pa1, pa2, pa3); SBAR();
    pv_d0(o, vb0 + (int)SHM_V, pa0, pa1, pa2, pa3);
    if (hi == 0) li_l[r32] = l_reg; asm volatile("s_waitcnt lgkmcnt(0)" ::: "memory");
    float rli[16];
#pragma unroll
    for (int r = 0; r < 16; ++r) rli[r] = __builtin_amdgcn_rcpf(li_l[crow(r, hi)]);
    bf16_t* Ow = Ob + (long)(wid * QBLK) * LDO;
#pragma unroll
    for (int r = 0; r < 16; ++r) { const int orow = crow(r, hi);
#pragma unroll
        for (int d0 = 0; d0 < 4; ++d0) Ow[(long)orow * LDO + d0 * 32 + r32] = (bf16_t)(cvt_pk_bf16(o[d0][r] * rli[r], 0.f) & 0xffffu); }
#undef SLOAD
#undef SWRITE
#undef SWAIT
#undef RESC
#undef Mw_
}
}

__device__ __forceinline__ void p3_attention(Frame& F) {
    const bf16_t* Q = (const bf16_t*)(F.ws + WS_Q); const bf16_t* K = (const bf16_t*)(F.ws + WS_K); const bf16_t* V = (const bf16_t*)(F.ws + WS_V);
    bf16_t* cat = (bf16_t*)(F.ws + WS_CAT); const unsigned* MASK = (const unsigned*)(F.ws + WS_MASK);
    const int j = F.bid;
    if (F.G == 256 && j >= 216) {
        convert_range(F, 2 * CV_PAIRS1, 2 * CV_PAIRS3, (j - 216) * 8 + F.wave, 40 * 8);
        return;
    }
    int qbs[2], phs[2], nu = 2;
    if (F.G != 256) { nu = 0; }
    else if (j < 48) { qbs[0] = 7; phs[0] = (j % 8) * 6 + j / 8; nu = 1; qbs[1] = 0; phs[1] = 0; }
    else if (j < 96) { const int jl = j - 48; qbs[0] = 6; phs[0] = (jl % 8) * 6 + jl / 8; qbs[1] = 0; phs[1] = phs[0]; }
    else if (j < 144) { const int jl = j - 96; qbs[0] = 5; phs[0] = (jl % 8) * 6 + jl / 8; qbs[1] = 1; phs[1] = phs[0]; }
    else if (j < 192) { const int jl = j - 144; qbs[0] = 4; phs[0] = (jl % 8) * 6 + jl / 8; qbs[1] = 2; phs[1] = phs[0]; }
    else { const int jl = j - 192; qbs[0] = 3; phs[0] = (jl % 8) * 6 + 2 * (jl / 8); qbs[1] = 3; phs[1] = phs[0] + 1; }
    for (int ui = 0; ui < nu; ++ui) {
        __syncthreads();
        const int qb = qbs[ui], b = phs[ui] / 6, h = phs[ui] % 6, g = h / 3;
        const size_t row0 = (size_t)b * SEQ + (size_t)qb * 256;
        att::attn_body(Q + row0 * 768 + h * 128, K + (size_t)b * SEQ * 256 + g * 128, V + (size_t)b * SEQ * 256 + g * 128, cat + row0 * 1024 + 256 + h * 128, MASK + row0 * 64, 4 * (qb + 1), (LAS char*)F.lds);
    }
    __syncthreads();
}

__device__ __forceinline__ void p5_ln1_router(Frame& F) {
    const bf16_t* MIX = (const bf16_t*)(F.ws + WS_MIX); const bf16_t* HA = (const bf16_t*)(F.ws + WS_HA);
    bf16_t* H1R = (bf16_t*)(F.ws + WS_H1F); unsigned char* H1Q = F.ws + WS_H1B; const float* wrA = (const float*)(F.ws + WS_WRA);
    unsigned* INV = (unsigned*)(F.ws + WS_INV); unsigned* TOKEP = (unsigned*)(F.ws + WS_TOKEP); float* TOKG = (float*)(F.ws + WS_TOKG);
    LAS float* tile = (LAS float*)F.lds;
    LAS float* part = (LAS float*)F.lds;
    LAS float* logit = (LAS float*)(F.lds + 36864);
    LAS int* sel_e = (LAS int*)(F.lds + MISC_OFF + 2048);
    LAS float* sel_g = (LAS float*)(F.lds + MISC_OFF + 3072);
    LAS int* sel_p = (LAS int*)(F.lds + MISC_OFF + 4096);
    LAS unsigned* lcnt = (LAS unsigned*)(F.lds + MISC_OFF + 5120);
    LAS int* ebase = (LAS int*)(F.lds + MISC_OFF + 5376);
    const int lane = F.lane, r32 = lane & 31, hi = lane >> 5;
    for (int blk = F.bid; blk < T / 64; blk += F.G) {
        const int t0 = blk * 64;
        if (F.tid < 32) lcnt[F.tid] = 0u;
        for (int pass = 0; pass < 2; ++pass) {
            __syncthreads();
            { f32x4 g1[4], b1[4];
#pragma unroll
              for (int j = 0; j < 4; ++j) { g1[j] = ((const f32x4*)F.ln1_g)[lane + 64 * j]; b1[j] = ((const f32x4*)F.ln1_b)[lane + 64 * j]; }
#pragma unroll
              for (int rb = 0; rb < 4; rb += 2) {
              u32x2 xv[2][4]; u32x2 mv[2][4];
#pragma unroll
              for (int rr = 0; rr < 2; ++rr) { const int m = t0 + pass * 32 + F.wave * 4 + rb + rr;
#pragma unroll
                  for (int j = 0; j < 4; ++j) { xv[rr][j] = ((const u32x2*)(HA + (size_t)m * 1024))[lane + 64 * j]; mv[rr][j] = ((const u32x2*)(MIX + (size_t)m * 1024))[lane + 64 * j]; } }
#pragma unroll
              for (int rr = 0; rr < 2; ++rr) { const int tl = F.wave * 4 + rb + rr, m = t0 + pass * 32 + tl;
                  f32x4 v[4]; float s = 0.f;
#pragma unroll
                  for (int j = 0; j < 4; ++j) { const u32x2 hw = xv[rr][j]; const f32x4 h = {bf16_lo(hw.x), bf16_hi(hw.x), bf16_lo(hw.y), bf16_hi(hw.y)};
                      const u32x2 w = mv[rr][j]; const f32x4 mx = {bf16_lo(w.x), bf16_hi(w.x), bf16_lo(w.y), bf16_hi(w.y)};
                      v[j] = ALPHA * h + mx; s += (v[j].x + v[j].y) + (v[j].z + v[j].w); }
                  const float mean = wave_sum(s) * (1.f / 1024.f); float s2 = 0.f;
#pragma unroll
                  for (int j = 0; j < 4; ++j) { v[j] = v[j] - mean; s2 += (v[j].x * v[j].x + v[j].y * v[j].y) + (v[j].z * v[j].z + v[j].w * v[j].w); }
                  const float rstd = 1.f / sqrtf(wave_sum(s2) * (1.f / 1024.f) + LN_EPS);
                  u32x2* of = (u32x2*)(H1R + (size_t)m * 1024) + lane; unsigned* ob = (unsigned*)(H1Q + (size_t)m * 1024) + lane;
#pragma unroll
                  for (int j = 0; j < 4; ++j) { const f32x4 h = v[j] * rstd * g1[j] + b1[j]; { u32x2 hw; hw.x = cvt_pk_bf16(h.x, h.y); hw.y = cvt_pk_bf16(h.z, h.w); of[64 * j] = hw; } ob[64 * j] = pk4_fp8(h.x, h.y, h.z, h.w);
                      *(LAS f32x4*)(tile + tl * 1024 + (((lane + 64 * j) ^ (tl & 15)) << 2)) = h; } } } }
            f32x4 a4[16];
#pragma unroll
            for (int i = 0; i < 16; ++i) a4[i] = *(const f32x4*)(wrA + (size_t)(((F.wave * 16 + i) * 2 + hi) * 32 + r32) * 4);
            __syncthreads();
            f32x16 acc = {};
#pragma unroll
            for (int i = 0; i < 16; ++i) { const int c = F.wave * 16 + i;
                const f32x4 b4 = *(const LAS f32x4*)(tile + r32 * 1024 + (((2 * c + hi) ^ (r32 & 15)) << 2));
                acc = __builtin_amdgcn_mfma_f32_32x32x2f32(a4[i].x, b4.x, acc, 0, 0, 0);
                acc = __builtin_amdgcn_mfma_f32_32x32x2f32(a4[i].y, b4.y, acc, 0, 0, 0);
                acc = __builtin_amdgcn_mfma_f32_32x32x2f32(a4[i].z, b4.z, acc, 0, 0, 0);
                acc = __builtin_amdgcn_mfma_f32_32x32x2f32(a4[i].w, b4.w, acc, 0, 0, 0); }
            __syncthreads();
#pragma unroll
            for (int r = 0; r < 16; ++r) part[(F.wave * 32 + r32) * 33 + crow(r, hi)] = acc[r];
            __syncthreads();
#pragma unroll
            for (int q = 0; q < 2; ++q) { const int o = F.tid * 2 + q, tok = o >> 5, e = o & 31; float sm = F.b_router[e];
#pragma unroll
                for (int kq = 0; kq < 8; ++kq) sm += part[(kq * 32 + tok) * 33 + e];
                logit[tok * 33 + e] = sm; }
            __syncthreads();
            if (F.tid < 32) {
                float bv_[4] = {-INFINITY, -INFINITY, -INFINITY, -INFINITY}; int bi[4] = {0, 0, 0, 0};
#pragma unroll
                for (int e = 0; e < 32; ++e) { const float v = logit[F.tid * 33 + e];
                    if (v > bv_[3]) { bv_[3] = v; bi[3] = e;
                        if (bv_[3] > bv_[2]) { float tv = bv_[2]; bv_[2] = bv_[3]; bv_[3] = tv; int ti = bi[2]; bi[2] = bi[3]; bi[3] = ti;
                            if (bv_[2] > bv_[1]) { tv = bv_[1]; bv_[1] = bv_[2]; bv_[2] = tv; ti = bi[1]; bi[1] = bi[2]; bi[2] = ti;
                                if (bv_[1] > bv_[0]) { tv = bv_[0]; bv_[0] = bv_[1]; bv_[1] = tv; ti = bi[0]; bi[0] = bi[1]; bi[1] = ti; } } } } }
                float ex[4], se = 0.f;
#pragma unroll
                for (int j = 0; j < 4; ++j) { ex[j] = __expf(bv_[j] - bv_[0]); se += ex[j]; }
#pragma unroll
                for (int j = 0; j < 4; ++j) { sel_g[(pass * 32 + F.tid) * 4 + j] = ex[j] / se; sel_e[(pass * 32 + F.tid) * 4 + j] = bi[j]; }
            }
        }
        __syncthreads();
        if (F.tid < 256) sel_p[F.tid] = (int)__hip_atomic_fetch_add(lcnt + sel_e[F.tid], 1u, __ATOMIC_RELAXED, __HIP_MEMORY_SCOPE_WORKGROUP);
        __syncthreads();
        if (F.tid < 32) { const unsigned c = lcnt[F.tid]; int base = 0; if (c > 0) base = (int)__hip_atomic_fetch_add(F.ctl + CW_CNT + F.tid, c, __ATOMIC_RELAXED, __HIP_MEMORY_SCOPE_AGENT); ebase[F.tid] = base; }
        __syncthreads();
        if (F.tid < 256) { const int tok = t0 + (F.tid >> 2), e = sel_e[F.tid], p = ebase[e] + sel_p[F.tid];
            INV[(size_t)e * CAP + p] = (unsigned)tok; TOKEP[(size_t)tok * 4 + (F.tid & 3)] = ((unsigned)e << 16) | (unsigned)p; TOKG[(size_t)tok * 4 + (F.tid & 3)] = sel_g[F.tid]; }
        __syncthreads();
    }
}

__device__ __forceinline__ void moe_tables(Frame& F, LAS int* tstart) {
    __syncthreads();
    if (F.tid < 64) {
        const unsigned c = (F.tid < NE) ? __hip_atomic_load(F.ctl + CW_CNT + (F.tid & 31), __ATOMIC_RELAXED, __HIP_MEMORY_SCOPE_AGENT) : 0u;
        const int nt = (int)((c + 255u) >> 8); int incl = nt;
#pragma unroll
        for (int d = 1; d < 32; d <<= 1) { const int o = __shfl_up(incl, d, 64); if ((int)F.tid >= d) incl += o; }
        if (F.tid < NE) { tstart[F.tid] = incl - nt; tstart[40 + F.tid] = (int)c; }
        if (F.tid == NE - 1) tstart[NE] = incl; }
    __syncthreads();
}

__device__ __forceinline__ float fp8_to_f32(unsigned w, int byte) {
    if (byte == 0) return __builtin_amdgcn_cvt_f32_fp8(w, 0); if (byte == 1) return __builtin_amdgcn_cvt_f32_fp8(w, 1); if (byte == 2) return __builtin_amdgcn_cvt_f32_fp8(w, 2); return __builtin_amdgcn_cvt_f32_fp8(w, 3);
}
__device__ __forceinline__ void p8_final(Frame& F, LAS int* tstart) {
    const bf16_t* H1R = (const bf16_t*)(F.ws + WS_H1F); const unsigned* TOKEP = (const unsigned*)(F.ws + WS_TOKEP); const float* TOKG = (const float*)(F.ws + WS_TOKG);
    const unsigned char* Y = F.ws + WS_Y;
    const int gw = F.bid * 8 + F.wave, NGW = F.G * 8;
    f32x4 gv[4], bv[4];
#pragma unroll
    for (int j = 0; j < 4; ++j) { gv[j] = ((const f32x4*)F.ln2_g)[F.lane + 64 * j]; bv[j] = ((const f32x4*)F.ln2_b)[F.lane + 64 * j]; }
    unsigned tk = 0; float tg = 0.f;
    { const int m = gw + (F.lane >> 2) * NGW; if (F.lane < 32 && m < T) { tk = TOKEP[(size_t)m * 4 + (F.lane & 3)]; tg = TOKG[(size_t)m * 4 + (F.lane & 3)] * (1.0f / 64.0f); } }
    u32x2 hwA[4], hwB[4]; unsigned ywA[4][4], ywB[4][4];
#define P8_LOAD(k, hw, yw) do { const int m_ = gw + (k) * NGW; if (m_ < T) { const u32x2* xr_ = (const u32x2*)(H1R + (size_t)m_ * 1024) + F.lane; \
        _Pragma("unroll") for (int j = 0; j < 4; ++j) hw[j] = xr_[64 * j]; \
        _Pragma("unroll") for (int q = 0; q < 4; ++q) { const unsigned ep_ = (unsigned)__builtin_amdgcn_readlane((int)tk, (k) * 4 + q); \
            const size_t slot_ = (size_t)tstart[ep_ >> 16] * 256 + (ep_ & 0xffffu); const unsigned* yr_ = (const unsigned*)(Y + slot_ * 1024) + F.lane; \
            _Pragma("unroll") for (int j = 0; j < 4; ++j) yw[q][j] = yr_[64 * j]; } } } while (0)
#define P8_ROW(k, hw, yw) do { const int m_ = gw + (k) * NGW; if (m_ < T) { f32x4 v[4]; float gt[4]; \
        _Pragma("unroll") for (int q = 0; q < 4; ++q) gt[q] = __builtin_bit_cast(float, __builtin_amdgcn_readlane(__builtin_bit_cast(int, tg), (k) * 4 + q)); \
        _Pragma("unroll") for (int j = 0; j < 4; ++j) { v[j] = (f32x4){ALPHA * bf16_lo(hw[j].x), ALPHA * bf16_hi(hw[j].x), ALPHA * bf16_lo(hw[j].y), ALPHA * bf16_hi(hw[j].y)}; \
            _Pragma("unroll") for (int q = 0; q < 4; ++q) { const unsigned w = yw[q][j]; \
                v[j].x += gt[q] * fp8_to_f32(w, 0); v[j].y += gt[q] * fp8_to_f32(w, 1); v[j].z += gt[q] * fp8_to_f32(w, 2); v[j].w += gt[q] * fp8_to_f32(w, 3); } } \
        float s_ = 0.f; _Pragma("unroll") for (int j = 0; j < 4; ++j) s_ += (v[j].x + v[j].y) + (v[j].z + v[j].w); \
        const float mean_ = wave_sum(s_) * (1.f / 1024.f); float s2_ = 0.f; \
        _Pragma("unroll") for (int j = 0; j < 4; ++j) { v[j] = v[j] - mean_; s2_ += (v[j].x * v[j].x + v[j].y * v[j].y) + (v[j].z * v[j].z + v[j].w * v[j].w); } \
        const float rstd_ = 1.f / sqrtf(wave_sum(s2_) * (1.f / 1024.f) + LN_EPS); \
        f32x4* orow_ = (f32x4*)(F.out + (size_t)m_ * 1024) + F.lane; \
        _Pragma("unroll") for (int j = 0; j < 4; ++j) orow_[64 * j] = v[j] * rstd_ * gv[j] + bv[j]; } } while (0)
    P8_LOAD(0, hwA, ywA);
    P8_LOAD(1, hwB, ywB); P8_ROW(0, hwA, ywA);
    P8_LOAD(2, hwA, ywA); P8_ROW(1, hwB, ywB);
    P8_LOAD(3, hwB, ywB); P8_ROW(2, hwA, ywA);
    P8_LOAD(4, hwA, ywA); P8_ROW(3, hwB, ywB);
    P8_LOAD(5, hwB, ywB); P8_ROW(4, hwA, ywA);
    P8_LOAD(6, hwA, ywA); P8_ROW(5, hwB, ywB);
    P8_LOAD(7, hwB, ywB); P8_ROW(6, hwA, ywA);
    P8_ROW(7, hwB, ywB);
#undef P8_LOAD
#undef P8_ROW
}

__global__ void __launch_bounds__(NTHREADS, 2) mk_fwd(Args args) {
    extern __shared__ __attribute__((aligned(16))) unsigned char lds_raw[];
    Frame F;
    F.lds = (LAS unsigned char*)lds_raw;
    F.tid = threadIdx.x; F.lane = F.tid & 63; F.wave = __builtin_amdgcn_readfirstlane(F.tid >> 6); F.G = gridDim.x; F.bid = blockIdx.x;
    frame_refresh(F);
    volatile LAS unsigned* misc = (volatile LAS unsigned*)(F.lds + MISC_OFF);
    LAS int* tstart = (LAS int*)(F.lds + MISC_OFF + 256);
    LAS int* toktab = (LAS int*)(F.lds + MISC_OFF + 1024);
    if (F.tid < 4) misc[F.tid] = 0u;
    __syncthreads();
    const int lo = args.ph_lo, hi = args.ph_hi;
    XcdBarrier bar; bar.bar = F.ctl; bar.x = 0; bar.st = misc;
    if (hi - lo > 1) bar = xcd_barrier_post(F.ctl, misc);
#define IN(k) (lo <= (k) && (k) < hi)
#ifdef ONLY
#define PH_ON(k) ((k) == ONLY)
#else
#define PH_ON(k) true
#endif
#define SEAM(k) do { if (IN(k) && IN((k) + 1)) xcd_barrier(bar); frame_refresh(F); } while (0)

    if (PH_ON(0) && IN(0)) { p0_prologue(F); } SEAM(0);
    if (PH_ON(1) && IN(1)) {
        EpiInProj E{(bf16_t*)(F.ws + WS_U), (bf16_t*)(F.ws + WS_Q), (bf16_t*)(F.ws + WS_K), (bf16_t*)(F.ws + WS_V), (bf16_t*)(F.ws + WS_IQ), (bf16_t*)(F.ws + WS_IK), (float*)(F.ws + WS_IW),
                    (const float*)(F.ws + WS_ROPEQK), (const float*)(F.ws + WS_ROPEIX)};
        { pg8::StaticSched S{T / 256, 5, F.G, F.bid, 1, 1};
          pg8::gemm_phase<EpiInProj, pg8::StaticSched, true, 0x79797979, 0x7f7f7f7f>(F.lds, (const char*)(F.ws + WS_HA8), (const char*)(F.ws + WS_BTIN8), S, E); }
        { pg8::StaticSched S{T / 256, 4, F.G, F.bid, 0, 5};
          pg8::gemm_phase<EpiInProj, pg8::StaticSched>(F.lds, (const char*)(F.ws + WS_HA), (const char*)(F.ws + WS_BTIN), S, E); }
        if (F.bid >= 64) {
            convert_range(F, 0, 2 * CV_PAIRS1, (F.bid - 64) * 8 + F.wave, (F.G - 64) * 8); }
    } SEAM(1);
    if (PH_ON(2) && IN(2)) {
#ifndef NO_POOL
 p2_pool(F);
#endif
 p2_indexer(F); } SEAM(2);
    if (PH_ON(3) && IN(3)) { p3_attention(F); } SEAM(3);
    if (PH_ON(4) && IN(4)) {
        pg8::StaticSched S{T / 256, 4, F.G, F.bid, 0, 0};
        EpiMix E{(bf16_t*)(F.ws + WS_MIX)};
        pg8::gemm_phase<EpiMix, pg8::StaticSched>(F.lds, (const char*)(F.ws + WS_CAT), (const char*)(F.ws + WS_BTOUT), S, E);
    } SEAM(4);
    if (PH_ON(5) && IN(5)) { p5_ln1_router(F); } SEAM(5);
    if (PH_ON(6) && IN(6)) {
        moe_tables(F, tstart);
        const int ntl = tstart[NE];
        pg8::MoeSched<true> S{ntl, 8, F.G, F.bid, 2048, tstart, toktab, 0};
        { const unsigned* INV = (const unsigned*)(F.ws + WS_INV); pg8::Unit u; unsigned tk[10];
#pragma unroll
          for (int i = 0; i < 10; ++i) { tk[i] = 0u; if (S.next(i, u) && F.tid < 256) { const int p = (u.pm - tstart[u.e]) * 256 + F.tid; const int cnt = tstart[40 + u.e];
                  tk[i] = INV[(size_t)u.e * CAP + (p < cnt ? p : 0)]; } }
#pragma unroll
          for (int i = 0; i < 10; ++i) if (F.tid < 256) toktab[i * 256 + F.tid] = (int)tk[i];
          __syncthreads(); }
        EpiGateUp E{F.ws + WS_ACT, F.b_gu, F.ctl + CW_ACTRDY};
#ifndef NO_GU
        pg8::gemm_phase<EpiGateUp, pg8::MoeSched<true>, true, 0x79797979, 0x7f7f7f7f>(F.lds, (const char*)(F.ws + WS_H1B), (const char*)(F.ws + WS_BTGU), S, E);
#endif
        { const int nwg6 = 8 * ntl, rounds6 = (nwg6 + F.G - 1) / F.G, nidle = rounds6 * F.G - nwg6, cfirst = nwg6 - (rounds6 - 1) * F.G;
          int early = ((nidle < 128 ? nidle : 128) / 32) * 32; if (rounds6 < 9 || ntl < 32) early = 0;
          const int rank = F.bid - cfirst;
#ifndef NO_EARLY
          if (rank >= 0 && rank < early) {
              pg8::MoeSched<false> S7{early / 4, 4, F.G, rank, 1024, tstart, toktab, 0};
              pg8::Unit u; S7.next(0, u);
              if (F.tid < 64) {
                  unsigned* cp = F.ctl + CW_ACTRDY + u.pm; unsigned sp = 0;
                  while ((unsigned)__builtin_amdgcn_readfirstlane((int)__hip_atomic_load(cp, __ATOMIC_RELAXED, __HIP_MEMORY_SCOPE_AGENT)) < 64u) {
                      __builtin_amdgcn_s_sleep(2); if (++sp > (1u << 20)) { if (F.tid == 0) __hip_atomic_store(F.ctl + CW_TMO2, 1u, __ATOMIC_RELAXED, __HIP_MEMORY_SCOPE_AGENT); break; } }
                  __builtin_amdgcn_fence(__ATOMIC_ACQUIRE, "agent");
                  asm volatile("s_waitcnt vmcnt(0)" ::: "memory"); }
              __syncthreads();
              EpiDown E7{F.ws + WS_Y, F.b_dn};
              pg8::gemm_phase<EpiDown, pg8::MoeSched<false>, true, 0x79797979, 0x7c7c7c7c>(F.lds, (const char*)(F.ws + WS_ACT), (const char*)(F.ws + WS_BTDN), S7, E7);
          }
#endif
          (void)rank; (void)early; }
    } SEAM(6);
    if (PH_ON(7) && IN(7)) {
        moe_tables(F, tstart);
        const int ntl = tstart[NE];
        const int nwg6 = 8 * ntl, rounds6 = (nwg6 + F.G - 1) / F.G, nidle = rounds6 * F.G - nwg6;
        int early = ((nidle < 128 ? nidle : 128) / 32) * 32; if (rounds6 < 9 || ntl < 32) early = 0;
        pg8::MoeSched<false> S{ntl, 4, F.G, F.bid, 1024, tstart, toktab, early};
        EpiDown E{F.ws + WS_Y, F.b_dn};
        pg8::gemm_phase<EpiDown, pg8::MoeSched<false>, true, 0x79797979, 0x7c7c7c7c>(F.lds, (const char*)(F.ws + WS_ACT), (const char*)(F.ws + WS_BTDN), S, E);
    } SEAM(7);
    if (PH_ON(8) && IN(8)) { moe_tables(F, tstart); p8_final(F, tstart); }
#undef IN
#undef SEAM
}

extern "C" void kernel_launch(void* const* d_in, const int* in_sizes, int n_in, void* d_out, int out_size, void* d_ws, size_t ws_size, hipStream_t stream) {
    static int grid = 0;
    if (grid == 0) {
        if (n_in != 18 || in_sizes[0] != T * DM || out_size != T * DM || ws_size < WS_END) {
            fprintf(stderr, "kernel_launch: shape mismatch (n_in %d, in0 %d, out %d, ws %zu, need %zu)\n", n_in, n_in > 0 ? in_sizes[0] : -1, out_size, ws_size, (size_t)WS_END); grid = -1; return; }
        int dev = 0, cus = 0, per_cu = 0;
        if (hipGetDevice(&dev) != hipSuccess || hipDeviceGetAttribute(&cus, hipDeviceAttributeMultiprocessorCount, dev) != hipSuccess) { grid = -1; return; }
        if (hipFuncSetAttribute((const void*)mk_fwd, hipFuncAttributeMaxDynamicSharedMemorySize, LDS_BYTES) != hipSuccess) { fprintf(stderr, "kernel_launch: hipFuncSetAttribute failed\n"); grid = -1; return; }
        if (hipOccupancyMaxActiveBlocksPerMultiprocessor(&per_cu, (const void*)mk_fwd, NTHREADS, LDS_BYTES) != hipSuccess || per_cu < 1) {
            fprintf(stderr, "kernel_launch: occupancy query reports %d workgroups per CU\n", per_cu); }
        (void)hipGetLastError();
        grid = cus;
        if (grid != 256) { fprintf(stderr, "kernel_launch: built for a 256-CU device (static work deals), found %d CUs\n", cus); grid = -1; return; }
    }
    if (grid < 0) return;
    (void)hipMemsetAsync((char*)d_ws + WS_CTL, 0, CTL_BYTES, stream);
    Args a{};
    for (int i = 0; i < 18; ++i) a.in[i] = d_in[i];
    a.out = (float*)d_out; a.ws = (unsigned char*)d_ws;
#if MK_N_LAUNCHES == 1
    a.ph_lo = 0; a.ph_hi = NPH;
    hipLaunchKernelGGL(mk_fwd, dim3(grid), dim3(NTHREADS), LDS_BYTES, stream, a);
#else
    for (int p = 0; p < NPH; ++p) { a.ph_lo = p; a.ph_hi = p + 1; hipLaunchKernelGGL(mk_fwd, dim3(grid), dim3(NTHREADS), LDS_BYTES, stream, a);
#ifdef PROBE_DUP
        if (p == PROBE_DUP) { if (p == 3 || p == 5) (void)hipMemsetAsync((char*)d_ws + WS_CTL + 4096 * 4, 0, 1024, stream); hipLaunchKernelGGL(mk_fwd, dim3(grid), dim3(NTHREADS), LDS_BYTES, stream, a); }
#endif
    }
#endif
    const hipError_t le = hipPeekAtLastError();
    if (le != hipSuccess) fprintf(stderr, "kernel_launch: launch failed: %s\n", hipGetErrorName(le));
}
```

```cpp
#include <hip/hip_runtime.h>
#include <cstdio>
#include <cstdint>
#include <utility>

#define LAS __attribute__((address_space(3)))
typedef unsigned short bf16_t;
typedef short bf16x8 __attribute__((ext_vector_type(8)));
typedef short s16x4 __attribute__((ext_vector_type(4)));
typedef float f32x2 __attribute__((ext_vector_type(2)));
typedef float f32x4 __attribute__((ext_vector_type(4)));
typedef float f32x16 __attribute__((ext_vector_type(16)));
typedef unsigned u32x2 __attribute__((ext_vector_type(2)));
typedef unsigned u32x4 __attribute__((ext_vector_type(4)));

#ifndef MK_N_LAUNCHES
#define MK_N_LAUNCHES 1
#endif

constexpr int T = 16384, DM = 1024, SEQ = 2048, NBATCH = 8;
constexpr int INW = 2120, INP = 2304;
constexpr int NE = 32, CAP = 16384, MAXT = 288;
constexpr int NPH = 9;
constexpr float ALPHA = 1.189207115002721f;
constexpr float LN_EPS = 1e-5f;
constexpr float W_SCALE = 0.04419417382415922f;
constexpr int NTHREADS = 512;
constexpr int LDS_BYTES = 147456;
constexpr int MISC_OFF = 131072;

constexpr size_t al256(size_t x) { return (x + 255) / 256 * 256; }
constexpr size_t WS_CTL = 0;
constexpr size_t CTL_BYTES = 65536;
constexpr size_t WS_BTIN = WS_CTL + CTL_BYTES;
constexpr size_t WS_BTOUT = WS_BTIN + al256((size_t)INP * 1024 * 2);
constexpr size_t WS_BTGU = WS_BTOUT + al256((size_t)1024 * 1024 * 2);
constexpr size_t WS_BTDN = WS_BTGU + al256((size_t)NE * 2048 * 1024 * 2);
constexpr size_t WS_WPT = WS_BTDN + al256((size_t)NE * 1024 * 1024 * 2);
constexpr size_t WS_WRA = WS_WPT + al256((size_t)4 * 64 * 64 * 2);
constexpr size_t WS_HA = WS_WRA + al256((size_t)1024 * 32 * 4);
constexpr size_t WS_STATS = WS_HA + al256((size_t)T * 1024 * 2);
constexpr size_t WS_ROPEQK = WS_STATS + al256((size_t)T * 2 * 4);
constexpr size_t WS_ROPEIX = WS_ROPEQK + al256((size_t)T * 32 * 4);
constexpr size_t WS_U = WS_ROPEIX + al256((size_t)T * 16 * 4);
constexpr size_t WS_Q = WS_U + al256((size_t)T * 256 * 2);
constexpr size_t WS_K = WS_Q + al256((size_t)T * 768 * 2);
constexpr size_t WS_V = WS_K + al256((size_t)T * 256 * 2);
constexpr size_t WS_IQ = WS_V + al256((size_t)T * 256 * 2);
constexpr size_t WS_IK = WS_IQ + al256((size_t)T * 512 * 2);
constexpr size_t WS_IW = WS_IK + al256((size_t)T * 64 * 2);
constexpr size_t WS_MASK = WS_IW + al256((size_t)T * 8 * 4);
constexpr size_t WS_CAT = WS_MASK + al256((size_t)T * 64 * 4);
constexpr size_t WS_H1F = WS_CAT + al256((size_t)T * 1024 * 2);
constexpr size_t WS_H1B = WS_H1F + al256((size_t)T * 1024 * 4);
constexpr size_t WS_INV = WS_H1B + al256((size_t)T * 1024 * 2);
constexpr size_t WS_TOKEP = WS_INV + al256((size_t)NE * CAP * 4);
constexpr size_t WS_TOKG = WS_TOKEP + al256((size_t)T * 4 * 4);
constexpr size_t WS_ACT = WS_TOKG + al256((size_t)T * 4 * 4);
constexpr size_t WS_Y = WS_ACT + al256((size_t)MAXT * 256 * 1024 * 2);
constexpr size_t WS_MIX = WS_Y + al256((size_t)MAXT * 256 * 1024 * 2);
constexpr size_t WS_HA8 = WS_MIX + al256((size_t)T * 1024 * 2);
constexpr size_t WS_BTIN8 = WS_HA8 + al256((size_t)T * 1024);
constexpr size_t WS_END = WS_BTIN8 + al256((size_t)1536 * 1024);
constexpr int CW_CNT = 4096;
constexpr int CW_ATTQ = 4224;
constexpr int CW_CVQ1 = 4288, CW_CVQ3 = 4352, CW_ACTRDY = 4608;
constexpr int CW_TMO2 = 4480;
constexpr int CV_PAIRS1 = 3072, CV_PAIRS3 = 5120, CV_HIDDEN = 2 * (CV_PAIRS1 + CV_PAIRS3);

#define XB_TMO      128
#define XB_XCNT(j)  (256  + 64 * (j))
#define XB_XSUB(j)  (1280 + 64 * (j))
#define XB_XGEN(j)  (2304 + 64 * (j))
#define XB_TOP      3328
#define XB_TOPGEN   3392
#define XCD_BAR_WORDS 3456
#define XB_SPIN_CAP (1u << 18)
__device__ __forceinline__ unsigned xb_ld(unsigned* p)              { return __hip_atomic_load(p, __ATOMIC_RELAXED, __HIP_MEMORY_SCOPE_AGENT); }
__device__ __forceinline__ unsigned xb_add(unsigned* p, unsigned v) { return __hip_atomic_fetch_add(p, v, __ATOMIC_RELAXED, __HIP_MEMORY_SCOPE_AGENT); }
__device__ __forceinline__ unsigned xb_xcc_id() { return (unsigned)__builtin_amdgcn_s_getreg((3 << 11) | 20) & 0xFu; }
#define XB_SPIN(cond, bar) do { unsigned _sp = 0; while (cond) { __builtin_amdgcn_s_sleep(1); \
    if ((++_sp & 255u) == 0u) { if (xb_ld(&(bar)[XB_TMO])) break; if (_sp > XB_SPIN_CAP) { atomicAdd(&(bar)[XB_TMO], 1u); break; } } } } while (0)
struct XcdBarrier { unsigned* bar; unsigned x; volatile LAS unsigned* st; };
__device__ __forceinline__ XcdBarrier xcd_barrier_post(unsigned* bar, volatile LAS unsigned* st) {
    XcdBarrier b; b.bar = bar; b.x = xb_xcc_id(); b.st = st;
    if (threadIdx.x == 0) (void)xb_add(&bar[XB_XCNT(b.x)], 1u);
    return b;
}
__device__ __forceinline__ void xcd_barrier_complete(unsigned* bar, unsigned x, unsigned& nloc, unsigned& nx) {
    const unsigned G = gridDim.x * gridDim.y * gridDim.z;
    unsigned sum, cnt, mine, sp = 0u;
    for (;;) {
        sum = 0u; cnt = 0u; mine = 0u;
#pragma unroll
        for (unsigned j = 0; j < 16; ++j) { const unsigned c = xb_ld(&bar[XB_XCNT(j)]); sum += c; cnt += (c > 0u) ? 1u : 0u; mine = (j == x) ? c : mine; }
        if (sum == G) break;
        __builtin_amdgcn_s_sleep(1);
        if ((++sp & 255u) == 0u) { if (xb_ld(&bar[XB_TMO])) break; if (sp > XB_SPIN_CAP) { atomicAdd(&bar[XB_TMO], 1u); break; } }
    }
    nloc = mine > 0u ? mine : 1u; nx = cnt > 0u ? cnt : 1u;
}
__device__ __forceinline__ void xcd_barrier(const XcdBarrier& b) {
    asm volatile("s_waitcnt vmcnt(0)" ::: "memory");
    __syncthreads();
    if (threadIdx.x == 0) {
        unsigned* bar = b.bar;
        __builtin_amdgcn_s_waitcnt(0);
        unsigned nloc = b.st[0], nx = b.st[1];
        if (nloc == 0u) { xcd_barrier_complete(bar, b.x, nloc, nx); b.st[0] = nloc; b.st[1] = nx; }
        const unsigned old = xb_add(&bar[XB_XSUB(b.x)], 1u);
        const unsigned gen = old / nloc;
        if (old + 1u == (gen + 1u) * nloc) {
            __builtin_amdgcn_fence(__ATOMIC_RELEASE, "agent");
            asm volatile("s_waitcnt vmcnt(0)" ::: "memory");
            const unsigned og = xb_add(&bar[XB_TOP], 1u);
            const unsigned tg = og / nx;
            if (og + 1u == (tg + 1u) * nx) xb_add(&bar[XB_TOPGEN], 1u);
            else XB_SPIN(xb_ld(&bar[XB_TOPGEN]) == tg, bar);
            __builtin_amdgcn_fence(__ATOMIC_ACQUIRE, "agent");
            xb_add(&bar[XB_XGEN(b.x)], 1u);
            asm volatile("s_waitcnt vmcnt(0)" ::: "memory");
        } else {
            XB_SPIN(xb_ld(&bar[XB_XGEN(b.x)]) == gen, bar);
            __builtin_amdgcn_fence(__ATOMIC_ACQUIRE, "agent");
            asm volatile("s_waitcnt vmcnt(0)" ::: "memory");
        }
    }
    __syncthreads();
}

__device__ __forceinline__ unsigned cvt_pk_bf16(float lo, float hi) { unsigned r; asm volatile("v_cvt_pk_bf16_f32 %0, %1, %2" : "=v"(r) : "v"(lo), "v"(hi)); return r; }
__device__ __forceinline__ unsigned pk4_fp8(float a, float b, float c, float d) { int w = __builtin_amdgcn_cvt_pk_fp8_f32(a, b, 0, false); w = __builtin_amdgcn_cvt_pk_fp8_f32(c, d, w, true); return (unsigned)w; }
__device__ __forceinline__ float bf16_lo(unsigned w) { return __uint_as_float(w << 16); }
__device__ __forceinline__ float bf16_hi(unsigned w) { return __uint_as_float(w & 0xffff0000u); }
template <int CTRL> __device__ __forceinline__ float dpp_f(float v) { return __builtin_bit_cast(float, __builtin_amdgcn_update_dpp(0, __builtin_bit_cast(int, v), CTRL, 0xf, 0xf, true)); }
__device__ __forceinline__ float wave_sum(float v) {
    v += dpp_f<0xB1>(v);
    v += dpp_f<0x4E>(v);
    v += dpp_f<0x141>(v);
    v += dpp_f<0x140>(v);
    const int vi = __builtin_bit_cast(int, v);
    const float r0 = __builtin_bit_cast(float, __builtin_amdgcn_readlane(vi, 0)), r1 = __builtin_bit_cast(float, __builtin_amdgcn_readlane(vi, 16));
    const float r2 = __builtin_bit_cast(float, __builtin_amdgcn_readlane(vi, 32)), r3 = __builtin_bit_cast(float, __builtin_amdgcn_readlane(vi, 48));
    return (r0 + r1) + (r2 + r3);
}
#define LDS_WAIT() asm volatile("s_waitcnt lgkmcnt(0)" ::: "memory")
#define VM_WAIT()  asm volatile("s_waitcnt vmcnt(0)" ::: "memory")
__device__ __forceinline__ int crow(int r, int hi) { return (r & 3) + 8 * (r >> 2) + 4 * hi; }

namespace pg8 {
constexpr int BM = 256, BK = 64, HALF = 128, HTB = HALF * BK * 2, STAGE_BYTES = 8 * HTB, NXCD = 8, WGM = 4, KD = 1024;
__device__ __forceinline__ int lds_byte(int r, int c) { const int st = (r >> 4) * 2 + (c >> 5), rr = r & 15, cc = c & 31, ob = rr * 64 + cc * 2; return st * 1024 + (ob ^ (((ob >> 9) & 1) << 5)); }
__device__ __forceinline__ void stage_rc(int b, int& R, int& C) { const int st = b / 1024, sb = b % 1024, swz = sb ^ (((sb >> 9) & 1) << 5); R = (st >> 1) * 16 + swz / 64; C = (st & 1) * 32 + (swz % 64) / 2; }
__device__ __forceinline__ int perm32(int rho) { const int n = rho >> 4, i = rho & 15; return 8 * (i >> 2) + 4 * n + (i & 3); }

struct Unit { int pm, pn, e, idx; };

__device__ __forceinline__ void order_decode(int wgid, int nM, int nN, int& pm, int& pn) {
    const int nig = WGM * nN, gid = wgid / nig, fm = gid * WGM, gsz = (nM - fm) < WGM ? (nM - fm) : WGM;
    pm = fm + ((wgid % nig) % gsz); pn = (wgid % nig) / gsz;
}
__device__ __forceinline__ bool order_next(int i, int G, int c, int nM, int nN, int& pm, int& pn, int woff = 0) {
    const int nwg = nM * nN - woff; const long L = (long)i * G + c; if (L >= nwg) return false;
    int wgid = (int)L; { const int q = nwg / NXCD, r = nwg % NXCD, xcd = wgid % NXCD, off = wgid / NXCD; wgid = (xcd < r ? xcd * (q + 1) : r * (q + 1) + (xcd - r) * q) + off; }
    order_decode(wgid + woff, nM, nN, pm, pn); return true;
}
struct StaticSched {
    int nM, nN, G, c, t0, toff;
    __device__ __forceinline__ bool next(int i, Unit& u) const { u.idx = i; const bool ok = order_next(i, G, c, nM, nN, u.pm, u.pn); u.e = (u.pn == 0) ? t0 : u.pn + toff; return ok; }
    __device__ __forceinline__ int a_row(const Unit& u, int h, int R) const { return u.pm * BM + h * HALF + R; }
    __device__ __forceinline__ int b_row(const Unit& u) const { return u.e * BM; }
};
template <bool GATHER> struct MoeSched {
    int nM, nN, G, c; int brows;
    const LAS int* tstart; const LAS int* toktab; int woff;
    __device__ __forceinline__ bool next(int i, Unit& u) const {
        u.idx = i;
        if (!order_next(i, G, c, nM, nN, u.pm, u.pn, woff)) return false;
        int e = 0;
#pragma unroll
        for (int k = 1; k < NE; ++k) e += (u.pm >= tstart[k]) ? 1 : 0;
        u.e = e; return true;
    }
    __device__ __forceinline__ int a_row(const Unit& u, int h, int R) const { if constexpr (GATHER) return toktab[u.idx * 256 + h * HALF + R]; else return u.pm * BM + h * HALF + R; }
    __device__ __forceinline__ int b_row(const Unit& u) const { return u.e * brows + u.pn * BM; }
};

typedef int v8i32 __attribute__((ext_vector_type(8)));
typedef int v4i32 __attribute__((ext_vector_type(4)));
__device__ __forceinline__ v8i32 cat8(bf16x8 a, bf16x8 b) { const v4i32 x = __builtin_bit_cast(v4i32, a), y = __builtin_bit_cast(v4i32, b); return __builtin_shufflevector(x, y, 0, 1, 2, 3, 4, 5, 6, 7); }
template <class Epi, class Sched, bool FP8 = false, int SW = 0x7f7f7f7f, int SA = 0x7f7f7f7f>
__device__ __forceinline__ void gemm_phase(LAS unsigned char* lds, const char* Abase, const char* Bbase, const Sched& S, const Epi& E) {
    const int tid = threadIdx.x, wid = __builtin_amdgcn_readfirstlane(tid >> 6), lane = tid & 63, wr = wid >> 2, wc = wid & 3, fr = lane & 15, fq = lane >> 4;
    constexpr int ROWB = FP8 ? KD : 2 * KD, nt = ROWB / 128;
    int RA[2], CA[2]; unsigned voffB[2];
#pragma unroll
    for (int i = 0; i < 2; ++i) { int R, C; stage_rc(tid * 16 + i * 8192, R, C); const int Rb = Epi::PERM ? ((R & ~31) + perm32(R & 31)) : R;
        RA[i] = R; CA[i] = C * 2; voffB[i] = (unsigned)(Rb * ROWB + C * 2); }
    const size_t kstep = (size_t)(BK * 2);
    const size_t hstep = (size_t)HALF * ROWB;
    const unsigned ldsw = (unsigned)wid * 1024u;
    const int aoff = lds_byte(wr * 64 + fr, fq * 8), boff = lds_byte(wc * 32 + fr, fq * 8);
#define PG8_SA(b, h) (((b) * 2 + (h)) * HTB)
#define PG8_SB(b, h) ((4 + (b) * 2 + (h)) * HTB)
#define PG8_STAGE(bufoff, gbase, voff) do { _Pragma("unroll") for (int _i = 0; _i < 2; ++_i) \
        __builtin_amdgcn_global_load_lds((const unsigned*)((const char*)(gbase) + (voff)[_i]), (LAS unsigned*)(lds + (bufoff) + ldsw + _i * 8192), 16, 0, 0); } while (0)
#define PG8_LDA(dst, b, h) do { _Pragma("unroll") for (int m = 0; m < 4; ++m) _Pragma("unroll") for (int k = 0; k < 2; ++k) dst[m][k] = *(const LAS bf16x8*)(lds + PG8_SA(b, h) + aoff + m * 2048 + k * 1024); } while (0)
#define PG8_LDB(dst, b, h) do { _Pragma("unroll") for (int n = 0; n < 2; ++n) _Pragma("unroll") for (int k = 0; k < 2; ++k) dst[n][k] = *(const LAS bf16x8*)(lds + PG8_SB(b, h) + boff + n * 2048 + k * 1024); } while (0)
#define PG8_MMA(ai, bj, At, Bt) do { __builtin_amdgcn_s_setprio(1); if constexpr (FP8) { _Pragma("unroll") for (int m = 0; m < 4; ++m) _Pragma("unroll") for (int n = 0; n < 2; ++n) \
        acc[ai][bj][m][n] = __builtin_amdgcn_mfma_scale_f32_16x16x128_f8f6f4(cat8(Bt[n][0], Bt[n][1]), cat8(At[m][0], At[m][1]), acc[ai][bj][m][n], 0, 0, 0, SW, 0, SA); } \
        else { _Pragma("unroll") for (int m = 0; m < 4; ++m) _Pragma("unroll") for (int n = 0; n < 2; ++n) _Pragma("unroll") for (int k = 0; k < 2; ++k) \
        acc[ai][bj][m][n] = __builtin_amdgcn_mfma_f32_16x16x32_bf16(Bt[n][k], At[m][k], acc[ai][bj][m][n], 0, 0, 0); } __builtin_amdgcn_s_setprio(0); } while (0)
#define PG8_WAIT_V(n) asm volatile("s_waitcnt vmcnt(" #n ")" ::: "memory")
#define PG8_WAIT_L(n) asm volatile("s_waitcnt lgkmcnt(" #n ")" ::: "memory")
#define PG8_BAR __builtin_amdgcn_s_barrier()
#define PG8_SCHED __builtin_amdgcn_sched_barrier(0)
    Unit cur, nxt; int ui = 0;
    if (!S.next(0, cur)) return;
    f32x4 acc[2][2][4][2]; f32x4 bini[2][2];
#pragma unroll
    for (int b = 0; b < 2; ++b)
#pragma unroll
        for (int n = 0; n < 2; ++n) bini[b][n] = Epi::BIAS_INIT ? E.bias4(cur, b, n, wc, fq) : (f32x4){0.f, 0.f, 0.f, 0.f};
#pragma unroll
    for (int a = 0; a < 2; ++a)
#pragma unroll
        for (int b = 0; b < 2; ++b)
#pragma unroll
            for (int m = 0; m < 4; ++m)
#pragma unroll
                for (int n = 0; n < 2; ++n) acc[a][b][m][n] = bini[b][n];
    bf16x8 At[4][2], B0[2][2], B1[2][2];
    unsigned oA[2][2];
#pragma unroll
    for (int h = 0; h < 2; ++h)
#pragma unroll
        for (int i = 0; i < 2; ++i) oA[h][i] = (unsigned)(S.a_row(cur, h, RA[i]) * ROWB + CA[i]);
    const char* cB = Bbase + (size_t)S.b_row(cur) * ROWB;
    const char* cA = Abase;
    PG8_STAGE(PG8_SB(0, 0), cB, voffB); PG8_STAGE(PG8_SA(0, 0), cA, oA[0]); PG8_STAGE(PG8_SB(0, 1), cB + hstep, voffB); PG8_STAGE(PG8_SA(0, 1), cA, oA[1]);
    if (wr == 1) PG8_BAR;
    PG8_WAIT_V(4); PG8_BAR;
    PG8_STAGE(PG8_SB(1, 0), cB + kstep, voffB); PG8_STAGE(PG8_SA(1, 0), cA + kstep, oA[0]); PG8_STAGE(PG8_SB(1, 1), cB + hstep + kstep, voffB);
    PG8_WAIT_V(6); PG8_BAR;
    for (;;) {
        const bool has_next = S.next(ui + 1, nxt);
        const char* nB = has_next ? Bbase + (size_t)S.b_row(nxt) * ROWB : cB;
        for (int t = 0; t < nt; t += 2) {
            const bool last = (t == nt - 2);
            const char* a1 = cA + (size_t)(t + 1) * kstep;
            const char* a2 = last ? cA : cA + (size_t)(t + 2) * kstep; const char* b2 = last ? nB : cB + (size_t)(t + 2) * kstep;
            const char* a3 = a2 + kstep; const char* b3 = b2 + kstep;
            PG8_LDB(B0, 0, 0); PG8_SCHED; PG8_LDA(At, 0, 0); PG8_STAGE(PG8_SA(1, 1), a1, oA[1]);
            if (last && has_next) {
#pragma unroll
                for (int h = 0; h < 2; ++h)
#pragma unroll
                    for (int i = 0; i < 2; ++i) oA[h][i] = (unsigned)(S.a_row(nxt, h, RA[i]) * ROWB + CA[i]);
            }
            PG8_WAIT_L(8); PG8_BAR; PG8_WAIT_L(0); PG8_MMA(0, 0, At, B0); PG8_BAR; PG8_SCHED;
            PG8_LDB(B1, 0, 1); PG8_STAGE(PG8_SB(0, 0), b2, voffB);
            PG8_BAR; PG8_WAIT_L(0); PG8_MMA(0, 1, At, B1); PG8_BAR;
            PG8_LDA(At, 0, 1); PG8_STAGE(PG8_SA(0, 0), a2, oA[0]);
            PG8_BAR; PG8_WAIT_L(0); PG8_MMA(1, 0, At, B0); PG8_BAR; PG8_SCHED;
            PG8_STAGE(PG8_SB(0, 1), b2 + hstep, voffB);
            PG8_WAIT_V(6); PG8_BAR; PG8_MMA(1, 1, At, B1); PG8_BAR;
            PG8_LDB(B0, 1, 0); PG8_SCHED; PG8_LDA(At, 1, 0); PG8_STAGE(PG8_SA(0, 1), a2, oA[1]);
            PG8_WAIT_L(8); PG8_BAR; PG8_WAIT_L(0); PG8_MMA(0, 0, At, B0); PG8_BAR; PG8_SCHED;
            PG8_LDB(B1, 1, 1); PG8_STAGE(PG8_SB(1, 0), b3, voffB);
            PG8_BAR; PG8_WAIT_L(0); PG8_MMA(0, 1, At, B1); PG8_BAR;
            PG8_LDA(At, 1, 1); PG8_STAGE(PG8_SA(1, 0), a3, oA[0]);
            PG8_BAR; PG8_WAIT_L(0); PG8_MMA(1, 0, At, B0); PG8_BAR; PG8_SCHED;
            PG8_STAGE(PG8_SB(1, 1), b3 + hstep, voffB);
            PG8_WAIT_V(6); PG8_BAR; PG8_MMA(1, 1, At, B1); PG8_BAR;
        }
        int l2 = threadIdx.x & 63; asm volatile("" : "+v"(l2));
        const int fr2 = l2 & 15, fq2 = l2 >> 4;
        if (Epi::BIAS_INIT && has_next) {
#pragma unroll
            for (int b = 0; b < 2; ++b)
#pragma unroll
                for (int n = 0; n < 2; ++n) bini[b][n] = E.bias4(nxt, b, n, wc, fq2);
        }
        E(acc, cur, wr, wc, fr2, fq2);
        if (!has_next) break;
#pragma unroll
        for (int a = 0; a < 2; ++a)
#pragma unroll
            for (int b = 0; b < 2; ++b)
#pragma unroll
                for (int m = 0; m < 4; ++m)
#pragma unroll
                    for (int n = 0; n < 2; ++n) acc[a][b][m][n] = bini[b][n];
        cur = nxt; cB = nB; ++ui;
    }
    PG8_WAIT_V(0);
    if (wr == 0) PG8_BAR;
    PG8_BAR;
#undef PG8_SA
#undef PG8_SB
#undef PG8_STAGE
#undef PG8_LDA
#undef PG8_LDB
#undef PG8_MMA
#undef PG8_WAIT_V
#undef PG8_WAIT_L
#undef PG8_BAR
#undef PG8_SCHED
}
}

struct EpiInProj {
    static constexpr bool PERM = true, BIAS_INIT = false;
    bf16_t *u, *q, *k, *v, *iq, *ik; float* iw; const float* ropeQK; const float* ropeIX;
    __device__ __forceinline__ f32x4 bias4(const pg8::Unit&, int, int, int, int) const { return (f32x4){0.f, 0.f, 0.f, 0.f}; }
    __device__ __forceinline__ void operator()(f32x4 (&acc)[2][2][4][2], const pg8::Unit& un, int wr, int wc, int fr, int fq) const {
        const int lane = threadIdx.x & 63;
#pragma unroll
        for (int bj = 0; bj < 2; ++bj) {
            const int gc = un.e * 256 + bj * 128;
            bf16_t* dst; int ld; int kind = 0;
            const int cin = wc * 32 + 8 * fq;
            if (gc < 256) { dst = u + gc + cin; ld = 256; }
            else if (gc < 1024) { dst = q + (gc - 256) + cin; ld = 768; kind = (wc == 0) ? 1 : 0; }
            else if (gc < 1280) { dst = k + (gc - 1024) + cin; ld = 256; kind = (wc == 0) ? 1 : 0; }
            else if (gc < 1536) { dst = v + (gc - 1280) + cin; ld = 256; }
            else if (gc < 2048) { dst = iq + (gc - 1536) + cin; ld = 512; kind = ((wc & 1) == 0) ? 2 : 0; }
            else if (gc == 2048) { if (wc >= 2) { if (wc == 2 && fq == 0) {
#pragma unroll
                        for (int ai = 0; ai < 2; ++ai)
#pragma unroll
                            for (int m = 0; m < 4; ++m) { const int row = un.pm * 256 + ai * 128 + wr * 64 + m * 16 + fr;
                                *(f32x4*)(iw + (size_t)row * 8) = acc[ai][bj][m][0]; *(f32x4*)(iw + (size_t)row * 8 + 4) = acc[ai][bj][m][1]; } }
                    continue; }
                dst = ik + cin; ld = 64; kind = (wc == 0) ? 2 : 0; }
            else continue;
#pragma unroll
            for (int ai = 0; ai < 2; ++ai)
#pragma unroll
                for (int m = 0; m < 4; ++m) {
                    const int row = un.pm * 256 + ai * 128 + wr * 64 + m * 16 + fr;
                    f32x4 v0 = acc[ai][bj][m][0], v1 = acc[ai][bj][m][1];
                    if (kind == 1) {
                        const float* rp = ropeQK + (size_t)row * 32 + 8 * (fq & 1);
                        const f32x4 c0 = *(const f32x4*)rp, c1 = *(const f32x4*)(rp + 4), s0 = *(const f32x4*)(rp + 16), s1 = *(const f32x4*)(rp + 20);
                        f32x4 p0, p1;
#pragma unroll
                        for (int j = 0; j < 4; ++j) { p0[j] = __shfl_xor(v0[j], 32); p1[j] = __shfl_xor(v1[j], 32); }
                        const float sg = (fq < 2) ? -1.f : 1.f;
                        v0 = v0 * c0 + sg * (p0 * s0); v1 = v1 * c1 + sg * (p1 * s1);
                    } else if (kind == 2) {
                        const float* rp = ropeIX + (size_t)row * 16;
                        const f32x4 c0 = *(const f32x4*)rp, c1 = *(const f32x4*)(rp + 4), s0 = *(const f32x4*)(rp + 8), s1 = *(const f32x4*)(rp + 12);
                        f32x4 p0, p1;
#pragma unroll
                        for (int j = 0; j < 4; ++j) { p0[j] = __shfl_xor(v0[j], 16); p1[j] = __shfl_xor(v1[j], 16); }
                        if (fq < 2) { const float sg = (fq == 0) ? -1.f : 1.f; v0 = v0 * c0 + sg * (p0 * s0); v1 = v1 * c1 + sg * (p1 * s1); }
                    }
                    u32x4 w; w.x = cvt_pk_bf16(v0[0], v0[1]); w.y = cvt_pk_bf16(v0[2], v0[3]); w.z = cvt_pk_bf16(v1[0], v1[1]); w.w = cvt_pk_bf16(v1[2], v1[3]);
                    *(u32x4*)(dst + (size_t)row * ld) = w;
                }
        }
        (void)lane;
    }
};
struct EpiMix {
    static constexpr bool PERM = true, BIAS_INIT = false;
    bf16_t* mix;
    __device__ __forceinline__ f32x4 bias4(const pg8::Unit&, int, int, int, int) const { return (f32x4){0.f, 0.f, 0.f, 0.f}; }
    __device__ __forceinline__ void operator()(f32x4 (&acc)[2][2][4][2], const pg8::Unit& un, int wr, int wc, int fr, int fq) const {
        const int row0 = un.pm * 256 + wr * 64 + fr, col0 = un.pn * 256 + wc * 32 + 8 * fq;
#pragma unroll
        for (int bj = 0; bj < 2; ++bj)
#pragma unroll
            for (int ai = 0; ai < 2; ++ai)
#pragma unroll
                for (int m = 0; m < 4; ++m) {
                    const f32x4 v0 = acc[ai][bj][m][0], v1 = acc[ai][bj][m][1];
                    u32x4 w; w.x = cvt_pk_bf16(v0[0], v0[1]); w.y = cvt_pk_bf16(v0[2], v0[3]); w.z = cvt_pk_bf16(v1[0], v1[1]); w.w = cvt_pk_bf16(v1[2], v1[3]);
                    *(u32x4*)(mix + (size_t)(row0 + ai * 128 + m * 16) * 1024 + col0 + bj * 128) = w;
                }
    }
};
struct EpiGateUp {
    static constexpr bool PERM = true, BIAS_INIT = true;
    unsigned char* act; const float* bias; unsigned* rdy;
    __device__ __forceinline__ f32x4 bias4(const pg8::Unit& un, int bj, int n, int wc, int fq) const { return *(const f32x4*)(bias + (size_t)un.e * 2048 + bj * 1024 + un.pn * 128 + wc * 32 + 8 * fq + 4 * n); }
    __device__ __forceinline__ void operator()(f32x4 (&acc)[2][2][4][2], const pg8::Unit& un, int wr, int wc, int fr, int fq) const {
        const int row0 = un.pm * 256 + wr * 64 + fr, col0 = un.pn * 128 + wc * 32 + 8 * fq;
#pragma unroll
        for (int ai = 0; ai < 2; ++ai)
#pragma unroll
            for (int m = 0; m < 4; ++m) {
                float o[8];
#pragma unroll
                for (int n = 0; n < 2; ++n) {
                    const f32x4 gt = acc[ai][0][m][n], up = acc[ai][1][m][n];
#pragma unroll
                    for (int j = 0; j < 4; ++j) {
                        const float gg = fminf(gt[j], 7.0f), uu = fminf(fmaxf(up[j], -7.0f), 7.0f);
                        const float sig = __builtin_amdgcn_rcpf(1.0f + __builtin_amdgcn_exp2f(-1.702f * 1.4426950408889634f * gg));
                        o[4 * n + j] = (uu * 8.0f + 8.0f) * gg * sig;
                    }
                }
                u32x2 w; w.x = pk4_fp8(o[0], o[1], o[2], o[3]); w.y = pk4_fp8(o[4], o[5], o[6], o[7]);
                const unsigned dofs = (unsigned)((row0 + ai * 128 + m * 16) * 1024 + col0);
                if (un.pm < 32) asm volatile("global_store_dwordx2 %0, %1, %2 sc1" :: "v"(dofs), "v"(w), "s"(act) : "memory");
                else *(u32x2*)(act + dofs) = w;
            }
        if (un.pm < 32) {
            asm volatile("s_waitcnt vmcnt(0)" ::: "memory");
            if ((threadIdx.x & 63) == 0) __hip_atomic_fetch_add(rdy + un.pm, 1u, __ATOMIC_RELAXED, __HIP_MEMORY_SCOPE_AGENT);
        }
    }
};
struct EpiDown {
    static constexpr bool PERM = true, BIAS_INIT = false;
    unsigned char* y; const float* bias;
    __device__ __forceinline__ f32x4 bias4(const pg8::Unit& un, int bj, int n, int wc, int fq) const { return *(const f32x4*)(bias + (size_t)un.e * 1024 + un.pn * 256 + bj * 128 + wc * 32 + 8 * fq + 4 * n); }
    __device__ __forceinline__ void operator()(f32x4 (&acc)[2][2][4][2], const pg8::Unit& un, int wr, int wc, int fr, int fq) const {
        const int row0 = un.pm * 256 + wr * 64 + fr, col0 = un.pn * 256 + wc * 32 + 8 * fq;
        const float* bp = bias + (size_t)un.e * 1024 + col0;
#pragma unroll
        for (int bj = 0; bj < 2; ++bj) {
            const f32x4 b0 = *(const f32x4*)(bp + bj * 128) * 64.0f, b1 = *(const f32x4*)(bp + bj * 128 + 4) * 64.0f;
#pragma unroll
            for (int ai = 0; ai < 2; ++ai)
#pragma unroll
                for (int m = 0; m < 4; ++m) {
                    const f32x4 v0 = acc[ai][bj][m][0] * 64.0f + b0, v1 = acc[ai][bj][m][1] * 64.0f + b1;
#define CL8(x) __builtin_amdgcn_fmed3f((x), -448.f, 448.f)
                    u32x2 w; w.x = pk4_fp8(CL8(v0[0]), CL8(v0[1]), CL8(v0[2]), CL8(v0[3])); w.y = pk4_fp8(CL8(v1[0]), CL8(v1[1]), CL8(v1[2]), CL8(v1[3]));
#undef CL8
                    *(u32x2*)(y + (size_t)(row0 + ai * 128 + m * 16) * 1024 + col0 + bj * 128) = w;
                }
        }
    }
};

struct Args { const void* in[18]; float* out; unsigned char* ws; int ph_lo, ph_hi; };
struct Frame {
    LAS unsigned char* lds; int tid, lane, wave, G, bid;
    const float *x, *ln_in_g, *ln_in_b, *w_in, *w_pool, *pool_scale, *w_out, *ln1_g, *ln1_b, *w_router, *b_router, *w_gu, *b_gu, *w_dn, *b_dn, *ln2_g, *ln2_b;
    const int* positions; float* out; unsigned char* ws; unsigned* ctl;
};

typedef const Args __attribute__((address_space(4))) * KArgP;
__device__ __forceinline__ void frame_refresh(Frame& F) {
    KArgP ap = (KArgP)__builtin_amdgcn_kernarg_segment_ptr(); asm volatile("" : "+s"(ap));
    int t_ = threadIdx.x; asm volatile("" : "+v"(t_)); F.tid = t_; F.lane = t_ & 63;
    F.x = (const float*)ap->in[0]; F.positions = (const int*)ap->in[1]; F.ln_in_g = (const float*)ap->in[2]; F.ln_in_b = (const float*)ap->in[3];
    F.w_in = (const float*)ap->in[4]; F.w_pool = (const float*)ap->in[5]; F.pool_scale = (const float*)ap->in[6]; F.w_out = (const float*)ap->in[7];
    F.ln1_g = (const float*)ap->in[8]; F.ln1_b = (const float*)ap->in[9]; F.w_router = (const float*)ap->in[10]; F.b_router = (const float*)ap->in[11];
    F.w_gu = (const float*)ap->in[12]; F.b_gu = (const float*)ap->in[13]; F.w_dn = (const float*)ap->in[14]; F.b_dn = (const float*)ap->in[15];
    F.ln2_g = (const float*)ap->in[16]; F.ln2_b = (const float*)ap->in[17];
    F.out = ap->out; F.ws = ap->ws; F.ctl = (unsigned*)(ap->ws + WS_CTL);
}
struct TrItem { const float* src; unsigned char* dst; int ldw, ldt, fp8; };
__device__ __forceinline__ TrItem mk_item(const float* W, unsigned char* WT, int ldw, int k0, int n0, int ldt, int drow0, int fp8) {
    TrItem t; t.src = W + (size_t)k0 * ldw + n0; t.dst = WT + ((size_t)drow0 * ldt + k0) * (fp8 ? 1 : 2); t.ldw = ldw; t.ldt = ldt; t.fp8 = fp8; return t;
}
__device__ __forceinline__ void tr_load(const TrItem& t, float (&tmp)[32], int lane) {
    if (t.fp8) {
        const float* p = t.src + (size_t)(lane >> 3) * t.ldw + (lane & 7) * 4;
#pragma unroll
        for (int j = 0; j < 8; ++j) { const f32x4 v = __builtin_nontemporal_load((const f32x4*)(p + (size_t)(8 * j) * t.ldw)); tmp[4 * j] = v.x; tmp[4 * j + 1] = v.y; tmp[4 * j + 2] = v.z; tmp[4 * j + 3] = v.w; }
    } else {
        const float* p = t.src + (size_t)(lane >> 5) * t.ldw + (lane & 31);
#pragma unroll
        for (int i = 0; i < 32; ++i) tmp[i] = __builtin_nontemporal_load(p + (size_t)(2 * i) * t.ldw);
    }
}
__device__ __forceinline__ void tr_store(const TrItem& t, const float (&tmp)[32], LAS float* scr, int lane) {
    if (t.fp8) {
#pragma unroll
        for (int j = 0; j < 8; ++j) *(LAS f32x4*)(scr + (8 * j + (lane >> 3)) * 32 + (lane & 7) * 4) = (f32x4){tmp[4 * j], tmp[4 * j + 1], tmp[4 * j + 2], tmp[4 * j + 3]};
        LDS_WAIT();
        const int n = lane >> 1, kb = 32 * (lane & 1); const LAS float* sp = scr + kb * 32 + n;
        unsigned o[8];
#pragma unroll
        for (int q = 0; q < 8; ++q) { float v[4];
#pragma unroll
            for (int j = 0; j < 4; ++j) v[j] = __builtin_amdgcn_fmed3f(sp[(4 * q + j) * 32] * 64.0f, -448.f, 448.f);
            o[q] = pk4_fp8(v[0], v[1], v[2], v[3]); }
        unsigned char* dp = t.dst + (size_t)n * 1024 + kb;
        *(u32x4*)dp = (u32x4){o[0], o[1], o[2], o[3]}; *(u32x4*)(dp + 16) = (u32x4){o[4], o[5], o[6], o[7]};
    } else {
#pragma unroll
        for (int i = 0; i < 32; ++i) { const int kk = 2 * i + (lane >> 5); scr[kk * 33 + (lane & 31)] = tmp[i]; }
        LDS_WAIT();
        const int c = lane & 7;
#pragma unroll
        for (int j = 0; j < 4; ++j) { const int n = (lane >> 3) + 8 * j; const LAS float* sp = scr + (8 * c) * 33 + n;
            u32x4 o; o.x = cvt_pk_bf16(sp[0 * 33], sp[1 * 33]); o.y = cvt_pk_bf16(sp[2 * 33], sp[3 * 33]); o.z = cvt_pk_bf16(sp[4 * 33], sp[5 * 33]); o.w = cvt_pk_bf16(sp[6 * 33], sp[7 * 33]);
            *(u32x4*)(t.dst + ((size_t)n * t.ldt + 8 * c) * 2) = o; }
    }
    LDS_WAIT();
}
__device__ __forceinline__ TrItem moe_item(Frame& F, int r) {
    constexpr int I_GU = NE * 16 * 64;
    if (r < I_GU) { const int e = r / 1024, rr = r % 1024, kb = rr / 64, nb = rr % 64, n0 = 32 * nb, bj = n0 / 1024, rem = n0 % 1024, pn = rem / 128, j0 = rem % 128;
        return mk_item(F.w_gu + (size_t)e * 1024 * 2048, F.ws + WS_BTGU + (size_t)e * 2048 * 1024, 2048, 64 * kb, n0, 1024, pn * 256 + bj * 128 + j0, 1); }
    r -= I_GU; const int e = r / 512, rr = r % 512, kb = rr / 32, nb = rr % 32;
    return mk_item(F.w_dn + (size_t)e * 1024 * 1024, F.ws + WS_BTDN + (size_t)e * 1024 * 1024, 1024, 64 * kb, 32 * nb, 1024, 32 * nb, 1);
}
__device__ __forceinline__ void convert_range(Frame& F, int first, int n, int widx, int nw) {
    LAS float* scr = (LAS float*)(F.lds + F.wave * 16384);
    int base = 2 * widx; if (base >= n) return;
    float va[32], vb[32], vc[32], vd[32];
    TrItem ta = moe_item(F, first + base), tb = moe_item(F, first + base + 1);
    tr_load(ta, va, F.lane); tr_load(tb, vb, F.lane);
    for (;;) {
        const int nb = base + 2 * nw; const bool more = nb < n;
        const TrItem tc = moe_item(F, first + (more ? nb : base)), td = moe_item(F, first + (more ? nb : base) + 1);
        if (more) { tr_load(tc, vc, F.lane); tr_load(td, vd, F.lane); }
        tr_store(ta, va, scr, F.lane); tr_store(tb, vb, scr, F.lane);
        if (!more) break;
        const int nb2 = nb + 2 * nw; const bool more2 = nb2 < n;
        ta = moe_item(F, first + (more2 ? nb2 : nb)); tb = moe_item(F, first + (more2 ? nb2 : nb) + 1);
        if (more2) { tr_load(ta, va, F.lane); tr_load(tb, vb, F.lane); }
        tr_store(tc, vc, scr, F.lane); tr_store(td, vd, scr, F.lane);
        if (!more2) break;
        base = nb2;
    }
}
__device__ __forceinline__ void cvq_pull(Frame& F, unsigned* head, int first, int npairs) {
    LAS float* scr = (LAS float*)(F.lds + F.wave * 16384);
    for (;;) {
        unsigned c = 0; if (F.lane == 0) c = __hip_atomic_fetch_add(head, 1u, __ATOMIC_RELAXED, __HIP_MEMORY_SCOPE_AGENT);
        c = (unsigned)__builtin_amdgcn_readfirstlane((int)c);
        if (c >= (unsigned)npairs) break;
        const int r = 2 * (first + (int)c);
        const TrItem ta = moe_item(F, r), tb = moe_item(F, r + 1);
        float va[32], vb[32];
        tr_load(ta, va, F.lane); tr_load(tb, vb, F.lane);
        tr_store(ta, va, scr, F.lane); tr_store(tb, vb, scr, F.lane);
    }
}
__constant__ double ROPE_QK_FREQ[16] = {1.0, 0.44036660267178046, 0.19392274474868576, 0.08539710028576561, 0.03760603093086393, 0.016560440080994446, 0.007292664737217109, 0.003211445994752591,
    0.001414213562373095, 0.000622772421914596, 0.0002742481756762073, 0.00012076973741146504, 5.318295896944988e-05, 2.341999896140934e-05, 1.031338537721246e-05, 4.5416704806078695e-06};
__constant__ double ROPE_IX_FREQ[8] = {1.0, 0.19392274474868576, 0.03760603093086393, 0.007292664737217109, 0.001414213562373095, 0.0002742481756762073, 5.318295896944988e-05, 1.031338537721246e-05};

__device__ __forceinline__ void p0_prologue(Frame& F) {
    LAS float* scr = (LAS float*)(F.lds + F.wave * 16384);
    const int gw = F.bid * 8 + F.wave, NGW = F.G * 8;
    const int gt = F.bid * NTHREADS + F.tid, NGT = F.G * NTHREADS;
    bf16_t* BtIn = (bf16_t*)(F.ws + WS_BTIN); bf16_t* BtOut = (bf16_t*)(F.ws + WS_BTOUT);
    bf16_t* WpT = (bf16_t*)(F.ws + WS_WPT);
    constexpr int I_IN = 16 * 66, I_OUT = 16 * 32, I_POOL = 8, I_MOE = NE * 16 * 64 + NE * 16 * 32;
    constexpr int NSMALL = I_IN + I_OUT + I_POOL, NITEMS = NSMALL + (I_MOE - CV_HIDDEN);
    auto decode = [&](int it) -> TrItem {
        int r = it;
        if (r < I_IN) { const int kb = r / 66, nb = r % 66;
            if (nb >= 8 && nb < 48) return mk_item(F.w_in, F.ws + WS_BTIN8, INW, 64 * kb, 32 * nb, 1024, 32 * nb, 1);
            return mk_item(F.w_in, (unsigned char*)BtIn, INW, 64 * kb, 32 * nb, 1024, 32 * nb, 0); } r -= I_IN;
        if (r < I_OUT) { const int kb = r / 32, nb = r % 32; return mk_item(F.w_out, (unsigned char*)BtOut, 1024, 64 * kb, 32 * nb, 1024, 32 * nb, 0); } r -= I_OUT;
        if (r < I_POOL) { const int g = r / 2, nb = r % 2; return mk_item(F.w_pool + g * 4096, (unsigned char*)(WpT + g * 4096), 64, 0, 32 * nb, 64, 32 * nb, 0); } r -= I_POOL;
        return moe_item(F, CV_HIDDEN + r);
    };
    for (int it = gw; it < NITEMS; it += 2 * NGW) {
        const bool two = (it + NGW < NITEMS);
        const TrItem ta = decode(it), tb = decode(two ? it + NGW : it);
        float va[32], vb[32];
        tr_load(ta, va, F.lane); if (two) tr_load(tb, vb, F.lane);
        tr_store(ta, va, scr, F.lane); if (two) tr_store(tb, vb, scr, F.lane);
    }
    for (int i = gt; i < 192 * 1024; i += NGT) { const int n = 2112 + i / 1024, k = i % 1024; const float v = (n < INW) ? F.w_in[(size_t)k * INW + n] : 0.f;
        BtIn[(size_t)n * 1024 + k] = (bf16_t)(cvt_pk_bf16(v, 0.f) & 0xffffu); }
    { float* wrA = (float*)(F.ws + WS_WRA);
      for (int i = gt; i < 32768; i += NGT) { const int ii = i & 3, e = (i >> 2) & 31, kh = (i >> 7) & 1, c = i >> 8; wrA[i] = F.w_router[(8 * c + 4 * kh + ii) * 32 + e]; } }
    { float* rq = (float*)(F.ws + WS_ROPEQK); float* ri = (float*)(F.ws + WS_ROPEIX);
      for (int i = gt; i < T * 24; i += NGT) { const int tok = i / 24, j = i % 24; const double pos = (double)F.positions[tok];
          const double inv = (j < 16) ? ROPE_QK_FREQ[j] : ROPE_IX_FREQ[j - 16];
          double rev = pos * inv * 0.15915494309189535; rev -= __builtin_floor(rev);
          const float c = __builtin_amdgcn_cosf((float)rev), s = __builtin_amdgcn_sinf((float)rev);
          if (j < 16) { rq[(size_t)tok * 32 + j] = c; rq[(size_t)tok * 32 + 16 + j] = s; } else { ri[(size_t)tok * 16 + (j - 16)] = c; ri[(size_t)tok * 16 + 8 + (j - 16)] = s; } } }
    if (F.bid == 0 && F.tid < 64) { F.ctl[CW_CNT + F.tid] = 0u; if (F.tid == 0) F.ctl[CW_ATTQ] = 0u; }
    { bf16_t* hA = (bf16_t*)(F.ws + WS_HA); float* stats = (float*)(F.ws + WS_STATS);
      f32x4 gv[4], bv[4];
#pragma unroll
      for (int j = 0; j < 4; ++j) { gv[j] = ((const f32x4*)F.ln_in_g)[F.lane + 64 * j]; bv[j] = ((const f32x4*)F.ln_in_b)[F.lane + 64 * j]; }
      f32x4 nx[4];
      if (gw < T) { const f32x4* xr = (const f32x4*)(F.x + (size_t)gw * 1024) + F.lane;
#pragma unroll
          for (int j = 0; j < 4; ++j) nx[j] = __builtin_nontemporal_load(xr + 64 * j); }
      for (int m = gw; m < T; m += NGW) {
          f32x4 v[4]; float s = 0.f;
#pragma unroll
          for (int j = 0; j < 4; ++j) { v[j] = nx[j]; s += (v[j].x + v[j].y) + (v[j].z + v[j].w); }
          if (m + NGW < T) { const f32x4* xr = (const f32x4*)(F.x + (size_t)(m + NGW) * 1024) + F.lane;
#pragma unroll
              for (int j = 0; j < 4; ++j) nx[j] = __builtin_nontemporal_load(xr + 64 * j); }
          const float mean = wave_sum(s) * (1.f / 1024.f); float s2 = 0.f;
#pragma unroll
          for (int j = 0; j < 4; ++j) { v[j] = v[j] - mean; s2 += (v[j].x * v[j].x + v[j].y * v[j].y) + (v[j].z * v[j].z + v[j].w * v[j].w); }
          const float rstd = 1.f / sqrtf(wave_sum(s2) * (1.f / 1024.f) + LN_EPS);
          u32x2* o8 = (u32x2*)(hA + (size_t)m * 1024) + F.lane; unsigned* q8 = (unsigned*)(F.ws + WS_HA8 + (size_t)m * 1024) + F.lane;
#pragma unroll
          for (int j = 0; j < 4; ++j) { const f32x4 h = v[j] * rstd * gv[j] + bv[j]; u32x2 w; w.x = cvt_pk_bf16(h.x, h.y); w.y = cvt_pk_bf16(h.z, h.w); o8[64 * j] = w; q8[64 * j] = pk4_fp8(h.x, h.y, h.z, h.w); }
          if (F.lane == 0) { stats[(size_t)m * 2] = mean; stats[(size_t)m * 2 + 1] = rstd; }
      } }
}

__device__ __forceinline__ void p2_pool(Frame& F) {
    const bf16_t* U = (const bf16_t*)(F.ws + WS_U); const bf16_t* WpT = (const bf16_t*)(F.ws + WS_WPT); bf16_t* cat = (bf16_t*)(F.ws + WS_CAT);
    LAS bf16_t* dl = (LAS bf16_t*)F.lds;
    LAS bf16_t* ul = (LAS bf16_t*)(F.lds + 33792);
    for (int tile = F.bid; tile < T / 64; tile += F.G) {
        const int t0 = tile * 64, pos0 = t0 % SEQ;
        __syncthreads();
        for (int i = F.tid; i < 79 * 32; i += NTHREADS) { const int r = i >> 5, c8 = i & 31; u32x4 v = {0u, 0u, 0u, 0u};
            if (pos0 + r - 15 >= 0) v = *(const u32x4*)(U + (size_t)(t0 + r - 15) * 256 + c8 * 8);
            *(LAS u32x4*)(ul + r * 256 + c8 * 8) = v; }
        __syncthreads();
        { const int c = F.tid & 255, half = F.tid >> 8, w = 2 << (c >> 6);
          const int ts = half * 32; float sum = 0.f;
          for (int d = 1; d < w; ++d) sum += __uint_as_float((unsigned)ul[(15 + ts - d) * 256 + c] << 16);
#pragma unroll 4
          for (int tt = 0; tt < 32; ++tt) { const int tl = ts + tt, p = pos0 + tl; const float cur = __uint_as_float((unsigned)ul[(15 + tl) * 256 + c] << 16);
              sum += cur; const int cnt = (p + 1 < w) ? (p + 1) : w;
              const float diff = sum / (float)cnt - cur;
              dl[tl * 264 + c] = (bf16_t)(cvt_pk_bf16(diff, 0.f) & 0xffffu);
              sum -= __uint_as_float((unsigned)ul[(15 + tl - (w - 1)) * 256 + c] << 16); } }
        __syncthreads();
        { const int g = F.wave & 3, th = F.wave >> 2, r32 = F.lane & 31, hi = F.lane >> 5;
          f32x16 c0 = {}, c1 = {};
#pragma unroll
          for (int s = 0; s < 4; ++s) {
              const bf16x8 a = *(const LAS bf16x8*)(dl + (th * 32 + r32) * 264 + g * 64 + 16 * s + 8 * hi);
              const bf16x8 b0 = *(const bf16x8*)(WpT + (size_t)g * 4096 + (size_t)r32 * 64 + 16 * s + 8 * hi);
              const bf16x8 b1 = *(const bf16x8*)(WpT + (size_t)g * 4096 + (size_t)(32 + r32) * 64 + 16 * s + 8 * hi);
              c0 = __builtin_amdgcn_mfma_f32_32x32x16_bf16(a, b0, c0, 0, 0, 0);
              c1 = __builtin_amdgcn_mfma_f32_32x32x16_bf16(a, b1, c1, 0, 0, 0); }
          const float ps0 = F.pool_scale[g * 64 + r32], ps1 = F.pool_scale[g * 64 + 32 + r32];
#pragma unroll
          for (int r = 0; r < 16; ++r) { const int tok = t0 + th * 32 + crow(r, hi);
              cat[(size_t)tok * 1024 + g * 64 + r32] = (bf16_t)(cvt_pk_bf16(c0[r] * ps0, 0.f) & 0xffffu);
              cat[(size_t)tok * 1024 + g * 64 + 32 + r32] = (bf16_t)(cvt_pk_bf16(c1[r] * ps1, 0.f) & 0xffffu); } }
    }
    __syncthreads();
}

constexpr int IDX_RING_OFF = 0, IDX_SLOT = 32768;
constexpr int IDX_HIST_OFF = 3 * IDX_SLOT;
constexpr int IDX_RES_OFF = IDX_HIST_OFF + 24576;
__device__ __forceinline__ void hist_find16(const LAS unsigned* hist, int li, unsigned need, unsigned& bsel, unsigned& above) {
    const u32x4 h0 = *(const LAS u32x4*)(hist + 4 * li);
    const unsigned c[8] = {h0.x & 0xffffu, h0.x >> 16, h0.y & 0xffffu, h0.y >> 16, h0.z & 0xffffu, h0.z >> 16, h0.w & 0xffffu, h0.w >> 16};
    unsigned s = 0;
#pragma unroll
    for (int k = 0; k < 8; ++k) s += c[k];
    unsigned S = s;
#pragma unroll
    for (int d = 1; d < 32; d <<= 1) { const unsigned o = __shfl_down(S, d, 32); if (li + d < 32) S += o; }
    const unsigned excl = S - s;
    unsigned b = 0xffffffffu, ab = 0;
    if (excl < need && need <= S) { unsigned cum = excl; bool found = false;
#pragma unroll
        for (int k = 7; k >= 0; --k) { if (!found && cum + c[k] >= need) { b = 8 * li + k; ab = cum; found = true; } if (!found) cum += c[k]; } }
    const unsigned long long bal = __ballot(b != 0xffffffffu);
    const unsigned halfmask = (unsigned)((threadIdx.x & 32) ? (bal >> 32) : (bal & 0xffffffffull));
    const int src = (halfmask ? (__ffs(halfmask) - 1) : 0) + (threadIdx.x & 32);
    bsel = __shfl(b, src, 64); above = __shfl(ab, src, 64);
    if (!halfmask) { bsel = 0; above = 0; }
}
template <int J> __device__ __forceinline__ void wlane(unsigned& m, unsigned v) { asm volatile("v_writelane_b32 %0, %1, %2" : "+v"(m) : "s"(v), "n"(J)); }
template <int J> __device__ __forceinline__ void mask_emit_step(const unsigned (&k0)[32], const unsigned (&k1)[32], unsigned T0, unsigned T1, int kh, int ntiles, unsigned& m0, unsigned& m1, unsigned& m2, unsigned& m3) {
    if (2 * J + kh < ntiles) {
        const unsigned long long ba = __ballot(k0[J] >= T0), bc = __ballot(k1[J] >= T1);
        wlane<J>(m0, (unsigned)ba); wlane<J>(m2, (unsigned)(ba >> 32)); wlane<J>(m1, (unsigned)bc); wlane<J>(m3, (unsigned)(bc >> 32));
    }
}
template <int... Js> __device__ __forceinline__ void mask_emit(std::integer_sequence<int, Js...>, const unsigned (&k0)[32], const unsigned (&k1)[32], unsigned T0, unsigned T1, int kh, int ntiles, unsigned& m0, unsigned& m1, unsigned& m2, unsigned& m3) {
    (mask_emit_step<Js>(k0, k1, T0, T1, kh, ntiles, m0, m1, m2, m3), ...);
}
__device__ __forceinline__ void p2_indexer_unit(Frame& F, int b, int qb) {
    const bf16_t* IQ = (const bf16_t*)(F.ws + WS_IQ); const bf16_t* IK = (const bf16_t*)(F.ws + WS_IK); const float* IW = (const float*)(F.ws + WS_IW);
    unsigned* MASK = (unsigned*)(F.ws + WS_MASK);
    const int qg = F.wave & 3, kh = F.wave >> 2;
    LAS unsigned* hist = (LAS unsigned*)(F.lds + IDX_HIST_OFF) + qg * 4 * 384;
    LAS float* mm = (LAS float*)(F.lds + IDX_RES_OFF);
    const int lane = F.lane, r32 = lane & 31, hi = lane >> 5;
    const int p0 = qb * 16 + qg * 4;
    const int tq0 = b * SEQ + p0;
    const int ntiles = (qb >> 1) + 1;
    const int nch = (ntiles + 7) >> 3;
    const char* ikb = (const char*)(IK + (size_t)b * SEQ * 64);
    unsigned dsrc[4];
#pragma unroll
    for (int i = 0; i < 4; ++i) { const int row = F.wave * 32 + i * 8 + (lane >> 3), pos = lane & 7; dsrc[i] = (unsigned)(row * 128 + ((pos ^ ((row >> 1) & 7)) << 4)); }
#define IDX_ISSUE(ch) do { _Pragma("unroll") for (int i_ = 0; i_ < 4; ++i_) \
        __builtin_amdgcn_global_load_lds((const unsigned*)(ikb + (size_t)(ch) * 32768 + dsrc[i_]), (LAS unsigned*)(F.lds + IDX_RING_OFF + ((ch) % 3) * IDX_SLOT + F.wave * 4096 + i_ * 1024), 16, 0, 0); } while (0)
    bf16x8 af[4];
    { const int i = r32, qi = 2 * ((i >> 2) & 1) + (i >> 4), hd = (i & 3) + 4 * ((i >> 3) & 1);
#pragma unroll
      for (int s = 0; s < 4; ++s) af[s] = *(const bf16x8*)(IQ + (size_t)(tq0 + qi) * 512 + hd * 64 + 16 * s + 8 * hi); }
    float wA[8], wB[8];
#pragma unroll
    for (int r = 0; r < 8; ++r) { const int hd = (r & 3) + 4 * (r >> 2); wA[r] = IW[(size_t)(tq0 + 2 * hi) * 8 + hd] * W_SCALE; wB[r] = IW[(size_t)(tq0 + 2 * hi + 1) * 8 + hd] * W_SCALE; }
    __builtin_amdgcn_s_barrier();
    asm volatile("" ::: "memory");
    IDX_ISSUE(0); if (nch > 1) IDX_ISSUE(1);
#pragma unroll
    for (int i = 0; i < 3; ++i) *(LAS u32x4*)(F.lds + IDX_HIST_OFF + (i * 512 + F.tid) * 16) = (u32x4){0u, 0u, 0u, 0u};
    const int limA = p0 + 2 * hi - 32 * (ntiles - 1), limB = limA + 1;
    float sc0[32], sc1[32];
#pragma unroll
    for (int j = 0; j < 32; ++j) { sc0[j] = -INFINITY; sc1[j] = -INFINITY; }
    float mx0 = -INFINITY, mn0 = INFINITY, mx1 = -INFINITY, mn1 = INFINITY;
    const int frag_off = r32 * 128;
    const int fx = (r32 >> 1) & 7;
#pragma unroll
    for (int ch = 0; ch < 8; ++ch) {
        if (ch < nch) {
            if (ch + 1 < nch) asm volatile("s_waitcnt vmcnt(4)" ::: "memory"); else asm volatile("s_waitcnt vmcnt(0)" ::: "memory");
            __builtin_amdgcn_s_barrier();
            asm volatile("" ::: "memory");
            if (ch + 2 < nch) IDX_ISSUE(ch + 2);
            const LAS char* slot = (const LAS char*)(F.lds + IDX_RING_OFF + (ch % 3) * IDX_SLOT);
#pragma unroll
            for (int j4 = 0; j4 < 4; ++j4) {
                const int jl = 2 * j4 + kh, j = ch * 8 + jl, idx = ch * 4 + j4;
                if (j < ntiles) {
                    f32x16 acc = {};
#pragma unroll
                    for (int s = 0; s < 4; ++s) { const bf16x8 bfr = *(const LAS bf16x8*)(slot + jl * 4096 + frag_off + (((2 * s + hi) ^ fx) << 4));
                        acc = __builtin_amdgcn_mfma_f32_32x32x16_bf16(af[s], bfr, acc, 0, 0, 0); }
                    float s0 = 0.f, s1 = 0.f;
#pragma unroll
                    for (int r = 0; r < 8; ++r) {
                        const int ia = __float_as_int(acc[r]), ib = __float_as_int(acc[8 + r]);
                        s0 = fmaf(wA[r], __int_as_float(ia > 0 ? ia : 0), s0); s1 = fmaf(wB[r], __int_as_float(ib > 0 ? ib : 0), s1); }
                    if (j == ntiles - 1) {
                        mn0 = fminf(mn0, (r32 > limA) ? INFINITY : s0); mn1 = fminf(mn1, (r32 > limB) ? INFINITY : s1);
                        s0 = (r32 > limA) ? -INFINITY : s0; s1 = (r32 > limB) ? -INFINITY : s1;
                    } else { mn0 = fminf(mn0, s0); mn1 = fminf(mn1, s1); }
                    mx0 = fmaxf(mx0, s0); mx1 = fmaxf(mx1, s1);
                    sc0[idx] = s0; sc1[idx] = s1;
                }
            }
        }
    }
#undef IDX_ISSUE
#pragma unroll
    for (int d = 1; d < 32; d <<= 1) { mx0 = fmaxf(mx0, __shfl_xor(mx0, d)); mx1 = fmaxf(mx1, __shfl_xor(mx1, d)); mn0 = fminf(mn0, __shfl_xor(mn0, d)); mn1 = fminf(mn1, __shfl_xor(mn1, d)); }
    if (r32 == 0) { LAS float* w = mm + ((qg * 2 + kh) * 4 + 2 * hi) * 2; w[0] = mx0; w[1] = mn0; w[2] = mx1; w[3] = mn1; }
    __syncthreads();
    { const LAS float* w = mm + ((qg * 2 + (kh ^ 1)) * 4 + 2 * hi) * 2; mx0 = fmaxf(mx0, w[0]); mn0 = fminf(mn0, w[1]); mx1 = fmaxf(mx1, w[2]); mn1 = fminf(mn1, w[3]); }
    const float scl0 = (mx0 > mn0) ? (16777212.0f / (mx0 - mn0)) : 0.f, scl1 = (mx1 > mn1) ? (16777212.0f / (mx1 - mn1)) : 0.f;
    const float off0 = 1.5f - mn0 * scl0, off1 = 1.5f - mn1 * scl1;
    unsigned k0[32], k1[32];
#pragma unroll
    for (int j = 0; j < 32; ++j) { k0[j] = (unsigned)fmaf(sc0[j], scl0, off0); k1[j] = (unsigned)fmaf(sc1[j], scl1, off1); }
    unsigned T0 = 1u, T1 = 1u;
#ifndef NO_SELECT
    if (qb >= 16) {
        LAS unsigned* hA = hist + (2 * hi) * 384; LAS unsigned* hB = hist + (2 * hi + 1) * 384;
        unsigned pre0 = 0, pre1 = 0, need0 = 256, need1 = 256;
#pragma unroll
        for (int lvl = 0; lvl < 3; ++lvl) {
            const int sh = 16 - 8 * lvl;
#pragma unroll
            for (int j = 0; j < 32; ++j) {
                if (2 * j + kh < ntiles) {
                    const unsigned ka = k0[j], kc = k1[j];
                    if (lvl == 0 || (ka >> (sh + 8)) == pre0) { const unsigned bn = (ka >> sh) & 255u; (void)__hip_atomic_fetch_add(hA + lvl * 128 + (bn >> 1), 1u << ((bn & 1u) << 4), __ATOMIC_RELAXED, __HIP_MEMORY_SCOPE_WORKGROUP); }
                    if (lvl == 0 || (kc >> (sh + 8)) == pre1) { const unsigned bn = (kc >> sh) & 255u; (void)__hip_atomic_fetch_add(hB + lvl * 128 + (bn >> 1), 1u << ((bn & 1u) << 4), __ATOMIC_RELAXED, __HIP_MEMORY_SCOPE_WORKGROUP); }
                }
            }
            __syncthreads();
            unsigned b0, a0, b1, a1;
            hist_find16(hA + lvl * 128, r32, need0, b0, a0);
            hist_find16(hB + lvl * 128, r32, need1, b1, a1);
            pre0 = (pre0 << 8) | b0; need0 -= a0;
            pre1 = (pre1 << 8) | b1; need1 -= a1;
        }
        T0 = pre0 > 1u ? pre0 : 1u; T1 = pre1 > 1u ? pre1 : 1u;
    }
#endif
    unsigned m0 = 0, m1 = 0, m2 = 0, m3 = 0;
    mask_emit(std::make_integer_sequence<int, 32>{}, k0, k1, T0, T1, kh, ntiles, m0, m1, m2, m3);
    if (lane < 32) { const int w = 2 * lane + kh;
        MASK[(size_t)(tq0 + 0) * 64 + w] = m0; MASK[(size_t)(tq0 + 1) * 64 + w] = m1; MASK[(size_t)(tq0 + 2) * 64 + w] = m2; MASK[(size_t)(tq0 + 3) * 64 + w] = m3; }
}
__device__ __forceinline__ void p2_indexer(Frame& F) {
    for (int pi = F.bid; pi < 512; pi += F.G) { const int b = pi >> 6, x = pi & 63;
        p2_indexer_unit(F, b, 127 - x);
        p2_indexer_unit(F, b, x); }
    __syncthreads();
}

namespace att {
constexpr int D = 128, NW = 8, QBLK = 32, KVBLK = 64;
constexpr float SCALE = 0.088388347648318440f;
constexpr float THR = 8.f;
constexpr int LDQ = 768, LDK = 256, LDO = 1024;
constexpr size_t SHM_V = KVBLK * D * 2, SHM_K = KVBLK * D * 2, SHM_ATTN = 2 * SHM_V + 2 * SHM_K + NW * 64 * 4;
#define KSWZ(row, colB) ((row) * 256 + ((colB) ^ (((row) & 7) << 4)))
#define SBAR() __builtin_amdgcn_sched_barrier(0)
__device__ __forceinline__ void apply_mask(f32x16& p0, f32x16& p1, u32x2 mk, int hi) {
    const int ml = (int)(mk.x >> (4 * hi)), mh = (int)(mk.y >> (4 * hi));
#pragma unroll
    for (int r = 0; r < 16; ++r) { const int cr = (r & 3) + 8 * (r >> 2);
        const unsigned t0 = (unsigned)__builtin_amdgcn_sbfe(ml, cr, 1), t1 = (unsigned)__builtin_amdgcn_sbfe(mh, cr, 1);
        p0[r] = __uint_as_float((__float_as_uint(p0[r]) & t0) | (0xff800000u & ~t0));
        p1[r] = __uint_as_float((__float_as_uint(p1[r]) & t1) | (0xff800000u & ~t1)); }
}
__device__ __forceinline__ void partialSM(f32x16& p0, f32x16& p1, float& m_reg, float& mn, float& alpha) {
    constexpr float C = SCALE * 1.4426950408889634f;
    float pmax = p0[0];
#pragma unroll
    for (int r = 1; r < 16; ++r) pmax = fmaxf(pmax, p0[r]);
#pragma unroll
    for (int r = 0; r < 16; ++r) pmax = fmaxf(pmax, p1[r]);
    { auto rr = __builtin_amdgcn_permlane32_swap(__float_as_uint(pmax), __float_as_uint(pmax), false, false);
      pmax = fmaxf(__uint_as_float(rr[0]), __uint_as_float(rr[1])); }
    if (__builtin_expect(__all(pmax - m_reg <= THR / SCALE), 1)) { mn = m_reg; alpha = 1.f; }
    else { mn = fmaxf(m_reg, pmax); alpha = __builtin_amdgcn_exp2f((m_reg - mn) * C); m_reg = mn; }
    const float mnC = -mn * C;
#pragma unroll
    for (int r = 0; r < 16; ++r) p0[r] = fmaf(p0[r], C, mnC);
#pragma unroll
    for (int r = 0; r < 16; ++r) p1[r] = fmaf(p1[r], C, mnC);
#pragma unroll
    for (int r = 0; r < 16; ++r) p0[r] = __builtin_amdgcn_exp2f(p0[r]);
}
__device__ __forceinline__ void finishSM(f32x16& p0, f32x16& p1, float alpha, float& l_reg, bf16x8& pa0, bf16x8& pa1, bf16x8& pa2, bf16x8& pa3) {
#pragma unroll
    for (int r = 0; r < 16; ++r) p1[r] = __builtin_amdgcn_exp2f(p1[r]);
    float ps = 0;
#pragma unroll
    for (int r = 0; r < 16; ++r) ps += p0[r];
#pragma unroll
    for (int r = 0; r < 16; ++r) ps += p1[r];
    { auto rr = __builtin_amdgcn_permlane32_swap(__float_as_uint(ps), __float_as_uint(ps), false, false);
      ps = __uint_as_float(rr[0]) + __uint_as_float(rr[1]); }
    l_reg = l_reg * alpha + ps;
#define PK4(P, BASE, OUT) do { unsigned a0 = cvt_pk_bf16(P[BASE + 0], P[BASE + 1]), a1 = cvt_pk_bf16(P[BASE + 2], P[BASE + 3]);   \
    unsigned b0 = cvt_pk_bf16(P[BASE + 4], P[BASE + 5]), b1 = cvt_pk_bf16(P[BASE + 6], P[BASE + 7]);                              \
    auto r0 = __builtin_amdgcn_permlane32_swap(a0, b0, false, false); auto r1 = __builtin_amdgcn_permlane32_swap(a1, b1, false, false); \
    u32x4 w = {r0[0], r1[0], r0[1], r1[1]}; OUT = *reinterpret_cast<bf16x8*>(&w); } while (0)
    PK4(p0, 0, pa0); PK4(p0, 8, pa1); PK4(p1, 0, pa2); PK4(p1, 8, pa3);
#undef PK4
}
__device__ __forceinline__ void qkt(f32x16& p0, f32x16& p1, const LAS char* Ks, const bf16x8* qr, int r32, int hi) {
    p0 = f32x16{}; p1 = f32x16{};
#pragma unroll
    for (int d0 = 0; d0 < 8; ++d0) { const int cb = (d0 * 16 + hi * 8) * 2;
        const bf16x8 b0 = *reinterpret_cast<const LAS bf16x8*>(Ks + KSWZ(r32, cb));
        const bf16x8 b1 = *reinterpret_cast<const LAS bf16x8*>(Ks + KSWZ(32 + r32, cb));
        p0 = __builtin_amdgcn_mfma_f32_32x32x16_bf16(b0, qr[d0], p0, 0, 0, 0);
        p1 = __builtin_amdgcn_mfma_f32_32x32x16_bf16(b1, qr[d0], p1, 0, 0, 0); }
}
__device__ __forceinline__ int v_st(int k, int c) { const int kk = (k & ~0xC) | ((k & 4) << 1) | ((k & 8) >> 1); return ((kk >> 3) * 4 + (c >> 5)) * 512 + ((kk & 7) * 32 + (c & 31)) * 2; }
__device__ __forceinline__ int v_rd_base(int lane) { return ((lane & 3) << 3) | (((lane >> 2) & 3) << 6) | (((lane >> 4) & 1) << 5) | (((lane >> 5) & 1) << 8); }
constexpr int v_rd_off(int d0, int ks, int half) { return d0 * 512 + ks * 4096 + half * 2048; }
template <int OFF> __device__ __forceinline__ s16x4 tr_read(int vb) {
    s16x4 r; asm volatile("ds_read_b64_tr_b16 %0, %1 offset:%2" : "=&v"(r) : "v"(vb), "i"(OFF) : "memory"); return r;
}
template <int D0> __device__ __forceinline__ void pv_one(f32x16& od, int vb, bf16x8 pa0, bf16x8 pa1, bf16x8 pa2, bf16x8 pa3) {
    const s16x4 l0 = tr_read<v_rd_off(D0, 0, 0)>(vb), h0 = tr_read<v_rd_off(D0, 0, 1)>(vb), l1 = tr_read<v_rd_off(D0, 1, 0)>(vb), h1 = tr_read<v_rd_off(D0, 1, 1)>(vb);
    const s16x4 l2 = tr_read<v_rd_off(D0, 2, 0)>(vb), h2 = tr_read<v_rd_off(D0, 2, 1)>(vb), l3 = tr_read<v_rd_off(D0, 3, 0)>(vb), h3 = tr_read<v_rd_off(D0, 3, 1)>(vb);
    asm volatile("s_waitcnt lgkmcnt(0)" ::: "memory"); SBAR();
#define PK(L, H) (bf16x8){L[0], L[1], L[2], L[3], H[0], H[1], H[2], H[3]}
    od = __builtin_amdgcn_mfma_f32_32x32x16_bf16(pa0, PK(l0, h0), od, 0, 0, 0);
    od = __builtin_amdgcn_mfma_f32_32x32x16_bf16(pa1, PK(l1, h1), od, 0, 0, 0);
    od = __builtin_amdgcn_mfma_f32_32x32x16_bf16(pa2, PK(l2, h2), od, 0, 0, 0);
    od = __builtin_amdgcn_mfma_f32_32x32x16_bf16(pa3, PK(l3, h3), od, 0, 0, 0);
#undef PK
}
__device__ __forceinline__ void pv_d0(f32x16* o, int vb, bf16x8 pa0, bf16x8 pa1, bf16x8 pa2, bf16x8 pa3) {
    pv_one<0>(o[0], vb, pa0, pa1, pa2, pa3); pv_one<1>(o[1], vb, pa0, pa1, pa2, pa3); pv_one<2>(o[2], vb, pa0, pa1, pa2, pa3); pv_one<3>(o[3], vb, pa0, pa1, pa2, pa3);
}
__device__ __forceinline__ void attn_body(const bf16_t* __restrict__ Qb, const bf16_t* __restrict__ Kh, const bf16_t* __restrict__ Vh, bf16_t* __restrict__ Ob, const unsigned* __restrict__ Mb, int NT, LAS char* lds) {
    const int tid = threadIdx.x, wid = tid >> 6, lane = tid & 63, r32 = lane & 31, hi = lane >> 5;
    LAS char* V_lds = lds; LAS char* K_lds = lds + 2 * SHM_V;
    LAS float* ws = (LAS float*)(lds + 2 * SHM_V + 2 * SHM_K) + wid * 64; LAS float* li_l = ws; LAS float* al_l = ws + 32;
    float m_reg = -1e30f, l_reg = 0; f32x16 o[4] = {}; bf16x8 qr[8];
    const bf16_t* Qw = Qb + (long)(wid * QBLK + r32) * LDQ + hi * 8;
#pragma unroll
    for (int d0 = 0; d0 < 8; ++d0) qr[d0] = *reinterpret_cast<const bf16x8*>(Qw + d0 * 16);
    const unsigned mofs = (unsigned)(wid * QBLK + r32) * 256u;
#define Mw_(j) (*(const u32x2*)((const char*)Mb + (mofs + 8u * (unsigned)(j))))
    const int sr = tid >> 4, sc = (tid & 15) * 8, vst0 = v_st(sr, sc), vst1 = v_st(32 + sr, sc);
    const int vb0 = (int)(uintptr_t)V_lds + v_rd_base(lane);
    struct { bf16x8 vs0, vs1, ks0, ks1; } sr_[2];
#define SLOAD(i, k0) do { sr_[i].vs0 = *(const bf16x8*)(&Vh[(long)((k0) + sr) * LDK + sc]); sr_[i].vs1 = *(const bf16x8*)(&Vh[(long)((k0) + 32 + sr) * LDK + sc]); \
    sr_[i].ks0 = *(const bf16x8*)(&Kh[(long)((k0) + sr) * LDK + sc]); sr_[i].ks1 = *(const bf16x8*)(&Kh[(long)((k0) + 32 + sr) * LDK + sc]); } while (0)
#define SWRITE(b, i) do { *(LAS bf16x8*)(V_lds + (b) * SHM_V + vst0) = sr_[i].vs0;          \
    *(LAS bf16x8*)(V_lds + (b) * SHM_V + vst1) = sr_[i].vs1; int kc = sc * 2;               \
    *(LAS bf16x8*)(K_lds + (b) * SHM_K + KSWZ(sr, kc)) = sr_[i].ks0;                       \
    *(LAS bf16x8*)(K_lds + (b) * SHM_K + KSWZ(32 + sr, kc)) = sr_[i].ks1; } while (0)
#define SWAIT() asm volatile("s_waitcnt vmcnt(5)" ::: "memory")
#define RESC(a) do { if (__any((a) < 1.f)) { if (hi == 0) al_l[r32] = (a); asm volatile("s_waitcnt lgkmcnt(0)" ::: "memory"); \
    _Pragma("unroll") for (int d = 0; d < 4; ++d) _Pragma("unroll") for (int r = 0; r < 16; ++r) o[d][r] *= al_l[crow(r, hi)]; } } while (0)
    f32x16 pA0, pA1, pB0, pB1; float mnA, mnB, alA, alB; bf16x8 pa0, pa1, pa2, pa3;
    u32x2 mkA = Mw_(0), mkB = Mw_(1);
    constexpr int SE = 0, SO = 1;
    SLOAD(SE, 0); asm volatile("s_waitcnt vmcnt(0)" ::: "memory"); SWRITE(0, SE); __syncthreads();
    qkt(pA0, pA1, K_lds, qr, r32, hi); apply_mask(pA0, pA1, mkA, hi); partialSM(pA0, pA1, m_reg, mnA, alA); mkA = Mw_(2);
    SLOAD(SO, KVBLK); if (2 < NT) SLOAD(SE, 2 * KVBLK);
    SWAIT(); SWRITE(1, SO); __syncthreads();
    for (int j = 1; j + 1 < NT; j += 2) {
        SBAR(); qkt(pB0, pB1, K_lds + SHM_K, qr, r32, hi);
        finishSM(pA0, pA1, alA, l_reg, pa0, pa1, pa2, pa3); SBAR();
        SLOAD(SO, (j + 2) * KVBLK); SBAR();
        pv_d0(o, vb0, pa0, pa1, pa2, pa3); apply_mask(pB0, pB1, mkB, hi); partialSM(pB0, pB1, m_reg, mnB, alB); mkB = Mw_((j + 2 < NT) ? (j + 2) : j);
        __syncthreads(); SWAIT(); SWRITE(0, SE);
        RESC(alB); __syncthreads();
        SBAR(); qkt(pA0, pA1, K_lds, qr, r32, hi);
        finishSM(pB0, pB1, alB, l_reg, pa0, pa1, pa2, pa3); SBAR();
        if (j + 3 < NT) SLOAD(SE, (j + 3) * KVBLK); SBAR();
        pv_d0(o, vb0 + (int)SHM_V, pa0, pa1, pa2, pa3); apply_mask(pA0, pA1, mkA, hi); partialSM(pA0, pA1, m_reg, mnA, alA); mkA = Mw_((j + 3 < NT) ? (j + 3) : (j + 1));
        __syncthreads(); SWAIT(); SWRITE(1, SO);
        RESC(alA); __syncthreads();
    }
    SBAR(); qkt(pB0, pB1, K_lds + SHM_K, qr, r32, hi);
    finishSM(pA0, pA1, alA, l_reg, pa0, pa1, pa2, pa3); SBAR();
    pv_d0(o, vb0, pa0, pa1, pa2, pa3); apply_mask(pB0, pB1, mkB, hi); partialSM(pB0, pB1, m_reg, mnB, alB);
    __syncthreads(); RESC(alB);
    finishSM(pB0, pB1, alB, l_reg, pa0, pa1, pa2, pa3); SBAR();
    pv_d0(o, vb0 + (int)SHM_V, pa0, pa1, pa2, pa3);
    if (hi == 0) li_l[r32] = l_reg; asm volatile("s_waitcnt lgkmcnt(0)" ::: "memory");
    float rli[16];
#pragma unroll
    for (int r = 0; r < 16; ++r) rli[r] = __builtin_amdgcn_rcpf(li_l[crow(r, hi)]);
    bf16_t* Ow = Ob + (long)(wid * QBLK) * LDO;
#pragma unroll
    for (int r = 0; r < 16; ++r) { const int orow = crow(r, hi);
#pragma unroll
        for (int d0 = 0; d0 < 4; ++d0) Ow[(long)orow * LDO + d0 * 32 + r32] = (bf16_t)(cvt_pk_bf16(o[d0][r] * rli[r], 0.f) & 0xffffu); }
#undef SLOAD
#undef SWRITE
#undef SWAIT
#undef RESC
#undef Mw_
}
}

__device__ __forceinline__ void p3_attention(Frame& F) {
    const bf16_t* Q = (const bf16_t*)(F.ws + WS_Q); const bf16_t* K = (const bf16_t*)(F.ws + WS_K); const bf16_t* V = (const bf16_t*)(F.ws + WS_V);
    bf16_t* cat = (bf16_t*)(F.ws + WS_CAT); const unsigned* MASK = (const unsigned*)(F.ws + WS_MASK);
    const int j = F.bid;
    if (F.G == 256 && j >= 216) {
        convert_range(F, 2 * CV_PAIRS1, 2 * CV_PAIRS3, (j - 216) * 8 + F.wave, 40 * 8);
        return;
    }
    int qbs[2], phs[2], nu = 2;
    if (F.G != 256) { nu = 0; }
    else if (j < 48) { qbs[0] = 7; phs[0] = (j % 8) * 6 + j / 8; nu = 1; qbs[1] = 0; phs[1] = 0; }
    else if (j < 96) { const int jl = j - 48; qbs[0] = 6; phs[0] = (jl % 8) * 6 + jl / 8; qbs[1] = 0; phs[1] = phs[0]; }
    else if (j < 144) { const int jl = j - 96; qbs[0] = 5; phs[0] = (jl % 8) * 6 + jl / 8; qbs[1] = 1; phs[1] = phs[0]; }
    else if (j < 192) { const int jl = j - 144; qbs[0] = 4; phs[0] = (jl % 8) * 6 + jl / 8; qbs[1] = 2; phs[1] = phs[0]; }
    else { const int jl = j - 192; qbs[0] = 3; phs[0] = (jl % 8) * 6 + 2 * (jl / 8); qbs[1] = 3; phs[1] = phs[0] + 1; }
    for (int ui = 0; ui < nu; ++ui) {
        __syncthreads();
        const int qb = qbs[ui], b = phs[ui] / 6, h = phs[ui] % 6, g = h / 3;
        const size_t row0 = (size_t)b * SEQ + (size_t)qb * 256;
        att::attn_body(Q + row0 * 768 + h * 128, K + (size_t)b * SEQ * 256 + g * 128, V + (size_t)b * SEQ * 256 + g * 128, cat + row0 * 1024 + 256 + h * 128, MASK + row0 * 64, 4 * (qb + 1), (LAS char*)F.lds);
    }
    __syncthreads();
}

__device__ __forceinline__ void p5_ln1_router(Frame& F) {
    const bf16_t* MIX = (const bf16_t*)(F.ws + WS_MIX); const bf16_t* HA = (const bf16_t*)(F.ws + WS_HA);
    bf16_t* H1R = (bf16_t*)(F.ws + WS_H1F); unsigned char* H1Q = F.ws + WS_H1B; const float* wrA = (const float*)(F.ws + WS_WRA);
    unsigned* INV = (unsigned*)(F.ws + WS_INV); unsigned* TOKEP = (unsigned*)(F.ws + WS_TOKEP); float* TOKG = (float*)(F.ws + WS_TOKG);
    LAS float* tile = (LAS float*)F.lds;
    LAS float* part = (LAS float*)F.lds;
    LAS float* logit = (LAS float*)(F.lds + 36864);
    LAS int* sel_e = (LAS int*)(F.lds + MISC_OFF + 2048);
    LAS float* sel_g = (LAS float*)(F.lds + MISC_OFF + 3072);
    LAS int* sel_p = (LAS int*)(F.lds + MISC_OFF + 4096);
    LAS unsigned* lcnt = (LAS unsigned*)(F.lds + MISC_OFF + 5120);
    LAS int* ebase = (LAS int*)(F.lds + MISC_OFF + 5376);
    const int lane = F.lane, r32 = lane & 31, hi = lane >> 5;
    for (int blk = F.bid; blk < T / 64; blk += F.G) {
        const int t0 = blk * 64;
        if (F.tid < 32) lcnt[F.tid] = 0u;
        for (int pass = 0; pass < 2; ++pass) {
            __syncthreads();
            { f32x4 g1[4], b1[4];
#pragma unroll
              for (int j = 0; j < 4; ++j) { g1[j] = ((const f32x4*)F.ln1_g)[lane + 64 * j]; b1[j] = ((const f32x4*)F.ln1_b)[lane + 64 * j]; }
#pragma unroll
              for (int rb = 0; rb < 4; rb += 2) {
              u32x2 xv[2][4]; u32x2 mv[2][4];
#pragma unroll
              for (int rr = 0; rr < 2; ++rr) { const int m = t0 + pass * 32 + F.wave * 4 + rb + rr;
#pragma unroll
                  for (int j = 0; j < 4; ++j) { xv[rr][j] = ((const u32x2*)(HA + (size_t)m * 1024))[lane + 64 * j]; mv[rr][j] = ((const u32x2*)(MIX + (size_t)m * 1024))[lane + 64 * j]; } }
#pragma unroll
              for (int rr = 0; rr < 2; ++rr) { const int tl = F.wave * 4 + rb + rr, m = t0 + pass * 32 + tl;
                  f32x4 v[4]; float s = 0.f;
#pragma unroll
                  for (int j = 0; j < 4; ++j) { const u32x2 hw = xv[rr][j]; const f32x4 h = {bf16_lo(hw.x), bf16_hi(hw.x), bf16_lo(hw.y), bf16_hi(hw.y)};
                      const u32x2 w = mv[rr][j]; const f32x4 mx = {bf16_lo(w.x), bf16_hi(w.x), bf16_lo(w.y), bf16_hi(w.y)};
                      v[j] = ALPHA * h + mx; s += (v[j].x + v[j].y) + (v[j].z + v[j].w); }
                  const float mean = wave_sum(s) * (1.f / 1024.f); float s2 = 0.f;
#pragma unroll
                  for (int j = 0; j < 4; ++j) { v[j] = v[j] - mean; s2 += (v[j].x * v[j].x + v[j].y * v[j].y) + (v[j].z * v[j].z + v[j].w * v[j].w); }
                  const float rstd = 1.f / sqrtf(wave_sum(s2) * (1.f / 1024.f) + LN_EPS);
                  u32x2* of = (u32x2*)(H1R + (size_t)m * 1024) + lane; unsigned* ob = (unsigned*)(H1Q + (size_t)m * 1024) + lane;
#pragma unroll
                  for (int j = 0; j < 4; ++j) { const f32x4 h = v[j] * rstd * g1[j] + b1[j]; { u32x2 hw; hw.x = cvt_pk_bf16(h.x, h.y); hw.y = cvt_pk_bf16(h.z, h.w); of[64 * j] = hw; } ob[64 * j] = pk4_fp8(h.x, h.y, h.z, h.w);
                      *(LAS f32x4*)(tile + tl * 1024 + (((lane + 64 * j) ^ (tl & 15)) << 2)) = h; } } } }
            f32x4 a4[16];
#pragma unroll
            for (int i = 0; i < 16; ++i) a4[i] = *(const f32x4*)(wrA + (size_t)(((F.wave * 16 + i) * 2 + hi) * 32 + r32) * 4);
            __syncthreads();
            f32x16 acc = {};
#pragma unroll
            for (int i = 0; i < 16; ++i) { const int c = F.wave * 16 + i;
                const f32x4 b4 = *(const LAS f32x4*)(tile + r32 * 1024 + (((2 * c + hi) ^ (r32 & 15)) << 2));
                acc = __builtin_amdgcn_mfma_f32_32x32x2f32(a4[i].x, b4.x, acc, 0, 0, 0);
                acc = __builtin_amdgcn_mfma_f32_32x32x2f32(a4[i].y, b4.y, acc, 0, 0, 0);
                acc = __builtin_amdgcn_mfma_f32_32x32x2f32(a4[i].z, b4.z, acc, 0, 0, 0);
                acc = __builtin_amdgcn_mfma_f32_32x32x2f32(a4[i].w, b4.w, acc, 0, 0, 0); }
            __syncthreads();
#pragma unroll
            for (int r = 0; r < 16; ++r) part[(F.wave * 32 + r32) * 33 + crow(r, hi)] = acc[r];
            __syncthreads();
#pragma unroll
            for (int q = 0; q < 2; ++q) { const int o = F.tid * 2 + q, tok = o >> 5, e = o & 31; float sm = F.b_router[e];
#pragma unroll
                for (int kq = 0; kq < 8; ++kq) sm += part[(kq * 32 + tok) * 33 + e];
                logit[tok * 33 + e] = sm; }
            __syncthreads();
            if (F.tid < 32) {
                float bv_[4] = {-INFINITY, -INFINITY, -INFINITY, -INFINITY}; int bi[4] = {0, 0, 0, 0};
#pragma unroll
                for (int e = 0; e < 32; ++e) { const float v = logit[F.tid * 33 + e];
                    if (v > bv_[3]) { bv_[3] = v; bi[3] = e;
                        if (bv_[3] > bv_[2]) { float tv = bv_[2]; bv_[2] = bv_[3]; bv_[3] = tv; int ti = bi[2]; bi[2] = bi[3]; bi[3] = ti;
                            if (bv_[2] > bv_[1]) { tv = bv_[1]; bv_[1] = bv_[2]; bv_[2] = tv; ti = bi[1]; bi[1] = bi[2]; bi[2] = ti;
                                if (bv_[1] > bv_[0]) { tv = bv_[0]; bv_[0] = bv_[1]; bv_[1] = tv; ti = bi[0]; bi[0] = bi[1]; bi[1] = ti; } } } } }
                float ex[4], se = 0.f;
#pragma unroll
                for (int j = 0; j < 4; ++j) { ex[j] = __expf(bv_[j] - bv_[0]); se += ex[j]; }
#pragma unroll
                for (int j = 0; j < 4; ++j) { sel_g[(pass * 32 + F.tid) * 4 + j] = ex[j] / se; sel_e[(pass * 32 + F.tid) * 4 + j] = bi[j]; }
            }
        }
        __syncthreads();
        if (F.tid < 256) sel_p[F.tid] = (int)__hip_atomic_fetch_add(lcnt + sel_e[F.tid], 1u, __ATOMIC_RELAXED, __HIP_MEMORY_SCOPE_WORKGROUP);
        __syncthreads();
        if (F.tid < 32) { const unsigned c = lcnt[F.tid]; int base = 0; if (c > 0) base = (int)__hip_atomic_fetch_add(F.ctl + CW_CNT + F.tid, c, __ATOMIC_RELAXED, __HIP_MEMORY_SCOPE_AGENT); ebase[F.tid] = base; }
        __syncthreads();
        if (F.tid < 256) { const int tok = t0 + (F.tid >> 2), e = sel_e[F.tid], p = ebase[e] + sel_p[F.tid];
            INV[(size_t)e * CAP + p] = (unsigned)tok; TOKEP[(size_t)tok * 4 + (F.tid & 3)] = ((unsigned)e << 16) | (unsigned)p; TOKG[(size_t)tok * 4 + (F.tid & 3)] = sel_g[F.tid]; }
        __syncthreads();
    }
}

__device__ __forceinline__ void moe_tables(Frame& F, LAS int* tstart) {
    __syncthreads();
    if (F.tid < 64) {
        const unsigned c = (F.tid < NE) ? __hip_atomic_load(F.ctl + CW_CNT + (F.tid & 31), __ATOMIC_RELAXED, __HIP_MEMORY_SCOPE_AGENT) : 0u;
        const int nt = (int)((c + 255u) >> 8); int incl = nt;
#pragma unroll
        for (int d = 1; d < 32; d <<= 1) { const int o = __shfl_up(incl, d, 64); if ((int)F.tid >= d) incl += o; }
        if (F.tid < NE) { tstart[F.tid] = incl - nt; tstart[40 + F.tid] = (int)c; }
        if (F.tid == NE - 1) tstart[NE] = incl; }
    __syncthreads();
}

__device__ __forceinline__ float fp8_to_f32(unsigned w, int byte) {
    if (byte == 0) return __builtin_amdgcn_cvt_f32_fp8(w, 0); if (byte == 1) return __builtin_amdgcn_cvt_f32_fp8(w, 1); if (byte == 2) return __builtin_amdgcn_cvt_f32_fp8(w, 2); return __builtin_amdgcn_cvt_f32_fp8(w, 3);
}
__device__ __forceinline__ void p8_final(Frame& F, LAS int* tstart) {
    const bf16_t* H1R = (const bf16_t*)(F.ws + WS_H1F); const unsigned* TOKEP = (const unsigned*)(F.ws + WS_TOKEP); const float* TOKG = (const float*)(F.ws + WS_TOKG);
    const unsigned char* Y = F.ws + WS_Y;
    const int gw = F.bid * 8 + F.wave, NGW = F.G * 8;
    f32x4 gv[4], bv[4];
#pragma unroll
    for (int j = 0; j < 4; ++j) { gv[j] = ((const f32x4*)F.ln2_g)[F.lane + 64 * j]; bv[j] = ((const f32x4*)F.ln2_b)[F.lane + 64 * j]; }
    unsigned tk = 0; float tg = 0.f;
    { const int m = gw + (F.lane >> 2) * NGW; if (F.lane < 32 && m < T) { tk = TOKEP[(size_t)m * 4 + (F.lane & 3)]; tg = TOKG[(size_t)m * 4 + (F.lane & 3)] * (1.0f / 64.0f); } }
    u32x2 hwA[4], hwB[4]; unsigned ywA[4][4], ywB[4][4];
#define P8_LOAD(k, hw, yw) do { const int m_ = gw + (k) * NGW; if (m_ < T) { const u32x2* xr_ = (const u32x2*)(H1R + (size_t)m_ * 1024) + F.lane; \
        _Pragma("unroll") for (int j = 0; j < 4; ++j) hw[j] = xr_[64 * j]; \
        _Pragma("unroll") for (int q = 0; q < 4; ++q) { const unsigned ep_ = (unsigned)__builtin_amdgcn_readlane((int)tk, (k) * 4 + q); \
            const size_t slot_ = (size_t)tstart[ep_ >> 16] * 256 + (ep_ & 0xffffu); const unsigned* yr_ = (const unsigned*)(Y + slot_ * 1024) + F.lane; \
            _Pragma("unroll") for (int j = 0; j < 4; ++j) yw[q][j] = yr_[64 * j]; } } } while (0)
#define P8_ROW(k, hw, yw) do { const int m_ = gw + (k) * NGW; if (m_ < T) { f32x4 v[4]; float gt[4]; \
        _Pragma("unroll") for (int q = 0; q < 4; ++q) gt[q] = __builtin_bit_cast(float, __builtin_amdgcn_readlane(__builtin_bit_cast(int, tg), (k) * 4 + q)); \
        _Pragma("unroll") for (int j = 0; j < 4; ++j) { v[j] = (f32x4){ALPHA * bf16_lo(hw[j].x), ALPHA * bf16_hi(hw[j].x), ALPHA * bf16_lo(hw[j].y), ALPHA * bf16_hi(hw[j].y)}; \
            _Pragma("unroll") for (int q = 0; q < 4; ++q) { const unsigned w = yw[q][j]; \
                v[j].x += gt[q] * fp8_to_f32(w, 0); v[j].y += gt[q] * fp8_to_f32(w, 1); v[j].z += gt[q] * fp8_to_f32(w, 2); v[j].w += gt[q] * fp8_to_f32(w, 3); } } \
        float s_ = 0.f; _Pragma("unroll") for (int j = 0; j < 4; ++j) s_ += (v[j].x + v[j].y) + (v[j].z + v[j].w); \
        const float mean_ = wave_sum(s_) * (1.f / 1024.f); float s2_ = 0.f; \
        _Pragma("unroll") for (int j = 0; j < 4; ++j) { v[j] = v[j] - mean_; s2_ += (v[j].x * v[j].x + v[j].y * v[j].y) + (v[j].z * v[j].z + v[j].w * v[j].w); } \
        const float rstd_ = 1.f / sqrtf(wave_sum(s2_) * (1.f / 1024.f) + LN_EPS); \
        f32x4* orow_ = (f32x4*)(F.out + (size_t)m_ * 1024) + F.lane; \
        _Pragma("unroll") for (int j = 0; j < 4; ++j) orow_[64 * j] = v[j] * rstd_ * gv[j] + bv[j]; } } while (0)
    P8_LOAD(0, hwA, ywA);
    P8_LOAD(1, hwB, ywB); P8_ROW(0, hwA, ywA);
    P8_LOAD(2, hwA, ywA); P8_ROW(1, hwB, ywB);
    P8_LOAD(3, hwB, ywB); P8_ROW(2, hwA, ywA);
    P8_LOAD(4, hwA, ywA); P8_ROW(3, hwB, ywB);
    P8_LOAD(5, hwB, ywB); P8_ROW(4, hwA, ywA);
    P8_LOAD(6, hwA, ywA); P8_ROW(5, hwB, ywB);
    P8_LOAD(7, hwB, ywB); P8_ROW(6, hwA, ywA);
    P8_ROW(7, hwB, ywB);
#undef P8_LOAD
#undef P8_ROW
}

__global__ void __launch_bounds__(NTHREADS, 2) mk_fwd(Args args) {
    extern __shared__ __attribute__((aligned(16))) unsigned char lds_raw[];
    Frame F;
    F.lds = (LAS unsigned char*)lds_raw;
    F.tid = threadIdx.x; F.lane = F.tid & 63; F.wave = __builtin_amdgcn_readfirstlane(F.tid >> 6); F.G = gridDim.x; F.bid = blockIdx.x;
    frame_refresh(F);
    volatile LAS unsigned* misc = (volatile LAS unsigned*)(F.lds + MISC_OFF);
    LAS int* tstart = (LAS int*)(F.lds + MISC_OFF + 256);
    LAS int* toktab = (LAS int*)(F.lds + MISC_OFF + 1024);
    if (F.tid < 4) misc[F.tid] = 0u;
    __syncthreads();
    const int lo = args.ph_lo, hi = args.ph_hi;
    XcdBarrier bar; bar.bar = F.ctl; bar.x = 0; bar.st = misc;
    if (hi - lo > 1) bar = xcd_barrier_post(F.ctl, misc);
#define IN(k) (lo <= (k) && (k) < hi)
#ifdef ONLY
#define PH_ON(k) ((k) == ONLY)
#else
#define PH_ON(k) true
#endif
#define SEAM(k) do { if (IN(k) && IN((k) + 1)) xcd_barrier(bar); frame_refresh(F); } while (0)

    if (PH_ON(0) && IN(0)) { p0_prologue(F); } SEAM(0);
    if (PH_ON(1) && IN(1)) {
        EpiInProj E{(bf16_t*)(F.ws + WS_U), (bf16_t*)(F.ws + WS_Q), (bf16_t*)(F.ws + WS_K), (bf16_t*)(F.ws + WS_V), (bf16_t*)(F.ws + WS_IQ), (bf16_t*)(F.ws + WS_IK), (float*)(F.ws + WS_IW),
                    (const float*)(F.ws + WS_ROPEQK), (const float*)(F.ws + WS_ROPEIX)};
        { pg8::StaticSched S{T / 256, 5, F.G, F.bid, 1, 1};
          pg8::gemm_phase<EpiInProj, pg8::StaticSched, true, 0x79797979, 0x7f7f7f7f>(F.lds, (const char*)(F.ws + WS_HA8), (const char*)(F.ws + WS_BTIN8), S, E); }
        { pg8::StaticSched S{T / 256, 4, F.G, F.bid, 0, 5};
          pg8::gemm_phase<EpiInProj, pg8::StaticSched>(F.lds, (const char*)(F.ws + WS_HA), (const char*)(F.ws + WS_BTIN), S, E); }
        if (F.bid >= 64) {
            convert_range(F, 0, 2 * CV_PAIRS1, (F.bid - 64) * 8 + F.wave, (F.G - 64) * 8); }
    } SEAM(1);
    if (PH_ON(2) && IN(2)) {
#ifndef NO_POOL
 p2_pool(F);
#endif
 p2_indexer(F); } SEAM(2);
    if (PH_ON(3) && IN(3)) { p3_attention(F); } SEAM(3);
    if (PH_ON(4) && IN(4)) {
        pg8::StaticSched S{T / 256, 4, F.G, F.bid, 0, 0};
        EpiMix E{(bf16_t*)(F.ws + WS_MIX)};
        pg8::gemm_phase<EpiMix, pg8::StaticSched>(F.lds, (const char*)(F.ws + WS_CAT), (const char*)(F.ws + WS_BTOUT), S, E);
    } SEAM(4);
    if (PH_ON(5) && IN(5)) { p5_ln1_router(F); } SEAM(5);
    if (PH_ON(6) && IN(6)) {
        moe_tables(F, tstart);
        const int ntl = tstart[NE];
        pg8::MoeSched<true> S{ntl, 8, F.G, F.bid, 2048, tstart, toktab, 0};
        { const unsigned* INV = (const unsigned*)(F.ws + WS_INV); pg8::Unit u; unsigned tk[10];
#pragma unroll
          for (int i = 0; i < 10; ++i) { tk[i] = 0u; if (S.next(i, u) && F.tid < 256) { const int p = (u.pm - tstart[u.e]) * 256 + F.tid; const int cnt = tstart[40 + u.e];
                  tk[i] = INV[(size_t)u.e * CAP + (p < cnt ? p : 0)]; } }
#pragma unroll
          for (int i = 0; i < 10; ++i) if (F.tid < 256) toktab[i * 256 + F.tid] = (int)tk[i];
          __syncthreads(); }
        EpiGateUp E{F.ws + WS_ACT, F.b_gu, F.ctl + CW_ACTRDY};
#ifndef NO_GU
        pg8::gemm_phase<EpiGateUp, pg8::MoeSched<true>, true, 0x79797979, 0x7f7f7f7f>(F.lds, (const char*)(F.ws + WS_H1B), (const char*)(F.ws + WS_BTGU), S, E);
#endif
        { const int nwg6 = 8 * ntl, rounds6 = (nwg6 + F.G - 1) / F.G, nidle = rounds6 * F.G - nwg6, cfirst = nwg6 - (rounds6 - 1) * F.G;
          int early = ((nidle < 128 ? nidle : 128) / 32) * 32; if (rounds6 < 9 || ntl < 32) early = 0;
          const int rank = F.bid - cfirst;
#ifndef NO_EARLY
          if (rank >= 0 && rank < early) {
              pg8::MoeSched<false> S7{early / 4, 4, F.G, rank, 1024, tstart, toktab, 0};
              pg8::Unit u; S7.next(0, u);
              if (F.tid < 64) {
                  unsigned* cp = F.ctl + CW_ACTRDY + u.pm; unsigned sp = 0;
                  while ((unsigned)__builtin_amdgcn_readfirstlane((int)__hip_atomic_load(cp, __ATOMIC_RELAXED, __HIP_MEMORY_SCOPE_AGENT)) < 64u) {
                      __builtin_amdgcn_s_sleep(2); if (++sp > (1u << 20)) { if (F.tid == 0) __hip_atomic_store(F.ctl + CW_TMO2, 1u, __ATOMIC_RELAXED, __HIP_MEMORY_SCOPE_AGENT); break; } }
                  __builtin_amdgcn_fence(__ATOMIC_ACQUIRE, "agent");
                  asm volatile("s_waitcnt vmcnt(0)" ::: "memory"); }
              __syncthreads();
              EpiDown E7{F.ws + WS_Y, F.b_dn};
              pg8::gemm_phase<EpiDown, pg8::MoeSched<false>, true, 0x79797979, 0x7c7c7c7c>(F.lds, (const char*)(F.ws + WS_ACT), (const char*)(F.ws + WS_BTDN), S7, E7);
          }
#endif
          (void)rank; (void)early; }
    } SEAM(6);
    if (PH_ON(7) && IN(7)) {
        moe_tables(F, tstart);
        const int ntl = tstart[NE];
        const int nwg6 = 8 * ntl, rounds6 = (nwg6 + F.G - 1) / F.G, nidle = rounds6 * F.G - nwg6;
        int early = ((nidle < 128 ? nidle : 128) / 32) * 32; if (rounds6 < 9 || ntl < 32) early = 0;
        pg8::MoeSched<false> S{ntl, 4, F.G, F.bid, 1024, tstart, toktab, early};
        EpiDown E{F.ws + WS_Y, F.b_dn};
        pg8::gemm_phase<EpiDown, pg8::MoeSched<false>, true, 0x79797979, 0x7c7c7c7c>(F.lds, (const char*)(F.ws + WS_ACT), (const char*)(F.ws + WS_BTDN), S, E);
    } SEAM(7);
    if (PH_ON(8) && IN(8)) { moe_tables(F, tstart); p8_final(F, tstart); }
#undef IN
#undef SEAM
}

extern "C" void kernel_launch(void* const* d_in, const int* in_sizes, int n_in, void* d_out, int out_size, void* d_ws, size_t ws_size, hipStream_t stream) {
    static int grid = 0;
    if (grid == 0) {
        if (n_in != 18 || in_sizes[0] != T * DM || out_size != T * DM || ws_size < WS_END) {
            fprintf(stderr, "kernel_launch: shape mismatch (n_in %d, in0 %d, out %d, ws %zu, need %zu)\n", n_in, n_in > 0 ? in_sizes[0] : -1, out_size, ws_size, (size_t)WS_END); grid = -1; return; }
        int dev = 0, cus = 0, per_cu = 0;
        if (hipGetDevice(&dev) != hipSuccess || hipDeviceGetAttribute(&cus, hipDeviceAttributeMultiprocessorCount, dev) != hipSuccess) { grid = -1; return; }
        if (hipFuncSetAttribute((const void*)mk_fwd, hipFuncAttributeMaxDynamicSharedMemorySize, LDS_BYTES) != hipSuccess) { fprintf(stderr, "kernel_launch: hipFuncSetAttribute failed\n"); grid = -1; return; }
        if (hipOccupancyMaxActiveBlocksPerMultiprocessor(&per_cu, (const void*)mk_fwd, NTHREADS, LDS_BYTES) != hipSuccess || per_cu < 1) {
            fprintf(stderr, "kernel_launch: occupancy query reports %d workgroups per CU\n", per_cu); }
        (void)hipGetLastError();
        grid = cus;
        if (grid != 256) { fprintf(stderr, "kernel_launch: built for a 256-CU device (static work deals), found %d CUs\n", cus); grid = -1; return; }
    }
    if (grid < 0) return;
    (void)hipMemsetAsync((char*)d_ws + WS_CTL, 0, CTL_BYTES, stream);
    Args a{};
    for (int i = 0; i < 18; ++i) a.in[i] = d_in[i];
    a.out = (float*)d_out; a.ws = (unsigned char*)d_ws;
#if MK_N_LAUNCHES == 1
    a.ph_lo = 0; a.ph_hi = NPH;
    hipLaunchKernelGGL(mk_fwd, dim3(grid), dim3(NTHREADS), LDS_BYTES, stream, a);
#else
    for (int p = 0; p < NPH; ++p) { a.ph_lo = p; a.ph_hi = p + 1; hipLaunchKernelGGL(mk_fwd, dim3(grid), dim3(NTHREADS), LDS_BYTES, stream, a);
#ifdef PROBE_DUP
        if (p == PROBE_DUP) { if (p == 3 || p == 5) (void)hipMemsetAsync((char*)d_ws + WS_CTL + 4096 * 4, 0, 1024, stream); hipLaunchKernelGGL(mk_fwd, dim3(grid), dim3(NTHREADS), LDS_BYTES, stream, a); }
#endif
    }
#endif
    const hipError_t le = hipPeekAtLastError();
    if (le != hipSuccess) fprintf(stderr, "kernel_launch: launch failed: %s\n", hipGetErrorName(le));
}
```

```cpp
#include <hip/hip_runtime.h>
#include <cstdio>
#include <cstdint>
#include <utility>

#define LAS __attribute__((address_space(3)))
typedef unsigned short bf16_t;
typedef short bf16x8 __attribute__((ext_vector_type(8)));
typedef short s16x4 __attribute__((ext_vector_type(4)));
typedef float f32x2 __attribute__((ext_vector_type(2)));
typedef float f32x4 __attribute__((ext_vector_type(4)));
typedef float f32x16 __attribute__((ext_vector_type(16)));
typedef unsigned u32x2 __attribute__((ext_vector_type(2)));
typedef unsigned u32x4 __attribute__((ext_vector_type(4)));

#ifndef MK_N_LAUNCHES
#define MK_N_LAUNCHES 1
#endif

constexpr int T = 16384, DM = 1024, SEQ = 2048, NBATCH = 8;
constexpr int INW = 2120, INP = 2304;
constexpr int NE = 32, CAP = 16384, MAXT = 288;
constexpr int NPH = 9;
constexpr float ALPHA = 1.189207115002721f;
constexpr float LN_EPS = 1e-5f;
constexpr float W_SCALE = 0.04419417382415922f;
constexpr int NTHREADS = 512;
constexpr int LDS_BYTES = 147456;
constexpr int MISC_OFF = 131072;

constexpr size_t al256(size_t x) { return (x + 255) / 256 * 256; }
constexpr size_t WS_CTL = 0;
constexpr size_t CTL_BYTES = 65536;
constexpr size_t WS_BTIN = WS_CTL + CTL_BYTES;
constexpr size_t WS_BTOUT = WS_BTIN + al256((size_t)INP * 1024 * 2);
constexpr size_t WS_BTGU = WS_BTOUT + al256((size_t)1024 * 1024 * 2);
constexpr size_t WS_BTDN = WS_BTGU + al256((size_t)NE * 2048 * 1024 * 2);
constexpr size_t WS_WPT = WS_BTDN + al256((size_t)NE * 1024 * 1024 * 2);
constexpr size_t WS_WRA = WS_WPT + al256((size_t)4 * 64 * 64 * 2);
constexpr size_t WS_HA = WS_WRA + al256((size_t)1024 * 32 * 4);
constexpr size_t WS_STATS = WS_HA + al256((size_t)T * 1024 * 2);
constexpr size_t WS_ROPEQK = WS_STATS + al256((size_t)T * 2 * 4);
constexpr size_t WS_ROPEIX = WS_ROPEQK + al256((size_t)T * 32 * 4);
constexpr size_t WS_U = WS_ROPEIX + al256((size_t)T * 16 * 4);
constexpr size_t WS_Q = WS_U + al256((size_t)T * 256 * 2);
constexpr size_t WS_K = WS_Q + al256((size_t)T * 768 * 2);
constexpr size_t WS_V = WS_K + al256((size_t)T * 256 * 2);
constexpr size_t WS_IQ = WS_V + al256((size_t)T * 256 * 2);
constexpr size_t WS_IK = WS_IQ + al256((size_t)T * 512 * 2);
constexpr size_t WS_IW = WS_IK + al256((size_t)T * 64 * 2);
constexpr size_t WS_MASK = WS_IW + al256((size_t)T * 8 * 4);
constexpr size_t WS_CAT = WS_MASK + al256((size_t)T * 64 * 4);
constexpr size_t WS_H1F = WS_CAT + al256((size_t)T * 1024 * 2);
constexpr size_t WS_H1B = WS_H1F + al256((size_t)T * 1024 * 4);
constexpr size_t WS_INV = WS_H1B + al256((size_t)T * 1024 * 2);
constexpr size_t WS_TOKEP = WS_INV + al256((size_t)NE * CAP * 4);
constexpr size_t WS_TOKG = WS_TOKEP + al256((size_t)T * 4 * 4);
constexpr size_t WS_ACT = WS_TOKG + al256((size_t)T * 4 * 4);
constexpr size_t WS_Y = WS_ACT + al256((size_t)MAXT * 256 * 1024 * 2);
constexpr size_t WS_MIX = WS_Y + al256((size_t)MAXT * 256 * 1024 * 2);
constexpr size_t WS_HA8 = WS_MIX + al256((size_t)T * 1024 * 2);
constexpr size_t WS_BTIN8 = WS_HA8 + al256((size_t)T * 1024);
constexpr size_t WS_END = WS_BTIN8 + al256((size_t)1536 * 1024);
constexpr int CW_CNT = 4096;
constexpr int CW_ATTQ = 4224;
constexpr int CW_CVQ1 = 4288, CW_CVQ3 = 4352, CW_ACTRDY = 4608;
constexpr int CW_TMO2 = 4480;
constexpr int CV_PAIRS1 = 3072, CV_PAIRS3 = 5120, CV_HIDDEN = 2 * (CV_PAIRS1 + CV_PAIRS3);

#define XB_TMO      128
#define XB_XCNT(j)  (256  + 64 * (j))
#define XB_XSUB(j)  (1280 + 64 * (j))
#define XB_XGEN(j)  (2304 + 64 * (j))
#define XB_TOP      3328
#define XB_TOPGEN   3392
#define XCD_BAR_WORDS 3456
#define XB_SPIN_CAP (1u << 18)
__device__ __forceinline__ unsigned xb_ld(unsigned* p)              { return __hip_atomic_load(p, __ATOMIC_RELAXED, __HIP_MEMORY_SCOPE_AGENT); }
__device__ __forceinline__ unsigned xb_add(unsigned* p, unsigned v) { return __hip_atomic_fetch_add(p, v, __ATOMIC_RELAXED, __HIP_MEMORY_SCOPE_AGENT); }
__device__ __forceinline__ unsigned xb_xcc_id() { return (unsigned)__builtin_amdgcn_s_getreg((3 << 11) | 20) & 0xFu; }
#define XB_SPIN(cond, bar) do { unsigned _sp = 0; while (cond) { __builtin_amdgcn_s_sleep(1); \
    if ((++_sp & 255u) == 0u) { if (xb_ld(&(bar)[XB_TMO])) break; if (_sp > XB_SPIN_CAP) { atomicAdd(&(bar)[XB_TMO], 1u); break; } } } } while (0)
struct XcdBarrier { unsigned* bar; unsigned x; volatile LAS unsigned* st; };
__device__ __forceinline__ XcdBarrier xcd_barrier_post(unsigned* bar, volatile LAS unsigned* st) {
    XcdBarrier b; b.bar = bar; b.x = xb_xcc_id(); b.st = st;
    if (threadIdx.x == 0) (void)xb_add(&bar[XB_XCNT(b.x)], 1u);
    return b;
}
__device__ __forceinline__ void xcd_barrier_complete(unsigned* bar, unsigned x, unsigned& nloc, unsigned& nx) {
    const unsigned G = gridDim.x * gridDim.y * gridDim.z;
    unsigned sum, cnt, mine, sp = 0u;
    for (;;) {
        sum = 0u; cnt = 0u; mine = 0u;
#pragma unroll
        for (unsigned j = 0; j < 16; ++j) { const unsigned c = xb_ld(&bar[XB_XCNT(j)]); sum += c; cnt += (c > 0u) ? 1u : 0u; mine = (j == x) ? c : mine; }
        if (sum == G) break;
        __builtin_amdgcn_s_sleep(1);
        if ((++sp & 255u) == 0u) { if (xb_ld(&bar[XB_TMO])) break; if (sp > XB_SPIN_CAP) { atomicAdd(&bar[XB_TMO], 1u); break; } }
    }
    nloc = mine > 0u ? mine : 1u; nx = cnt > 0u ? cnt : 1u;
}
__device__ __forceinline__ void xcd_barrier(const XcdBarrier& b) {
    asm volatile("s_waitcnt vmcnt(0)" ::: "memory");
    __syncthreads();
    if (threadIdx.x == 0) {
        unsigned* bar = b.bar;
        __builtin_amdgcn_s_waitcnt(0);
        unsigned nloc = b.st[0], nx = b.st[1];
        if (nloc == 0u) { xcd_barrier_complete(bar, b.x, nloc, nx); b.st[0] = nloc; b.st[1] = nx; }
        const unsigned old = xb_add(&bar[XB_XSUB(b.x)], 1u);
        const unsigned gen = old / nloc;
        if (old + 1u == (gen + 1u) * nloc) {
            __builtin_amdgcn_fence(__ATOMIC_RELEASE, "agent");
            asm volatile("s_waitcnt vmcnt(0)" ::: "memory");
            const unsigned og = xb_add(&bar[XB_TOP], 1u);
            const unsigned tg = og / nx;
            if (og + 1u == (tg + 1u) * nx) xb_add(&bar[XB_TOPGEN], 1u);
            else XB_SPIN(xb_ld(&bar[XB_TOPGEN]) == tg, bar);
            __builtin_amdgcn_fence(__ATOMIC_ACQUIRE, "agent");
            xb_add(&bar[XB_XGEN(b.x)], 1u);
            asm volatile("s_waitcnt vmcnt(0)" ::: "memory");
        } else {
            XB_SPIN(xb_ld(&bar[XB_XGEN(b.x)]) == gen, bar);
            __builtin_amdgcn_fence(__ATOMIC_ACQUIRE, "agent");
            asm volatile("s_waitcnt vmcnt(0)" ::: "memory");
        }
    }
    __syncthreads();
}

__device__ __forceinline__ unsigned cvt_pk_bf16(float lo, float hi) { unsigned r; asm volatile("v_cvt_pk_bf16_f32 %0, %1, %2" : "=v"(r) : "v"(lo), "v"(hi)); return r; }
__device__ __forceinline__ unsigned pk4_fp8(float a, float b, float c, float d) { int w = __builtin_amdgcn_cvt_pk_fp8_f32(a, b, 0, false); w = __builtin_amdgcn_cvt_pk_fp8_f32(c, d, w, true); return (unsigned)w; }
__device__ __forceinline__ float bf16_lo(unsigned w) { return __uint_as_float(w << 16); }
__device__ __forceinline__ float bf16_hi(unsigned w) { return __uint_as_float(w & 0xffff0000u); }
template <int CTRL> __device__ __forceinline__ float dpp_f(float v) { return __builtin_bit_cast(float, __builtin_amdgcn_update_dpp(0, __builtin_bit_cast(int, v), CTRL, 0xf, 0xf, true)); }
__device__ __forceinline__ float wave_sum(float v) {
    v += dpp_f<0xB1>(v);
    v += dpp_f<0x4E>(v);
    v += dpp_f<0x141>(v);
    v += dpp_f<0x140>(v);
    const int vi = __builtin_bit_cast(int, v);
    const float r0 = __builtin_bit_cast(float, __builtin_amdgcn_readlane(vi, 0)), r1 = __builtin_bit_cast(float, __builtin_amdgcn_readlane(vi, 16));
    const float r2 = __builtin_bit_cast(float, __builtin_amdgcn_readlane(vi, 32)), r3 = __builtin_bit_cast(float, __builtin_amdgcn_readlane(vi, 48));
    return (r0 + r1) + (r2 + r3);
}
#define LDS_WAIT() asm volatile("s_waitcnt lgkmcnt(0)" ::: "memory")
#define VM_WAIT()  asm volatile("s_waitcnt vmcnt(0)" ::: "memory")
__device__ __forceinline__ int crow(int r, int hi) { return (r & 3) + 8 * (r >> 2) + 4 * hi; }

namespace pg8 {
constexpr int BM = 256, BK = 64, HALF = 128, HTB = HALF * BK * 2, STAGE_BYTES = 8 * HTB, NXCD = 8, WGM = 4, KD = 1024;
__device__ __forceinline__ int lds_byte(int r, int c) { const int st = (r >> 4) * 2 + (c >> 5), rr = r & 15, cc = c & 31, ob = rr * 64 + cc * 2; return st * 1024 + (ob ^ (((ob >> 9) & 1) << 5)); }
__device__ __forceinline__ void stage_rc(int b, int& R, int& C) { const int st = b / 1024, sb = b % 1024, swz = sb ^ (((sb >> 9) & 1) << 5); R = (st >> 1) * 16 + swz / 64; C = (st & 1) * 32 + (swz % 64) / 2; }
__device__ __forceinline__ int perm32(int rho) { const int n = rho >> 4, i = rho & 15; return 8 * (i >> 2) + 4 * n + (i & 3); }

struct Unit { int pm, pn, e, idx; };

__device__ __forceinline__ void order_decode(int wgid, int nM, int nN, int& pm, int& pn) {
    const int nig = WGM * nN, gid = wgid / nig, fm = gid * WGM, gsz = (nM - fm) < WGM ? (nM - fm) : WGM;
    pm = fm + ((wgid % nig) % gsz); pn = (wgid % nig) / gsz;
}
__device__ __forceinline__ bool order_next(int i, int G, int c, int nM, int nN, int& pm, int& pn, int woff = 0) {
    const int nwg = nM * nN - woff; const long L = (long)i * G + c; if (L >= nwg) return false;
    int wgid = (int)L; { const int q = nwg / NXCD, r = nwg % NXCD, xcd = wgid % NXCD, off = wgid / NXCD; wgid = (xcd < r ? xcd * (q + 1) : r * (q + 1) + (xcd - r) * q) + off; }
    order_decode(wgid + woff, nM, nN, pm, pn); return true;
}
struct StaticSched {
    int nM, nN, G, c, t0, toff;
    __device__ __forceinline__ bool next(int i, Unit& u) const { u.idx = i; const bool ok = order_next(i, G, c, nM, nN, u.pm, u.pn); u.e = (u.pn == 0) ? t0 : u.pn + toff; return ok; }
    __device__ __forceinline__ int a_row(const Unit& u, int h, int R) const { return u.pm * BM + h * HALF + R; }
    __device__ __forceinline__ int b_row(const Unit& u) const { return u.e * BM; }
};
template <bool GATHER> struct MoeSched {
    int nM, nN, G, c; int brows;
    const LAS int* tstart; const LAS int* toktab; int woff;
    __device__ __forceinline__ bool next(int i, Unit& u) const {
        u.idx = i;
        if (!order_next(i, G, c, nM, nN, u.pm, u.pn, woff)) return false;
        int e = 0;
#pragma unroll
        for (int k = 1; k < NE; ++k) e += (u.pm >= tstart[k]) ? 1 : 0;
        u.e = e; return true;
    }
    __device__ __forceinline__ int a_row(const Unit& u, int h, int R) const { if constexpr (GATHER) return toktab[u.idx * 256 + h * HALF + R]; else return u.pm * BM + h * HALF + R; }
    __device__ __forceinline__ int b_row(const Unit& u) const { return u.e * brows + u.pn * BM; }
};

typedef int v8i32 __attribute__((ext_vector_type(8)));
typedef int v4i32 __attribute__((ext_vector_type(4)));
__device__ __forceinline__ v8i32 cat8(bf16x8 a, bf16x8 b) { const v4i32 x = __builtin_bit_cast(v4i32, a), y = __builtin_bit_cast(v4i32, b); return __builtin_shufflevector(x, y, 0, 1, 2, 3, 4, 5, 6, 7); }
template <class Epi, class Sched, bool FP8 = false, int SW = 0x7f7f7f7f, int SA = 0x7f7f7f7f>
__device__ __forceinline__ void gemm_phase(LAS unsigned char* lds, const char* Abase, const char* Bbase, const Sched& S, const Epi& E) {
    const int tid = threadIdx.x, wid = __builtin_amdgcn_readfirstlane(tid >> 6), lane = tid & 63, wr = wid >> 2, wc = wid & 3, fr = lane & 15, fq = lane >> 4;
    constexpr int ROWB = FP8 ? KD : 2 * KD, nt = ROWB / 128;
    int RA[2], CA[2]; unsigned voffB[2];
#pragma unroll
    for (int i = 0; i < 2; ++i) { int R, C; stage_rc(tid * 16 + i * 8192, R, C); const int Rb = Epi::PERM ? ((R & ~31) + perm32(R & 31)) : R;
        RA[i] = R; CA[i] = C * 2; voffB[i] = (unsigned)(Rb * ROWB + C * 2); }
    const size_t kstep = (size_t)(BK * 2);
    const size_t hstep = (size_t)HALF * ROWB;
    const unsigned ldsw = (unsigned)wid * 1024u;
    const int aoff = lds_byte(wr * 64 + fr, fq * 8), boff = lds_byte(wc * 32 + fr, fq * 8);
#define PG8_SA(b, h) (((b) * 2 + (h)) * HTB)
#define PG8_SB(b, h) ((4 + (b) * 2 + (h)) * HTB)
#define PG8_STAGE(bufoff, gbase, voff) do { _Pragma("unroll") for (int _i = 0; _i < 2; ++_i) \
        __builtin_amdgcn_global_load_lds((const unsigned*)((const char*)(gbase) + (voff)[_i]), (LAS unsigned*)(lds + (bufoff) + ldsw + _i * 8192), 16, 0, 0); } while (0)
#define PG8_LDA(dst, b, h) do { _Pragma("unroll") for (int m = 0; m < 4; ++m) _Pragma("unroll") for (int k = 0; k < 2; ++k) dst[m][k] = *(const LAS bf16x8*)(lds + PG8_SA(b, h) + aoff + m * 2048 + k * 1024); } while (0)
#define PG8_LDB(dst, b, h) do { _Pragma("unroll") for (int n = 0; n < 2; ++n) _Pragma("unroll") for (int k = 0; k < 2; ++k) dst[n][k] = *(const LAS bf16x8*)(lds + PG8_SB(b, h) + boff + n * 2048 + k * 1024); } while (0)
#define PG8_MMA(ai, bj, At, Bt) do { __builtin_amdgcn_s_setprio(1); if constexpr (FP8) { _Pragma("unroll") for (int m = 0; m < 4; ++m) _Pragma("unroll") for (int n = 0; n < 2; ++n) \
        acc[ai][bj][m][n] = __builtin_amdgcn_mfma_scale_f32_16x16x128_f8f6f4(cat8(Bt[n][0], Bt[n][1]), cat8(At[m][0], At[m][1]), acc[ai][bj][m][n], 0, 0, 0, SW, 0, SA); } \
        else { _Pragma("unroll") for (int m = 0; m < 4; ++m) _Pragma("unroll") for (int n = 0; n < 2; ++n) _Pragma("unroll") for (int k = 0; k < 2; ++k) \
        acc[ai][bj][m][n] = __builtin_amdgcn_mfma_f32_16x16x32_bf16(Bt[n][k], At[m][k], acc[ai][bj][m][n], 0, 0, 0); } __builtin_amdgcn_s_setprio(0); } while (0)
#define PG8_WAIT_V(n) asm volatile("s_waitcnt vmcnt(" #n ")" ::: "memory")
#define PG8_WAIT_L(n) asm volatile("s_waitcnt lgkmcnt(" #n ")" ::: "memory")
#define PG8_BAR __builtin_amdgcn_s_barrier()
#define PG8_SCHED __builtin_amdgcn_sched_barrier(0)
    Unit cur, nxt; int ui = 0;
    if (!S.next(0, cur)) return;
    f32x4 acc[2][2][4][2]; f32x4 bini[2][2];
#pragma unroll
    for (int b = 0; b < 2; ++b)
#pragma unroll
        for (int n = 0; n < 2; ++n) bini[b][n] = Epi::BIAS_INIT ? E.bias4(cur, b, n, wc, fq) : (f32x4){0.f, 0.f, 0.f, 0.f};
#pragma unroll
    for (int a = 0; a < 2; ++a)
#pragma unroll
        for (int b = 0; b < 2; ++b)
#pragma unroll
            for (int m = 0; m < 4; ++m)
#pragma unroll
                for (int n = 0; n < 2; ++n) acc[a][b][m][n] = bini[b][n];
    bf16x8 At[4][2], B0[2][2], B1[2][2];
    unsigned oA[2][2];
#pragma unroll
    for (int h = 0; h < 2; ++h)
#pragma unroll
        for (int i = 0; i < 2; ++i) oA[h][i] = (unsigned)(S.a_row(cur, h, RA[i]) * ROWB + CA[i]);
    const char* cB = Bbase + (size_t)S.b_row(cur) * ROWB;
    const char* cA = Abase;
    PG8_STAGE(PG8_SB(0, 0), cB, voffB); PG8_STAGE(PG8_SA(0, 0), cA, oA[0]); PG8_STAGE(PG8_SB(0, 1), cB + hstep, voffB); PG8_STAGE(PG8_SA(0, 1), cA, oA[1]);
    if (wr == 1) PG8_BAR;
    PG8_WAIT_V(4); PG8_BAR;
    PG8_STAGE(PG8_SB(1, 0), cB + kstep, voffB); PG8_STAGE(PG8_SA(1, 0), cA + kstep, oA[0]); PG8_STAGE(PG8_SB(1, 1), cB + hstep + kstep, voffB);
    PG8_WAIT_V(6); PG8_BAR;
    for (;;) {
        const bool has_next = S.next(ui + 1, nxt);
        const char* nB = has_next ? Bbase + (size_t)S.b_row(nxt) * ROWB : cB;
        for (int t = 0; t < nt; t += 2) {
            const bool last = (t == nt - 2);
            const char* a1 = cA + (size_t)(t + 1) * kstep;
            const char* a2 = last ? cA : cA + (size_t)(t + 2) * kstep; const char* b2 = last ? nB : cB + (size_t)(t + 2) * kstep;
            const char* a3 = a2 + kstep; const char* b3 = b2 + kstep;
            PG8_LDB(B0, 0, 0); PG8_SCHED; PG8_LDA(At, 0, 0); PG8_STAGE(PG8_SA(1, 1), a1, oA[1]);
            if (last && has_next) {
#pragma unroll
                for (int h = 0; h < 2; ++h)
#pragma unroll
                    for (int i = 0; i < 2; ++i) oA[h][i] = (unsigned)(S.a_row(nxt, h, RA[i]) * ROWB + CA[i]);
            }
            PG8_WAIT_L(8); PG8_BAR; PG8_WAIT_L(0); PG8_MMA(0, 0, At, B0); PG8_BAR; PG8_SCHED;
            PG8_LDB(B1, 0, 1); PG8_STAGE(PG8_SB(0, 0), b2, voffB);
            PG8_BAR; PG8_WAIT_L(0); PG8_MMA(0, 1, At, B1); PG8_BAR;
            PG8_LDA(At, 0, 1); PG8_STAGE(PG8_SA(0, 0), a2, oA[0]);
            PG8_BAR; PG8_WAIT_L(0); PG8_MMA(1, 0, At, B0); PG8_BAR; PG8_SCHED;
            PG8_STAGE(PG8_SB(0, 1), b2 + hstep, voffB);
            PG8_WAIT_V(6); PG8_BAR; PG8_MMA(1, 1, At, B1); PG8_BAR;
            PG8_LDB(B0, 1, 0); PG8_SCHED; PG8_LDA(At, 1, 0); PG8_STAGE(PG8_SA(0, 1), a2, oA[1]);
            PG8_WAIT_L(8); PG8_BAR; PG8_WAIT_L(0); PG8_MMA(0, 0, At, B0); PG8_BAR; PG8_SCHED;
            PG8_LDB(B1, 1, 1); PG8_STAGE(PG8_SB(1, 0), b3, voffB);
            PG8_BAR; PG8_WAIT_L(0); PG8_MMA(0, 1, At, B1); PG8_BAR;
            PG8_LDA(At, 1, 1); PG8_STAGE(PG8_SA(1, 0), a3, oA[0]);
            PG8_BAR; PG8_WAIT_L(0); PG8_MMA(1, 0, At, B0); PG8_BAR; PG8_SCHED;
            PG8_STAGE(PG8_SB(1, 1), b3 + hstep, voffB);
            PG8_WAIT_V(6); PG8_BAR; PG8_MMA(1, 1, At, B1); PG8_BAR;
        }
        int l2 = threadIdx.x & 63; asm volatile("" : "+v"(l2));
        const int fr2 = l2 & 15, fq2 = l2 >> 4;
        if (Epi::BIAS_INIT && has_next) {
#pragma unroll
            for (int b = 0; b < 2; ++b)
#pragma unroll
                for (int n = 0; n < 2; ++n) bini[b][n] = E.bias4(nxt, b, n, wc, fq2);
        }
        E(acc, cur, wr, wc, fr2, fq2);
        if (!has_next) break;
#pragma unroll
        for (int a = 0; a < 2; ++a)
#pragma unroll
            for (int b = 0; b < 2; ++b)
#pragma unroll
                for (int m = 0; m < 4; ++m)
#pragma unroll
                    for (int n = 0; n < 2; ++n) acc[a][b][m][n] = bini[b][n];
        cur = nxt; cB = nB; ++ui;
    }
    PG8_WAIT_V(0);
    if (wr == 0) PG8_BAR;
    PG8_BAR;
#undef PG8_SA
#undef PG8_SB
#undef PG8_STAGE
#undef PG8_LDA
#undef PG8_LDB
#undef PG8_MMA
#undef PG8_WAIT_V
#undef PG8_WAIT_L
#undef PG8_BAR
#undef PG8_SCHED
}
}

struct EpiInProj {
    static constexpr bool PERM = true, BIAS_INIT = false;
    bf16_t *u, *q, *k, *v, *iq, *ik; float* iw; const float* ropeQK; const float* ropeIX;
    __device__ __forceinline__ f32x4 bias4(const pg8::Unit&, int, int, int, int) const { return (f32x4){0.f, 0.f, 0.f, 0.f}; }
    __device__ __forceinline__ void operator()(f32x4 (&acc)[2][2][4][2], const pg8::Unit& un, int wr, int wc, int fr, int fq) const {
        const int lane = threadIdx.x & 63;
#pragma unroll
        for (int bj = 0; bj < 2; ++bj) {
            const int gc = un.e * 256 + bj * 128;
            bf16_t* dst; int ld; int kind = 0;
            const int cin = wc * 32 + 8 * fq;
            if (gc < 256) { dst = u + gc + cin; ld = 256; }
            else if (gc < 1024) { dst = q + (gc - 256) + cin; ld = 768; kind = (wc == 0) ? 1 : 0; }
            else if (gc < 1280) { dst = k + (gc - 1024) + cin; ld = 256; kind = (wc == 0) ? 1 : 0; }
            else if (gc < 1536) { dst = v + (gc - 1280) + cin; ld = 256; }
            else if (gc < 2048) { dst = iq + (gc - 1536) + cin; ld = 512; kind = ((wc & 1) == 0) ? 2 : 0; }
            else if (gc == 2048) { if (wc >= 2) { if (wc == 2 && fq == 0) {
#pragma unroll
                        for (int ai = 0; ai < 2; ++ai)
#pragma unroll
                            for (int m = 0; m < 4; ++m) { const int row = un.pm * 256 + ai * 128 + wr * 64 + m * 16 + fr;
                                *(f32x4*)(iw + (size_t)row * 8) = acc[ai][bj][m][0]; *(f32x4*)(iw + (size_t)row * 8 + 4) = acc[ai][bj][m][1]; } }
                    continue; }
                dst = ik + cin; ld = 64; kind = (wc == 0) ? 2 : 0; }
            else continue;
#pragma unroll
            for (int ai = 0; ai < 2; ++ai)
#pragma unroll
                for (int m = 0; m < 4; ++m) {
                    const int row = un.pm * 256 + ai * 128 + wr * 64 + m * 16 + fr;
                    f32x4 v0 = acc[ai][bj][m][0], v1 = acc[ai][bj][m][1];
                    if (kind == 1) {
                        const float* rp = ropeQK + (size_t)row * 32 + 8 * (fq & 1);
                        const f32x4 c0 = *(const f32x4*)rp, c1 = *(const f32x4*)(rp + 4), s0 = *(const f32x4*)(rp + 16), s1 = *(const f32x4*)(rp + 20);
                        f32x4 p0, p1;
#pragma unroll
                        for (int j = 0; j < 4; ++j) { p0[j] = __shfl_xor(v0[j], 32); p1[j] = __shfl_xor(v1[j], 32); }
                        const float sg = (fq < 2) ? -1.f : 1.f;
                        v0 = v0 * c0 + sg * (p0 * s0); v1 = v1 * c1 + sg * (p1 * s1);
                    } else if (kind == 2) {
                        const float* rp = ropeIX + (size_t)row * 16;
                        const f32x4 c0 = *(const f32x4*)rp, c1 = *(const f32x4*)(rp + 4), s0 = *(const f32x4*)(rp + 8), s1 = *(const f32x4*)(rp + 12);
                        f32x4 p0, p1;
#pragma unroll
                        for (int j = 0; j < 4; ++j) { p0[j] = __shfl_xor(v0[j], 16); p1[j] = __shfl_xor(v1[j], 16); }
                        if (fq < 2) { const float sg = (fq == 0) ? -1.f : 1.f; v0 = v0 * c0 + sg * (p0 * s0); v1 = v1 * c1 + sg * (p1 * s1); }
                    }
                    u32x4 w; w.x = cvt_pk_bf16(v0[0], v0[1]); w.y = cvt_pk_bf16(v0[2], v0[3]); w.z = cvt_pk_bf16(v1[0], v1[1]); w.w = cvt_pk_bf16(v1[2], v1[3]);
                    *(u32x4*)(dst + (size_t)row * ld) = w;
                }
        }
        (void)lane;
    }
};
struct EpiMix {
    static constexpr bool PERM = true, BIAS_INIT = false;
    bf16_t* mix;
    __device__ __forceinline__ f32x4 bias4(const pg8::Unit&, int, int, int, int) const { return (f32x4){0.f, 0.f, 0.f, 0.f}; }
    __device__ __forceinline__ void operator()(f32x4 (&acc)[2][2][4][2], const pg8::Unit& un, int wr, int wc, int fr, int fq) const {
        const int row0 = un.pm * 256 + wr * 64 + fr, col0 = un.pn * 256 + wc * 32 + 8 * fq;
#pragma unroll
        for (int bj = 0; bj < 2; ++bj)
#pragma unroll
            for (int ai = 0; ai < 2; ++ai)
#pragma unroll
                for (int m = 0; m < 4; ++m) {
                    const f32x4 v0 = acc[ai][bj][m][0], v1 = acc[ai][bj][m][1];
                    u32x4 w; w.x = cvt_pk_bf16(v0[0], v0[1]); w.y = cvt_pk_bf16(v0[2], v0[3]); w.z = cvt_pk_bf16(v1[0], v1[1]); w.w = cvt_pk_bf16(v1[2], v1[3]);
                    *(u32x4*)(mix + (size_t)(row0 + ai * 128 + m * 16) * 1024 + col0 + bj * 128) = w;
                }
    }
};
struct EpiGateUp {
    static constexpr bool PERM = true, BIAS_INIT = true;
    unsigned char* act; const float* bias; unsigned* rdy;
    __device__ __forceinline__ f32x4 bias4(const pg8::Unit& un, int bj, int n, int wc, int fq) const { return *(const f32x4*)(bias + (size_t)un.e * 2048 + bj * 1024 + un.pn * 128 + wc * 32 + 8 * fq + 4 * n); }
    __device__ __forceinline__ void operator()(f32x4 (&acc)[2][2][4][2], const pg8::Unit& un, int wr, int wc, int fr, int fq) const {
        const int row0 = un.pm * 256 + wr * 64 + fr, col0 = un.pn * 128 + wc * 32 + 8 * fq;
#pragma unroll
        for (int ai = 0; ai < 2; ++ai)
#pragma unroll
            for (int m = 0; m < 4; ++m) {
                float o[8];
#pragma unroll
                for (int n = 0; n < 2; ++n) {
                    const f32x4 gt = acc[ai][0][m][n], up = acc[ai][1][m][n];
#pragma unroll
                    for (int j = 0; j < 4; ++j) {
                        const float gg = __builtin_amdgcn_fmed3f(gt[j], -INFINITY, 7.0f), uu = __builtin_amdgcn_fmed3f(up[j], -7.0f, 7.0f);
                        const float sig = __builtin_amdgcn_rcpf(1.0f + __builtin_amdgcn_exp2f(-1.702f * 1.4426950408889634f * gg));
                        o[4 * n + j] = (uu * 8.0f + 8.0f) * gg * sig;
                    }
                }
                u32x2 w; w.x = pk4_fp8(o[0], o[1], o[2], o[3]); w.y = pk4_fp8(o[4], o[5], o[6], o[7]);
                const unsigned dofs = (unsigned)((row0 + ai * 128 + m * 16) * 1024 + col0);
                if (un.pm < 32) asm volatile("global_store_dwordx2 %0, %1, %2 sc1" :: "v"(dofs), "v"(w), "s"(act) : "memory");
                else *(u32x2*)(act + dofs) = w;
            }
        if (un.pm < 32) {
            asm volatile("s_waitcnt vmcnt(0)" ::: "memory");
            if ((threadIdx.x & 63) == 0) __hip_atomic_fetch_add(rdy + un.pm, 1u, __ATOMIC_RELAXED, __HIP_MEMORY_SCOPE_AGENT);
        }
    }
};
struct EpiDown {
    static constexpr bool PERM = true, BIAS_INIT = false;
    unsigned char* y; const float* bias;
    __device__ __forceinline__ f32x4 bias4(const pg8::Unit& un, int bj, int n, int wc, int fq) const { return *(const f32x4*)(bias + (size_t)un.e * 1024 + un.pn * 256 + bj * 128 + wc * 32 + 8 * fq + 4 * n); }
    __device__ __forceinline__ void operator()(f32x4 (&acc)[2][2][4][2], const pg8::Unit& un, int wr, int wc, int fr, int fq) const {
        const int row0 = un.pm * 256 + wr * 64 + fr, col0 = un.pn * 256 + wc * 32 + 8 * fq;
        const float* bp = bias + (size_t)un.e * 1024 + col0;
#pragma unroll
        for (int bj = 0; bj < 2; ++bj) {
            const f32x4 b0 = *(const f32x4*)(bp + bj * 128) * 64.0f, b1 = *(const f32x4*)(bp + bj * 128 + 4) * 64.0f;
#pragma unroll
            for (int ai = 0; ai < 2; ++ai)
#pragma unroll
                for (int m = 0; m < 4; ++m) {
                    const f32x4 v0 = acc[ai][bj][m][0] * 64.0f + b0, v1 = acc[ai][bj][m][1] * 64.0f + b1;
#define CL8(x) __builtin_amdgcn_fmed3f((x), -448.f, 448.f)
                    u32x2 w; w.x = pk4_fp8(CL8(v0[0]), CL8(v0[1]), CL8(v0[2]), CL8(v0[3])); w.y = pk4_fp8(CL8(v1[0]), CL8(v1[1]), CL8(v1[2]), CL8(v1[3]));
#undef CL8
                    *(u32x2*)(y + (size_t)(row0 + ai * 128 + m * 16) * 1024 + col0 + bj * 128) = w;
                }
        }
    }
};

struct Args { const void* in[18]; float* out; unsigned char* ws; int ph_lo, ph_hi; };
struct Frame {
    LAS unsigned char* lds; int tid, lane, wave, G, bid;
    const float *x, *ln_in_g, *ln_in_b, *w_in, *w_pool, *pool_scale, *w_out, *ln1_g, *ln1_b, *w_router, *b_router, *w_gu, *b_gu, *w_dn, *b_dn, *ln2_g, *ln2_b;
    const int* positions; float* out; unsigned char* ws; unsigned* ctl;
};

typedef const Args __attribute__((address_space(4))) * KArgP;
__device__ __forceinline__ void frame_refresh(Frame& F) {
    KArgP ap = (KArgP)__builtin_amdgcn_kernarg_segment_ptr(); asm volatile("" : "+s"(ap));
    int t_ = threadIdx.x; asm volatile("" : "+v"(t_)); F.tid = t_; F.lane = t_ & 63;
    F.x = (const float*)ap->in[0]; F.positions = (const int*)ap->in[1]; F.ln_in_g = (const float*)ap->in[2]; F.ln_in_b = (const float*)ap->in[3];
    F.w_in = (const float*)ap->in[4]; F.w_pool = (const float*)ap->in[5]; F.pool_scale = (const float*)ap->in[6]; F.w_out = (const float*)ap->in[7];
    F.ln1_g = (const float*)ap->in[8]; F.ln1_b = (const float*)ap->in[9]; F.w_router = (const float*)ap->in[10]; F.b_router = (const float*)ap->in[11];
    F.w_gu = (const float*)ap->in[12]; F.b_gu = (const float*)ap->in[13]; F.w_dn = (const float*)ap->in[14]; F.b_dn = (const float*)ap->in[15];
    F.ln2_g = (const float*)ap->in[16]; F.ln2_b = (const float*)ap->in[17];
    F.out = ap->out; F.ws = ap->ws; F.ctl = (unsigned*)(ap->ws + WS_CTL);
}
struct TrItem { const float* src; unsigned char* dst; int ldw, ldt, fp8; };
__device__ __forceinline__ TrItem mk_item(const float* W, unsigned char* WT, int ldw, int k0, int n0, int ldt, int drow0, int fp8) {
    TrItem t; t.src = W + (size_t)k0 * ldw + n0; t.dst = WT + ((size_t)drow0 * ldt + k0) * (fp8 ? 1 : 2); t.ldw = ldw; t.ldt = ldt; t.fp8 = fp8; return t;
}
__device__ __forceinline__ void tr_load(const TrItem& t, float (&tmp)[32], int lane) {
    if (t.fp8) {
        const float* p = t.src + (size_t)(lane >> 3) * t.ldw + (lane & 7) * 4;
#pragma unroll
        for (int j = 0; j < 8; ++j) { const f32x4 v = __builtin_nontemporal_load((const f32x4*)(p + (size_t)(8 * j) * t.ldw)); tmp[4 * j] = v.x; tmp[4 * j + 1] = v.y; tmp[4 * j + 2] = v.z; tmp[4 * j + 3] = v.w; }
    } else {
        const float* p = t.src + (size_t)(lane >> 5) * t.ldw + (lane & 31);
#pragma unroll
        for (int i = 0; i < 32; ++i) tmp[i] = __builtin_nontemporal_load(p + (size_t)(2 * i) * t.ldw);
    }
}
__device__ __forceinline__ void tr_store(const TrItem& t, const float (&tmp)[32], LAS float* scr, int lane) {
    if (t.fp8) {
#pragma unroll
        for (int j = 0; j < 8; ++j) *(LAS f32x4*)(scr + (8 * j + (lane >> 3)) * 32 + (lane & 7) * 4) = (f32x4){tmp[4 * j], tmp[4 * j + 1], tmp[4 * j + 2], tmp[4 * j + 3]};
        LDS_WAIT();
        const int n = lane >> 1, kb = 32 * (lane & 1); const LAS float* sp = scr + kb * 32 + n;
        unsigned o[8];
#pragma unroll
        for (int q = 0; q < 8; ++q) { float v[4];
#pragma unroll
            for (int j = 0; j < 4; ++j) v[j] = __builtin_amdgcn_fmed3f(sp[(4 * q + j) * 32] * 64.0f, -448.f, 448.f);
            o[q] = pk4_fp8(v[0], v[1], v[2], v[3]); }
        unsigned char* dp = t.dst + (size_t)n * 1024 + kb;
        *(u32x4*)dp = (u32x4){o[0], o[1], o[2], o[3]}; *(u32x4*)(dp + 16) = (u32x4){o[4], o[5], o[6], o[7]};
    } else {
#pragma unroll
        for (int i = 0; i < 32; ++i) { const int kk = 2 * i + (lane >> 5); scr[kk * 33 + (lane & 31)] = tmp[i]; }
        LDS_WAIT();
        const int c = lane & 7;
#pragma unroll
        for (int j = 0; j < 4; ++j) { const int n = (lane >> 3) + 8 * j; const LAS float* sp = scr + (8 * c) * 33 + n;
            u32x4 o; o.x = cvt_pk_bf16(sp[0 * 33], sp[1 * 33]); o.y = cvt_pk_bf16(sp[2 * 33], sp[3 * 33]); o.z = cvt_pk_bf16(sp[4 * 33], sp[5 * 33]); o.w = cvt_pk_bf16(sp[6 * 33], sp[7 * 33]);
            *(u32x4*)(t.dst + ((size_t)n * t.ldt + 8 * c) * 2) = o; }
    }
    LDS_WAIT();
}
__device__ __forceinline__ TrItem moe_item(Frame& F, int r) {
    constexpr int I_GU = NE * 16 * 64;
    if (r < I_GU) { const int e = r / 1024, rr = r % 1024, kb = rr / 64, nb = rr % 64, n0 = 32 * nb, bj = n0 / 1024, rem = n0 % 1024, pn = rem / 128, j0 = rem % 128;
        return mk_item(F.w_gu + (size_t)e * 1024 * 2048, F.ws + WS_BTGU + (size_t)e * 2048 * 1024, 2048, 64 * kb, n0, 1024, pn * 256 + bj * 128 + j0, 1); }
    r -= I_GU; const int e = r / 512, rr = r % 512, kb = rr / 32, nb = rr % 32;
    return mk_item(F.w_dn + (size_t)e * 1024 * 1024, F.ws + WS_BTDN + (size_t)e * 1024 * 1024, 1024, 64 * kb, 32 * nb, 1024, 32 * nb, 1);
}
__device__ __forceinline__ void convert_range(Frame& F, int first, int n, int widx, int nw) {
    LAS float* scr = (LAS float*)(F.lds + F.wave * 16384);
    int base = 2 * widx; if (base >= n) return;
    float va[32], vb[32], vc[32], vd[32];
    TrItem ta = moe_item(F, first + base), tb = moe_item(F, first + base + 1);
    tr_load(ta, va, F.lane); tr_load(tb, vb, F.lane);
    for (;;) {
        const int nb = base + 2 * nw; const bool more = nb < n;
        const TrItem tc = moe_item(F, first + (more ? nb : base)), td = moe_item(F, first + (more ? nb : base) + 1);
        if (more) { tr_load(tc, vc, F.lane); tr_load(td, vd, F.lane); }
        tr_store(ta, va, scr, F.lane); tr_store(tb, vb, scr, F.lane);
        if (!more) break;
        const int nb2 = nb + 2 * nw; const bool more2 = nb2 < n;
        ta = moe_item(F, first + (more2 ? nb2 : nb)); tb = moe_item(F, first + (more2 ? nb2 : nb) + 1);
        if (more2) { tr_load(ta, va, F.lane); tr_load(tb, vb, F.lane); }
        tr_store(tc, vc, scr, F.lane); tr_store(td, vd, scr, F.lane);
        if (!more2) break;
        base = nb2;
    }
}
__device__ __forceinline__ void cvq_pull(Frame& F, unsigned* head, int first, int npairs) {
    LAS float* scr = (LAS float*)(F.lds + F.wave * 16384);
    for (;;) {
        unsigned c = 0; if (F.lane == 0) c = __hip_atomic_fetch_add(head, 1u, __ATOMIC_RELAXED, __HIP_MEMORY_SCOPE_AGENT);
        c = (unsigned)__builtin_amdgcn_readfirstlane((int)c);
        if (c >= (unsigned)npairs) break;
        const int r = 2 * (first + (int)c);
        const TrItem ta = moe_item(F, r), tb = moe_item(F, r + 1);
        float va[32], vb[32];
        tr_load(ta, va, F.lane); tr_load(tb, vb, F.lane);
        tr_store(ta, va, scr, F.lane); tr_store(tb, vb, scr, F.lane);
    }
}
__constant__ double ROPE_QK_FREQ[16] = {1.0, 0.44036660267178046, 0.19392274474868576, 0.08539710028576561, 0.03760603093086393, 0.016560440080994446, 0.007292664737217109, 0.003211445994752591,
    0.001414213562373095, 0.000622772421914596, 0.0002742481756762073, 0.00012076973741146504, 5.318295896944988e-05, 2.341999896140934e-05, 1.031338537721246e-05, 4.5416704806078695e-06};
__constant__ double ROPE_IX_FREQ[8] = {1.0, 0.19392274474868576, 0.03760603093086393, 0.007292664737217109, 0.001414213562373095, 0.0002742481756762073, 5.318295896944988e-05, 1.031338537721246e-05};

__device__ __forceinline__ void p0_prologue(Frame& F) {
    LAS float* scr = (LAS float*)(F.lds + F.wave * 16384);
    const int gw = F.bid * 8 + F.wave, NGW = F.G * 8;
    const int gt = F.bid * NTHREADS + F.tid, NGT = F.G * NTHREADS;
    bf16_t* BtIn = (bf16_t*)(F.ws + WS_BTIN); bf16_t* BtOut = (bf16_t*)(F.ws + WS_BTOUT);
    bf16_t* WpT = (bf16_t*)(F.ws + WS_WPT);
    constexpr int I_IN = 16 * 66, I_OUT = 16 * 32, I_POOL = 8, I_MOE = NE * 16 * 64 + NE * 16 * 32;
    constexpr int NSMALL = I_IN + I_OUT + I_POOL, NITEMS = NSMALL + (I_MOE - CV_HIDDEN);
    auto decode = [&](int it) -> TrItem {
        int r = it;
        if (r < I_IN) { const int kb = r / 66, nb = r % 66;
            if (nb >= 8 && nb < 48) return mk_item(F.w_in, F.ws + WS_BTIN8, INW, 64 * kb, 32 * nb, 1024, 32 * nb, 1);
            return mk_item(F.w_in, (unsigned char*)BtIn, INW, 64 * kb, 32 * nb, 1024, 32 * nb, 0); } r -= I_IN;
        if (r < I_OUT) { const int kb = r / 32, nb = r % 32; return mk_item(F.w_out, (unsigned char*)BtOut, 1024, 64 * kb, 32 * nb, 1024, 32 * nb, 0); } r -= I_OUT;
        if (r < I_POOL) { const int g = r / 2, nb = r % 2; return mk_item(F.w_pool + g * 4096, (unsigned char*)(WpT + g * 4096), 64, 0, 32 * nb, 64, 32 * nb, 0); } r -= I_POOL;
        return moe_item(F, CV_HIDDEN + r);
    };
    for (int it = gw; it < NITEMS; it += 2 * NGW) {
        const bool two = (it + NGW < NITEMS);
        const TrItem ta = decode(it), tb = decode(two ? it + NGW : it);
        float va[32], vb[32];
        tr_load(ta, va, F.lane); if (two) tr_load(tb, vb, F.lane);
        tr_store(ta, va, scr, F.lane); if (two) tr_store(tb, vb, scr, F.lane);
    }
    for (int i = gt; i < 192 * 1024; i += NGT) { const int n = 2112 + i / 1024, k = i % 1024; const float v = (n < INW) ? F.w_in[(size_t)k * INW + n] : 0.f;
        BtIn[(size_t)n * 1024 + k] = (bf16_t)(cvt_pk_bf16(v, 0.f) & 0xffffu); }
    { float* wrA = (float*)(F.ws + WS_WRA);
      for (int i = gt; i < 32768; i += NGT) { const int ii = i & 3, e = (i >> 2) & 31, kh = (i >> 7) & 1, c = i >> 8; wrA[i] = F.w_router[(8 * c + 4 * kh + ii) * 32 + e]; } }
    { float* rq = (float*)(F.ws + WS_ROPEQK); float* ri = (float*)(F.ws + WS_ROPEIX);
      for (int i = gt; i < T * 24; i += NGT) { const int tok = i / 24, j = i % 24; const double pos = (double)F.positions[tok];
          const double inv = (j < 16) ? ROPE_QK_FREQ[j] : ROPE_IX_FREQ[j - 16];
          double rev = pos * inv * 0.15915494309189535; rev -= __builtin_floor(rev);
          const float c = __builtin_amdgcn_cosf((float)rev), s = __builtin_amdgcn_sinf((float)rev);
          if (j < 16) { rq[(size_t)tok * 32 + j] = c; rq[(size_t)tok * 32 + 16 + j] = s; } else { ri[(size_t)tok * 16 + (j - 16)] = c; ri[(size_t)tok * 16 + 8 + (j - 16)] = s; } } }
    if (F.bid == 0 && F.tid < 64) { F.ctl[CW_CNT + F.tid] = 0u; if (F.tid == 0) F.ctl[CW_ATTQ] = 0u; }
    { bf16_t* hA = (bf16_t*)(F.ws + WS_HA); float* stats = (float*)(F.ws + WS_STATS);
      f32x4 gv[4], bv[4];
#pragma unroll
      for (int j = 0; j < 4; ++j) { gv[j] = ((const f32x4*)F.ln_in_g)[F.lane + 64 * j]; bv[j] = ((const f32x4*)F.ln_in_b)[F.lane + 64 * j]; }
      f32x4 nx[4];
      if (gw < T) { const f32x4* xr = (const f32x4*)(F.x + (size_t)gw * 1024) + F.lane;
#pragma unroll
          for (int j = 0; j < 4; ++j) nx[j] = __builtin_nontemporal_load(xr + 64 * j); }
      for (int m = gw; m < T; m += NGW) {
          f32x4 v[4]; float s = 0.f;
#pragma unroll
          for (int j = 0; j < 4; ++j) { v[j] = nx[j]; s += (v[j].x + v[j].y) + (v[j].z + v[j].w); }
          if (m + NGW < T) { const f32x4* xr = (const f32x4*)(F.x + (size_t)(m + NGW) * 1024) + F.lane;
#pragma unroll
              for (int j = 0; j < 4; ++j) nx[j] = __builtin_nontemporal_load(xr + 64 * j); }
          const float mean = wave_sum(s) * (1.f / 1024.f); float s2 = 0.f;
#pragma unroll
          for (int j = 0; j < 4; ++j) { v[j] = v[j] - mean; s2 += (v[j].x * v[j].x + v[j].y * v[j].y) + (v[j].z * v[j].z + v[j].w * v[j].w); }
          const float rstd = 1.f / sqrtf(wave_sum(s2) * (1.f / 1024.f) + LN_EPS);
          u32x2* o8 = (u32x2*)(hA + (size_t)m * 1024) + F.lane; unsigned* q8 = (unsigned*)(F.ws + WS_HA8 + (size_t)m * 1024) + F.lane;
#pragma unroll
          for (int j = 0; j < 4; ++j) { const f32x4 h = v[j] * rstd * gv[j] + bv[j]; u32x2 w; w.x = cvt_pk_bf16(h.x, h.y); w.y = cvt_pk_bf16(h.z, h.w); o8[64 * j] = w; q8[64 * j] = pk4_fp8(h.x, h.y, h.z, h.w); }
          if (F.lane == 0) { stats[(size_t)m * 2] = mean; stats[(size_t)m * 2 + 1] = rstd; }
      } }
}

__device__ __forceinline__ void p2_pool(Frame& F) {
    const bf16_t* U = (const bf16_t*)(F.ws + WS_U); const bf16_t* WpT = (const bf16_t*)(F.ws + WS_WPT); bf16_t* cat = (bf16_t*)(F.ws + WS_CAT);
    LAS bf16_t* dl = (LAS bf16_t*)F.lds;
    LAS bf16_t* ul = (LAS bf16_t*)(F.lds + 33792);
    for (int tile = F.bid; tile < T / 64; tile += F.G) {
        const int t0 = tile * 64, pos0 = t0 % SEQ;
        __syncthreads();
        for (int i = F.tid; i < 79 * 32; i += NTHREADS) { const int r = i >> 5, c8 = i & 31; u32x4 v = {0u, 0u, 0u, 0u};
            if (pos0 + r - 15 >= 0) v = *(const u32x4*)(U + (size_t)(t0 + r - 15) * 256 + c8 * 8);
            *(LAS u32x4*)(ul + r * 256 + c8 * 8) = v; }
        __syncthreads();
        { const int c = F.tid & 255, half = F.tid >> 8, w = 2 << (c >> 6);
          const int ts = half * 32; float sum = 0.f;
          for (int d = 1; d < w; ++d) sum += __uint_as_float((unsigned)ul[(15 + ts - d) * 256 + c] << 16);
#pragma unroll 4
          for (int tt = 0; tt < 32; ++tt) { const int tl = ts + tt, p = pos0 + tl; const float cur = __uint_as_float((unsigned)ul[(15 + tl) * 256 + c] << 16);
              sum += cur; const int cnt = (p + 1 < w) ? (p + 1) : w;
              const float diff = sum / (float)cnt - cur;
              dl[tl * 264 + c] = (bf16_t)(cvt_pk_bf16(diff, 0.f) & 0xffffu);
              sum -= __uint_as_float((unsigned)ul[(15 + tl - (w - 1)) * 256 + c] << 16); } }
        __syncthreads();
        { const int g = F.wave & 3, th = F.wave >> 2, r32 = F.lane & 31, hi = F.lane >> 5;
          f32x16 c0 = {}, c1 = {};
#pragma unroll
          for (int s = 0; s < 4; ++s) {
              const bf16x8 a = *(const LAS bf16x8*)(dl + (th * 32 + r32) * 264 + g * 64 + 16 * s + 8 * hi);
              const bf16x8 b0 = *(const bf16x8*)(WpT + (size_t)g * 4096 + (size_t)r32 * 64 + 16 * s + 8 * hi);
              const bf16x8 b1 = *(const bf16x8*)(WpT + (size_t)g * 4096 + (size_t)(32 + r32) * 64 + 16 * s + 8 * hi);
              c0 = __builtin_amdgcn_mfma_f32_32x32x16_bf16(a, b0, c0, 0, 0, 0);
              c1 = __builtin_amdgcn_mfma_f32_32x32x16_bf16(a, b1, c1, 0, 0, 0); }
          const float ps0 = F.pool_scale[g * 64 + r32], ps1 = F.pool_scale[g * 64 + 32 + r32];
#pragma unroll
          for (int r = 0; r < 16; ++r) { const int tok = t0 + th * 32 + crow(r, hi);
              cat[(size_t)tok * 1024 + g * 64 + r32] = (bf16_t)(cvt_pk_bf16(c0[r] * ps0, 0.f) & 0xffffu);
              cat[(size_t)tok * 1024 + g * 64 + 32 + r32] = (bf16_t)(cvt_pk_bf16(c1[r] * ps1, 0.f) & 0xffffu); } }
    }
    __syncthreads();
}

constexpr int IDX_RING_OFF = 0, IDX_SLOT = 32768;
constexpr int IDX_HIST_OFF = 3 * IDX_SLOT;
constexpr int IDX_RES_OFF = IDX_HIST_OFF + 24576;
__device__ __forceinline__ void hist_find16(const LAS unsigned* hist, int li, unsigned need, unsigned& bsel, unsigned& above) {
    const u32x4 h0 = *(const LAS u32x4*)(hist + 4 * li);
    const unsigned c[8] = {h0.x & 0xffffu, h0.x >> 16, h0.y & 0xffffu, h0.y >> 16, h0.z & 0xffffu, h0.z >> 16, h0.w & 0xffffu, h0.w >> 16};
    unsigned s = 0;
#pragma unroll
    for (int k = 0; k < 8; ++k) s += c[k];
    unsigned S = s;
#pragma unroll
    for (int d = 1; d < 32; d <<= 1) { const unsigned o = __shfl_down(S, d, 32); if (li + d < 32) S += o; }
    const unsigned excl = S - s;
    unsigned b = 0xffffffffu, ab = 0;
    if (excl < need && need <= S) { unsigned cum = excl; bool found = false;
#pragma unroll
        for (int k = 7; k >= 0; --k) { if (!found && cum + c[k] >= need) { b = 8 * li + k; ab = cum; found = true; } if (!found) cum += c[k]; } }
    const unsigned long long bal = __ballot(b != 0xffffffffu);
    const unsigned halfmask = (unsigned)((threadIdx.x & 32) ? (bal >> 32) : (bal & 0xffffffffull));
    const int src = (halfmask ? (__ffs(halfmask) - 1) : 0) + (threadIdx.x & 32);
    bsel = __shfl(b, src, 64); above = __shfl(ab, src, 64);
    if (!halfmask) { bsel = 0; above = 0; }
}
template <int J> __device__ __forceinline__ void wlane(unsigned& m, unsigned v) { asm volatile("v_writelane_b32 %0, %1, %2" : "+v"(m) : "s"(v), "n"(J)); }
template <int J> __device__ __forceinline__ void mask_emit_step(const unsigned (&k0)[32], const unsigned (&k1)[32], unsigned T0, unsigned T1, int kh, int ntiles, unsigned& m0, unsigned& m1, unsigned& m2, unsigned& m3) {
    if (2 * J + kh < ntiles) {
        const unsigned long long ba = __ballot(k0[J] >= T0), bc = __ballot(k1[J] >= T1);
        wlane<J>(m0, (unsigned)ba); wlane<J>(m2, (unsigned)(ba >> 32)); wlane<J>(m1, (unsigned)bc); wlane<J>(m3, (unsigned)(bc >> 32));
    }
}
template <int... Js> __device__ __forceinline__ void mask_emit(std::integer_sequence<int, Js...>, const unsigned (&k0)[32], const unsigned (&k1)[32], unsigned T0, unsigned T1, int kh, int ntiles, unsigned& m0, unsigned& m1, unsigned& m2, unsigned& m3) {
    (mask_emit_step<Js>(k0, k1, T0, T1, kh, ntiles, m0, m1, m2, m3), ...);
}
__device__ __forceinline__ void p2_indexer_unit(Frame& F, int b, int qb) {
    const bf16_t* IQ = (const bf16_t*)(F.ws + WS_IQ); const bf16_t* IK = (const bf16_t*)(F.ws + WS_IK); const float* IW = (const float*)(F.ws + WS_IW);
    unsigned* MASK = (unsigned*)(F.ws + WS_MASK);
    const int qg = F.wave & 3, kh = F.wave >> 2;
    LAS unsigned* hist = (LAS unsigned*)(F.lds + IDX_HIST_OFF) + qg * 4 * 384;
    LAS float* mm = (LAS float*)(F.lds + IDX_RES_OFF);
    const int lane = F.lane, r32 = lane & 31, hi = lane >> 5;
    const int p0 = qb * 16 + qg * 4;
    const int tq0 = b * SEQ + p0;
    const int ntiles = (qb >> 1) + 1;
    const int nch = (ntiles + 7) >> 3;
    const char* ikb = (const char*)(IK + (size_t)b * SEQ * 64);
    unsigned dsrc[4];
#pragma unroll
    for (int i = 0; i < 4; ++i) { const int row = F.wave * 32 + i * 8 + (lane >> 3), pos = lane & 7; dsrc[i] = (unsigned)(row * 128 + ((pos ^ ((row >> 1) & 7)) << 4)); }
#define IDX_ISSUE(ch) do { _Pragma("unroll") for (int i_ = 0; i_ < 4; ++i_) \
        __builtin_amdgcn_global_load_lds((const unsigned*)(ikb + (size_t)(ch) * 32768 + dsrc[i_]), (LAS unsigned*)(F.lds + IDX_RING_OFF + ((ch) % 3) * IDX_SLOT + F.wave * 4096 + i_ * 1024), 16, 0, 0); } while (0)
    bf16x8 af[4];
    { const int i = r32, qi = 2 * ((i >> 2) & 1) + (i >> 4), hd = (i & 3) + 4 * ((i >> 3) & 1);
#pragma unroll
      for (int s = 0; s < 4; ++s) af[s] = *(const bf16x8*)(IQ + (size_t)(tq0 + qi) * 512 + hd * 64 + 16 * s + 8 * hi); }
    float wA[8], wB[8];
#pragma unroll
    for (int r = 0; r < 8; ++r) { const int hd = (r & 3) + 4 * (r >> 2); wA[r] = IW[(size_t)(tq0 + 2 * hi) * 8 + hd] * W_SCALE; wB[r] = IW[(size_t)(tq0 + 2 * hi + 1) * 8 + hd] * W_SCALE; }
    __builtin_amdgcn_s_barrier();
    asm volatile("" ::: "memory");
    IDX_ISSUE(0); if (nch > 1) IDX_ISSUE(1);
#pragma unroll
    for (int i = 0; i < 3; ++i) *(LAS u32x4*)(F.lds + IDX_HIST_OFF + (i * 512 + F.tid) * 16) = (u32x4){0u, 0u, 0u, 0u};
    const int limA = p0 + 2 * hi - 32 * (ntiles - 1), limB = limA + 1;
    float sc0[32], sc1[32];
#pragma unroll
    for (int j = 0; j < 32; ++j) { sc0[j] = -INFINITY; sc1[j] = -INFINITY; }
    float mx0 = -INFINITY, mn0 = INFINITY, mx1 = -INFINITY, mn1 = INFINITY;
    const int frag_off = r32 * 128;
    const int fx = (r32 >> 1) & 7;
#pragma unroll
    for (int ch = 0; ch < 8; ++ch) {
        if (ch < nch) {
            if (ch + 1 < nch) asm volatile("s_waitcnt vmcnt(4)" ::: "memory"); else asm volatile("s_waitcnt vmcnt(0)" ::: "memory");
            __builtin_amdgcn_s_barrier();
            asm volatile("" ::: "memory");
            if (ch + 2 < nch) IDX_ISSUE(ch + 2);
            const LAS char* slot = (const LAS char*)(F.lds + IDX_RING_OFF + (ch % 3) * IDX_SLOT);
#pragma unroll
            for (int j4 = 0; j4 < 4; ++j4) {
                const int jl = 2 * j4 + kh, j = ch * 8 + jl, idx = ch * 4 + j4;
                if (j < ntiles) {
                    f32x16 acc = {};
#pragma unroll
                    for (int s = 0; s < 4; ++s) { const bf16x8 bfr = *(const LAS bf16x8*)(slot + jl * 4096 + frag_off + (((2 * s + hi) ^ fx) << 4));
                        acc = __builtin_amdgcn_mfma_f32_32x32x16_bf16(af[s], bfr, acc, 0, 0, 0); }
                    float s0 = 0.f, s1 = 0.f;
#pragma unroll
                    for (int r = 0; r < 8; ++r) {
                        const int ia = __float_as_int(acc[r]), ib = __float_as_int(acc[8 + r]);
                        s0 = fmaf(wA[r], __int_as_float(ia > 0 ? ia : 0), s0); s1 = fmaf(wB[r], __int_as_float(ib > 0 ? ib : 0), s1); }
                    if (j == ntiles - 1) {
                        mn0 = fminf(mn0, (r32 > limA) ? INFINITY : s0); mn1 = fminf(mn1, (r32 > limB) ? INFINITY : s1);
                        s0 = (r32 > limA) ? -INFINITY : s0; s1 = (r32 > limB) ? -INFINITY : s1;
                    } else { mn0 = fminf(mn0, s0); mn1 = fminf(mn1, s1); }
                    mx0 = fmaxf(mx0, s0); mx1 = fmaxf(mx1, s1);
                    sc0[idx] = s0; sc1[idx] = s1;
                }
            }
        }
    }
#undef IDX_ISSUE
#pragma unroll
    for (int d = 1; d < 32; d <<= 1) { mx0 = fmaxf(mx0, __shfl_xor(mx0, d)); mx1 = fmaxf(mx1, __shfl_xor(mx1, d)); mn0 = fminf(mn0, __shfl_xor(mn0, d)); mn1 = fminf(mn1, __shfl_xor(mn1, d)); }
    if (r32 == 0) { LAS float* w = mm + ((qg * 2 + kh) * 4 + 2 * hi) * 2; w[0] = mx0; w[1] = mn0; w[2] = mx1; w[3] = mn1; }
    __syncthreads();
    { const LAS float* w = mm + ((qg * 2 + (kh ^ 1)) * 4 + 2 * hi) * 2; mx0 = fmaxf(mx0, w[0]); mn0 = fminf(mn0, w[1]); mx1 = fmaxf(mx1, w[2]); mn1 = fminf(mn1, w[3]); }
    const float scl0 = (mx0 > mn0) ? (16777212.0f / (mx0 - mn0)) : 0.f, scl1 = (mx1 > mn1) ? (16777212.0f / (mx1 - mn1)) : 0.f;
    const float off0 = 1.5f - mn0 * scl0, off1 = 1.5f - mn1 * scl1;
    unsigned k0[32], k1[32];
#pragma unroll
    for (int j = 0; j < 32; ++j) { k0[j] = (unsigned)fmaf(sc0[j], scl0, off0); k1[j] = (unsigned)fmaf(sc1[j], scl1, off1); }
    unsigned T0 = 1u, T1 = 1u;
#ifndef NO_SELECT
    if (qb >= 16) {
        LAS unsigned* hA = hist + (2 * hi) * 384; LAS unsigned* hB = hist + (2 * hi + 1) * 384;
        unsigned pre0 = 0, pre1 = 0, need0 = 256, need1 = 256;
#pragma unroll
        for (int lvl = 0; lvl < 3; ++lvl) {
            const int sh = 16 - 8 * lvl;
#pragma unroll
            for (int j = 0; j < 32; ++j) {
                if (2 * j + kh < ntiles) {
                    const unsigned ka = k0[j], kc = k1[j];
                    if (lvl == 0 || (ka >> (sh + 8)) == pre0) { const unsigned bn = (ka >> sh) & 255u; (void)__hip_atomic_fetch_add(hA + lvl * 128 + (bn >> 1), 1u << ((bn & 1u) << 4), __ATOMIC_RELAXED, __HIP_MEMORY_SCOPE_WORKGROUP); }
                    if (lvl == 0 || (kc >> (sh + 8)) == pre1) { const unsigned bn = (kc >> sh) & 255u; (void)__hip_atomic_fetch_add(hB + lvl * 128 + (bn >> 1), 1u << ((bn & 1u) << 4), __ATOMIC_RELAXED, __HIP_MEMORY_SCOPE_WORKGROUP); }
                }
            }
            __syncthreads();
            unsigned b0, a0, b1, a1;
            hist_find16(hA + lvl * 128, r32, need0, b0, a0);
            hist_find16(hB + lvl * 128, r32, need1, b1, a1);
            pre0 = (pre0 << 8) | b0; need0 -= a0;
            pre1 = (pre1 << 8) | b1; need1 -= a1;
        }
        T0 = pre0 > 1u ? pre0 : 1u; T1 = pre1 > 1u ? pre1 : 1u;
    }
#endif
    unsigned m0 = 0, m1 = 0, m2 = 0, m3 = 0;
    mask_emit(std::make_integer_sequence<int, 32>{}, k0, k1, T0, T1, kh, ntiles, m0, m1, m2, m3);
    if (lane < 32) { const int w = 2 * lane + kh;
        MASK[(size_t)(tq0 + 0) * 64 + w] = m0; MASK[(size_t)(tq0 + 1) * 64 + w] = m1; MASK[(size_t)(tq0 + 2) * 64 + w] = m2; MASK[(size_t)(tq0 + 3) * 64 + w] = m3; }
}
__device__ __forceinline__ void p2_indexer(Frame& F) {
    for (int pi = F.bid; pi < 512; pi += F.G) { const int b = pi >> 6, x = pi & 63;
        p2_indexer_unit(F, b, 127 - x);
        p2_indexer_unit(F, b, x); }
    __syncthreads();
}

namespace att {
constexpr int D = 128, NW = 8, QBLK = 32, KVBLK = 64;
constexpr float SCALE = 0.088388347648318440f;
constexpr float THR = 8.f;
constexpr int LDQ = 768, LDK = 256, LDO = 1024;
constexpr size_t SHM_V = KVBLK * D * 2, SHM_K = KVBLK * D * 2, SHM_ATTN = 2 * SHM_V + 2 * SHM_K + NW * 64 * 4;
#define KSWZ(row, colB) ((row) * 256 + ((colB) ^ (((row) & 7) << 4)))
#define SBAR() __builtin_amdgcn_sched_barrier(0)
__device__ __forceinline__ void apply_mask(f32x16& p0, f32x16& p1, u32x2 mk, int hi) {
    const int ml = (int)(mk.x >> (4 * hi)), mh = (int)(mk.y >> (4 * hi));
#pragma unroll
    for (int r = 0; r < 16; ++r) { const int cr = (r & 3) + 8 * (r >> 2);
        const unsigned t0 = (unsigned)__builtin_amdgcn_sbfe(ml, cr, 1), t1 = (unsigned)__builtin_amdgcn_sbfe(mh, cr, 1);
        p0[r] = __uint_as_float((__float_as_uint(p0[r]) & t0) | (0xff800000u & ~t0));
        p1[r] = __uint_as_float((__float_as_uint(p1[r]) & t1) | (0xff800000u & ~t1)); }
}
__device__ __forceinline__ void partialSM(f32x16& p0, f32x16& p1, float& m_reg, float& mn, float& alpha) {
    constexpr float C = SCALE * 1.4426950408889634f;
    float pmax = p0[0];
#pragma unroll
    for (int r = 1; r < 16; ++r) pmax = fmaxf(pmax, p0[r]);
#pragma unroll
    for (int r = 0; r < 16; ++r) pmax = fmaxf(pmax, p1[r]);
    { auto rr = __builtin_amdgcn_permlane32_swap(__float_as_uint(pmax), __float_as_uint(pmax), false, false);
      pmax = fmaxf(__uint_as_float(rr[0]), __uint_as_float(rr[1])); }
    if (__builtin_expect(__all(pmax - m_reg <= THR / SCALE), 1)) { mn = m_reg; alpha = 1.f; }
    else { mn = fmaxf(m_reg, pmax); alpha = __builtin_amdgcn_exp2f((m_reg - mn) * C); m_reg = mn; }
    const float mnC = -mn * C;
#pragma unroll
    for (int r = 0; r < 16; ++r) p0[r] = fmaf(p0[r], C, mnC);
#pragma unroll
    for (int r = 0; r < 16; ++r) p1[r] = fmaf(p1[r], C, mnC);
#pragma unroll
    for (int r = 0; r < 16; ++r) p0[r] = __builtin_amdgcn_exp2f(p0[r]);
}
__device__ __forceinline__ void finishSM(f32x16& p0, f32x16& p1, float alpha, float& l_reg, bf16x8& pa0, bf16x8& pa1, bf16x8& pa2, bf16x8& pa3) {
#pragma unroll
    for (int r = 0; r < 16; ++r) p1[r] = __builtin_amdgcn_exp2f(p1[r]);
    float ps = 0;
#pragma unroll
    for (int r = 0; r < 16; ++r) ps += p0[r];
#pragma unroll
    for (int r = 0; r < 16; ++r) ps += p1[r];
    { auto rr = __builtin_amdgcn_permlane32_swap(__float_as_uint(ps), __float_as_uint(ps), false, false);
      ps = __uint_as_float(rr[0]) + __uint_as_float(rr[1]); }
    l_reg = l_reg * alpha + ps;
#define PK4(P, BASE, OUT) do { unsigned a0 = cvt_pk_bf16(P[BASE + 0], P[BASE + 1]), a1 = cvt_pk_bf16(P[BASE + 2], P[BASE + 3]);   \
    unsigned b0 = cvt_pk_bf16(P[BASE + 4], P[BASE + 5]), b1 = cvt_pk_bf16(P[BASE + 6], P[BASE + 7]);                              \
    auto r0 = __builtin_amdgcn_permlane32_swap(a0, b0, false, false); auto r1 = __builtin_amdgcn_permlane32_swap(a1, b1, false, false); \
    u32x4 w = {r0[0], r1[0], r0[1], r1[1]}; OUT = *reinterpret_cast<bf16x8*>(&w); } while (0)
    PK4(p0, 0, pa0); PK4(p0, 8, pa1); PK4(p1, 0, pa2); PK4(p1, 8, pa3);
#undef PK4
}
__device__ __forceinline__ void qkt(f32x16& p0, f32x16& p1, const LAS char* Ks, const bf16x8* qr, int r32, int hi) {
    p0 = f32x16{}; p1 = f32x16{};
#pragma unroll
    for (int d0 = 0; d0 < 8; ++d0) { const int cb = (d0 * 16 + hi * 8) * 2;
        const bf16x8 b0 = *reinterpret_cast<const LAS bf16x8*>(Ks + KSWZ(r32, cb));
        const bf16x8 b1 = *reinterpret_cast<const LAS bf16x8*>(Ks + KSWZ(32 + r32, cb));
        p0 = __builtin_amdgcn_mfma_f32_32x32x16_bf16(b0, qr[d0], p0, 0, 0, 0);
        p1 = __builtin_amdgcn_mfma_f32_32x32x16_bf16(b1, qr[d0], p1, 0, 0, 0); }
}
__device__ __forceinline__ int v_st(int k, int c) { const int kk = (k & ~0xC) | ((k & 4) << 1) | ((k & 8) >> 1); return ((kk >> 3) * 4 + (c >> 5)) * 512 + ((kk & 7) * 32 + (c & 31)) * 2; }
__device__ __forceinline__ int v_rd_base(int lane) { return ((lane & 3) << 3) | (((lane >> 2) & 3) << 6) | (((lane >> 4) & 1) << 5) | (((lane >> 5) & 1) << 8); }
constexpr int v_rd_off(int d0, int ks, int half) { return d0 * 512 + ks * 4096 + half * 2048; }
template <int OFF> __device__ __forceinline__ s16x4 tr_read(int vb) {
    s16x4 r; asm volatile("ds_read_b64_tr_b16 %0, %1 offset:%2" : "=&v"(r) : "v"(vb), "i"(OFF) : "memory"); return r;
}
template <int D0> __device__ __forceinline__ void pv_one(f32x16& od, int vb, bf16x8 pa0, bf16x8 pa1, bf16x8 pa2, bf16x8 pa3) {
    const s16x4 l0 = tr_read<v_rd_off(D0, 0, 0)>(vb), h0 = tr_read<v_rd_off(D0, 0, 1)>(vb), l1 = tr_read<v_rd_off(D0, 1, 0)>(vb), h1 = tr_read<v_rd_off(D0, 1, 1)>(vb);
    const s16x4 l2 = tr_read<v_rd_off(D0, 2, 0)>(vb), h2 = tr_read<v_rd_off(D0, 2, 1)>(vb), l3 = tr_read<v_rd_off(D0, 3, 0)>(vb), h3 = tr_read<v_rd_off(D0, 3, 1)>(vb);
    asm volatile("s_waitcnt lgkmcnt(0)" ::: "memory"); SBAR();
#define PK(L, H) (bf16x8){L[0], L[1], L[2], L[3], H[0], H[1], H[2], H[3]}
    od = __builtin_amdgcn_mfma_f32_32x32x16_bf16(pa0, PK(l0, h0), od, 0, 0, 0);
    od = __builtin_amdgcn_mfma_f32_32x32x16_bf16(pa1, PK(l1, h1), od, 0, 0, 0);
    od = __builtin_amdgcn_mfma_f32_32x32x16_bf16(pa2, PK(l2, h2), od, 0, 0, 0);
    od = __builtin_amdgcn_mfma_f32_32x32x16_bf16(pa3, PK(l3, h3), od, 0, 0, 0);
#undef PK
}
__device__ __forceinline__ void pv_d0(f32x16* o, int vb, bf16x8 pa0, bf16x8 pa1, bf16x8 pa2, bf16x8 pa3) {
    pv_one<0>(o[0], vb, pa0, pa1, pa2, pa3); pv_one<1>(o[1], vb, pa0, pa1, pa2, pa3); pv_one<2>(o[2], vb, pa0, pa1, pa2, pa3); pv_one<3>(o[3], vb, pa0, pa1, pa2, pa3);
}
__device__ __forceinline__ void attn_body(const bf16_t* __restrict__ Qb, const bf16_t* __restrict__ Kh, const bf16_t* __restrict__ Vh, bf16_t* __restrict__ Ob, const unsigned* __restrict__ Mb, int NT, LAS char* lds) {
    const int tid = threadIdx.x, wid = tid >> 6, lane = tid & 63, r32 = lane & 31, hi = lane >> 5;
    LAS char* V_lds = lds; LAS char* K_lds = lds + 2 * SHM_V;
    LAS float* ws = (LAS float*)(lds + 2 * SHM_V + 2 * SHM_K) + wid * 64; LAS float* li_l = ws; LAS float* al_l = ws + 32;
    float m_reg = -1e30f, l_reg = 0; f32x16 o[4] = {}; bf16x8 qr[8];
    const bf16_t* Qw = Qb + (long)(wid * QBLK + r32) * LDQ + hi * 8;
#pragma unroll
    for (int d0 = 0; d0 < 8; ++d0) qr[d0] = *reinterpret_cast<const bf16x8*>(Qw + d0 * 16);
    const unsigned mofs = (unsigned)(wid * QBLK + r32) * 256u;
#define Mw_(j) (*(const u32x2*)((const char*)Mb + (mofs + 8u * (unsigned)(j))))
    const int sr = tid >> 4, sc = (tid & 15) * 8, vst0 = v_st(sr, sc), vst1 = v_st(32 + sr, sc);
    const int vb0 = (int)(uintptr_t)V_lds + v_rd_base(lane);
    struct { bf16x8 vs0, vs1, ks0, ks1; } sr_[2];
#define SLOAD(i, k0) do { sr_[i].vs0 = *(const bf16x8*)(&Vh[(long)((k0) + sr) * LDK + sc]); sr_[i].vs1 = *(const bf16x8*)(&Vh[(long)((k0) + 32 + sr) * LDK + sc]); \
    sr_[i].ks0 = *(const bf16x8*)(&Kh[(long)((k0) + sr) * LDK + sc]); sr_[i].ks1 = *(const bf16x8*)(&Kh[(long)((k0) + 32 + sr) * LDK + sc]); } while (0)
#define SWRITE(b, i) do { *(LAS bf16x8*)(V_lds + (b) * SHM_V + vst0) = sr_[i].vs0;          \
    *(LAS bf16x8*)(V_lds + (b) * SHM_V + vst1) = sr_[i].vs1; int kc = sc * 2;               \
    *(LAS bf16x8*)(K_lds + (b) * SHM_K + KSWZ(sr, kc)) = sr_[i].ks0;                       \
    *(LAS bf16x8*)(K_lds + (b) * SHM_K + KSWZ(32 + sr, kc)) = sr_[i].ks1; } while (0)
#define SWAIT() asm volatile("s_waitcnt vmcnt(5)" ::: "memory")
#define RESC(a) do { if (__any((a) < 1.f)) { if (hi == 0) al_l[r32] = (a); asm volatile("s_waitcnt lgkmcnt(0)" ::: "memory"); \
    _Pragma("unroll") for (int d = 0; d < 4; ++d) _Pragma("unroll") for (int r = 0; r < 16; ++r) o[d][r] *= al_l[crow(r, hi)]; } } while (0)
    f32x16 pA0, pA1, pB0, pB1; float mnA, mnB, alA, alB; bf16x8 pa0, pa1, pa2, pa3;
    u32x2 mkA = Mw_(0), mkB = Mw_(1);
    constexpr int SE = 0, SO = 1;
    SLOAD(SE, 0); asm volatile("s_waitcnt vmcnt(0)" ::: "memory"); SWRITE(0, SE); __syncthreads();
    qkt(pA0, pA1, K_lds, qr, r32, hi); apply_mask(pA0, pA1, mkA, hi); partialSM(pA0, pA1, m_reg, mnA, alA); mkA = Mw_(2);
    SLOAD(SO, KVBLK); if (2 < NT) SLOAD(SE, 2 * KVBLK);
    SWAIT(); SWRITE(1, SO); __syncthreads();
    for (int j = 1; j + 1 < NT; j += 2) {
        SBAR(); qkt(pB0, pB1, K_lds + SHM_K, qr, r32, hi);
        finishSM(pA0, pA1, alA, l_reg, pa0, pa1, pa2, pa3); SBAR();
        SLOAD(SO, (j + 2) * KVBLK); SBAR();
        pv_d0(o, vb0, pa0, pa1, pa2, pa3); apply_mask(pB0, pB1, mkB, hi); partialSM(pB0, pB1, m_reg, mnB, alB); mkB = Mw_((j + 2 < NT) ? (j + 2) : j);
        __syncthreads(); SWAIT(); SWRITE(0, SE);
        RESC(alB); __syncthreads();
        SBAR(); qkt(pA0, pA1, K_lds, qr, r32, hi);
        finishSM(pB0, pB1, alB, l_reg, pa0, pa1, pa2, pa3); SBAR();
        if (j + 3 < NT) SLOAD(SE, (j + 3) * KVBLK); SBAR();
        pv_d0(o, vb0 + (int)SHM_V, pa0, pa1, pa2, pa3); apply_mask(pA0, pA1, mkA, hi); partialSM(pA0, pA1, m_reg, mnA, alA); mkA = Mw_((j + 3 < NT) ? (j + 3) : (j + 1));
        __syncthreads(); SWAIT(); SWRITE(1, SO);
        RESC(alA); __syncthreads();
    }
    SBAR(); qkt(pB0, pB1, K_lds + SHM_K, qr, r32, hi);
    finishSM(pA0, pA1, alA, l_reg, pa0, pa1, pa2, pa3); SBAR();
    pv_d0(o, vb0, pa0, pa1, pa2, pa3); apply_mask(pB0, pB1, mkB, hi); partialSM(pB0, pB1, m_reg, mnB, alB);
    __syncthreads(); RESC(alB);
    finishSM(pB0, pB1, alB, l_reg, pa0, pa1, pa2, pa3); SBAR();
    pv_d0(o, vb0 + (int)SHM_V, pa0, pa1, pa2, pa3);
    if (hi == 0) li_l[r32] = l_reg; asm volatile("s_waitcnt lgkmcnt(0)" ::: "memory");
    float rli[16];
#pragma unroll
    for (int r = 0; r < 16; ++r) rli[r] = __builtin_amdgcn_rcpf(li_l[crow(r, hi)]);
    bf16_t* Ow = Ob + (long)(wid * QBLK) * LDO;
#pragma unroll
    for (int r = 0; r < 16; ++r) { const int orow = crow(r, hi);
#pragma unroll
        for (int d0 = 0; d0 < 4; ++d0) Ow[(long)orow * LDO + d0 * 32 + r32] = (bf16_t)(cvt_pk_bf16(o[d0][r] * rli[r], 0.f) & 0xffffu); }
#undef SLOAD
#undef SWRITE
#undef SWAIT
#undef RESC
#undef Mw_
}
}

__device__ __forceinline__ void p3_attention(Frame& F) {
    const bf16_t* Q = (const bf16_t*)(F.ws + WS_Q); const bf16_t* K = (const bf16_t*)(F.ws + WS_K); const bf16_t* V = (const bf16_t*)(F.ws + WS_V);
    bf16_t* cat = (bf16_t*)(F.ws + WS_CAT); const unsigned* MASK = (const unsigned*)(F.ws + WS_MASK);
    const int j = F.bid;
    if (F.G == 256 && j >= 216) {
        convert_range(F, 2 * CV_PAIRS1, 2 * CV_PAIRS3, (j - 216) * 8 + F.wave, 40 * 8);
        return;
    }
    int qbs[2], phs[2], nu = 2;
    if (F.G != 256) { nu = 0; }
    else if (j < 48) { qbs[0] = 7; phs[0] = (j % 8) * 6 + j / 8; nu = 1; qbs[1] = 0; phs[1] = 0; }
    else if (j < 96) { const int jl = j - 48; qbs[0] = 6; phs[0] = (jl % 8) * 6 + jl / 8; qbs[1] = 0; phs[1] = phs[0]; }
    else if (j < 144) { const int jl = j - 96; qbs[0] = 5; phs[0] = (jl % 8) * 6 + jl / 8; qbs[1] = 1; phs[1] = phs[0]; }
    else if (j < 192) { const int jl = j - 144; qbs[0] = 4; phs[0] = (jl % 8) * 6 + jl / 8; qbs[1] = 2; phs[1] = phs[0]; }
    else { const int jl = j - 192; qbs[0] = 3; phs[0] = (jl % 8) * 6 + 2 * (jl / 8); qbs[1] = 3; phs[1] = phs[0] + 1; }
    for (int ui = 0; ui < nu; ++ui) {
        __syncthreads();
        const int qb = qbs[ui], b = phs[ui] / 6, h = phs[ui] % 6, g = h / 3;
        const size_t row0 = (size_t)b * SEQ + (size_t)qb * 256;
        att::attn_body(Q + row0 * 768 + h * 128, K + (size_t)b * SEQ * 256 + g * 128, V + (size_t)b * SEQ * 256 + g * 128, cat + row0 * 1024 + 256 + h * 128, MASK + row0 * 64, 4 * (qb + 1), (LAS char*)F.lds);
    }
    __syncthreads();
}

__device__ __forceinline__ void p5_ln1_router(Frame& F) {
    const bf16_t* MIX = (const bf16_t*)(F.ws + WS_MIX); const bf16_t* HA = (const bf16_t*)(F.ws + WS_HA);
    bf16_t* H1R = (bf16_t*)(F.ws + WS_H1F); unsigned char* H1Q = F.ws + WS_H1B; const float* wrA = (const float*)(F.ws + WS_WRA);
    unsigned* INV = (unsigned*)(F.ws + WS_INV); unsigned* TOKEP = (unsigned*)(F.ws + WS_TOKEP); float* TOKG = (float*)(F.ws + WS_TOKG);
    LAS float* tile = (LAS float*)F.lds;
    LAS float* part = (LAS float*)F.lds;
    LAS float* logit = (LAS float*)(F.lds + 36864);
    LAS int* sel_e = (LAS int*)(F.lds + MISC_OFF + 2048);
    LAS float* sel_g = (LAS float*)(F.lds + MISC_OFF + 3072);
    LAS int* sel_p = (LAS int*)(F.lds + MISC_OFF + 4096);
    LAS unsigned* lcnt = (LAS unsigned*)(F.lds + MISC_OFF + 5120);
    LAS int* ebase = (LAS int*)(F.lds + MISC_OFF + 5376);
    const int lane = F.lane, r32 = lane & 31, hi = lane >> 5;
    for (int blk = F.bid; blk < T / 64; blk += F.G) {
        const int t0 = blk * 64;
        if (F.tid < 32) lcnt[F.tid] = 0u;
        for (int pass = 0; pass < 2; ++pass) {
            __syncthreads();
            { f32x4 g1[4], b1[4];
#pragma unroll
              for (int j = 0; j < 4; ++j) { g1[j] = ((const f32x4*)F.ln1_g)[lane + 64 * j]; b1[j] = ((const f32x4*)F.ln1_b)[lane + 64 * j]; }
#pragma unroll
              for (int rb = 0; rb < 4; rb += 2) {
              u32x2 xv[2][4]; u32x2 mv[2][4];
#pragma unroll
              for (int rr = 0; rr < 2; ++rr) { const int m = t0 + pass * 32 + F.wave * 4 + rb + rr;
#pragma unroll
                  for (int j = 0; j < 4; ++j) { xv[rr][j] = ((const u32x2*)(HA + (size_t)m * 1024))[lane + 64 * j]; mv[rr][j] = ((const u32x2*)(MIX + (size_t)m * 1024))[lane + 64 * j]; } }
#pragma unroll
              for (int rr = 0; rr < 2; ++rr) { const int tl = F.wave * 4 + rb + rr, m = t0 + pass * 32 + tl;
                  f32x4 v[4]; float s = 0.f;
#pragma unroll
                  for (int j = 0; j < 4; ++j) { const u32x2 hw = xv[rr][j]; const f32x4 h = {bf16_lo(hw.x), bf16_hi(hw.x), bf16_lo(hw.y), bf16_hi(hw.y)};
                      const u32x2 w = mv[rr][j]; const f32x4 mx = {bf16_lo(w.x), bf16_hi(w.x), bf16_lo(w.y), bf16_hi(w.y)};
                      v[j] = ALPHA * h + mx; s += (v[j].x + v[j].y) + (v[j].z + v[j].w); }
                  const float mean = wave_sum(s) * (1.f / 1024.f); float s2 = 0.f;
#pragma unroll
                  for (int j = 0; j < 4; ++j) { v[j] = v[j] - mean; s2 += (v[j].x * v[j].x + v[j].y * v[j].y) + (v[j].z * v[j].z + v[j].w * v[j].w); }
                  const float rstd = 1.f / sqrtf(wave_sum(s2) * (1.f / 1024.f) + LN_EPS);
                  u32x2* of = (u32x2*)(H1R + (size_t)m * 1024) + lane; unsigned* ob = (unsigned*)(H1Q + (size_t)m * 1024) + lane;
#pragma unroll
                  for (int j = 0; j < 4; ++j) { const f32x4 h = v[j] * rstd * g1[j] + b1[j]; { u32x2 hw; hw.x = cvt_pk_bf16(h.x, h.y); hw.y = cvt_pk_bf16(h.z, h.w); of[64 * j] = hw; } ob[64 * j] = pk4_fp8(h.x, h.y, h.z, h.w);
                      *(LAS f32x4*)(tile + tl * 1024 + (((lane + 64 * j) ^ (tl & 15)) << 2)) = h; } } } }
            f32x4 a4[16];
#pragma unroll
            for (int i = 0; i < 16; ++i) a4[i] = *(const f32x4*)(wrA + (size_t)(((F.wave * 16 + i) * 2 + hi) * 32 + r32) * 4);
            __syncthreads();
            f32x16 acc = {};
#pragma unroll
            for (int i = 0; i < 16; ++i) { const int c = F.wave * 16 + i;
                const f32x4 b4 = *(const LAS f32x4*)(tile + r32 * 1024 + (((2 * c + hi) ^ (r32 & 15)) << 2));
                acc = __builtin_amdgcn_mfma_f32_32x32x2f32(a4[i].x, b4.x, acc, 0, 0, 0);
                acc = __builtin_amdgcn_mfma_f32_32x32x2f32(a4[i].y, b4.y, acc, 0, 0, 0);
                acc = __builtin_amdgcn_mfma_f32_32x32x2f32(a4[i].z, b4.z, acc, 0, 0, 0);
                acc = __builtin_amdgcn_mfma_f32_32x32x2f32(a4[i].w, b4.w, acc, 0, 0, 0); }
            __syncthreads();
#pragma unroll
            for (int r = 0; r < 16; ++r) part[(F.wave * 32 + r32) * 33 + crow(r, hi)] = acc[r];
            __syncthreads();
#pragma unroll
            for (int q = 0; q < 2; ++q) { const int o = F.tid * 2 + q, tok = o >> 5, e = o & 31; float sm = F.b_router[e];
#pragma unroll
                for (int kq = 0; kq < 8; ++kq) sm += part[(kq * 32 + tok) * 33 + e];
                logit[tok * 33 + e] = sm; }
            __syncthreads();
            if (F.tid < 32) {
                float bv_[4] = {-INFINITY, -INFINITY, -INFINITY, -INFINITY}; int bi[4] = {0, 0, 0, 0};
#pragma unroll
                for (int e = 0; e < 32; ++e) { const float v = logit[F.tid * 33 + e];
                    if (v > bv_[3]) { bv_[3] = v; bi[3] = e;
                        if (bv_[3] > bv_[2]) { float tv = bv_[2]; bv_[2] = bv_[3]; bv_[3] = tv; int ti = bi[2]; bi[2] = bi[3]; bi[3] = ti;
                            if (bv_[2] > bv_[1]) { tv = bv_[1]; bv_[1] = bv_[2]; bv_[2] = tv; ti = bi[1]; bi[1] = bi[2]; bi[2] = ti;
                                if (bv_[1] > bv_[0]) { tv = bv_[0]; bv_[0] = bv_[1]; bv_[1] = tv; ti = bi[0]; bi[0] = bi[1]; bi[1] = ti; } } } } }
                float ex[4], se = 0.f;
#pragma unroll
                for (int j = 0; j < 4; ++j) { ex[j] = __expf(bv_[j] - bv_[0]); se += ex[j]; }
#pragma unroll
                for (int j = 0; j < 4; ++j) { sel_g[(pass * 32 + F.tid) * 4 + j] = ex[j] / se; sel_e[(pass * 32 + F.tid) * 4 + j] = bi[j]; }
            }
        }
        __syncthreads();
        if (F.tid < 256) sel_p[F.tid] = (int)__hip_atomic_fetch_add(lcnt + sel_e[F.tid], 1u, __ATOMIC_RELAXED, __HIP_MEMORY_SCOPE_WORKGROUP);
        __syncthreads();
        if (F.tid < 32) { const unsigned c = lcnt[F.tid]; int base = 0; if (c > 0) base = (int)__hip_atomic_fetch_add(F.ctl + CW_CNT + F.tid, c, __ATOMIC_RELAXED, __HIP_MEMORY_SCOPE_AGENT); ebase[F.tid] = base; }
        __syncthreads();
        if (F.tid < 256) { const int tok = t0 + (F.tid >> 2), e = sel_e[F.tid], p = ebase[e] + sel_p[F.tid];
            INV[(size_t)e * CAP + p] = (unsigned)tok; TOKEP[(size_t)tok * 4 + (F.tid & 3)] = ((unsigned)e << 16) | (unsigned)p; TOKG[(size_t)tok * 4 + (F.tid & 3)] = sel_g[F.tid]; }
        __syncthreads();
    }
}

__device__ __forceinline__ void moe_tables(Frame& F, LAS int* tstart) {
    __syncthreads();
    if (F.tid < 64) {
        const unsigned c = (F.tid < NE) ? __hip_atomic_load(F.ctl + CW_CNT + (F.tid & 31), __ATOMIC_RELAXED, __HIP_MEMORY_SCOPE_AGENT) : 0u;
        const int nt = (int)((c + 255u) >> 8); int incl = nt;
#pragma unroll
        for (int d = 1; d < 32; d <<= 1) { const int o = __shfl_up(incl, d, 64); if ((int)F.tid >= d) incl += o; }
        if (F.tid < NE) { tstart[F.tid] = incl - nt; tstart[40 + F.tid] = (int)c; }
        if (F.tid == NE - 1) tstart[NE] = incl; }
    __syncthreads();
}

__device__ __forceinline__ float fp8_to_f32(unsigned w, int byte) {
    if (byte == 0) return __builtin_amdgcn_cvt_f32_fp8(w, 0); if (byte == 1) return __builtin_amdgcn_cvt_f32_fp8(w, 1); if (byte == 2) return __builtin_amdgcn_cvt_f32_fp8(w, 2); return __builtin_amdgcn_cvt_f32_fp8(w, 3);
}
__device__ __forceinline__ void p8_final(Frame& F, LAS int* tstart) {
    const bf16_t* H1R = (const bf16_t*)(F.ws + WS_H1F); const unsigned* TOKEP = (const unsigned*)(F.ws + WS_TOKEP); const float* TOKG = (const float*)(F.ws + WS_TOKG);
    const unsigned char* Y = F.ws + WS_Y;
    const int gw = F.bid * 8 + F.wave, NGW = F.G * 8;
    f32x4 gv[4], bv[4];
#pragma unroll
    for (int j = 0; j < 4; ++j) { gv[j] = ((const f32x4*)F.ln2_g)[F.lane + 64 * j]; bv[j] = ((const f32x4*)F.ln2_b)[F.lane + 64 * j]; }
    unsigned tk = 0; float tg = 0.f;
    { const int m = gw + (F.lane >> 2) * NGW; if (F.lane < 32 && m < T) { tk = TOKEP[(size_t)m * 4 + (F.lane & 3)]; tg = TOKG[(size_t)m * 4 + (F.lane & 3)] * (1.0f / 64.0f); } }
    u32x2 hwA[4], hwB[4]; unsigned ywA[4][4], ywB[4][4];
#define P8_LOAD(k, hw, yw) do { const int m_ = gw + (k) * NGW; if (m_ < T) { const u32x2* xr_ = (const u32x2*)(H1R + (size_t)m_ * 1024) + F.lane; \
        _Pragma("unroll") for (int j = 0; j < 4; ++j) hw[j] = xr_[64 * j]; \
        _Pragma("unroll") for (int q = 0; q < 4; ++q) { const unsigned ep_ = (unsigned)__builtin_amdgcn_readlane((int)tk, (k) * 4 + q); \
            const size_t slot_ = (size_t)tstart[ep_ >> 16] * 256 + (ep_ & 0xffffu); const unsigned* yr_ = (const unsigned*)(Y + slot_ * 1024) + F.lane; \
            _Pragma("unroll") for (int j = 0; j < 4; ++j) yw[q][j] = yr_[64 * j]; } } } while (0)
#define P8_ROW(k, hw, yw) do { const int m_ = gw + (k) * NGW; if (m_ < T) { f32x4 v[4]; float gt[4]; \
        _Pragma("unroll") for (int q = 0; q < 4; ++q) gt[q] = __builtin_bit_cast(float, __builtin_amdgcn_readlane(__builtin_bit_cast(int, tg), (k) * 4 + q)); \
        _Pragma("unroll") for (int j = 0; j < 4; ++j) { v[j] = (f32x4){ALPHA * bf16_lo(hw[j].x), ALPHA * bf16_hi(hw[j].x), ALPHA * bf16_lo(hw[j].y), ALPHA * bf16_hi(hw[j].y)}; \
            _Pragma("unroll") for (int q = 0; q < 4; ++q) { const unsigned w = yw[q][j]; \
                v[j].x += gt[q] * fp8_to_f32(w, 0); v[j].y += gt[q] * fp8_to_f32(w, 1); v[j].z += gt[q] * fp8_to_f32(w, 2); v[j].w += gt[q] * fp8_to_f32(w, 3); } } \
        float s_ = 0.f; _Pragma("unroll") for (int j = 0; j < 4; ++j) s_ += (v[j].x + v[j].y) + (v[j].z + v[j].w); \
        const float mean_ = wave_sum(s_) * (1.f / 1024.f); float s2_ = 0.f; \
        _Pragma("unroll") for (int j = 0; j < 4; ++j) { v[j] = v[j] - mean_; s2_ += (v[j].x * v[j].x + v[j].y * v[j].y) + (v[j].z * v[j].z + v[j].w * v[j].w); } \
        const float rstd_ = 1.f / sqrtf(wave_sum(s2_) * (1.f / 1024.f) + LN_EPS); \
        f32x4* orow_ = (f32x4*)(F.out + (size_t)m_ * 1024) + F.lane; \
        _Pragma("unroll") for (int j = 0; j < 4; ++j) orow_[64 * j] = v[j] * rstd_ * gv[j] + bv[j]; } } while (0)
    P8_LOAD(0, hwA, ywA);
    P8_LOAD(1, hwB, ywB); P8_ROW(0, hwA, ywA);
    P8_LOAD(2, hwA, ywA); P8_ROW(1, hwB, ywB);
    P8_LOAD(3, hwB, ywB); P8_ROW(2, hwA, ywA);
    P8_LOAD(4, hwA, ywA); P8_ROW(3, hwB, ywB);
    P8_LOAD(5, hwB, ywB); P8_ROW(4, hwA, ywA);
    P8_LOAD(6, hwA, ywA); P8_ROW(5, hwB, ywB);
    P8_LOAD(7, hwB, ywB); P8_ROW(6, hwA, ywA);
    P8_ROW(7, hwB, ywB);
#undef P8_LOAD
#undef P8_ROW
}

__global__ void __launch_bounds__(NTHREADS, 2) mk_fwd(Args args) {
    extern __shared__ __attribute__((aligned(16))) unsigned char lds_raw[];
    Frame F;
    F.lds = (LAS unsigned char*)lds_raw;
    F.tid = threadIdx.x; F.lane = F.tid & 63; F.wave = __builtin_amdgcn_readfirstlane(F.tid >> 6); F.G = gridDim.x; F.bid = blockIdx.x;
    frame_refresh(F);
    volatile LAS unsigned* misc = (volatile LAS unsigned*)(F.lds + MISC_OFF);
    LAS int* tstart = (LAS int*)(F.lds + MISC_OFF + 256);
    LAS int* toktab = (LAS int*)(F.lds + MISC_OFF + 1024);
    if (F.tid < 4) misc[F.tid] = 0u;
    __syncthreads();
    const int lo = args.ph_lo, hi = args.ph_hi;
    XcdBarrier bar; bar.bar = F.ctl; bar.x = 0; bar.st = misc;
    if (hi - lo > 1) bar = xcd_barrier_post(F.ctl, misc);
#define IN(k) (lo <= (k) && (k) < hi)
#ifdef ONLY
#define PH_ON(k) ((k) == ONLY)
#else
#define PH_ON(k) true
#endif
#define SEAM(k) do { if (IN(k) && IN((k) + 1)) xcd_barrier(bar); frame_refresh(F); } while (0)

    if (PH_ON(0) && IN(0)) { p0_prologue(F); } SEAM(0);
    if (PH_ON(1) && IN(1)) {
        EpiInProj E{(bf16_t*)(F.ws + WS_U), (bf16_t*)(F.ws + WS_Q), (bf16_t*)(F.ws + WS_K), (bf16_t*)(F.ws + WS_V), (bf16_t*)(F.ws + WS_IQ), (bf16_t*)(F.ws + WS_IK), (float*)(F.ws + WS_IW),
                    (const float*)(F.ws + WS_ROPEQK), (const float*)(F.ws + WS_ROPEIX)};
        { pg8::StaticSched S{T / 256, 5, F.G, F.bid, 1, 1};
          pg8::gemm_phase<EpiInProj, pg8::StaticSched, true, 0x79797979, 0x7f7f7f7f>(F.lds, (const char*)(F.ws + WS_HA8), (const char*)(F.ws + WS_BTIN8), S, E); }
        { pg8::StaticSched S{T / 256, 4, F.G, F.bid, 0, 5};
          pg8::gemm_phase<EpiInProj, pg8::StaticSched>(F.lds, (const char*)(F.ws + WS_HA), (const char*)(F.ws + WS_BTIN), S, E); }
        if (F.bid >= 64) {
            convert_range(F, 0, 2 * CV_PAIRS1, (F.bid - 64) * 8 + F.wave, (F.G - 64) * 8); }
    } SEAM(1);
    if (PH_ON(2) && IN(2)) {
#ifndef NO_POOL
 p2_pool(F);
#endif
 p2_indexer(F); } SEAM(2);
    if (PH_ON(3) && IN(3)) { p3_attention(F); } SEAM(3);
    if (PH_ON(4) && IN(4)) {
        pg8::StaticSched S{T / 256, 4, F.G, F.bid, 0, 0};
        EpiMix E{(bf16_t*)(F.ws + WS_MIX)};
        pg8::gemm_phase<EpiMix, pg8::StaticSched>(F.lds, (const char*)(F.ws + WS_CAT), (const char*)(F.ws + WS_BTOUT), S, E);
    } SEAM(4);
    if (PH_ON(5) && IN(5)) { p5_ln1_router(F); } SEAM(5);
    if (PH_ON(6) && IN(6)) {
        moe_tables(F, tstart);
        const int ntl = tstart[NE];
        pg8::MoeSched<true> S{ntl, 8, F.G, F.bid, 2048, tstart, toktab, 0};
        { const unsigned* INV = (const unsigned*)(F.ws + WS_INV); pg8::Unit u; unsigned tk[10];
#pragma unroll
          for (int i = 0; i < 10; ++i) { tk[i] = 0u; if (S.next(i, u) && F.tid < 256) { const int p = (u.pm - tstart[u.e]) * 256 + F.tid; const int cnt = tstart[40 + u.e];
                  tk[i] = INV[(size_t)u.e * CAP + (p < cnt ? p : 0)]; } }
#pragma unroll
          for (int i = 0; i < 10; ++i) if (F.tid < 256) toktab[i * 256 + F.tid] = (int)tk[i];
          __syncthreads(); }
        EpiGateUp E{F.ws + WS_ACT, F.b_gu, F.ctl + CW_ACTRDY};
#ifndef NO_GU
        pg8::gemm_phase<EpiGateUp, pg8::MoeSched<true>, true, 0x79797979, 0x7f7f7f7f>(F.lds, (const char*)(F.ws + WS_H1B), (const char*)(F.ws + WS_BTGU), S, E);
#endif
        { const int nwg6 = 8 * ntl, rounds6 = (nwg6 + F.G - 1) / F.G, nidle = rounds6 * F.G - nwg6, cfirst = nwg6 - (rounds6 - 1) * F.G;
          int early = ((nidle < 128 ? nidle : 128) / 32) * 32; if (rounds6 < 9 || ntl < 32) early = 0;
          const int rank = F.bid - cfirst;
#ifndef NO_EARLY
          if (rank >= 0 && rank < early) {
              pg8::MoeSched<false> S7{early / 4, 4, F.G, rank, 1024, tstart, toktab, 0};
              pg8::Unit u; S7.next(0, u);
              if (F.tid < 64) {
                  unsigned* cp = F.ctl + CW_ACTRDY + u.pm; unsigned sp = 0;
                  while ((unsigned)__builtin_amdgcn_readfirstlane((int)__hip_atomic_load(cp, __ATOMIC_RELAXED, __HIP_MEMORY_SCOPE_AGENT)) < 64u) {
                      __builtin_amdgcn_s_sleep(2); if (++sp > (1u << 20)) { if (F.tid == 0) __hip_atomic_store(F.ctl + CW_TMO2, 1u, __ATOMIC_RELAXED, __HIP_MEMORY_SCOPE_AGENT); break; } }
                  __builtin_amdgcn_fence(__ATOMIC_ACQUIRE, "agent");
                  asm volatile("s_waitcnt vmcnt(0)" ::: "memory"); }
              __syncthreads();
              EpiDown E7{F.ws + WS_Y, F.b_dn};
              pg8::gemm_phase<EpiDown, pg8::MoeSched<false>, true, 0x79797979, 0x7c7c7c7c>(F.lds, (const char*)(F.ws + WS_ACT), (const char*)(F.ws + WS_BTDN), S7, E7);
          }
#endif
          (void)rank; (void)early; }
    } SEAM(6);
    if (PH_ON(7) && IN(7)) {
        moe_tables(F, tstart);
        const int ntl = tstart[NE];
        const int nwg6 = 8 * ntl, rounds6 = (nwg6 + F.G - 1) / F.G, nidle = rounds6 * F.G - nwg6;
        int early = ((nidle < 128 ? nidle : 128) / 32) * 32; if (rounds6 < 9 || ntl < 32) early = 0;
        pg8::MoeSched<false> S{ntl, 4, F.G, F.bid, 1024, tstart, toktab, early};
        EpiDown E{F.ws + WS_Y, F.b_dn};
        pg8::gemm_phase<EpiDown, pg8::MoeSched<false>, true, 0x79797979, 0x7c7c7c7c>(F.lds, (const char*)(F.ws + WS_ACT), (const char*)(F.ws + WS_BTDN), S, E);
    } SEAM(7);
    if (PH_ON(8) && IN(8)) { moe_tables(F, tstart); p8_final(F, tstart); }
#undef IN
#undef SEAM
}

extern "C" void kernel_launch(void* const* d_in, const int* in_sizes, int n_in, void* d_out, int out_size, void* d_ws, size_t ws_size, hipStream_t stream) {
    static int grid = 0;
    if (grid == 0) {
        if (n_in != 18 || in_sizes[0] != T * DM || out_size != T * DM || ws_size < WS_END) {
            fprintf(stderr, "kernel_launch: shape mismatch (n_in %d, in0 %d, out %d, ws %zu, need %zu)\n", n_in, n_in > 0 ? in_sizes[0] : -1, out_size, ws_size, (size_t)WS_END); grid = -1; return; }
        int dev = 0, cus = 0, per_cu = 0;
        if (hipGetDevice(&dev) != hipSuccess || hipDeviceGetAttribute(&cus, hipDeviceAttributeMultiprocessorCount, dev) != hipSuccess) { grid = -1; return; }
        if (hipFuncSetAttribute((const void*)mk_fwd, hipFuncAttributeMaxDynamicSharedMemorySize, LDS_BYTES) != hipSuccess) { fprintf(stderr, "kernel_launch: hipFuncSetAttribute failed\n"); grid = -1; return; }
        if (hipOccupancyMaxActiveBlocksPerMultiprocessor(&per_cu, (const void*)mk_fwd, NTHREADS, LDS_BYTES) != hipSuccess || per_cu < 1) {
            fprintf(stderr, "kernel_launch: occupancy query reports %d workgroups per CU\n", per_cu); }
        (void)hipGetLastError();
        grid = cus;
        if (grid != 256) { fprintf(stderr, "kernel_launch: built for a 256-CU device (static work deals), found %d CUs\n", cus); grid = -1; return; }
    }
    if (grid < 0) return;
    (void)hipMemsetAsync((char*)d_ws + WS_CTL, 0, CTL_BYTES, stream);
    Args a{};
    for (int i = 0; i < 18; ++i) a.in[i] = d_in[i];
    a.out = (float*)d_out; a.ws = (unsigned char*)d_ws;
#if MK_N_LAUNCHES == 1
    a.ph_lo = 0; a.ph_hi = NPH;
    hipLaunchKernelGGL(mk_fwd, dim3(grid), dim3(NTHREADS), LDS_BYTES, stream, a);
#else
    for (int p = 0; p < NPH; ++p) { a.ph_lo = p; a.ph_hi = p + 1; hipLaunchKernelGGL(mk_fwd, dim3(grid), dim3(NTHREADS), LDS_BYTES, stream, a);
#ifdef PROBE_DUP
        if (p == PROBE_DUP) { if (p == 3 || p == 5) (void)hipMemsetAsync((char*)d_ws + WS_CTL + 4096 * 4, 0, 1024, stream); hipLaunchKernelGGL(mk_fwd, dim3(grid), dim3(NTHREADS), LDS_BYTES, stream, a); }
#endif
    }
#endif
    const hipError_t le = hipPeekAtLastError();
    if (le != hipSuccess) fprintf(stderr, "kernel_launch: launch failed: %s\n", hipGetErrorName(le));
}
```

```cpp
#include <hip/hip_runtime.h>
#include <cstdio>
#include <cstdint>
#include <utility>

#define LAS __attribute__((address_space(3)))
typedef unsigned short bf16_t;
typedef short bf16x8 __attribute__((ext_vector_type(8)));
typedef short s16x4 __attribute__((ext_vector_type(4)));
typedef float f32x2 __attribute__((ext_vector_type(2)));
typedef float f32x4 __attribute__((ext_vector_type(4)));
typedef float f32x16 __attribute__((ext_vector_type(16)));
typedef unsigned u32x2 __attribute__((ext_vector_type(2)));
typedef unsigned u32x4 __attribute__((ext_vector_type(4)));

#ifndef MK_N_LAUNCHES
#define MK_N_LAUNCHES 1
#endif

constexpr int T = 16384, DM = 1024, SEQ = 2048, NBATCH = 8;
constexpr int INW = 2120, INP = 2304;
constexpr int NE = 32, CAP = 16384, MAXT = 288;
constexpr int NPH = 9;
constexpr float ALPHA = 1.189207115002721f;
constexpr float LN_EPS = 1e-5f;
constexpr float W_SCALE = 0.04419417382415922f;
constexpr int NTHREADS = 512;
constexpr int LDS_BYTES = 147456;
constexpr int MISC_OFF = 131072;

constexpr size_t al256(size_t x) { return (x + 255) / 256 * 256; }
constexpr size_t WS_CTL = 0;
constexpr size_t CTL_BYTES = 65536;
constexpr size_t WS_BTIN = WS_CTL + CTL_BYTES;
constexpr size_t WS_BTOUT = WS_BTIN + al256((size_t)INP * 1024 * 2);
constexpr size_t WS_BTGU = WS_BTOUT + al256((size_t)1024 * 1024 * 2);
constexpr size_t WS_BTDN = WS_BTGU + al256((size_t)NE * 2048 * 1024 * 2);
constexpr size_t WS_WPT = WS_BTDN + al256((size_t)NE * 1024 * 1024 * 2);
constexpr size_t WS_WRA = WS_WPT + al256((size_t)4 * 64 * 64 * 2);
constexpr size_t WS_HA = WS_WRA + al256((size_t)1024 * 32 * 4);
constexpr size_t WS_STATS = WS_HA + al256((size_t)T * 1024 * 2);
constexpr size_t WS_ROPEQK = WS_STATS + al256((size_t)T * 2 * 4);
constexpr size_t WS_ROPEIX = WS_ROPEQK + al256((size_t)T * 32 * 4);
constexpr size_t WS_U = WS_ROPEIX + al256((size_t)T * 16 * 4);
constexpr size_t WS_Q = WS_U + al256((size_t)T * 256 * 2);
constexpr size_t WS_K = WS_Q + al256((size_t)T * 768 * 2);
constexpr size_t WS_V = WS_K + al256((size_t)T * 256 * 2);
constexpr size_t WS_IQ = WS_V + al256((size_t)T * 256 * 2);
constexpr size_t WS_IK = WS_IQ + al256((size_t)T * 512 * 2);
constexpr size_t WS_IW = WS_IK + al256((size_t)T * 64 * 2);
constexpr size_t WS_MASK = WS_IW + al256((size_t)T * 8 * 4);
constexpr size_t WS_CAT = WS_MASK + al256((size_t)T * 64 * 4);
constexpr size_t WS_H1F = WS_CAT + al256((size_t)T * 1024 * 2);
constexpr size_t WS_H1B = WS_H1F + al256((size_t)T * 1024 * 4);
constexpr size_t WS_INV = WS_H1B + al256((size_t)T * 1024 * 2);
constexpr size_t WS_TOKEP = WS_INV + al256((size_t)NE * CAP * 4);
constexpr size_t WS_TOKG = WS_TOKEP + al256((size_t)T * 4 * 4);
constexpr size_t WS_ACT = WS_TOKG + al256((size_t)T * 4 * 4);
constexpr size_t WS_Y = WS_ACT + al256((size_t)MAXT * 256 * 1024 * 2);
constexpr size_t WS_MIX = WS_Y + al256((size_t)MAXT * 256 * 1024 * 2);
constexpr size_t WS_HA8 = WS_MIX + al256((size_t)T * 1024 * 2);
constexpr size_t WS_BTIN8 = WS_HA8 + al256((size_t)T * 1024);
constexpr size_t WS_END = WS_BTIN8 + al256((size_t)1536 * 1024);
constexpr int CW_CNT = 4096;
constexpr int CW_ATTQ = 4224;
constexpr int CW_CVQ1 = 4288, CW_CVQ3 = 4352, CW_ACTRDY = 4608;
constexpr int CW_TMO2 = 4480;
constexpr int CV_PAIRS1 = 3072, CV_PAIRS3 = 4096, CV_HIDDEN = 2 * (CV_PAIRS1 + CV_PAIRS3);

#define XB_TMO      128
#define XB_XCNT(j)  (256  + 64 * (j))
#define XB_XSUB(j)  (1280 + 64 * (j))
#define XB_XGEN(j)  (2304 + 64 * (j))
#define XB_TOP      3328
#define XB_TOPGEN   3392
#define XCD_BAR_WORDS 3456
#define XB_SPIN_CAP (1u << 18)
__device__ __forceinline__ unsigned xb_ld(unsigned* p)              { return __hip_atomic_load(p, __ATOMIC_RELAXED, __HIP_MEMORY_SCOPE_AGENT); }
__device__ __forceinline__ unsigned xb_add(unsigned* p, unsigned v) { return __hip_atomic_fetch_add(p, v, __ATOMIC_RELAXED, __HIP_MEMORY_SCOPE_AGENT); }
__device__ __forceinline__ unsigned xb_xcc_id() { return (unsigned)__builtin_amdgcn_s_getreg((3 << 11) | 20) & 0xFu; }
#define XB_SPIN(cond, bar) do { unsigned _sp = 0; while (cond) { __builtin_amdgcn_s_sleep(1); \
    if ((++_sp & 255u) == 0u) { if (xb_ld(&(bar)[XB_TMO])) break; if (_sp > XB_SPIN_CAP) { atomicAdd(&(bar)[XB_TMO], 1u); break; } } } } while (0)
struct XcdBarrier { unsigned* bar; unsigned x; volatile LAS unsigned* st; };
__device__ __forceinline__ XcdBarrier xcd_barrier_post(unsigned* bar, volatile LAS unsigned* st) {
    XcdBarrier b; b.bar = bar; b.x = xb_xcc_id(); b.st = st;
    if (threadIdx.x == 0) (void)xb_add(&bar[XB_XCNT(b.x)], 1u);
    return b;
}
__device__ __forceinline__ void xcd_barrier_complete(unsigned* bar, unsigned x, unsigned& nloc, unsigned& nx) {
    const unsigned G = gridDim.x * gridDim.y * gridDim.z;
    unsigned sum, cnt, mine, sp = 0u;
    for (;;) {
        sum = 0u; cnt = 0u; mine = 0u;
#pragma unroll
        for (unsigned j = 0; j < 16; ++j) { const unsigned c = xb_ld(&bar[XB_XCNT(j)]); sum += c; cnt += (c > 0u) ? 1u : 0u; mine = (j == x) ? c : mine; }
        if (sum == G) break;
        __builtin_amdgcn_s_sleep(1);
        if ((++sp & 255u) == 0u) { if (xb_ld(&bar[XB_TMO])) break; if (sp > XB_SPIN_CAP) { atomicAdd(&bar[XB_TMO], 1u); break; } }
    }
    nloc = mine > 0u ? mine : 1u; nx = cnt > 0u ? cnt : 1u;
}
__device__ __forceinline__ void xcd_barrier(const XcdBarrier& b) {
    asm volatile("s_waitcnt vmcnt(0)" ::: "memory");
    __syncthreads();
    if (threadIdx.x == 0) {
        unsigned* bar = b.bar;
        __builtin_amdgcn_s_waitcnt(0);
        unsigned nloc = b.st[0], nx = b.st[1];
        if (nloc == 0u) { xcd_barrier_complete(bar, b.x, nloc, nx); b.st[0] = nloc; b.st[1] = nx; }
        const unsigned old = xb_add(&bar[XB_XSUB(b.x)], 1u);
        const unsigned gen = old / nloc;
        if (old + 1u == (gen + 1u) * nloc) {
            __builtin_amdgcn_fence(__ATOMIC_RELEASE, "agent");
            asm volatile("s_waitcnt vmcnt(0)" ::: "memory");
            const unsigned og = xb_add(&bar[XB_TOP], 1u);
            const unsigned tg = og / nx;
            if (og + 1u == (tg + 1u) * nx) xb_add(&bar[XB_TOPGEN], 1u);
            else XB_SPIN(xb_ld(&bar[XB_TOPGEN]) == tg, bar);
            __builtin_amdgcn_fence(__ATOMIC_ACQUIRE, "agent");
            xb_add(&bar[XB_XGEN(b.x)], 1u);
            asm volatile("s_waitcnt vmcnt(0)" ::: "memory");
        } else {
            XB_SPIN(xb_ld(&bar[XB_XGEN(b.x)]) == gen, bar);
            __builtin_amdgcn_fence(__ATOMIC_ACQUIRE, "agent");
            asm volatile("s_waitcnt vmcnt(0)" ::: "memory");
        }
    }
    __syncthreads();
}

__device__ __forceinline__ unsigned cvt_pk_bf16(float lo, float hi) { unsigned r; asm volatile("v_cvt_pk_bf16_f32 %0, %1, %2" : "=v"(r) : "v"(lo), "v"(hi)); return r; }
__device__ __forceinline__ unsigned pk4_fp8(float a, float b, float c, float d) { int w = __builtin_amdgcn_cvt_pk_fp8_f32(a, b, 0, false); w = __builtin_amdgcn_cvt_pk_fp8_f32(c, d, w, true); return (unsigned)w; }
__device__ __forceinline__ float bf16_lo(unsigned w) { return __uint_as_float(w << 16); }
__device__ __forceinline__ float bf16_hi(unsigned w) { return __uint_as_float(w & 0xffff0000u); }
template <int CTRL> __device__ __forceinline__ float dpp_f(float v) { return __builtin_bit_cast(float, __builtin_amdgcn_update_dpp(0, __builtin_bit_cast(int, v), CTRL, 0xf, 0xf, true)); }
__device__ __forceinline__ float wave_sum(float v) {
    v += dpp_f<0xB1>(v);
    v += dpp_f<0x4E>(v);
    v += dpp_f<0x141>(v);
    v += dpp_f<0x140>(v);
    const int vi = __builtin_bit_cast(int, v);
    const float r0 = __builtin_bit_cast(float, __builtin_amdgcn_readlane(vi, 0)), r1 = __builtin_bit_cast(float, __builtin_amdgcn_readlane(vi, 16));
    const float r2 = __builtin_bit_cast(float, __builtin_amdgcn_readlane(vi, 32)), r3 = __builtin_bit_cast(float, __builtin_amdgcn_readlane(vi, 48));
    return (r0 + r1) + (r2 + r3);
}
#define LDS_WAIT() asm volatile("s_waitcnt lgkmcnt(0)" ::: "memory")
#define VM_WAIT()  asm volatile("s_waitcnt vmcnt(0)" ::: "memory")
__device__ __forceinline__ int crow(int r, int hi) { return (r & 3) + 8 * (r >> 2) + 4 * hi; }

namespace pg8 {
constexpr int BM = 256, BK = 64, HALF = 128, HTB = HALF * BK * 2, STAGE_BYTES = 8 * HTB, NXCD = 8, WGM = 4, KD = 1024;
__device__ __forceinline__ int lds_byte(int r, int c) { const int st = (r >> 4) * 2 + (c >> 5), rr = r & 15, cc = c & 31, ob = rr * 64 + cc * 2; return st * 1024 + (ob ^ (((ob >> 9) & 1) << 5)); }
__device__ __forceinline__ void stage_rc(int b, int& R, int& C) { const int st = b / 1024, sb = b % 1024, swz = sb ^ (((sb >> 9) & 1) << 5); R = (st >> 1) * 16 + swz / 64; C = (st & 1) * 32 + (swz % 64) / 2; }
__device__ __forceinline__ int perm32(int rho) { const int n = rho >> 4, i = rho & 15; return 8 * (i >> 2) + 4 * n + (i & 3); }

struct Unit { int pm, pn, e, idx; };

__device__ __forceinline__ void order_decode(int wgid, int nM, int nN, int& pm, int& pn) {
    const int nig = WGM * nN, gid = wgid / nig, fm = gid * WGM, gsz = (nM - fm) < WGM ? (nM - fm) : WGM;
    pm = fm + ((wgid % nig) % gsz); pn = (wgid % nig) / gsz;
}
__device__ __forceinline__ bool order_next(int i, int G, int c, int nM, int nN, int& pm, int& pn, int woff = 0) {
    const int nwg = nM * nN - woff; const long L = (long)i * G + c; if (L >= nwg) return false;
    int wgid = (int)L; { const int q = nwg / NXCD, r = nwg % NXCD, xcd = wgid % NXCD, off = wgid / NXCD; wgid = (xcd < r ? xcd * (q + 1) : r * (q + 1) + (xcd - r) * q) + off; }
    order_decode(wgid + woff, nM, nN, pm, pn); return true;
}
struct StaticSched {
    int nM, nN, G, c, t0, toff;
    __device__ __forceinline__ bool next(int i, Unit& u) const { u.idx = i; const bool ok = order_next(i, G, c, nM, nN, u.pm, u.pn); u.e = (u.pn == 0) ? t0 : u.pn + toff; return ok; }
    __device__ __forceinline__ int a_row(const Unit& u, int h, int R) const { return u.pm * BM + h * HALF + R; }
    __device__ __forceinline__ int b_row(const Unit& u) const { return u.e * BM; }
};
template <bool GATHER> struct MoeSched {
    int nM, nN, G, c; int brows;
    const LAS int* tstart; const LAS int* toktab; int woff;
    __device__ __forceinline__ bool next(int i, Unit& u) const {
        u.idx = i;
        if (!order_next(i, G, c, nM, nN, u.pm, u.pn, woff)) return false;
        int e = 0;
#pragma unroll
        for (int k = 1; k < NE; ++k) e += (u.pm >= tstart[k]) ? 1 : 0;
        u.e = e; return true;
    }
    __device__ __forceinline__ int a_row(const Unit& u, int h, int R) const { if constexpr (GATHER) return toktab[u.idx * 256 + h * HALF + R]; else return u.pm * BM + h * HALF + R; }
    __device__ __forceinline__ int b_row(const Unit& u) const { return u.e * brows + u.pn * BM; }
};

typedef int v8i32 __attribute__((ext_vector_type(8)));
typedef int v4i32 __attribute__((ext_vector_type(4)));
__device__ __forceinline__ v8i32 cat8(bf16x8 a, bf16x8 b) { const v4i32 x = __builtin_bit_cast(v4i32, a), y = __builtin_bit_cast(v4i32, b); return __builtin_shufflevector(x, y, 0, 1, 2, 3, 4, 5, 6, 7); }
template <class Epi, class Sched, bool FP8 = false, int SW = 0x7f7f7f7f, int SA = 0x7f7f7f7f>
__device__ __forceinline__ void gemm_phase(LAS unsigned char* lds, const char* Abase, const char* Bbase, const Sched& S, const Epi& E) {
    const int tid = threadIdx.x, wid = __builtin_amdgcn_readfirstlane(tid >> 6), lane = tid & 63, wr = wid >> 2, wc = wid & 3, fr = lane & 15, fq = lane >> 4;
    constexpr int ROWB = FP8 ? KD : 2 * KD, nt = ROWB / 128;
    int RA[2], CA[2]; unsigned voffB[2];
#pragma unroll
    for (int i = 0; i < 2; ++i) { int R, C; stage_rc(tid * 16 + i * 8192, R, C); const int Rb = Epi::PERM ? ((R & ~31) + perm32(R & 31)) : R;
        RA[i] = R; CA[i] = C * 2; voffB[i] = (unsigned)(Rb * ROWB + C * 2); }
    const size_t kstep = (size_t)(BK * 2);
    const size_t hstep = (size_t)HALF * ROWB;
    const unsigned ldsw = (unsigned)wid * 1024u;
    const int aoff = lds_byte(wr * 64 + fr, fq * 8), boff = lds_byte(wc * 32 + fr, fq * 8);
#define PG8_SA(b, h) (((b) * 2 + (h)) * HTB)
#define PG8_SB(b, h) ((4 + (b) * 2 + (h)) * HTB)
#define PG8_STAGE(bufoff, gbase, voff) do { _Pragma("unroll") for (int _i = 0; _i < 2; ++_i) \
        __builtin_amdgcn_global_load_lds((const unsigned*)((const char*)(gbase) + (voff)[_i]), (LAS unsigned*)(lds + (bufoff) + ldsw + _i * 8192), 16, 0, 0); } while (0)
#define PG8_LDA(dst, b, h) do { _Pragma("unroll") for (int m = 0; m < 4; ++m) _Pragma("unroll") for (int k = 0; k < 2; ++k) dst[m][k] = *(const LAS bf16x8*)(lds + PG8_SA(b, h) + aoff + m * 2048 + k * 1024); } while (0)
#define PG8_LDB(dst, b, h) do { _Pragma("unroll") for (int n = 0; n < 2; ++n) _Pragma("unroll") for (int k = 0; k < 2; ++k) dst[n][k] = *(const LAS bf16x8*)(lds + PG8_SB(b, h) + boff + n * 2048 + k * 1024); } while (0)
#define PG8_MMA(ai, bj, At, Bt) do { __builtin_amdgcn_s_setprio(1); if constexpr (FP8) { _Pragma("unroll") for (int m = 0; m < 4; ++m) _Pragma("unroll") for (int n = 0; n < 2; ++n) \
        acc[ai][bj][m][n] = __builtin_amdgcn_mfma_scale_f32_16x16x128_f8f6f4(cat8(Bt[n][0], Bt[n][1]), cat8(At[m][0], At[m][1]), acc[ai][bj][m][n], 0, 0, 0, SW, 0, SA); } \
        else { _Pragma("unroll") for (int m = 0; m < 4; ++m) _Pragma("unroll") for (int n = 0; n < 2; ++n) _Pragma("unroll") for (int k = 0; k < 2; ++k) \
        acc[ai][bj][m][n] = __builtin_amdgcn_mfma_f32_16x16x32_bf16(Bt[n][k], At[m][k], acc[ai][bj][m][n], 0, 0, 0); } __builtin_amdgcn_s_setprio(0); } while (0)
#define PG8_WAIT_V(n) asm volatile("s_waitcnt vmcnt(" #n ")" ::: "memory")
#define PG8_WAIT_L(n) asm volatile("s_waitcnt lgkmcnt(" #n ")" ::: "memory")
#define PG8_BAR __builtin_amdgcn_s_barrier()
#define PG8_SCHED __builtin_amdgcn_sched_barrier(0)
    Unit cur, nxt; int ui = 0;
    if (!S.next(0, cur)) return;
    f32x4 acc[2][2][4][2]; f32x4 bini[2][2];
#pragma unroll
    for (int b = 0; b < 2; ++b)
#pragma unroll
        for (int n = 0; n < 2; ++n) bini[b][n] = Epi::BIAS_INIT ? E.bias4(cur, b, n, wc, fq) : (f32x4){0.f, 0.f, 0.f, 0.f};
#pragma unroll
    for (int a = 0; a < 2; ++a)
#pragma unroll
        for (int b = 0; b < 2; ++b)
#pragma unroll
            for (int m = 0; m < 4; ++m)
#pragma unroll
                for (int n = 0; n < 2; ++n) acc[a][b][m][n] = bini[b][n];
    bf16x8 At[4][2], B0[2][2], B1[2][2];
    unsigned oA[2][2];
#pragma unroll
    for (int h = 0; h < 2; ++h)
#pragma unroll
        for (int i = 0; i < 2; ++i) oA[h][i] = (unsigned)(S.a_row(cur, h, RA[i]) * ROWB + CA[i]);
    const char* cB = Bbase + (size_t)S.b_row(cur) * ROWB;
    const char* cA = Abase;
    PG8_STAGE(PG8_SB(0, 0), cB, voffB); PG8_STAGE(PG8_SA(0, 0), cA, oA[0]); PG8_STAGE(PG8_SB(0, 1), cB + hstep, voffB); PG8_STAGE(PG8_SA(0, 1), cA, oA[1]);
    if (wr == 1) PG8_BAR;
    PG8_WAIT_V(4); PG8_BAR;
    PG8_STAGE(PG8_SB(1, 0), cB + kstep, voffB); PG8_STAGE(PG8_SA(1, 0), cA + kstep, oA[0]); PG8_STAGE(PG8_SB(1, 1), cB + hstep + kstep, voffB);
    PG8_WAIT_V(6); PG8_BAR;
    for (;;) {
        const bool has_next = S.next(ui + 1, nxt);
        const char* nB = has_next ? Bbase + (size_t)S.b_row(nxt) * ROWB : cB;
        for (int t = 0; t < nt; t += 2) {
            const bool last = (t == nt - 2);
            const char* a1 = cA + (size_t)(t + 1) * kstep;
            const char* a2 = last ? cA : cA + (size_t)(t + 2) * kstep; const char* b2 = last ? nB : cB + (size_t)(t + 2) * kstep;
            const char* a3 = a2 + kstep; const char* b3 = b2 + kstep;
            PG8_LDB(B0, 0, 0); PG8_SCHED; PG8_LDA(At, 0, 0); PG8_STAGE(PG8_SA(1, 1), a1, oA[1]);
            if (last && has_next) {
#pragma unroll
                for (int h = 0; h < 2; ++h)
#pragma unroll
                    for (int i = 0; i < 2; ++i) oA[h][i] = (unsigned)(S.a_row(nxt, h, RA[i]) * ROWB + CA[i]);
            }
            PG8_WAIT_L(8); PG8_BAR; PG8_WAIT_L(0); PG8_MMA(0, 0, At, B0); PG8_BAR; PG8_SCHED;
            PG8_LDB(B1, 0, 1); PG8_STAGE(PG8_SB(0, 0), b2, voffB);
            PG8_BAR; PG8_WAIT_L(0); PG8_MMA(0, 1, At, B1); PG8_BAR;
            PG8_LDA(At, 0, 1); PG8_STAGE(PG8_SA(0, 0), a2, oA[0]);
            PG8_BAR; PG8_WAIT_L(0); PG8_MMA(1, 0, At, B0); PG8_BAR; PG8_SCHED;
            PG8_STAGE(PG8_SB(0, 1), b2 + hstep, voffB);
            PG8_WAIT_V(6); PG8_BAR; PG8_MMA(1, 1, At, B1); PG8_BAR;
            PG8_LDB(B0, 1, 0); PG8_SCHED; PG8_LDA(At, 1, 0); PG8_STAGE(PG8_SA(0, 1), a2, oA[1]);
            PG8_WAIT_L(8); PG8_BAR; PG8_WAIT_L(0); PG8_MMA(0, 0, At, B0); PG8_BAR; PG8_SCHED;
            PG8_LDB(B1, 1, 1); PG8_STAGE(PG8_SB(1, 0), b3, voffB);
            PG8_BAR; PG8_WAIT_L(0); PG8_MMA(0, 1, At, B1); PG8_BAR;
            PG8_LDA(At, 1, 1); PG8_STAGE(PG8_SA(1, 0), a3, oA[0]);
            PG8_BAR; PG8_WAIT_L(0); PG8_MMA(1, 0, At, B0); PG8_BAR; PG8_SCHED;
            PG8_STAGE(PG8_SB(1, 1), b3 + hstep, voffB);
            PG8_WAIT_V(6); PG8_BAR; PG8_MMA(1, 1, At, B1); PG8_BAR;
        }
        int l2 = threadIdx.x & 63; asm volatile("" : "+v"(l2));
        const int fr2 = l2 & 15, fq2 = l2 >> 4;
        if (Epi::BIAS_INIT && has_next) {
#pragma unroll
            for (int b = 0; b < 2; ++b)
#pragma unroll
                for (int n = 0; n < 2; ++n) bini[b][n] = E.bias4(nxt, b, n, wc, fq2);
        }
        E(acc, cur, wr, wc, fr2, fq2);
        if (!has_next) break;
#pragma unroll
        for (int a = 0; a < 2; ++a)
#pragma unroll
            for (int b = 0; b < 2; ++b)
#pragma unroll
                for (int m = 0; m < 4; ++m)
#pragma unroll
                    for (int n = 0; n < 2; ++n) acc[a][b][m][n] = bini[b][n];
        cur = nxt; cB = nB; ++ui;
    }
    PG8_WAIT_V(0);
    if (wr == 0) PG8_BAR;
    PG8_BAR;
#undef PG8_SA
#undef PG8_SB
#undef PG8_STAGE
#undef PG8_LDA
#undef PG8_LDB
#undef PG8_MMA
#undef PG8_WAIT_V
#undef PG8_WAIT_L
#undef PG8_BAR
#undef PG8_SCHED
}
}

struct EpiInProj {
    static constexpr bool PERM = true, BIAS_INIT = false;
    bf16_t *u, *q, *k, *v, *iq, *ik; float* iw; const float* ropeQK; const float* ropeIX;
    __device__ __forceinline__ f32x4 bias4(const pg8::Unit&, int, int, int, int) const { return (f32x4){0.f, 0.f, 0.f, 0.f}; }
    __device__ __forceinline__ void operator()(f32x4 (&acc)[2][2][4][2], const pg8::Unit& un, int wr, int wc, int fr, int fq) const {
        const int lane = threadIdx.x & 63;
#pragma unroll
        for (int bj = 0; bj < 2; ++bj) {
            const int gc = un.e * 256 + bj * 128;
            bf16_t* dst; unsigned char* dst8 = nullptr; int ld; int kind = 0; bool f8 = false;
            const int cin = wc * 32 + 8 * fq;
            if (gc < 256) { dst = u + gc + cin; ld = 256; }
            else if (gc < 1024) { dst8 = (unsigned char*)q + (gc - 256) + cin; dst = q; ld = 768; kind = (wc == 0) ? 1 : 0; f8 = true; }
            else if (gc < 1280) { dst8 = (unsigned char*)k + (gc - 1024) + cin; dst = k; ld = 256; kind = (wc == 0) ? 1 : 0; f8 = true; }
            else if (gc < 1536) { dst = v + (gc - 1280) + cin; ld = 256; }
            else if (gc < 2048) { dst = iq + (gc - 1536) + cin; ld = 512; kind = ((wc & 1) == 0) ? 2 : 0; }
            else if (gc == 2048) { if (wc >= 2) { if (wc == 2 && fq == 0) {
#pragma unroll
                        for (int ai = 0; ai < 2; ++ai)
#pragma unroll
                            for (int m = 0; m < 4; ++m) { const int row = un.pm * 256 + ai * 128 + wr * 64 + m * 16 + fr;
                                *(f32x4*)(iw + (size_t)row * 8) = acc[ai][bj][m][0]; *(f32x4*)(iw + (size_t)row * 8 + 4) = acc[ai][bj][m][1]; } }
                    continue; }
                dst = ik + cin; ld = 64; kind = (wc == 0) ? 2 : 0; }
            else continue;
#pragma unroll
            for (int ai = 0; ai < 2; ++ai)
#pragma unroll
                for (int m = 0; m < 4; ++m) {
                    const int row = un.pm * 256 + ai * 128 + wr * 64 + m * 16 + fr;
                    f32x4 v0 = acc[ai][bj][m][0], v1 = acc[ai][bj][m][1];
                    if (kind == 1) {
                        const float* rp = ropeQK + (size_t)row * 32 + 8 * (fq & 1);
                        const f32x4 c0 = *(const f32x4*)rp, c1 = *(const f32x4*)(rp + 4), s0 = *(const f32x4*)(rp + 16), s1 = *(const f32x4*)(rp + 20);
                        f32x4 p0, p1;
#pragma unroll
                        for (int j = 0; j < 4; ++j) { p0[j] = __shfl_xor(v0[j], 32); p1[j] = __shfl_xor(v1[j], 32); }
                        const float sg = (fq < 2) ? -1.f : 1.f;
                        v0 = v0 * c0 + sg * (p0 * s0); v1 = v1 * c1 + sg * (p1 * s1);
                    } else if (kind == 2) {
                        const float* rp = ropeIX + (size_t)row * 16;
                        const f32x4 c0 = *(const f32x4*)rp, c1 = *(const f32x4*)(rp + 4), s0 = *(const f32x4*)(rp + 8), s1 = *(const f32x4*)(rp + 12);
                        f32x4 p0, p1;
#pragma unroll
                        for (int j = 0; j < 4; ++j) { p0[j] = __shfl_xor(v0[j], 16); p1[j] = __shfl_xor(v1[j], 16); }
                        if (fq < 2) { const float sg = (fq == 0) ? -1.f : 1.f; v0 = v0 * c0 + sg * (p0 * s0); v1 = v1 * c1 + sg * (p1 * s1); }
                    }
                    if (f8) { u32x2 w8; w8.x = pk4_fp8(v0[0], v0[1], v0[2], v0[3]); w8.y = pk4_fp8(v1[0], v1[1], v1[2], v1[3]); *(u32x2*)(dst8 + (size_t)row * ld) = w8; }
                    else {
                    u32x4 w; w.x = cvt_pk_bf16(v0[0], v0[1]); w.y = cvt_pk_bf16(v0[2], v0[3]); w.z = cvt_pk_bf16(v1[0], v1[1]); w.w = cvt_pk_bf16(v1[2], v1[3]);
                    *(u32x4*)(dst + (size_t)row * ld) = w;
                    }
                }
        }
        (void)lane;
    }
};
struct EpiMix {
    static constexpr bool PERM = true, BIAS_INIT = false;
    bf16_t* mix;
    __device__ __forceinline__ f32x4 bias4(const pg8::Unit&, int, int, int, int) const { return (f32x4){0.f, 0.f, 0.f, 0.f}; }
    __device__ __forceinline__ void operator()(f32x4 (&acc)[2][2][4][2], const pg8::Unit& un, int wr, int wc, int fr, int fq) const {
        const int row0 = un.pm * 256 + wr * 64 + fr, col0 = un.pn * 256 + wc * 32 + 8 * fq;
#pragma unroll
        for (int bj = 0; bj < 2; ++bj)
#pragma unroll
            for (int ai = 0; ai < 2; ++ai)
#pragma unroll
                for (int m = 0; m < 4; ++m) {
                    const f32x4 v0 = acc[ai][bj][m][0], v1 = acc[ai][bj][m][1];
                    u32x4 w; w.x = cvt_pk_bf16(v0[0], v0[1]); w.y = cvt_pk_bf16(v0[2], v0[3]); w.z = cvt_pk_bf16(v1[0], v1[1]); w.w = cvt_pk_bf16(v1[2], v1[3]);
                    *(u32x4*)(mix + (size_t)(row0 + ai * 128 + m * 16) * 1024 + col0 + bj * 128) = w;
                }
    }
};
struct EpiGateUp {
    static constexpr bool PERM = true, BIAS_INIT = true;
    unsigned char* act; const float* bias; unsigned* rdy;
    __device__ __forceinline__ f32x4 bias4(const pg8::Unit& un, int bj, int n, int wc, int fq) const { return *(const f32x4*)(bias + (size_t)un.e * 2048 + bj * 1024 + un.pn * 128 + wc * 32 + 8 * fq + 4 * n); }
    __device__ __forceinline__ void operator()(f32x4 (&acc)[2][2][4][2], const pg8::Unit& un, int wr, int wc, int fr, int fq) const {
        const int row0 = un.pm * 256 + wr * 64 + fr, col0 = un.pn * 128 + wc * 32 + 8 * fq;
#pragma unroll
        for (int ai = 0; ai < 2; ++ai)
#pragma unroll
            for (int m = 0; m < 4; ++m) {
                float o[8];
#pragma unroll
                for (int n = 0; n < 2; ++n) {
                    const f32x4 gt = acc[ai][0][m][n], up = acc[ai][1][m][n];
#pragma unroll
                    for (int j = 0; j < 4; ++j) {
                        const float gg = __builtin_amdgcn_fmed3f(gt[j], -INFINITY, 7.0f), uu = __builtin_amdgcn_fmed3f(up[j], -7.0f, 7.0f);
                        const float sig = __builtin_amdgcn_rcpf(1.0f + __builtin_amdgcn_exp2f(-1.702f * 1.4426950408889634f * gg));
                        o[4 * n + j] = (uu * 8.0f + 8.0f) * gg * sig;
                    }
                }
                u32x2 w; w.x = pk4_fp8(o[0], o[1], o[2], o[3]); w.y = pk4_fp8(o[4], o[5], o[6], o[7]);
                const unsigned dofs = (unsigned)((row0 + ai * 128 + m * 16) * 1024 + col0);
                if (un.pm < 32) asm volatile("global_store_dwordx2 %0, %1, %2 sc1" :: "v"(dofs), "v"(w), "s"(act) : "memory");
                else *(u32x2*)(act + dofs) = w;
            }
        if (un.pm < 32) {
            asm volatile("s_waitcnt vmcnt(0)" ::: "memory");
            if ((threadIdx.x & 63) == 0) __hip_atomic_fetch_add(rdy + un.pm, 1u, __ATOMIC_RELAXED, __HIP_MEMORY_SCOPE_AGENT);
        }
    }
};
struct EpiDown {
    static constexpr bool PERM = true, BIAS_INIT = false;
    unsigned char* y; const float* bias;
    __device__ __forceinline__ f32x4 bias4(const pg8::Unit& un, int bj, int n, int wc, int fq) const { return *(const f32x4*)(bias + (size_t)un.e * 1024 + un.pn * 256 + bj * 128 + wc * 32 + 8 * fq + 4 * n); }
    __device__ __forceinline__ void operator()(f32x4 (&acc)[2][2][4][2], const pg8::Unit& un, int wr, int wc, int fr, int fq) const {
        const int row0 = un.pm * 256 + wr * 64 + fr, col0 = un.pn * 256 + wc * 32 + 8 * fq;
        const float* bp = bias + (size_t)un.e * 1024 + col0;
#pragma unroll
        for (int bj = 0; bj < 2; ++bj) {
            const f32x4 b0 = *(const f32x4*)(bp + bj * 128) * 64.0f, b1 = *(const f32x4*)(bp + bj * 128 + 4) * 64.0f;
#pragma unroll
            for (int ai = 0; ai < 2; ++ai)
#pragma unroll
                for (int m = 0; m < 4; ++m) {
                    const f32x4 v0 = acc[ai][bj][m][0] * 64.0f + b0, v1 = acc[ai][bj][m][1] * 64.0f + b1;
#define CL8(x) __builtin_amdgcn_fmed3f((x), -448.f, 448.f)
                    u32x2 w; w.x = pk4_fp8(CL8(v0[0]), CL8(v0[1]), CL8(v0[2]), CL8(v0[3])); w.y = pk4_fp8(CL8(v1[0]), CL8(v1[1]), CL8(v1[2]), CL8(v1[3]));
#undef CL8
                    *(u32x2*)(y + (size_t)(row0 + ai * 128 + m * 16) * 1024 + col0 + bj * 128) = w;
                }
        }
    }
};

struct Args { const void* in[18]; float* out; unsigned char* ws; int ph_lo, ph_hi; };
struct Frame {
    LAS unsigned char* lds; int tid, lane, wave, G, bid;
    const float *x, *ln_in_g, *ln_in_b, *w_in, *w_pool, *pool_scale, *w_out, *ln1_g, *ln1_b, *w_router, *b_router, *w_gu, *b_gu, *w_dn, *b_dn, *ln2_g, *ln2_b;
    const int* positions; float* out; unsigned char* ws; unsigned* ctl;
};

typedef const Args __attribute__((address_space(4))) * KArgP;
__device__ __forceinline__ void frame_refresh(Frame& F) {
    KArgP ap = (KArgP)__builtin_amdgcn_kernarg_segment_ptr(); asm volatile("" : "+s"(ap));
    int t_ = threadIdx.x; asm volatile("" : "+v"(t_)); F.tid = t_; F.lane = t_ & 63;
    F.x = (const float*)ap->in[0]; F.positions = (const int*)ap->in[1]; F.ln_in_g = (const float*)ap->in[2]; F.ln_in_b = (const float*)ap->in[3];
    F.w_in = (const float*)ap->in[4]; F.w_pool = (const float*)ap->in[5]; F.pool_scale = (const float*)ap->in[6]; F.w_out = (const float*)ap->in[7];
    F.ln1_g = (const float*)ap->in[8]; F.ln1_b = (const float*)ap->in[9]; F.w_router = (const float*)ap->in[10]; F.b_router = (const float*)ap->in[11];
    F.w_gu = (const float*)ap->in[12]; F.b_gu = (const float*)ap->in[13]; F.w_dn = (const float*)ap->in[14]; F.b_dn = (const float*)ap->in[15];
    F.ln2_g = (const float*)ap->in[16]; F.ln2_b = (const float*)ap->in[17];
    F.out = ap->out; F.ws = ap->ws; F.ctl = (unsigned*)(ap->ws + WS_CTL);
}
struct TrItem { const float* src; unsigned char* dst; int ldw, ldt, fp8; };
__device__ __forceinline__ TrItem mk_item(const float* W, unsigned char* WT, int ldw, int k0, int n0, int ldt, int drow0, int fp8) {
    TrItem t; t.src = W + (size_t)k0 * ldw + n0; t.dst = WT + ((size_t)drow0 * ldt + k0) * (fp8 ? 1 : 2); t.ldw = ldw; t.ldt = ldt; t.fp8 = fp8; return t;
}
__device__ __forceinline__ void tr_load(const TrItem& t, float (&tmp)[32], int lane) {
    if (t.fp8) {
        const float* p = t.src + (size_t)(lane >> 3) * t.ldw + (lane & 7) * 4;
#pragma unroll
        for (int j = 0; j < 8; ++j) { const f32x4 v = __builtin_nontemporal_load((const f32x4*)(p + (size_t)(8 * j) * t.ldw)); tmp[4 * j] = v.x; tmp[4 * j + 1] = v.y; tmp[4 * j + 2] = v.z; tmp[4 * j + 3] = v.w; }
    } else {
        const float* p = t.src + (size_t)(lane >> 5) * t.ldw + (lane & 31);
#pragma unroll
        for (int i = 0; i < 32; ++i) tmp[i] = __builtin_nontemporal_load(p + (size_t)(2 * i) * t.ldw);
    }
}
__device__ __forceinline__ void tr_store(const TrItem& t, const float (&tmp)[32], LAS float* scr, int lane) {
    if (t.fp8) {
#pragma unroll
        for (int j = 0; j < 8; ++j) *(LAS f32x4*)(scr + (8 * j + (lane >> 3)) * 32 + (lane & 7) * 4) = (f32x4){tmp[4 * j], tmp[4 * j + 1], tmp[4 * j + 2], tmp[4 * j + 3]};
        LDS_WAIT();
        const int n = lane >> 1, kb = 32 * (lane & 1); const LAS float* sp = scr + kb * 32 + n;
        unsigned o[8];
#pragma unroll
        for (int q = 0; q < 8; ++q) { float v[4];
#pragma unroll
            for (int j = 0; j < 4; ++j) v[j] = __builtin_amdgcn_fmed3f(sp[(4 * q + j) * 32] * 64.0f, -448.f, 448.f);
            o[q] = pk4_fp8(v[0], v[1], v[2], v[3]); }
        unsigned char* dp = t.dst + (size_t)n * 1024 + kb;
        *(u32x4*)dp = (u32x4){o[0], o[1], o[2], o[3]}; *(u32x4*)(dp + 16) = (u32x4){o[4], o[5], o[6], o[7]};
    } else {
#pragma unroll
        for (int i = 0; i < 32; ++i) { const int kk = 2 * i + (lane >> 5); scr[kk * 33 + (lane & 31)] = tmp[i]; }
        LDS_WAIT();
        const int c = lane & 7;
#pragma unroll
        for (int j = 0; j < 4; ++j) { const int n = (lane >> 3) + 8 * j; const LAS float* sp = scr + (8 * c) * 33 + n;
            u32x4 o; o.x = cvt_pk_bf16(sp[0 * 33], sp[1 * 33]); o.y = cvt_pk_bf16(sp[2 * 33], sp[3 * 33]); o.z = cvt_pk_bf16(sp[4 * 33], sp[5 * 33]); o.w = cvt_pk_bf16(sp[6 * 33], sp[7 * 33]);
            *(u32x4*)(t.dst + ((size_t)n * t.ldt + 8 * c) * 2) = o; }
    }
    LDS_WAIT();
}
__device__ __forceinline__ TrItem moe_item(Frame& F, int r) {
    constexpr int I_GU = NE * 16 * 64;
    if (r < I_GU) { const int e = r / 1024, rr = r % 1024, kb = rr / 64, nb = rr % 64, n0 = 32 * nb, bj = n0 / 1024, rem = n0 % 1024, pn = rem / 128, j0 = rem % 128;
        return mk_item(F.w_gu + (size_t)e * 1024 * 2048, F.ws + WS_BTGU + (size_t)e * 2048 * 1024, 2048, 64 * kb, n0, 1024, pn * 256 + bj * 128 + j0, 1); }
    r -= I_GU; const int e = r / 512, rr = r % 512, kb = rr / 32, nb = rr % 32;
    return mk_item(F.w_dn + (size_t)e * 1024 * 1024, F.ws + WS_BTDN + (size_t)e * 1024 * 1024, 1024, 64 * kb, 32 * nb, 1024, 32 * nb, 1);
}
__device__ __forceinline__ void convert_range(Frame& F, int first, int n, int widx, int nw) {
    LAS float* scr = (LAS float*)(F.lds + F.wave * 16384);
    int base = 2 * widx; if (base >= n) return;
    float va[32], vb[32], vc[32], vd[32];
    TrItem ta = moe_item(F, first + base), tb = moe_item(F, first + base + 1);
    tr_load(ta, va, F.lane); tr_load(tb, vb, F.lane);
    for (;;) {
        const int nb = base + 2 * nw; const bool more = nb < n;
        const TrItem tc = moe_item(F, first + (more ? nb : base)), td = moe_item(F, first + (more ? nb : base) + 1);
        if (more) { tr_load(tc, vc, F.lane); tr_load(td, vd, F.lane); }
        tr_store(ta, va, scr, F.lane); tr_store(tb, vb, scr, F.lane);
        if (!more) break;
        const int nb2 = nb + 2 * nw; const bool more2 = nb2 < n;
        ta = moe_item(F, first + (more2 ? nb2 : nb)); tb = moe_item(F, first + (more2 ? nb2 : nb) + 1);
        if (more2) { tr_load(ta, va, F.lane); tr_load(tb, vb, F.lane); }
        tr_store(tc, vc, scr, F.lane); tr_store(td, vd, scr, F.lane);
        if (!more2) break;
        base = nb2;
    }
}
__device__ __forceinline__ void cvq_pull(Frame& F, unsigned* head, int first, int npairs) {
    LAS float* scr = (LAS float*)(F.lds + F.wave * 16384);
    for (;;) {
        unsigned c = 0; if (F.lane == 0) c = __hip_atomic_fetch_add(head, 1u, __ATOMIC_RELAXED, __HIP_MEMORY_SCOPE_AGENT);
        c = (unsigned)__builtin_amdgcn_readfirstlane((int)c);
        if (c >= (unsigned)npairs) break;
        const int r = 2 * (first + (int)c);
        const TrItem ta = moe_item(F, r), tb = moe_item(F, r + 1);
        float va[32], vb[32];
        tr_load(ta, va, F.lane); tr_load(tb, vb, F.lane);
        tr_store(ta, va, scr, F.lane); tr_store(tb, vb, scr, F.lane);
    }
}
__constant__ double ROPE_QK_FREQ[16] = {1.0, 0.44036660267178046, 0.19392274474868576, 0.08539710028576561, 0.03760603093086393, 0.016560440080994446, 0.007292664737217109, 0.003211445994752591,
    0.001414213562373095, 0.000622772421914596, 0.0002742481756762073, 0.00012076973741146504, 5.318295896944988e-05, 2.341999896140934e-05, 1.031338537721246e-05, 4.5416704806078695e-06};
__constant__ double ROPE_IX_FREQ[8] = {1.0, 0.19392274474868576, 0.03760603093086393, 0.007292664737217109, 0.001414213562373095, 0.0002742481756762073, 5.318295896944988e-05, 1.031338537721246e-05};

__device__ __forceinline__ void p0_prologue(Frame& F) {
    LAS float* scr = (LAS float*)(F.lds + F.wave * 16384);
    const int gw = F.bid * 8 + F.wave, NGW = F.G * 8;
    const int gt = F.bid * NTHREADS + F.tid, NGT = F.G * NTHREADS;
    bf16_t* BtIn = (bf16_t*)(F.ws + WS_BTIN); bf16_t* BtOut = (bf16_t*)(F.ws + WS_BTOUT);
    bf16_t* WpT = (bf16_t*)(F.ws + WS_WPT);
    constexpr int I_IN = 16 * 66, I_OUT = 16 * 32, I_POOL = 8, I_MOE = NE * 16 * 64 + NE * 16 * 32;
    constexpr int NSMALL = I_IN + I_OUT + I_POOL, NITEMS = NSMALL + (I_MOE - CV_HIDDEN);
    auto decode = [&](int it) -> TrItem {
        int r = it;
        if (r < I_IN) { const int kb = r / 66, nb = r % 66;
            if (nb >= 8 && nb < 48) return mk_item(F.w_in, F.ws + WS_BTIN8, INW, 64 * kb, 32 * nb, 1024, 32 * nb, 1);
            return mk_item(F.w_in, (unsigned char*)BtIn, INW, 64 * kb, 32 * nb, 1024, 32 * nb, 0); } r -= I_IN;
        if (r < I_OUT) { const int kb = r / 32, nb = r % 32; return mk_item(F.w_out, (unsigned char*)BtOut, 1024, 64 * kb, 32 * nb, 1024, 32 * nb, 0); } r -= I_OUT;
        if (r < I_POOL) { const int g = r / 2, nb = r % 2; return mk_item(F.w_pool + g * 4096, (unsigned char*)(WpT + g * 4096), 64, 0, 32 * nb, 64, 32 * nb, 0); } r -= I_POOL;
        return moe_item(F, CV_HIDDEN + r);
    };
    for (int it = gw; it < NITEMS; it += 2 * NGW) {
        const bool two = (it + NGW < NITEMS);
        const TrItem ta = decode(it), tb = decode(two ? it + NGW : it);
        float va[32], vb[32];
        tr_load(ta, va, F.lane); if (two) tr_load(tb, vb, F.lane);
        tr_store(ta, va, scr, F.lane); if (two) tr_store(tb, vb, scr, F.lane);
    }
    for (int i = gt; i < 192 * 1024; i += NGT) { const int n = 2112 + i / 1024, k = i % 1024; const float v = (n < INW) ? F.w_in[(size_t)k * INW + n] : 0.f;
        BtIn[(size_t)n * 1024 + k] = (bf16_t)(cvt_pk_bf16(v, 0.f) & 0xffffu); }
    { float* wrA = (float*)(F.ws + WS_WRA);
      for (int i = gt; i < 32768; i += NGT) { const int ii = i & 3, e = (i >> 2) & 31, kh = (i >> 7) & 1, c = i >> 8; wrA[i] = F.w_router[(8 * c + 4 * kh + ii) * 32 + e]; } }
    { float* rq = (float*)(F.ws + WS_ROPEQK); float* ri = (float*)(F.ws + WS_ROPEIX);
      for (int i = gt; i < T * 24; i += NGT) { const int tok = i / 24, j = i % 24; const double pos = (double)F.positions[tok];
          const double inv = (j < 16) ? ROPE_QK_FREQ[j] : ROPE_IX_FREQ[j - 16];
          double rev = pos * inv * 0.15915494309189535; rev -= __builtin_floor(rev);
          const float c = __builtin_amdgcn_cosf((float)rev), s = __builtin_amdgcn_sinf((float)rev);
          if (j < 16) { rq[(size_t)tok * 32 + j] = c; rq[(size_t)tok * 32 + 16 + j] = s; } else { ri[(size_t)tok * 16 + (j - 16)] = c; ri[(size_t)tok * 16 + 8 + (j - 16)] = s; } } }
    if (F.bid == 0 && F.tid < 64) { F.ctl[CW_CNT + F.tid] = 0u; if (F.tid == 0) F.ctl[CW_ATTQ] = 0u; }
    { bf16_t* hA = (bf16_t*)(F.ws + WS_HA); float* stats = (float*)(F.ws + WS_STATS);
      f32x4 gv[4], bv[4];
#pragma unroll
      for (int j = 0; j < 4; ++j) { gv[j] = ((const f32x4*)F.ln_in_g)[F.lane + 64 * j]; bv[j] = ((const f32x4*)F.ln_in_b)[F.lane + 64 * j]; }
      f32x4 nx[4];
      if (gw < T) { const f32x4* xr = (const f32x4*)(F.x + (size_t)gw * 1024) + F.lane;
#pragma unroll
          for (int j = 0; j < 4; ++j) nx[j] = __builtin_nontemporal_load(xr + 64 * j); }
      for (int m = gw; m < T; m += NGW) {
          f32x4 v[4]; float s = 0.f;
#pragma unroll
          for (int j = 0; j < 4; ++j) { v[j] = nx[j]; s += (v[j].x + v[j].y) + (v[j].z + v[j].w); }
          if (m + NGW < T) { const f32x4* xr = (const f32x4*)(F.x + (size_t)(m + NGW) * 1024) + F.lane;
#pragma unroll
              for (int j = 0; j < 4; ++j) nx[j] = __builtin_nontemporal_load(xr + 64 * j); }
          const float mean = wave_sum(s) * (1.f / 1024.f); float s2 = 0.f;
#pragma unroll
          for (int j = 0; j < 4; ++j) { v[j] = v[j] - mean; s2 += (v[j].x * v[j].x + v[j].y * v[j].y) + (v[j].z * v[j].z + v[j].w * v[j].w); }
          const float rstd = 1.f / sqrtf(wave_sum(s2) * (1.f / 1024.f) + LN_EPS);
          u32x2* o8 = (u32x2*)(hA + (size_t)m * 1024) + F.lane; unsigned* q8 = (unsigned*)(F.ws + WS_HA8 + (size_t)m * 1024) + F.lane;
#pragma unroll
          for (int j = 0; j < 4; ++j) { const f32x4 h = v[j] * rstd * gv[j] + bv[j]; u32x2 w; w.x = cvt_pk_bf16(h.x, h.y); w.y = cvt_pk_bf16(h.z, h.w); o8[64 * j] = w; q8[64 * j] = pk4_fp8(h.x, h.y, h.z, h.w); }
          if (F.lane == 0) { stats[(size_t)m * 2] = mean; stats[(size_t)m * 2 + 1] = rstd; }
      } }
}

__device__ __forceinline__ void p2_pool(Frame& F) {
    const bf16_t* U = (const bf16_t*)(F.ws + WS_U); const bf16_t* WpT = (const bf16_t*)(F.ws + WS_WPT); bf16_t* cat = (bf16_t*)(F.ws + WS_CAT);
    LAS bf16_t* dl = (LAS bf16_t*)F.lds;
    LAS bf16_t* ul = (LAS bf16_t*)(F.lds + 33792);
    for (int tile = F.bid; tile < T / 64; tile += F.G) {
        const int t0 = tile * 64, pos0 = t0 % SEQ;
        __syncthreads();
        for (int i = F.tid; i < 79 * 32; i += NTHREADS) { const int r = i >> 5, c8 = i & 31; u32x4 v = {0u, 0u, 0u, 0u};
            if (pos0 + r - 15 >= 0) v = *(const u32x4*)(U + (size_t)(t0 + r - 15) * 256 + c8 * 8);
            *(LAS u32x4*)(ul + r * 256 + c8 * 8) = v; }
        __syncthreads();
        { const int c = F.tid & 255, half = F.tid >> 8, w = 2 << (c >> 6);
          const int ts = half * 32; float sum = 0.f;
          for (int d = 1; d < w; ++d) sum += __uint_as_float((unsigned)ul[(15 + ts - d) * 256 + c] << 16);
#pragma unroll 4
          for (int tt = 0; tt < 32; ++tt) { const int tl = ts + tt, p = pos0 + tl; const float cur = __uint_as_float((unsigned)ul[(15 + tl) * 256 + c] << 16);
              sum += cur; const int cnt = (p + 1 < w) ? (p + 1) : w;
              const float diff = sum / (float)cnt - cur;
              dl[tl * 264 + c] = (bf16_t)(cvt_pk_bf16(diff, 0.f) & 0xffffu);
              sum -= __uint_as_float((unsigned)ul[(15 + tl - (w - 1)) * 256 + c] << 16); } }
        __syncthreads();
        { const int g = F.wave & 3, th = F.wave >> 2, r32 = F.lane & 31, hi = F.lane >> 5;
          f32x16 c0 = {}, c1 = {};
#pragma unroll
          for (int s = 0; s < 4; ++s) {
              const bf16x8 a = *(const LAS bf16x8*)(dl + (th * 32 + r32) * 264 + g * 64 + 16 * s + 8 * hi);
              const bf16x8 b0 = *(const bf16x8*)(WpT + (size_t)g * 4096 + (size_t)r32 * 64 + 16 * s + 8 * hi);
              const bf16x8 b1 = *(const bf16x8*)(WpT + (size_t)g * 4096 + (size_t)(32 + r32) * 64 + 16 * s + 8 * hi);
              c0 = __builtin_amdgcn_mfma_f32_32x32x16_bf16(a, b0, c0, 0, 0, 0);
              c1 = __builtin_amdgcn_mfma_f32_32x32x16_bf16(a, b1, c1, 0, 0, 0); }
          const float ps0 = F.pool_scale[g * 64 + r32], ps1 = F.pool_scale[g * 64 + 32 + r32];
#pragma unroll
          for (int r = 0; r < 16; ++r) { const int tok = t0 + th * 32 + crow(r, hi);
              cat[(size_t)tok * 1024 + g * 64 + r32] = (bf16_t)(cvt_pk_bf16(c0[r] * ps0, 0.f) & 0xffffu);
              cat[(size_t)tok * 1024 + g * 64 + 32 + r32] = (bf16_t)(cvt_pk_bf16(c1[r] * ps1, 0.f) & 0xffffu); } }
    }
    __syncthreads();
}

constexpr int IDX_RING_OFF = 0, IDX_SLOT = 32768;
constexpr int IDX_HIST_OFF = 3 * IDX_SLOT;
constexpr int IDX_RES_OFF = IDX_HIST_OFF + 24576;
__device__ __forceinline__ void hist_find16(const LAS unsigned* hist, int li, unsigned need, unsigned& bsel, unsigned& above) {
    const u32x4 h0 = *(const LAS u32x4*)(hist + 4 * li);
    const unsigned c[8] = {h0.x & 0xffffu, h0.x >> 16, h0.y & 0xffffu, h0.y >> 16, h0.z & 0xffffu, h0.z >> 16, h0.w & 0xffffu, h0.w >> 16};
    unsigned s = 0;
#pragma unroll
    for (int k = 0; k < 8; ++k) s += c[k];
    unsigned S = s;
#pragma unroll
    for (int d = 1; d < 32; d <<= 1) { const unsigned o = __shfl_down(S, d, 32); if (li + d < 32) S += o; }
    const unsigned excl = S - s;
    unsigned b = 0xffffffffu, ab = 0;
    if (excl < need && need <= S) { unsigned cum = excl; bool found = false;
#pragma unroll
        for (int k = 7; k >= 0; --k) { if (!found && cum + c[k] >= need) { b = 8 * li + k; ab = cum; found = true; } if (!found) cum += c[k]; } }
    const unsigned long long bal = __ballot(b != 0xffffffffu);
    const unsigned halfmask = (unsigned)((threadIdx.x & 32) ? (bal >> 32) : (bal & 0xffffffffull));
    const int src = (halfmask ? (__ffs(halfmask) - 1) : 0) + (threadIdx.x & 32);
    bsel = __shfl(b, src, 64); above = __shfl(ab, src, 64);
    if (!halfmask) { bsel = 0; above = 0; }
}
template <int J> __device__ __forceinline__ void wlane(unsigned& m, unsigned v) { asm volatile("v_writelane_b32 %0, %1, %2" : "+v"(m) : "s"(v), "n"(J)); }
template <int J> __device__ __forceinline__ void mask_emit_step(const unsigned (&k0)[32], const unsigned (&k1)[32], unsigned T0, unsigned T1, int kh, int ntiles, unsigned& m0, unsigned& m1, unsigned& m2, unsigned& m3) {
    if (2 * J + kh < ntiles) {
        const unsigned long long ba = __ballot(k0[J] >= T0), bc = __ballot(k1[J] >= T1);
        wlane<J>(m0, (unsigned)ba); wlane<J>(m2, (unsigned)(ba >> 32)); wlane<J>(m1, (unsigned)bc); wlane<J>(m3, (unsigned)(bc >> 32));
    }
}
template <int... Js> __device__ __forceinline__ void mask_emit(std::integer_sequence<int, Js...>, const unsigned (&k0)[32], const unsigned (&k1)[32], unsigned T0, unsigned T1, int kh, int ntiles, unsigned& m0, unsigned& m1, unsigned& m2, unsigned& m3) {
    (mask_emit_step<Js>(k0, k1, T0, T1, kh, ntiles, m0, m1, m2, m3), ...);
}
__device__ __forceinline__ void p2_indexer_unit(Frame& F, int b, int qb) {
    const bf16_t* IQ = (const bf16_t*)(F.ws + WS_IQ); const bf16_t* IK = (const bf16_t*)(F.ws + WS_IK); const float* IW = (const float*)(F.ws + WS_IW);
    unsigned* MASK = (unsigned*)(F.ws + WS_MASK);
    const int qg = F.wave & 3, kh = F.wave >> 2;
    LAS unsigned* hist = (LAS unsigned*)(F.lds + IDX_HIST_OFF) + qg * 4 * 384;
    LAS float* mm = (LAS float*)(F.lds + IDX_RES_OFF);
    const int lane = F.lane, r32 = lane & 31, hi = lane >> 5;
    const int p0 = qb * 16 + qg * 4;
    const int tq0 = b * SEQ + p0;
    const int ntiles = (qb >> 1) + 1;
    const int nch = (ntiles + 7) >> 3;
    const char* ikb = (const char*)(IK + (size_t)b * SEQ * 64);
    unsigned dsrc[4];
#pragma unroll
    for (int i = 0; i < 4; ++i) { const int row = F.wave * 32 + i * 8 + (lane >> 3), pos = lane & 7; dsrc[i] = (unsigned)(row * 128 + ((pos ^ ((row >> 1) & 7)) << 4)); }
#define IDX_ISSUE(ch) do { _Pragma("unroll") for (int i_ = 0; i_ < 4; ++i_) \
        __builtin_amdgcn_global_load_lds((const unsigned*)(ikb + (size_t)(ch) * 32768 + dsrc[i_]), (LAS unsigned*)(F.lds + IDX_RING_OFF + ((ch) % 3) * IDX_SLOT + F.wave * 4096 + i_ * 1024), 16, 0, 0); } while (0)
    bf16x8 af[4];
    { const int i = r32, qi = 2 * ((i >> 2) & 1) + (i >> 4), hd = (i & 3) + 4 * ((i >> 3) & 1);
#pragma unroll
      for (int s = 0; s < 4; ++s) af[s] = *(const bf16x8*)(IQ + (size_t)(tq0 + qi) * 512 + hd * 64 + 16 * s + 8 * hi); }
    float wA[8], wB[8];
#pragma unroll
    for (int r = 0; r < 8; ++r) { const int hd = (r & 3) + 4 * (r >> 2); wA[r] = IW[(size_t)(tq0 + 2 * hi) * 8 + hd] * W_SCALE; wB[r] = IW[(size_t)(tq0 + 2 * hi + 1) * 8 + hd] * W_SCALE; }
    __builtin_amdgcn_s_barrier();
    asm volatile("" ::: "memory");
    IDX_ISSUE(0); if (nch > 1) IDX_ISSUE(1);
#pragma unroll
    for (int i = 0; i < 3; ++i) *(LAS u32x4*)(F.lds + IDX_HIST_OFF + (i * 512 + F.tid) * 16) = (u32x4){0u, 0u, 0u, 0u};
    const int limA = p0 + 2 * hi - 32 * (ntiles - 1), limB = limA + 1;
    float sc0[32], sc1[32];
#pragma unroll
    for (int j = 0; j < 32; ++j) { sc0[j] = -INFINITY; sc1[j] = -INFINITY; }
    float mx0 = -INFINITY, mn0 = INFINITY, mx1 = -INFINITY, mn1 = INFINITY;
    const int frag_off = r32 * 128;
    const int fx = (r32 >> 1) & 7;
#pragma unroll
    for (int ch = 0; ch < 8; ++ch) {
        if (ch < nch) {
            if (ch + 1 < nch) asm volatile("s_waitcnt vmcnt(4)" ::: "memory"); else asm volatile("s_waitcnt vmcnt(0)" ::: "memory");
            __builtin_amdgcn_s_barrier();
            asm volatile("" ::: "memory");
            if (ch + 2 < nch) IDX_ISSUE(ch + 2);
            const LAS char* slot = (const LAS char*)(F.lds + IDX_RING_OFF + (ch % 3) * IDX_SLOT);
#pragma unroll
            for (int j4 = 0; j4 < 4; ++j4) {
                const int jl = 2 * j4 + kh, j = ch * 8 + jl, idx = ch * 4 + j4;
                if (j < ntiles) {
                    f32x16 acc = {};
#pragma unroll
                    for (int s = 0; s < 4; ++s) { const bf16x8 bfr = *(const LAS bf16x8*)(slot + jl * 4096 + frag_off + (((2 * s + hi) ^ fx) << 4));
                        acc = __builtin_amdgcn_mfma_f32_32x32x16_bf16(af[s], bfr, acc, 0, 0, 0); }
                    float s0 = 0.f, s1 = 0.f;
#pragma unroll
                    for (int r = 0; r < 8; ++r) {
                        const int ia = __float_as_int(acc[r]), ib = __float_as_int(acc[8 + r]);
                        s0 = fmaf(wA[r], __int_as_float(ia > 0 ? ia : 0), s0); s1 = fmaf(wB[r], __int_as_float(ib > 0 ? ib : 0), s1); }
                    if (j == ntiles - 1) {
                        mn0 = fminf(mn0, (r32 > limA) ? INFINITY : s0); mn1 = fminf(mn1, (r32 > limB) ? INFINITY : s1);
                        s0 = (r32 > limA) ? -INFINITY : s0; s1 = (r32 > limB) ? -INFINITY : s1;
                    } else { mn0 = fminf(mn0, s0); mn1 = fminf(mn1, s1); }
                    mx0 = fmaxf(mx0, s0); mx1 = fmaxf(mx1, s1);
                    sc0[idx] = s0; sc1[idx] = s1;
                }
            }
        }
    }
#undef IDX_ISSUE
#pragma unroll
    for (int d = 1; d < 32; d <<= 1) { mx0 = fmaxf(mx0, __shfl_xor(mx0, d)); mx1 = fmaxf(mx1, __shfl_xor(mx1, d)); mn0 = fminf(mn0, __shfl_xor(mn0, d)); mn1 = fminf(mn1, __shfl_xor(mn1, d)); }
    if (r32 == 0) { LAS float* w = mm + ((qg * 2 + kh) * 4 + 2 * hi) * 2; w[0] = mx0; w[1] = mn0; w[2] = mx1; w[3] = mn1; }
    __syncthreads();
    { const LAS float* w = mm + ((qg * 2 + (kh ^ 1)) * 4 + 2 * hi) * 2; mx0 = fmaxf(mx0, w[0]); mn0 = fminf(mn0, w[1]); mx1 = fmaxf(mx1, w[2]); mn1 = fminf(mn1, w[3]); }
    const float scl0 = (mx0 > mn0) ? (16777212.0f / (mx0 - mn0)) : 0.f, scl1 = (mx1 > mn1) ? (16777212.0f / (mx1 - mn1)) : 0.f;
    const float off0 = 1.5f - mn0 * scl0, off1 = 1.5f - mn1 * scl1;
    unsigned k0[32], k1[32];
#pragma unroll
    for (int j = 0; j < 32; ++j) { k0[j] = (unsigned)fmaf(sc0[j], scl0, off0); k1[j] = (unsigned)fmaf(sc1[j], scl1, off1); }
    unsigned T0 = 1u, T1 = 1u;
#ifndef NO_SELECT
    if (qb >= 16) {
        LAS unsigned* hA = hist + (2 * hi) * 384; LAS unsigned* hB = hist + (2 * hi + 1) * 384;
        unsigned pre0 = 0, pre1 = 0, need0 = 256, need1 = 256;
#pragma unroll
        for (int lvl = 0; lvl < 3; ++lvl) {
            const int sh = 16 - 8 * lvl;
#pragma unroll
            for (int j = 0; j < 32; ++j) {
                if (2 * j + kh < ntiles) {
                    const unsigned ka = k0[j], kc = k1[j];
                    if (lvl == 0 || (ka >> (sh + 8)) == pre0) { const unsigned bn = (ka >> sh) & 255u; (void)__hip_atomic_fetch_add(hA + lvl * 128 + (bn >> 1), 1u << ((bn & 1u) << 4), __ATOMIC_RELAXED, __HIP_MEMORY_SCOPE_WORKGROUP); }
                    if (lvl == 0 || (kc >> (sh + 8)) == pre1) { const unsigned bn = (kc >> sh) & 255u; (void)__hip_atomic_fetch_add(hB + lvl * 128 + (bn >> 1), 1u << ((bn & 1u) << 4), __ATOMIC_RELAXED, __HIP_MEMORY_SCOPE_WORKGROUP); }
                }
            }
            __syncthreads();
            unsigned b0, a0, b1, a1;
            hist_find16(hA + lvl * 128, r32, need0, b0, a0);
            hist_find16(hB + lvl * 128, r32, need1, b1, a1);
            pre0 = (pre0 << 8) | b0; need0 -= a0;
            pre1 = (pre1 << 8) | b1; need1 -= a1;
        }
        T0 = pre0 > 1u ? pre0 : 1u; T1 = pre1 > 1u ? pre1 : 1u;
    }
#endif
    unsigned m0 = 0, m1 = 0, m2 = 0, m3 = 0;
    mask_emit(std::make_integer_sequence<int, 32>{}, k0, k1, T0, T1, kh, ntiles, m0, m1, m2, m3);
    if (lane < 32) { const int w = 2 * lane + kh;
        MASK[(size_t)(tq0 + 0) * 64 + w] = m0; MASK[(size_t)(tq0 + 1) * 64 + w] = m1; MASK[(size_t)(tq0 + 2) * 64 + w] = m2; MASK[(size_t)(tq0 + 3) * 64 + w] = m3; }
}
__device__ __forceinline__ void p2_indexer(Frame& F) {
    for (int pi = F.bid; pi < 512; pi += F.G) { const int b = pi >> 6, x = pi & 63;
        p2_indexer_unit(F, b, 127 - x);
        p2_indexer_unit(F, b, x); }
    __syncthreads();
}

namespace att {
constexpr int D = 128, NW = 8, QBLK = 32, KVBLK = 64;
constexpr float SCALE = 0.088388347648318440f;
constexpr float THR = 8.f;
constexpr int LDQ = 768, LDK = 256, LDO = 1024;
constexpr size_t SHM_V = KVBLK * D * 2, SHM_K = KVBLK * D, SHM_ATTN = 2 * SHM_V + 2 * SHM_K + NW * 64 * 4;
#define KSWZ(row, colB) ((row) * 256 + ((colB) ^ (((row) & 7) << 4)))
#define SBAR() __builtin_amdgcn_sched_barrier(0)
__device__ __forceinline__ void apply_mask(f32x16& p0, f32x16& p1, u32x2 mk, int hi) {
    const int ml = (int)(mk.x >> (4 * hi)), mh = (int)(mk.y >> (4 * hi));
#pragma unroll
    for (int r = 0; r < 16; ++r) { const int cr = (r & 3) + 8 * (r >> 2);
        const unsigned t0 = (unsigned)__builtin_amdgcn_sbfe(ml, cr, 1), t1 = (unsigned)__builtin_amdgcn_sbfe(mh, cr, 1);
        p0[r] = __uint_as_float((__float_as_uint(p0[r]) & t0) | (0xff800000u & ~t0));
        p1[r] = __uint_as_float((__float_as_uint(p1[r]) & t1) | (0xff800000u & ~t1)); }
}
__device__ __forceinline__ void partialSM(f32x16& p0, f32x16& p1, float& m_reg, float& mn, float& alpha) {
    constexpr float C = SCALE * 1.4426950408889634f;
    float pmax = p0[0];
#pragma unroll
    for (int r = 1; r < 16; ++r) pmax = fmaxf(pmax, p0[r]);
#pragma unroll
    for (int r = 0; r < 16; ++r) pmax = fmaxf(pmax, p1[r]);
    { auto rr = __builtin_amdgcn_permlane32_swap(__float_as_uint(pmax), __float_as_uint(pmax), false, false);
      pmax = fmaxf(__uint_as_float(rr[0]), __uint_as_float(rr[1])); }
    if (__builtin_expect(__all(pmax - m_reg <= THR / SCALE), 1)) { mn = m_reg; alpha = 1.f; }
    else { mn = fmaxf(m_reg, pmax); alpha = __builtin_amdgcn_exp2f((m_reg - mn) * C); m_reg = mn; }
    const float mnC = -mn * C;
#pragma unroll
    for (int r = 0; r < 16; ++r) p0[r] = fmaf(p0[r], C, mnC);
#pragma unroll
    for (int r = 0; r < 16; ++r) p1[r] = fmaf(p1[r], C, mnC);
#pragma unroll
    for (int r = 0; r < 16; ++r) p0[r] = __builtin_amdgcn_exp2f(p0[r]);
}
__device__ __forceinline__ void finishSM(f32x16& p0, f32x16& p1, float alpha, float& l_reg, bf16x8& pa0, bf16x8& pa1, bf16x8& pa2, bf16x8& pa3) {
#pragma unroll
    for (int r = 0; r < 16; ++r) p1[r] = __builtin_amdgcn_exp2f(p1[r]);
    float ps = 0;
#pragma unroll
    for (int r = 0; r < 16; ++r) ps += p0[r];
#pragma unroll
    for (int r = 0; r < 16; ++r) ps += p1[r];
    { auto rr = __builtin_amdgcn_permlane32_swap(__float_as_uint(ps), __float_as_uint(ps), false, false);
      ps = __uint_as_float(rr[0]) + __uint_as_float(rr[1]); }
    l_reg = l_reg * alpha + ps;
#define PK4(P, BASE, OUT) do { unsigned a0 = cvt_pk_bf16(P[BASE + 0], P[BASE + 1]), a1 = cvt_pk_bf16(P[BASE + 2], P[BASE + 3]);   \
    unsigned b0 = cvt_pk_bf16(P[BASE + 4], P[BASE + 5]), b1 = cvt_pk_bf16(P[BASE + 6], P[BASE + 7]);                              \
    auto r0 = __builtin_amdgcn_permlane32_swap(a0, b0, false, false); auto r1 = __builtin_amdgcn_permlane32_swap(a1, b1, false, false); \
    u32x4 w = {r0[0], r1[0], r0[1], r1[1]}; OUT = *reinterpret_cast<bf16x8*>(&w); } while (0)
    PK4(p0, 0, pa0); PK4(p0, 8, pa1); PK4(p1, 0, pa2); PK4(p1, 8, pa3);
#undef PK4
}
typedef int v8i32a __attribute__((ext_vector_type(8)));
typedef int v4i32a __attribute__((ext_vector_type(4)));
__device__ __forceinline__ void qkt(f32x16& p0, f32x16& p1, const LAS char* Ks, const v8i32a* qr, int r32, int hi) {
    p0 = f32x16{}; p1 = f32x16{};
    const int fx = (r32 >> 1) & 7;
#pragma unroll
    for (int s2 = 0; s2 < 2; ++s2) { const int c0 = 4 * s2 + 2 * hi;
        const v4i32a a0l = *reinterpret_cast<const LAS v4i32a*>(Ks + r32 * 128 + ((c0 ^ fx) << 4)), a0h = *reinterpret_cast<const LAS v4i32a*>(Ks + r32 * 128 + (((c0 + 1) ^ fx) << 4));
        const v4i32a a1l = *reinterpret_cast<const LAS v4i32a*>(Ks + (32 + r32) * 128 + ((c0 ^ fx) << 4)), a1h = *reinterpret_cast<const LAS v4i32a*>(Ks + (32 + r32) * 128 + (((c0 + 1) ^ fx) << 4));
        p0 = __builtin_amdgcn_mfma_scale_f32_32x32x64_f8f6f4(__builtin_shufflevector(a0l, a0h, 0, 1, 2, 3, 4, 5, 6, 7), qr[s2], p0, 0, 0, 0, 0x7f7f7f7f, 0, 0x7f7f7f7f);
        p1 = __builtin_amdgcn_mfma_scale_f32_32x32x64_f8f6f4(__builtin_shufflevector(a1l, a1h, 0, 1, 2, 3, 4, 5, 6, 7), qr[s2], p1, 0, 0, 0, 0x7f7f7f7f, 0, 0x7f7f7f7f); }
}
__device__ __forceinline__ int v_st(int k, int c) { const int kk = (k & ~0xC) | ((k & 4) << 1) | ((k & 8) >> 1); return ((kk >> 3) * 4 + (c >> 5)) * 512 + ((kk & 7) * 32 + (c & 31)) * 2; }
__device__ __forceinline__ int v_rd_base(int lane) { return ((lane & 3) << 3) | (((lane >> 2) & 3) << 6) | (((lane >> 4) & 1) << 5) | (((lane >> 5) & 1) << 8); }
constexpr int v_rd_off(int d0, int ks, int half) { return d0 * 512 + ks * 4096 + half * 2048; }
template <int OFF> __device__ __forceinline__ s16x4 tr_read(int vb) {
    s16x4 r; asm volatile("ds_read_b64_tr_b16 %0, %1 offset:%2" : "=&v"(r) : "v"(vb), "i"(OFF) : "memory"); return r;
}
template <int D0> __device__ __forceinline__ void pv_one(f32x16& od, int vb, bf16x8 pa0, bf16x8 pa1, bf16x8 pa2, bf16x8 pa3) {
    const s16x4 l0 = tr_read<v_rd_off(D0, 0, 0)>(vb), h0 = tr_read<v_rd_off(D0, 0, 1)>(vb), l1 = tr_read<v_rd_off(D0, 1, 0)>(vb), h1 = tr_read<v_rd_off(D0, 1, 1)>(vb);
    const s16x4 l2 = tr_read<v_rd_off(D0, 2, 0)>(vb), h2 = tr_read<v_rd_off(D0, 2, 1)>(vb), l3 = tr_read<v_rd_off(D0, 3, 0)>(vb), h3 = tr_read<v_rd_off(D0, 3, 1)>(vb);
    asm volatile("s_waitcnt lgkmcnt(0)" ::: "memory"); SBAR();
#define PK(L, H) (bf16x8){L[0], L[1], L[2], L[3], H[0], H[1], H[2], H[3]}
    od = __builtin_amdgcn_mfma_f32_32x32x16_bf16(pa0, PK(l0, h0), od, 0, 0, 0);
    od = __builtin_amdgcn_mfma_f32_32x32x16_bf16(pa1, PK(l1, h1), od, 0, 0, 0);
    od = __builtin_amdgcn_mfma_f32_32x32x16_bf16(pa2, PK(l2, h2), od, 0, 0, 0);
    od = __builtin_amdgcn_mfma_f32_32x32x16_bf16(pa3, PK(l3, h3), od, 0, 0, 0);
#undef PK
}
__device__ __forceinline__ void pv_d0(f32x16* o, int vb, bf16x8 pa0, bf16x8 pa1, bf16x8 pa2, bf16x8 pa3) {
    pv_one<0>(o[0], vb, pa0, pa1, pa2, pa3); pv_one<1>(o[1], vb, pa0, pa1, pa2, pa3); pv_one<2>(o[2], vb, pa0, pa1, pa2, pa3); pv_one<3>(o[3], vb, pa0, pa1, pa2, pa3);
}
__device__ __forceinline__ void attn_body(const unsigned char* __restrict__ Qb, const unsigned char* __restrict__ Kh, const bf16_t* __restrict__ Vh, bf16_t* __restrict__ Ob, const unsigned* __restrict__ Mb, int NT, LAS char* lds) {
    const int tid = threadIdx.x, wid = tid >> 6, lane = tid & 63, r32 = lane & 31, hi = lane >> 5;
    LAS char* V_lds = lds; LAS char* K_lds = lds + 2 * SHM_V;
    LAS float* ws = (LAS float*)(lds + 2 * SHM_V + 2 * SHM_K) + wid * 64; LAS float* li_l = ws; LAS float* al_l = ws + 32;
    float m_reg = -1e30f, l_reg = 0; f32x16 o[4] = {}; v8i32a qr[2];
    const unsigned char* Qw = Qb + (long)(wid * QBLK + r32) * LDQ + hi * 32;
#pragma unroll
    for (int s2 = 0; s2 < 2; ++s2) { const v4i32a ql = *reinterpret_cast<const v4i32a*>(Qw + s2 * 64), qh = *reinterpret_cast<const v4i32a*>(Qw + s2 * 64 + 16); qr[s2] = __builtin_shufflevector(ql, qh, 0, 1, 2, 3, 4, 5, 6, 7); }
    const int krow = tid >> 3, kdst = krow * 128 + (((tid & 7) ^ ((krow >> 1) & 7)) << 4);
    const unsigned mofs = (unsigned)(wid * QBLK + r32) * 256u;
#define Mw_(j) (*(const u32x2*)((const char*)Mb + (mofs + 8u * (unsigned)(j))))
    const int sr = tid >> 4, sc = (tid & 15) * 8, vst0 = v_st(sr, sc), vst1 = v_st(32 + sr, sc);
    const int vb0 = (int)(uintptr_t)V_lds + v_rd_base(lane);
    struct { bf16x8 vs0, vs1; v4i32a ks; } sr_[2];
#define SLOAD(i, k0) do { sr_[i].vs0 = *(const bf16x8*)(&Vh[(long)((k0) + sr) * LDK + sc]); sr_[i].vs1 = *(const bf16x8*)(&Vh[(long)((k0) + 32 + sr) * LDK + sc]); \
    sr_[i].ks = *(const v4i32a*)(Kh + (long)((k0) + krow) * LDK + (tid & 7) * 16); } while (0)
#define SWRITE(b, i) do { *(LAS bf16x8*)(V_lds + (b) * SHM_V + vst0) = sr_[i].vs0;          \
    *(LAS bf16x8*)(V_lds + (b) * SHM_V + vst1) = sr_[i].vs1;                               \
    *(LAS v4i32a*)(K_lds + (b) * SHM_K + kdst) = sr_[i].ks; } while (0)
#define SWAIT() asm volatile("s_waitcnt vmcnt(4)" ::: "memory")
#define RESC(a) do { if (__any((a) < 1.f)) { if (hi == 0) al_l[r32] = (a); asm volatile("s_waitcnt lgkmcnt(0)" ::: "memory"); \
    _Pragma("unroll") for (int d = 0; d < 4; ++d) _Pragma("unroll") for (int r = 0; r < 16; ++r) o[d][r] *= al_l[crow(r, hi)]; } } while (0)
    f32x16 pA0, pA1, pB0, pB1; float mnA, mnB, alA, alB; bf16x8 pa0, pa1, pa2, pa3;
    u32x2 mkA = Mw_(0), mkB = Mw_(1);
    constexpr int SE = 0, SO = 1;
    const int jmax = NT - 4 + (__builtin_amdgcn_readfirstlane(wid) >> 1);
#define VAL(t) ((t) <= jmax)
    SLOAD(SE, 0); asm volatile("s_waitcnt vmcnt(0)" ::: "memory"); SWRITE(0, SE); __syncthreads();
    qkt(pA0, pA1, K_lds, qr, r32, hi); apply_mask(pA0, pA1, mkA, hi); partialSM(pA0, pA1, m_reg, mnA, alA); mkA = Mw_(2);
    SLOAD(SO, KVBLK); if (2 < NT) SLOAD(SE, 2 * KVBLK);
    SWAIT(); SWRITE(1, SO); __syncthreads();
    for (int j = 1; j + 1 < NT; j += 2) {
        SBAR(); if (VAL(j)) qkt(pB0, pB1, K_lds + SHM_K, qr, r32, hi);
        if (VAL(j - 1)) finishSM(pA0, pA1, alA, l_reg, pa0, pa1, pa2, pa3); SBAR();
        SLOAD(SO, (j + 2) * KVBLK); SBAR();
        if (VAL(j - 1)) pv_d0(o, vb0, pa0, pa1, pa2, pa3);
        alB = 1.f; if (VAL(j)) { apply_mask(pB0, pB1, mkB, hi); partialSM(pB0, pB1, m_reg, mnB, alB); } mkB = Mw_((j + 2 < NT) ? (j + 2) : j);
        __syncthreads(); SWAIT(); SWRITE(0, SE);
        RESC(alB); __syncthreads();
        SBAR(); if (VAL(j + 1)) qkt(pA0, pA1, K_lds, qr, r32, hi);
        if (VAL(j)) finishSM(pB0, pB1, alB, l_reg, pa0, pa1, pa2, pa3); SBAR();
        if (j + 3 < NT) SLOAD(SE, (j + 3) * KVBLK); SBAR();
        if (VAL(j)) pv_d0(o, vb0 + (int)SHM_V, pa0, pa1, pa2, pa3);
        alA = 1.f; if (VAL(j + 1)) { apply_mask(pA0, pA1, mkA, hi); partialSM(pA0, pA1, m_reg, mnA, alA); } mkA = Mw_((j + 3 < NT) ? (j + 3) : (j + 1));
        __syncthreads(); SWAIT(); SWRITE(1, SO);
        RESC(alA); __syncthreads();
    }
    SBAR(); if (VAL(NT - 1)) qkt(pB0, pB1, K_lds + SHM_K, qr, r32, hi);
    if (VAL(NT - 2)) finishSM(pA0, pA1, alA, l_reg, pa0, pa1, pa2, pa3); SBAR();
    if (VAL(NT - 2)) pv_d0(o, vb0, pa0, pa1, pa2, pa3);
    alB = 1.f; if (VAL(NT - 1)) { apply_mask(pB0, pB1, mkB, hi); partialSM(pB0, pB1, m_reg, mnB, alB); }
    __syncthreads(); RESC(alB);
    if (VAL(NT - 1)) { finishSM(pB0, pB1, alB, l_reg, pa0, pa1, pa2, pa3); SBAR();
        pv_d0(o, vb0 + (int)SHM_V, pa0, pa1, pa2, pa3); }
#undef VAL
    if (hi == 0) li_l[r32] = l_reg; asm volatile("s_waitcnt lgkmcnt(0)" ::: "memory");
    float rli[16];
#pragma unroll
    for (int r = 0; r < 16; ++r) rli[r] = __builtin_amdgcn_rcpf(li_l[crow(r, hi)]);
    bf16_t* Ow = Ob + (long)(wid * QBLK) * LDO;
#pragma unroll
    for (int r = 0; r < 16; ++r) { const int orow = crow(r, hi);
#pragma unroll
        for (int d0 = 0; d0 < 4; ++d0) Ow[(long)orow * LDO + d0 * 32 + r32] = (bf16_t)(cvt_pk_bf16(o[d0][r] * rli[r], 0.f) & 0xffffu); }
#undef SLOAD
#undef SWRITE
#undef SWAIT
#undef RESC
#undef Mw_
}
}

__device__ __forceinline__ void p3_attention(Frame& F) {
    const bf16_t* Q = (const bf16_t*)(F.ws + WS_Q); const bf16_t* K = (const bf16_t*)(F.ws + WS_K); const bf16_t* V = (const bf16_t*)(F.ws + WS_V);
    bf16_t* cat = (bf16_t*)(F.ws + WS_CAT); const unsigned* MASK = (const unsigned*)(F.ws + WS_MASK);
    const int j = F.bid;
    if (F.G == 256 && j >= 216) {
        convert_range(F, 2 * CV_PAIRS1, 2 * CV_PAIRS3, (j - 216) * 8 + F.wave, 40 * 8);
        return;
    }
    int qbs[2], phs[2], nu = 2;
    if (F.G != 256) { nu = 0; }
    else if (j < 48) { qbs[0] = 7; phs[0] = (j % 8) * 6 + j / 8; nu = 1; qbs[1] = 0; phs[1] = 0; }
    else if (j < 96) { const int jl = j - 48; qbs[0] = 6; phs[0] = (jl % 8) * 6 + jl / 8; qbs[1] = 0; phs[1] = phs[0]; }
    else if (j < 144) { const int jl = j - 96; qbs[0] = 5; phs[0] = (jl % 8) * 6 + jl / 8; qbs[1] = 1; phs[1] = phs[0]; }
    else if (j < 192) { const int jl = j - 144; qbs[0] = 4; phs[0] = (jl % 8) * 6 + jl / 8; qbs[1] = 2; phs[1] = phs[0]; }
    else { const int jl = j - 192; qbs[0] = 3; phs[0] = (jl % 8) * 6 + 2 * (jl / 8); qbs[1] = 3; phs[1] = phs[0] + 1; }
    for (int ui = 0; ui < nu; ++ui) {
        __syncthreads();
        const int qb = qbs[ui], b = phs[ui] / 6, h = phs[ui] % 6, g = h / 3;
        const size_t row0 = (size_t)b * SEQ + (size_t)qb * 256;
        att::attn_body((const unsigned char*)Q + row0 * 768 + h * 128, (const unsigned char*)K + (size_t)b * SEQ * 256 + g * 128, V + (size_t)b * SEQ * 256 + g * 128, cat + row0 * 1024 + 256 + h * 128, MASK + row0 * 64, 4 * (qb + 1), (LAS char*)F.lds);
    }
    __syncthreads();
}

__device__ __forceinline__ void p5_ln1_router(Frame& F) {
    const bf16_t* MIX = (const bf16_t*)(F.ws + WS_MIX); const bf16_t* HA = (const bf16_t*)(F.ws + WS_HA);
    bf16_t* H1R = (bf16_t*)(F.ws + WS_H1F); unsigned char* H1Q = F.ws + WS_H1B; const float* wrA = (const float*)(F.ws + WS_WRA);
    unsigned* INV = (unsigned*)(F.ws + WS_INV); unsigned* TOKEP = (unsigned*)(F.ws + WS_TOKEP); float* TOKG = (float*)(F.ws + WS_TOKG);
    LAS float* tile = (LAS float*)F.lds;
    LAS float* part = (LAS float*)F.lds;
    LAS float* logit = (LAS float*)(F.lds + 36864);
    LAS int* sel_e = (LAS int*)(F.lds + MISC_OFF + 2048);
    LAS float* sel_g = (LAS float*)(F.lds + MISC_OFF + 3072);
    LAS int* sel_p = (LAS int*)(F.lds + MISC_OFF + 4096);
    LAS unsigned* lcnt = (LAS unsigned*)(F.lds + MISC_OFF + 5120);
    LAS int* ebase = (LAS int*)(F.lds + MISC_OFF + 5376);
    const int lane = F.lane, r32 = lane & 31, hi = lane >> 5;
    for (int blk = F.bid; blk < T / 64; blk += F.G) {
        const int t0 = blk * 64;
        if (F.tid < 32) lcnt[F.tid] = 0u;
        for (int pass = 0; pass < 2; ++pass) {
            __syncthreads();
            { f32x4 g1[4], b1[4];
#pragma unroll
              for (int j = 0; j < 4; ++j) { g1[j] = ((const f32x4*)F.ln1_g)[lane + 64 * j]; b1[j] = ((const f32x4*)F.ln1_b)[lane + 64 * j]; }
#pragma unroll
              for (int rb = 0; rb < 4; rb += 2) {
              u32x2 xv[2][4]; u32x2 mv[2][4];
#pragma unroll
              for (int rr = 0; rr < 2; ++rr) { const int m = t0 + pass * 32 + F.wave * 4 + rb + rr;
#pragma unroll
                  for (int j = 0; j < 4; ++j) { xv[rr][j] = ((const u32x2*)(HA + (size_t)m * 1024))[lane + 64 * j]; mv[rr][j] = ((const u32x2*)(MIX + (size_t)m * 1024))[lane + 64 * j]; } }
#pragma unroll
              for (int rr = 0; rr < 2; ++rr) { const int tl = F.wave * 4 + rb + rr, m = t0 + pass * 32 + tl;
                  f32x4 v[4]; float s = 0.f;
#pragma unroll
                  for (int j = 0; j < 4; ++j) { const u32x2 hw = xv[rr][j]; const f32x4 h = {bf16_lo(hw.x), bf16_hi(hw.x), bf16_lo(hw.y), bf16_hi(hw.y)};
                      const u32x2 w = mv[rr][j]; const f32x4 mx = {bf16_lo(w.x), bf16_hi(w.x), bf16_lo(w.y), bf16_hi(w.y)};
                      v[j] = ALPHA * h + mx; s += (v[j].x + v[j].y) + (v[j].z + v[j].w); }
                  const float mean = wave_sum(s) * (1.f / 1024.f); float s2 = 0.f;
#pragma unroll
                  for (int j = 0; j < 4; ++j) { v[j] = v[j] - mean; s2 += (v[j].x * v[j].x + v[j].y * v[j].y) + (v[j].z * v[j].z + v[j].w * v[j].w); }
                  const float rstd = 1.f / sqrtf(wave_sum(s2) * (1.f / 1024.f) + LN_EPS);
                  u32x2* of = (u32x2*)(H1R + (size_t)m * 1024) + lane; unsigned* ob = (unsigned*)(H1Q + (size_t)m * 1024) + lane;
#pragma unroll
                  for (int j = 0; j < 4; ++j) { const f32x4 h = v[j] * rstd * g1[j] + b1[j]; { u32x2 hw; hw.x = cvt_pk_bf16(h.x, h.y); hw.y = cvt_pk_bf16(h.z, h.w); of[64 * j] = hw; } ob[64 * j] = pk4_fp8(h.x, h.y, h.z, h.w);
                      *(LAS f32x4*)(tile + tl * 1024 + (((lane + 64 * j) ^ (tl & 15)) << 2)) = h; } } } }
            f32x4 a4[16];
#pragma unroll
            for (int i = 0; i < 16; ++i) a4[i] = *(const f32x4*)(wrA + (size_t)(((F.wave * 16 + i) * 2 + hi) * 32 + r32) * 4);
            __syncthreads();
            f32x16 acc = {};
#pragma unroll
            for (int i = 0; i < 16; ++i) { const int c = F.wave * 16 + i;
                const f32x4 b4 = *(const LAS f32x4*)(tile + r32 * 1024 + (((2 * c + hi) ^ (r32 & 15)) << 2));
                acc = __builtin_amdgcn_mfma_f32_32x32x2f32(a4[i].x, b4.x, acc, 0, 0, 0);
                acc = __builtin_amdgcn_mfma_f32_32x32x2f32(a4[i].y, b4.y, acc, 0, 0, 0);
                acc = __builtin_amdgcn_mfma_f32_32x32x2f32(a4[i].z, b4.z, acc, 0, 0, 0);
                acc = __builtin_amdgcn_mfma_f32_32x32x2f32(a4[i].w, b4.w, acc, 0, 0, 0); }
            __syncthreads();
#pragma unroll
            for (int r = 0; r < 16; ++r) part[(F.wave * 32 + r32) * 33 + crow(r, hi)] = acc[r];
            __syncthreads();
#pragma unroll
            for (int q = 0; q < 2; ++q) { const int o = F.tid * 2 + q, tok = o >> 5, e = o & 31; float sm = F.b_router[e];
#pragma unroll
                for (int kq = 0; kq < 8; ++kq) sm += part[(kq * 32 + tok) * 33 + e];
                logit[tok * 33 + e] = sm; }
            __syncthreads();
            if (F.tid < 32) {
                float bv_[4] = {-INFINITY, -INFINITY, -INFINITY, -INFINITY}; int bi[4] = {0, 0, 0, 0};
#pragma unroll
                for (int e = 0; e < 32; ++e) { const float v = logit[F.tid * 33 + e];
                    if (v > bv_[3]) { bv_[3] = v; bi[3] = e;
                        if (bv_[3] > bv_[2]) { float tv = bv_[2]; bv_[2] = bv_[3]; bv_[3] = tv; int ti = bi[2]; bi[2] = bi[3]; bi[3] = ti;
                            if (bv_[2] > bv_[1]) { tv = bv_[1]; bv_[1] = bv_[2]; bv_[2] = tv; ti = bi[1]; bi[1] = bi[2]; bi[2] = ti;
                                if (bv_[1] > bv_[0]) { tv = bv_[0]; bv_[0] = bv_[1]; bv_[1] = tv; ti = bi[0]; bi[0] = bi[1]; bi[1] = ti; } } } } }
                float ex[4], se = 0.f;
#pragma unroll
                for (int j = 0; j < 4; ++j) { ex[j] = __expf(bv_[j] - bv_[0]); se += ex[j]; }
#pragma unroll
                for (int j = 0; j < 4; ++j) { sel_g[(pass * 32 + F.tid) * 4 + j] = ex[j] / se; sel_e[(pass * 32 + F.tid) * 4 + j] = bi[j]; }
            }
        }
        __syncthreads();
        if (F.tid < 256) sel_p[F.tid] = (int)__hip_atomic_fetch_add(lcnt + sel_e[F.tid], 1u, __ATOMIC_RELAXED, __HIP_MEMORY_SCOPE_WORKGROUP);
        __syncthreads();
        if (F.tid < 32) { const unsigned c = lcnt[F.tid]; int base = 0; if (c > 0) base = (int)__hip_atomic_fetch_add(F.ctl + CW_CNT + F.tid, c, __ATOMIC_RELAXED, __HIP_MEMORY_SCOPE_AGENT); ebase[F.tid] = base; }
        __syncthreads();
        if (F.tid < 256) { const int tok = t0 + (F.tid >> 2), e = sel_e[F.tid], p = ebase[e] + sel_p[F.tid];
            INV[(size_t)e * CAP + p] = (unsigned)tok; TOKEP[(size_t)tok * 4 + (F.tid & 3)] = ((unsigned)e << 16) | (unsigned)p; TOKG[(size_t)tok * 4 + (F.tid & 3)] = sel_g[F.tid]; }
        __syncthreads();
    }
}

__device__ __forceinline__ void moe_tables(Frame& F, LAS int* tstart) {
    __syncthreads();
    if (F.tid < 64) {
        const unsigned c = (F.tid < NE) ? __hip_atomic_load(F.ctl + CW_CNT + (F.tid & 31), __ATOMIC_RELAXED, __HIP_MEMORY_SCOPE_AGENT) : 0u;
        const int nt = (int)((c + 255u) >> 8); int incl = nt;
#pragma unroll
        for (int d = 1; d < 32; d <<= 1) { const int o = __shfl_up(incl, d, 64); if ((int)F.tid >= d) incl += o; }
        if (F.tid < NE) { tstart[F.tid] = incl - nt; tstart[40 + F.tid] = (int)c; }
        if (F.tid == NE - 1) tstart[NE] = incl; }
    __syncthreads();
}

__device__ __forceinline__ float fp8_to_f32(unsigned w, int byte) {
    if (byte == 0) return __builtin_amdgcn_cvt_f32_fp8(w, 0); if (byte == 1) return __builtin_amdgcn_cvt_f32_fp8(w, 1); if (byte == 2) return __builtin_amdgcn_cvt_f32_fp8(w, 2); return __builtin_amdgcn_cvt_f32_fp8(w, 3);
}
__device__ __forceinline__ void p8_final(Frame& F, LAS int* tstart) {
    const bf16_t* H1R = (const bf16_t*)(F.ws + WS_H1F); const unsigned* TOKEP = (const unsigned*)(F.ws + WS_TOKEP); const float* TOKG = (const float*)(F.ws + WS_TOKG);
    const unsigned char* Y = F.ws + WS_Y;
    const int gw = F.bid * 8 + F.wave, NGW = F.G * 8;
    f32x4 gv[4], bv[4];
#pragma unroll
    for (int j = 0; j < 4; ++j) { gv[j] = ((const f32x4*)F.ln2_g)[F.lane + 64 * j]; bv[j] = ((const f32x4*)F.ln2_b)[F.lane + 64 * j]; }
    unsigned tk = 0; float tg = 0.f;
    { const int m = gw + (F.lane >> 2) * NGW; if (F.lane < 32 && m < T) { tk = TOKEP[(size_t)m * 4 + (F.lane & 3)]; tg = TOKG[(size_t)m * 4 + (F.lane & 3)] * (1.0f / 64.0f); } }
    u32x2 hwA[4], hwB[4]; unsigned ywA[4][4], ywB[4][4];
#define P8_LOAD(k, hw, yw) do { const int m_ = gw + (k) * NGW; if (m_ < T) { const u32x2* xr_ = (const u32x2*)(H1R + (size_t)m_ * 1024) + F.lane; \
        _Pragma("unroll") for (int j = 0; j < 4; ++j) hw[j] = xr_[64 * j]; \
        _Pragma("unroll") for (int q = 0; q < 4; ++q) { const unsigned ep_ = (unsigned)__builtin_amdgcn_readlane((int)tk, (k) * 4 + q); \
            const size_t slot_ = (size_t)tstart[ep_ >> 16] * 256 + (ep_ & 0xffffu); const unsigned* yr_ = (const unsigned*)(Y + slot_ * 1024) + F.lane; \
            _Pragma("unroll") for (int j = 0; j < 4; ++j) yw[q][j] = yr_[64 * j]; } } } while (0)
#define P8_ROW(k, hw, yw) do { const int m_ = gw + (k) * NGW; if (m_ < T) { f32x4 v[4]; float gt[4]; \
        _Pragma("unroll") for (int q = 0; q < 4; ++q) gt[q] = __builtin_bit_cast(float, __builtin_amdgcn_readlane(__builtin_bit_cast(int, tg), (k) * 4 + q)); \
        _Pragma("unroll") for (int j = 0; j < 4; ++j) { v[j] = (f32x4){ALPHA * bf16_lo(hw[j].x), ALPHA * bf16_hi(hw[j].x), ALPHA * bf16_lo(hw[j].y), ALPHA * bf16_hi(hw[j].y)}; \
            _Pragma("unroll") for (int q = 0; q < 4; ++q) { const unsigned w = yw[q][j]; \
                v[j].x += gt[q] * fp8_to_f32(w, 0); v[j].y += gt[q] * fp8_to_f32(w, 1); v[j].z += gt[q] * fp8_to_f32(w, 2); v[j].w += gt[q] * fp8_to_f32(w, 3); } } \
        float s_ = 0.f; _Pragma("unroll") for (int j = 0; j < 4; ++j) s_ += (v[j].x + v[j].y) + (v[j].z + v[j].w); \
        const float mean_ = wave_sum(s_) * (1.f / 1024.f); float s2_ = 0.f; \
        _Pragma("unroll") for (int j = 0; j < 4; ++j) { v[j] = v[j] - mean_; s2_ += (v[j].x * v[j].x + v[j].y * v[j].y) + (v[j].z * v[j].z + v[j].w * v[j].w); } \
        const float rstd_ = 1.f / sqrtf(wave_sum(s2_) * (1.f / 1024.f) + LN_EPS); \
        f32x4* orow_ = (f32x4*)(F.out + (size_t)m_ * 1024) + F.lane; \
        _Pragma("unroll") for (int j = 0; j < 4; ++j) orow_[64 * j] = v[j] * rstd_ * gv[j] + bv[j]; } } while (0)
    P8_LOAD(0, hwA, ywA);
    P8_LOAD(1, hwB, ywB); P8_ROW(0, hwA, ywA);
    P8_LOAD(2, hwA, ywA); P8_ROW(1, hwB, ywB);
    P8_LOAD(3, hwB, ywB); P8_ROW(2, hwA, ywA);
    P8_LOAD(4, hwA, ywA); P8_ROW(3, hwB, ywB);
    P8_LOAD(5, hwB, ywB); P8_ROW(4, hwA, ywA);
    P8_LOAD(6, hwA, ywA); P8_ROW(5, hwB, ywB);
    P8_LOAD(7, hwB, ywB); P8_ROW(6, hwA, ywA);
    P8_ROW(7, hwB, ywB);
#undef P8_LOAD
#undef P8_ROW
}

__global__ void __launch_bounds__(NTHREADS, 2) mk_fwd(Args args) {
    extern __shared__ __attribute__((aligned(16))) unsigned char lds_raw[];
    Frame F;
    F.lds = (LAS unsigned char*)lds_raw;
    F.tid = threadIdx.x; F.lane = F.tid & 63; F.wave = __builtin_amdgcn_readfirstlane(F.tid >> 6); F.G = gridDim.x; F.bid = blockIdx.x;
    frame_refresh(F);
    volatile LAS unsigned* misc = (volatile LAS unsigned*)(F.lds + MISC_OFF);
    LAS int* tstart = (LAS int*)(F.lds + MISC_OFF + 256);
    LAS int* toktab = (LAS int*)(F.lds + MISC_OFF + 1024);
    if (F.tid < 4) misc[F.tid] = 0u;
    __syncthreads();
    const int lo = args.ph_lo, hi = args.ph_hi;
    XcdBarrier bar; bar.bar = F.ctl; bar.x = 0; bar.st = misc;
    if (hi - lo > 1) bar = xcd_barrier_post(F.ctl, misc);
#define IN(k) (lo <= (k) && (k) < hi)
#ifdef ONLY
#define PH_ON(k) ((k) == ONLY)
#else
#define PH_ON(k) true
#endif
#define SEAM(k) do { if (IN(k) && IN((k) + 1)) xcd_barrier(bar); frame_refresh(F); } while (0)

    if (PH_ON(0) && IN(0)) { p0_prologue(F); } SEAM(0);
    if (PH_ON(1) && IN(1)) {
        EpiInProj E{(bf16_t*)(F.ws + WS_U), (bf16_t*)(F.ws + WS_Q), (bf16_t*)(F.ws + WS_K), (bf16_t*)(F.ws + WS_V), (bf16_t*)(F.ws + WS_IQ), (bf16_t*)(F.ws + WS_IK), (float*)(F.ws + WS_IW),
                    (const float*)(F.ws + WS_ROPEQK), (const float*)(F.ws + WS_ROPEIX)};
        { pg8::StaticSched S{T / 256, 5, F.G, F.bid, 1, 1};
          pg8::gemm_phase<EpiInProj, pg8::StaticSched, true, 0x79797979, 0x7f7f7f7f>(F.lds, (const char*)(F.ws + WS_HA8), (const char*)(F.ws + WS_BTIN8), S, E); }
        { pg8::StaticSched S{T / 256, 4, F.G, F.bid, 0, 5};
          pg8::gemm_phase<EpiInProj, pg8::StaticSched>(F.lds, (const char*)(F.ws + WS_HA), (const char*)(F.ws + WS_BTIN), S, E); }
        if (F.bid >= 64) {
            convert_range(F, 0, 2 * CV_PAIRS1, (F.bid - 64) * 8 + F.wave, (F.G - 64) * 8); }
    } SEAM(1);
    if (PH_ON(2) && IN(2)) {
#ifndef NO_POOL
 p2_pool(F);
#endif
 p2_indexer(F); } SEAM(2);
    if (PH_ON(3) && IN(3)) { p3_attention(F); } SEAM(3);
    if (PH_ON(4) && IN(4)) {
        pg8::StaticSched S{T / 256, 4, F.G, F.bid, 0, 0};
        EpiMix E{(bf16_t*)(F.ws + WS_MIX)};
        pg8::gemm_phase<EpiMix, pg8::StaticSched>(F.lds, (const char*)(F.ws + WS_CAT), (const char*)(F.ws + WS_BTOUT), S, E);
    } SEAM(4);
    if (PH_ON(5) && IN(5)) { p5_ln1_router(F); } SEAM(5);
    if (PH_ON(6) && IN(6)) {
        moe_tables(F, tstart);
        const int ntl = tstart[NE];
        pg8::MoeSched<true> S{ntl, 8, F.G, F.bid, 2048, tstart, toktab, 0};
        { const unsigned* INV = (const unsigned*)(F.ws + WS_INV); pg8::Unit u; unsigned tk[10];
#pragma unroll
          for (int i = 0; i < 10; ++i) { tk[i] = 0u; if (S.next(i, u) && F.tid < 256) { const int p = (u.pm - tstart[u.e]) * 256 + F.tid; const int cnt = tstart[40 + u.e];
                  tk[i] = INV[(size_t)u.e * CAP + (p < cnt ? p : 0)]; } }
#pragma unroll
          for (int i = 0; i < 10; ++i) if (F.tid < 256) toktab[i * 256 + F.tid] = (int)tk[i];
          __syncthreads(); }
        EpiGateUp E{F.ws + WS_ACT, F.b_gu, F.ctl + CW_ACTRDY};
#ifndef NO_GU
        pg8::gemm_phase<EpiGateUp, pg8::MoeSched<true>, true, 0x79797979, 0x7f7f7f7f>(F.lds, (const char*)(F.ws + WS_H1B), (const char*)(F.ws + WS_BTGU), S, E);
#endif
        { const int nwg6 = 8 * ntl, rounds6 = (nwg6 + F.G - 1) / F.G, nidle = rounds6 * F.G - nwg6, cfirst = nwg6 - (rounds6 - 1) * F.G;
          int early = ((nidle < 128 ? nidle : 128) / 32) * 32; if (rounds6 < 9 || ntl < 32) early = 0;
          const int rank = F.bid - cfirst;
#ifndef NO_EARLY
          if (rank >= 0 && rank < early) {
              pg8::MoeSched<false> S7{early / 4, 4, F.G, rank, 1024, tstart, toktab, 0};
              pg8::Unit u; S7.next(0, u);
              if (F.tid < 64) {
                  unsigned* cp = F.ctl + CW_ACTRDY + u.pm; unsigned sp = 0;
                  while ((unsigned)__builtin_amdgcn_readfirstlane((int)__hip_atomic_load(cp, __ATOMIC_RELAXED, __HIP_MEMORY_SCOPE_AGENT)) < 64u) {
                      __builtin_amdgcn_s_sleep(2); if (++sp > (1u << 20)) { if (F.tid == 0) __hip_atomic_store(F.ctl + CW_TMO2, 1u, __ATOMIC_RELAXED, __HIP_MEMORY_SCOPE_AGENT); break; } }
                  __builtin_amdgcn_fence(__ATOMIC_ACQUIRE, "agent");
                  asm volatile("s_waitcnt vmcnt(0)" ::: "memory"); }
              __syncthreads();
              EpiDown E7{F.ws + WS_Y, F.b_dn};
              pg8::gemm_phase<EpiDown, pg8::MoeSched<false>, true, 0x79797979, 0x7c7c7c7c>(F.lds, (const char*)(F.ws + WS_ACT), (const char*)(F.ws + WS_BTDN), S7, E7);
          }
#endif
          (void)rank; (void)early; }
    } SEAM(6);
    if (PH_ON(7) && IN(7)) {
        moe_tables(F, tstart);
        const int ntl = tstart[NE];
        const int nwg6 = 8 * ntl, rounds6 = (nwg6 + F.G - 1) / F.G, nidle = rounds6 * F.G - nwg6;
        int early = ((nidle < 128 ? nidle : 128) / 32) * 32; if (rounds6 < 9 || ntl < 32) early = 0;
        pg8::MoeSched<false> S{ntl, 4, F.G, F.bid, 1024, tstart, toktab, early};
        EpiDown E{F.ws + WS_Y, F.b_dn};
        pg8::gemm_phase<EpiDown, pg8::MoeSched<false>, true, 0x79797979, 0x7c7c7c7c>(F.lds, (const char*)(F.ws + WS_ACT), (const char*)(F.ws + WS_BTDN), S, E);
    } SEAM(7);
    if (PH_ON(8) && IN(8)) { moe_tables(F, tstart); p8_final(F, tstart); }
#undef IN
#undef SEAM
}

extern "C" void kernel_launch(void* const* d_in, const int* in_sizes, int n_in, void* d_out, int out_size, void* d_ws, size_t ws_size, hipStream_t stream) {
    static int grid = 0;
    if (grid == 0) {
        if (n_in != 18 || in_sizes[0] != T * DM || out_size != T * DM || ws_size < WS_END) {
            fprintf(stderr, "kernel_launch: shape mismatch (n_in %d, in0 %d, out %d, ws %zu, need %zu)\n", n_in, n_in > 0 ? in_sizes[0] : -1, out_size, ws_size, (size_t)WS_END); grid = -1; return; }
        int dev = 0, cus = 0, per_cu = 0;
        if (hipGetDevice(&dev) != hipSuccess || hipDeviceGetAttribute(&cus, hipDeviceAttributeMultiprocessorCount, dev) != hipSuccess) { grid = -1; return; }
        if (hipFuncSetAttribute((const void*)mk_fwd, hipFuncAttributeMaxDynamicSharedMemorySize, LDS_BYTES) != hipSuccess) { fprintf(stderr, "kernel_launch: hipFuncSetAttribute failed\n"); grid = -1; return; }
        if (hipOccupancyMaxActiveBlocksPerMultiprocessor(&per_cu, (const void*)mk_fwd, NTHREADS, LDS_BYTES) != hipSuccess || per_cu < 1) {
            fprintf(stderr, "kernel_launch: occupancy query reports %d workgroups per CU\n", per_cu); }
        (void)hipGetLastError();
        grid = cus;
        if (grid != 256) { fprintf(stderr, "kernel_launch: built for a 256-CU device (static work deals), found %d CUs\n", cus); grid = -1; return; }
    }
    if (grid < 0) return;
    (void)hipMemsetAsync((char*)d_ws + WS_CTL, 0, CTL_BYTES, stream);
    Args a{};
    for (int i = 0; i < 18; ++i) a.in[i] = d_in[i];
    a.out = (float*)d_out; a.ws = (unsigned char*)d_ws;
#if MK_N_LAUNCHES == 1
    a.ph_lo = 0; a.ph_hi = NPH;
    hipLaunchKernelGGL(mk_fwd, dim3(grid), dim3(NTHREADS), LDS_BYTES, stream, a);
#else
    for (int p = 0; p < NPH; ++p) { a.ph_lo = p; a.ph_hi = p + 1; hipLaunchKernelGGL(mk_fwd, dim3(grid), dim3(NTHREADS), LDS_BYTES, stream, a);
#ifdef PROBE_DUP
        if (p == PROBE_DUP) { if (p == 3 || p == 5) (void)hipMemsetAsync((char*)d_ws + WS_CTL + 4096 * 4, 0, 1024, stream); hipLaunchKernelGGL(mk_fwd, dim3(grid), dim3(NTHREADS), LDS_BYTES, stream, a); }
#endif
    }
#endif
    const hipError_t le = hipPeekAtLastError();
    if (le != hipSuccess) fprintf(stderr, "kernel_launch: launch failed: %s\n", hipGetErrorName(le));
}
```

```cpp
#include <hip/hip_runtime.h>
#include <cstdio>
#include <cstdint>
#include <utility>

#define LAS __attribute__((address_space(3)))
typedef unsigned short bf16_t;
typedef short bf16x8 __attribute__((ext_vector_type(8)));
typedef short s16x4 __attribute__((ext_vector_type(4)));
typedef float f32x2 __attribute__((ext_vector_type(2)));
typedef float f32x4 __attribute__((ext_vector_type(4)));
typedef float f32x16 __attribute__((ext_vector_type(16)));
typedef unsigned u32x2 __attribute__((ext_vector_type(2)));
typedef unsigned u32x4 __attribute__((ext_vector_type(4)));

#ifndef MK_N_LAUNCHES
#define MK_N_LAUNCHES 1
#endif

constexpr int T = 16384, DM = 1024, SEQ = 2048, NBATCH = 8;
constexpr int INW = 2120, INP = 2304;
constexpr int NE = 32, CAP = 16384, MAXT = 288;
constexpr int NPH = 9;
constexpr float ALPHA = 1.189207115002721f;
constexpr float LN_EPS = 1e-5f;
constexpr float W_SCALE = 0.04419417382415922f;
constexpr int NTHREADS = 512;
constexpr int LDS_BYTES = 147456;
constexpr int MISC_OFF = 131072;

constexpr size_t al256(size_t x) { return (x + 255) / 256 * 256; }
constexpr size_t WS_CTL = 0;
constexpr size_t CTL_BYTES = 65536;
constexpr size_t WS_BTIN = WS_CTL + CTL_BYTES;
constexpr size_t WS_BTOUT = WS_BTIN + al256((size_t)INP * 1024 * 2);
constexpr size_t WS_BTGU = WS_BTOUT + al256((size_t)1024 * 1024 * 2);
constexpr size_t WS_BTDN = WS_BTGU + al256((size_t)NE * 2048 * 1024 * 2);
constexpr size_t WS_WPT = WS_BTDN + al256((size_t)NE * 1024 * 1024 * 2);
constexpr size_t WS_WRA = WS_WPT + al256((size_t)4 * 64 * 64 * 2);
constexpr size_t WS_HA = WS_WRA + al256((size_t)1024 * 32 * 4);
constexpr size_t WS_STATS = WS_HA + al256((size_t)T * 1024 * 2);
constexpr size_t WS_ROPEQK = WS_STATS + al256((size_t)T * 2 * 4);
constexpr size_t WS_ROPEIX = WS_ROPEQK + al256((size_t)T * 32 * 4);
constexpr size_t WS_U = WS_ROPEIX + al256((size_t)T * 16 * 4);
constexpr size_t WS_Q = WS_U + al256((size_t)T * 256 * 2);
constexpr size_t WS_K = WS_Q + al256((size_t)T * 768 * 2);
constexpr size_t WS_V = WS_K + al256((size_t)T * 256 * 2);
constexpr size_t WS_IQ = WS_V + al256((size_t)T * 256 * 2);
constexpr size_t WS_IK = WS_IQ + al256((size_t)T * 512 * 2);
constexpr size_t WS_IW = WS_IK + al256((size_t)T * 64 * 2);
constexpr size_t WS_MASK = WS_IW + al256((size_t)T * 8 * 4);
constexpr size_t WS_CAT = WS_MASK + al256((size_t)T * 64 * 4);
constexpr size_t WS_H1F = WS_CAT + al256((size_t)T * 1024 * 2);
constexpr size_t WS_H1B = WS_H1F + al256((size_t)T * 1024 * 4);
constexpr size_t WS_INV = WS_H1B + al256((size_t)T * 1024 * 2);
constexpr size_t WS_TOKEP = WS_INV + al256((size_t)NE * CAP * 4);
constexpr size_t WS_TOKG = WS_TOKEP + al256((size_t)T * 4 * 4);
constexpr size_t WS_ACT = WS_TOKG + al256((size_t)T * 4 * 4);
constexpr size_t WS_Y = WS_ACT + al256((size_t)MAXT * 256 * 1024 * 2);
constexpr size_t WS_MIX = WS_Y + al256((size_t)MAXT * 256 * 1024 * 2);
constexpr size_t WS_HA8 = WS_MIX + al256((size_t)T * 1024 * 2);
constexpr size_t WS_BTIN8 = WS_HA8 + al256((size_t)T * 1024);
constexpr size_t WS_END = WS_BTIN8 + al256((size_t)1536 * 1024);
constexpr int CW_CNT = 4096;
constexpr int CW_ATTQ = 4224;
constexpr int CW_CVQ1 = 4288, CW_CVQ3 = 4352, CW_ACTRDY = 4608;
constexpr int CW_TMO2 = 4480;
constexpr int CV_PAIRS1 = 3072, CV_PAIRS3 = 3072, CV_HIDDEN = 2 * (CV_PAIRS1 + CV_PAIRS3);

#define XB_TMO      128
#define XB_XCNT(j)  (256  + 64 * (j))
#define XB_XSUB(j)  (1280 + 64 * (j))
#define XB_XGEN(j)  (2304 + 64 * (j))
#define XB_TOP      3328
#define XB_TOPGEN   3392
#define XCD_BAR_WORDS 3456
#define XB_SPIN_CAP (1u << 18)
__device__ __forceinline__ unsigned xb_ld(unsigned* p)              { return __hip_atomic_load(p, __ATOMIC_RELAXED, __HIP_MEMORY_SCOPE_AGENT); }
__device__ __forceinline__ unsigned xb_add(unsigned* p, unsigned v) { return __hip_atomic_fetch_add(p, v, __ATOMIC_RELAXED, __HIP_MEMORY_SCOPE_AGENT); }
__device__ __forceinline__ unsigned xb_xcc_id() { return (unsigned)__builtin_amdgcn_s_getreg((3 << 11) | 20) & 0xFu; }
#define XB_SPIN(cond, bar) do { unsigned _sp = 0; while (cond) { __builtin_amdgcn_s_sleep(1); \
    if ((++_sp & 255u) == 0u) { if (xb_ld(&(bar)[XB_TMO])) break; if (_sp > XB_SPIN_CAP) { atomicAdd(&(bar)[XB_TMO], 1u); break; } } } } while (0)
struct XcdBarrier { unsigned* bar; unsigned x; volatile LAS unsigned* st; };
__device__ __forceinline__ XcdBarrier xcd_barrier_post(unsigned* bar, volatile LAS unsigned* st) {
    XcdBarrier b; b.bar = bar; b.x = xb_xcc_id(); b.st = st;
    if (threadIdx.x == 0) (void)xb_add(&bar[XB_XCNT(b.x)], 1u);
    return b;
}
__device__ __forceinline__ void xcd_barrier_complete(unsigned* bar, unsigned x, unsigned& nloc, unsigned& nx) {
    const unsigned G = gridDim.x * gridDim.y * gridDim.z;
    unsigned sum, cnt, mine, sp = 0u;
    for (;;) {
        sum = 0u; cnt = 0u; mine = 0u;
#pragma unroll
        for (unsigned j = 0; j < 16; ++j) { const unsigned c = xb_ld(&bar[XB_XCNT(j)]); sum += c; cnt += (c > 0u) ? 1u : 0u; mine = (j == x) ? c : mine; }
        if (sum == G) break;
        __builtin_amdgcn_s_sleep(1);
        if ((++sp & 255u) == 0u) { if (xb_ld(&bar[XB_TMO])) break; if (sp > XB_SPIN_CAP) { atomicAdd(&bar[XB_TMO], 1u); break; } }
    }
    nloc = mine > 0u ? mine : 1u; nx = cnt > 0u ? cnt : 1u;
}
__device__ __forceinline__ void xcd_barrier(const XcdBarrier& b) {
    asm volatile("s_waitcnt vmcnt(0)" ::: "memory");
    __syncthreads();
    if (threadIdx.x == 0) {
        unsigned* bar = b.bar;
        __builtin_amdgcn_s_waitcnt(0);
        unsigned nloc = b.st[0], nx = b.st[1];
        if (nloc == 0u) { xcd_barrier_complete(bar, b.x, nloc, nx); b.st[0] = nloc; b.st[1] = nx; }
        const unsigned old = xb_add(&bar[XB_XSUB(b.x)], 1u);
        const unsigned gen = old / nloc;
        if (old + 1u == (gen + 1u) * nloc) {
            __builtin_amdgcn_fence(__ATOMIC_RELEASE, "agent");
            asm volatile("s_waitcnt vmcnt(0)" ::: "memory");
            const unsigned og = xb_add(&bar[XB_TOP], 1u);
            const unsigned tg = og / nx;
            if (og + 1u == (tg + 1u) * nx) xb_add(&bar[XB_TOPGEN], 1u);
            else XB_SPIN(xb_ld(&bar[XB_TOPGEN]) == tg, bar);
            __builtin_amdgcn_fence(__ATOMIC_ACQUIRE, "agent");
            xb_add(&bar[XB_XGEN(b.x)], 1u);
            asm volatile("s_waitcnt vmcnt(0)" ::: "memory");
        } else {
            XB_SPIN(xb_ld(&bar[XB_XGEN(b.x)]) == gen, bar);
            __builtin_amdgcn_fence(__ATOMIC_ACQUIRE, "agent");
            asm volatile("s_waitcnt vmcnt(0)" ::: "memory");
        }
    }
    __syncthreads();
}

__device__ __forceinline__ unsigned cvt_pk_bf16(float lo, float hi) { unsigned r; asm volatile("v_cvt_pk_bf16_f32 %0, %1, %2" : "=v"(r) : "v"(lo), "v"(hi)); return r; }
__device__ __forceinline__ unsigned pk4_fp8(float a, float b, float c, float d) { int w = __builtin_amdgcn_cvt_pk_fp8_f32(a, b, 0, false); w = __builtin_amdgcn_cvt_pk_fp8_f32(c, d, w, true); return (unsigned)w; }
__device__ __forceinline__ float bf16_lo(unsigned w) { return __uint_as_float(w << 16); }
__device__ __forceinline__ float bf16_hi(unsigned w) { return __uint_as_float(w & 0xffff0000u); }
template <int CTRL> __device__ __forceinline__ float dpp_f(float v) { return __builtin_bit_cast(float, __builtin_amdgcn_update_dpp(0, __builtin_bit_cast(int, v), CTRL, 0xf, 0xf, true)); }
__device__ __forceinline__ float wave_sum(float v) {
    v += dpp_f<0xB1>(v);
    v += dpp_f<0x4E>(v);
    v += dpp_f<0x141>(v);
    v += dpp_f<0x140>(v);
    const int vi = __builtin_bit_cast(int, v);
    const float r0 = __builtin_bit_cast(float, __builtin_amdgcn_readlane(vi, 0)), r1 = __builtin_bit_cast(float, __builtin_amdgcn_readlane(vi, 16));
    const float r2 = __builtin_bit_cast(float, __builtin_amdgcn_readlane(vi, 32)), r3 = __builtin_bit_cast(float, __builtin_amdgcn_readlane(vi, 48));
    return (r0 + r1) + (r2 + r3);
}
#define LDS_WAIT() asm volatile("s_waitcnt lgkmcnt(0)" ::: "memory")
#define VM_WAIT()  asm volatile("s_waitcnt vmcnt(0)" ::: "memory")
__device__ __forceinline__ int crow(int r, int hi) { return (r & 3) + 8 * (r >> 2) + 4 * hi; }

namespace pg8 {
constexpr int BM = 256, BK = 64, HALF = 128, HTB = HALF * BK * 2, STAGE_BYTES = 8 * HTB, NXCD = 8, WGM = 4, KD = 1024;
__device__ __forceinline__ int lds_byte(int r, int c) { const int st = (r >> 4) * 2 + (c >> 5), rr = r & 15, cc = c & 31, ob = rr * 64 + cc * 2; return st * 1024 + (ob ^ (((ob >> 9) & 1) << 5)); }
__device__ __forceinline__ void stage_rc(int b, int& R, int& C) { const int st = b / 1024, sb = b % 1024, swz = sb ^ (((sb >> 9) & 1) << 5); R = (st >> 1) * 16 + swz / 64; C = (st & 1) * 32 + (swz % 64) / 2; }
__device__ __forceinline__ int perm32(int rho) { const int n = rho >> 4, i = rho & 15; return 8 * (i >> 2) + 4 * n + (i & 3); }

struct Unit { int pm, pn, e, idx; };

__device__ __forceinline__ void order_decode(int wgid, int nM, int nN, int& pm, int& pn) {
    const int nig = WGM * nN, gid = wgid / nig, fm = gid * WGM, gsz = (nM - fm) < WGM ? (nM - fm) : WGM;
    pm = fm + ((wgid % nig) % gsz); pn = (wgid % nig) / gsz;
}
__device__ __forceinline__ bool order_next(int i, int G, int c, int nM, int nN, int& pm, int& pn, int woff = 0) {
    const int nwg = nM * nN - woff; const long L = (long)i * G + c; if (L >= nwg) return false;
    int wgid = (int)L; { const int q = nwg / NXCD, r = nwg % NXCD, xcd = wgid % NXCD, off = wgid / NXCD; wgid = (xcd < r ? xcd * (q + 1) : r * (q + 1) + (xcd - r) * q) + off; }
    order_decode(wgid + woff, nM, nN, pm, pn); return true;
}
struct StaticSched {
    int nM, nN, G, c, t0, toff;
    __device__ __forceinline__ bool next(int i, Unit& u) const { u.idx = i; const bool ok = order_next(i, G, c, nM, nN, u.pm, u.pn); u.e = (u.pn == 0) ? t0 : u.pn + toff; return ok; }
    __device__ __forceinline__ int a_row(const Unit& u, int h, int R) const { return u.pm * BM + h * HALF + R; }
    __device__ __forceinline__ int b_row(const Unit& u) const { return u.e * BM; }
};
template <bool GATHER> struct MoeSched {
    int nM, nN, G, c; int brows;
    const LAS int* tstart; const LAS int* toktab; int woff;
    __device__ __forceinline__ bool next(int i, Unit& u) const {
        u.idx = i;
        if (!order_next(i, G, c, nM, nN, u.pm, u.pn, woff)) return false;
        int e = 0;
#pragma unroll
        for (int k = 1; k < NE; ++k) e += (u.pm >= tstart[k]) ? 1 : 0;
        u.e = e; return true;
    }
    __device__ __forceinline__ int a_row(const Unit& u, int h, int R) const { if constexpr (GATHER) return toktab[u.idx * 256 + h * HALF + R]; else return u.pm * BM + h * HALF + R; }
    __device__ __forceinline__ int b_row(const Unit& u) const { return u.e * brows + u.pn * BM; }
};

typedef int v8i32 __attribute__((ext_vector_type(8)));
typedef int v4i32 __attribute__((ext_vector_type(4)));
__device__ __forceinline__ v8i32 cat8(bf16x8 a, bf16x8 b) { const v4i32 x = __builtin_bit_cast(v4i32, a), y = __builtin_bit_cast(v4i32, b); return __builtin_shufflevector(x, y, 0, 1, 2, 3, 4, 5, 6, 7); }
template <class Epi, class Sched, bool FP8 = false, int SW = 0x7f7f7f7f, int SA = 0x7f7f7f7f>
__device__ __forceinline__ void gemm_phase(LAS unsigned char* lds, const char* Abase, const char* Bbase, const Sched& S, const Epi& E) {
    const int tid = threadIdx.x, wid = __builtin_amdgcn_readfirstlane(tid >> 6), lane = tid & 63, wr = wid >> 2, wc = wid & 3, fr = lane & 15, fq = lane >> 4;
    constexpr int ROWB = FP8 ? KD : 2 * KD, nt = ROWB / 128;
    int RA[2], CA[2]; unsigned voffB[2];
#pragma unroll
    for (int i = 0; i < 2; ++i) { int R, C; stage_rc(tid * 16 + i * 8192, R, C); const int Rb = Epi::PERM ? ((R & ~31) + perm32(R & 31)) : R;
        RA[i] = R; CA[i] = C * 2; voffB[i] = (unsigned)(Rb * ROWB + C * 2); }
    const size_t kstep = (size_t)(BK * 2);
    const size_t hstep = (size_t)HALF * ROWB;
    const unsigned ldsw = (unsigned)wid * 1024u;
    const int aoff = lds_byte(wr * 64 + fr, fq * 8), boff = lds_byte(wc * 32 + fr, fq * 8);
#define PG8_SA(b, h) (((b) * 2 + (h)) * HTB)
#define PG8_SB(b, h) ((4 + (b) * 2 + (h)) * HTB)
#define PG8_STAGE(bufoff, gbase, voff) do { _Pragma("unroll") for (int _i = 0; _i < 2; ++_i) \
        __builtin_amdgcn_global_load_lds((const unsigned*)((const char*)(gbase) + (voff)[_i]), (LAS unsigned*)(lds + (bufoff) + ldsw + _i * 8192), 16, 0, 0); } while (0)
#define PG8_LDA(dst, b, h) do { _Pragma("unroll") for (int m = 0; m < 4; ++m) _Pragma("unroll") for (int k = 0; k < 2; ++k) dst[m][k] = *(const LAS bf16x8*)(lds + PG8_SA(b, h) + aoff + m * 2048 + k * 1024); } while (0)
#define PG8_LDB(dst, b, h) do { _Pragma("unroll") for (int n = 0; n < 2; ++n) _Pragma("unroll") for (int k = 0; k < 2; ++k) dst[n][k] = *(const LAS bf16x8*)(lds + PG8_SB(b, h) + boff + n * 2048 + k * 1024); } while (0)
#define PG8_MMA(ai, bj, At, Bt) do { __builtin_amdgcn_s_setprio(1); if constexpr (FP8) { _Pragma("unroll") for (int m = 0; m < 4; ++m) _Pragma("unroll") for (int n = 0; n < 2; ++n) \
        acc[ai][bj][m][n] = __builtin_amdgcn_mfma_scale_f32_16x16x128_f8f6f4(cat8(Bt[n][0], Bt[n][1]), cat8(At[m][0], At[m][1]), acc[ai][bj][m][n], 0, 0, 0, SW, 0, SA); } \
        else { _Pragma("unroll") for (int m = 0; m < 4; ++m) _Pragma("unroll") for (int n = 0; n < 2; ++n) _Pragma("unroll") for (int k = 0; k < 2; ++k) \
        acc[ai][bj][m][n] = __builtin_amdgcn_mfma_f32_16x16x32_bf16(Bt[n][k], At[m][k], acc[ai][bj][m][n], 0, 0, 0); } __builtin_amdgcn_s_setprio(0); } while (0)
#define PG8_WAIT_V(n) asm volatile("s_waitcnt vmcnt(" #n ")" ::: "memory")
#define PG8_WAIT_L(n) asm volatile("s_waitcnt lgkmcnt(" #n ")" ::: "memory")
#define PG8_BAR __builtin_amdgcn_s_barrier()
#define PG8_SCHED __builtin_amdgcn_sched_barrier(0)
    Unit cur, nxt; int ui = 0;
    if (!S.next(0, cur)) return;
    f32x4 acc[2][2][4][2]; f32x4 bini[2][2];
#pragma unroll
    for (int b = 0; b < 2; ++b)
#pragma unroll
        for (int n = 0; n < 2; ++n) bini[b][n] = Epi::BIAS_INIT ? E.bias4(cur, b, n, wc, fq) : (f32x4){0.f, 0.f, 0.f, 0.f};
#pragma unroll
    for (int a = 0; a < 2; ++a)
#pragma unroll
        for (int b = 0; b < 2; ++b)
#pragma unroll
            for (int m = 0; m < 4; ++m)
#pragma unroll
                for (int n = 0; n < 2; ++n) acc[a][b][m][n] = bini[b][n];
    bf16x8 At[4][2], B0[2][2], B1[2][2];
    unsigned oA[2][2];
#pragma unroll
    for (int h = 0; h < 2; ++h)
#pragma unroll
        for (int i = 0; i < 2; ++i) oA[h][i] = (unsigned)(S.a_row(cur, h, RA[i]) * ROWB + CA[i]);
    const char* cB = Bbase + (size_t)S.b_row(cur) * ROWB;
    const char* cA = Abase;
    PG8_STAGE(PG8_SB(0, 0), cB, voffB); PG8_STAGE(PG8_SA(0, 0), cA, oA[0]); PG8_STAGE(PG8_SB(0, 1), cB + hstep, voffB); PG8_STAGE(PG8_SA(0, 1), cA, oA[1]);
    if (wr == 1) PG8_BAR;
    PG8_WAIT_V(4); PG8_BAR;
    PG8_STAGE(PG8_SB(1, 0), cB + kstep, voffB); PG8_STAGE(PG8_SA(1, 0), cA + kstep, oA[0]); PG8_STAGE(PG8_SB(1, 1), cB + hstep + kstep, voffB);
    PG8_WAIT_V(6); PG8_BAR;
    for (;;) {
        const bool has_next = S.next(ui + 1, nxt);
        const char* nB = has_next ? Bbase + (size_t)S.b_row(nxt) * ROWB : cB;
        for (int t = 0; t < nt; t += 2) {
            const bool last = (t == nt - 2);
            const char* a1 = cA + (size_t)(t + 1) * kstep;
            const char* a2 = last ? cA : cA + (size_t)(t + 2) * kstep; const char* b2 = last ? nB : cB + (size_t)(t + 2) * kstep;
            const char* a3 = a2 + kstep; const char* b3 = b2 + kstep;
            PG8_LDB(B0, 0, 0); PG8_SCHED; PG8_LDA(At, 0, 0); PG8_STAGE(PG8_SA(1, 1), a1, oA[1]);
            if (last && has_next) {
#pragma unroll
                for (int h = 0; h < 2; ++h)
#pragma unroll
                    for (int i = 0; i < 2; ++i) oA[h][i] = (unsigned)(S.a_row(nxt, h, RA[i]) * ROWB + CA[i]);
            }
            PG8_WAIT_L(8); PG8_BAR; PG8_WAIT_L(0); PG8_MMA(0, 0, At, B0); PG8_BAR; PG8_SCHED;
            PG8_LDB(B1, 0, 1); PG8_STAGE(PG8_SB(0, 0), b2, voffB);
            PG8_BAR; PG8_WAIT_L(0); PG8_MMA(0, 1, At, B1); PG8_BAR;
            PG8_LDA(At, 0, 1); PG8_STAGE(PG8_SA(0, 0), a2, oA[0]);
            PG8_BAR; PG8_WAIT_L(0); PG8_MMA(1, 0, At, B0); PG8_BAR; PG8_SCHED;
            PG8_STAGE(PG8_SB(0, 1), b2 + hstep, voffB);
            PG8_WAIT_V(6); PG8_BAR; PG8_MMA(1, 1, At, B1); PG8_BAR;
            PG8_LDB(B0, 1, 0); PG8_SCHED; PG8_LDA(At, 1, 0); PG8_STAGE(PG8_SA(0, 1), a2, oA[1]);
            PG8_WAIT_L(8); PG8_BAR; PG8_WAIT_L(0); PG8_MMA(0, 0, At, B0); PG8_BAR; PG8_SCHED;
            PG8_LDB(B1, 1, 1); PG8_STAGE(PG8_SB(1, 0), b3, voffB);
            PG8_BAR; PG8_WAIT_L(0); PG8_MMA(0, 1, At, B1); PG8_BAR;
            PG8_LDA(At, 1, 1); PG8_STAGE(PG8_SA(1, 0), a3, oA[0]);
            PG8_BAR; PG8_WAIT_L(0); PG8_MMA(1, 0, At, B0); PG8_BAR; PG8_SCHED;
            PG8_STAGE(PG8_SB(1, 1), b3 + hstep, voffB);
            PG8_WAIT_V(6); PG8_BAR; PG8_MMA(1, 1, At, B1); PG8_BAR;
        }
        int l2 = threadIdx.x & 63; asm volatile("" : "+v"(l2));
        const int fr2 = l2 & 15, fq2 = l2 >> 4;
        if (Epi::BIAS_INIT && has_next) {
#pragma unroll
            for (int b = 0; b < 2; ++b)
#pragma unroll
                for (int n = 0; n < 2; ++n) bini[b][n] = E.bias4(nxt, b, n, wc, fq2);
        }
        E(acc, cur, wr, wc, fr2, fq2);
        if (!has_next) break;
#pragma unroll
        for (int a = 0; a < 2; ++a)
#pragma unroll
            for (int b = 0; b < 2; ++b)
#pragma unroll
                for (int m = 0; m < 4; ++m)
#pragma unroll
                    for (int n = 0; n < 2; ++n) acc[a][b][m][n] = bini[b][n];
        cur = nxt; cB = nB; ++ui;
    }
    PG8_WAIT_V(0);
    if (wr == 0) PG8_BAR;
    PG8_BAR;
#undef PG8_SA
#undef PG8_SB
#undef PG8_STAGE
#undef PG8_LDA
#undef PG8_LDB
#undef PG8_MMA
#undef PG8_WAIT_V
#undef PG8_WAIT_L
#undef PG8_BAR
#undef PG8_SCHED
}
}

struct EpiInProj {
    static constexpr bool PERM = true, BIAS_INIT = false;
    bf16_t *u, *q, *k, *v, *iq, *ik; float* iw; const float* ropeQK; const float* ropeIX;
    __device__ __forceinline__ f32x4 bias4(const pg8::Unit&, int, int, int, int) const { return (f32x4){0.f, 0.f, 0.f, 0.f}; }
    __device__ __forceinline__ void operator()(f32x4 (&acc)[2][2][4][2], const pg8::Unit& un, int wr, int wc, int fr, int fq) const {
        const int lane = threadIdx.x & 63;
#pragma unroll
        for (int bj = 0; bj < 2; ++bj) {
            const int gc = un.e * 256 + bj * 128;
            bf16_t* dst; unsigned char* dst8 = nullptr; int ld; int kind = 0; bool f8 = false;
            const int cin = wc * 32 + 8 * fq;
            if (gc < 256) { dst = u + gc + cin; ld = 256; }
            else if (gc < 1024) { dst8 = (unsigned char*)q + (gc - 256) + cin; dst = q; ld = 768; kind = (wc == 0) ? 1 : 0; f8 = true; }
            else if (gc < 1280) { dst8 = (unsigned char*)k + (gc - 1024) + cin; dst = k; ld = 256; kind = (wc == 0) ? 1 : 0; f8 = true; }
            else if (gc < 1536) {
#pragma unroll
                for (int ai = 0; ai < 2; ++ai)
#pragma unroll
                    for (int m = 0; m < 4; ++m) { const int row = un.pm * 256 + ai * 128 + wr * 64 + m * 16 + fr;
                        const int bb = row >> 11, key = row & 2047, kp = key & 63, pos = 32 * ((kp >> 2) & 1) + 16 * (kp >> 5) + (kp & 3) + 4 * ((kp & 31) >> 3);
                        unsigned char* vp = (unsigned char*)v + ((size_t)((bb * 2 + bj) * 32 + (key >> 6))) * 8192 + (size_t)cin * 64 + pos;
                        const f32x4 v0 = acc[ai][bj][m][0], v1 = acc[ai][bj][m][1];
                        const unsigned w0 = pk4_fp8(v0[0], v0[1], v0[2], v0[3]), w1 = pk4_fp8(v1[0], v1[1], v1[2], v1[3]);
#pragma unroll
                        for (int i = 0; i < 4; ++i) { vp[i * 64] = (unsigned char)(w0 >> (8 * i)); vp[(4 + i) * 64] = (unsigned char)(w1 >> (8 * i)); } }
                continue; }
            else if (gc < 2048) { dst = iq + (gc - 1536) + cin; ld = 512; kind = ((wc & 1) == 0) ? 2 : 0; }
            else if (gc == 2048) { if (wc >= 2) { if (wc == 2 && fq == 0) {
#pragma unroll
                        for (int ai = 0; ai < 2; ++ai)
#pragma unroll
                            for (int m = 0; m < 4; ++m) { const int row = un.pm * 256 + ai * 128 + wr * 64 + m * 16 + fr;
                                *(f32x4*)(iw + (size_t)row * 8) = acc[ai][bj][m][0]; *(f32x4*)(iw + (size_t)row * 8 + 4) = acc[ai][bj][m][1]; } }
                    continue; }
                dst = ik + cin; ld = 64; kind = (wc == 0) ? 2 : 0; }
            else continue;
#pragma unroll
            for (int ai = 0; ai < 2; ++ai)
#pragma unroll
                for (int m = 0; m < 4; ++m) {
                    const int row = un.pm * 256 + ai * 128 + wr * 64 + m * 16 + fr;
                    f32x4 v0 = acc[ai][bj][m][0], v1 = acc[ai][bj][m][1];
                    if (kind == 1) {
                        const float* rp = ropeQK + (size_t)row * 32 + 8 * (fq & 1);
                        const f32x4 c0 = *(const f32x4*)rp, c1 = *(const f32x4*)(rp + 4), s0 = *(const f32x4*)(rp + 16), s1 = *(const f32x4*)(rp + 20);
                        f32x4 p0, p1;
#pragma unroll
                        for (int j = 0; j < 4; ++j) { p0[j] = __shfl_xor(v0[j], 32); p1[j] = __shfl_xor(v1[j], 32); }
                        const float sg = (fq < 2) ? -1.f : 1.f;
                        v0 = v0 * c0 + sg * (p0 * s0); v1 = v1 * c1 + sg * (p1 * s1);
                    } else if (kind == 2) {
                        const float* rp = ropeIX + (size_t)row * 16;
                        const f32x4 c0 = *(const f32x4*)rp, c1 = *(const f32x4*)(rp + 4), s0 = *(const f32x4*)(rp + 8), s1 = *(const f32x4*)(rp + 12);
                        f32x4 p0, p1;
#pragma unroll
                        for (int j = 0; j < 4; ++j) { p0[j] = __shfl_xor(v0[j], 16); p1[j] = __shfl_xor(v1[j], 16); }
                        if (fq < 2) { const float sg = (fq == 0) ? -1.f : 1.f; v0 = v0 * c0 + sg * (p0 * s0); v1 = v1 * c1 + sg * (p1 * s1); }
                    }
                    if (f8) { u32x2 w8; w8.x = pk4_fp8(v0[0], v0[1], v0[2], v0[3]); w8.y = pk4_fp8(v1[0], v1[1], v1[2], v1[3]); *(u32x2*)(dst8 + (size_t)row * ld) = w8; }
                    else {
                    u32x4 w; w.x = cvt_pk_bf16(v0[0], v0[1]); w.y = cvt_pk_bf16(v0[2], v0[3]); w.z = cvt_pk_bf16(v1[0], v1[1]); w.w = cvt_pk_bf16(v1[2], v1[3]);
                    *(u32x4*)(dst + (size_t)row * ld) = w;
                    }
                }
        }
        (void)lane;
    }
};
struct EpiMix {
    static constexpr bool PERM = true, BIAS_INIT = false;
    bf16_t* mix;
    __device__ __forceinline__ f32x4 bias4(const pg8::Unit&, int, int, int, int) const { return (f32x4){0.f, 0.f, 0.f, 0.f}; }
    __device__ __forceinline__ void operator()(f32x4 (&acc)[2][2][4][2], const pg8::Unit& un, int wr, int wc, int fr, int fq) const {
        const int row0 = un.pm * 256 + wr * 64 + fr, col0 = un.pn * 256 + wc * 32 + 8 * fq;
#pragma unroll
        for (int bj = 0; bj < 2; ++bj)
#pragma unroll
            for (int ai = 0; ai < 2; ++ai)
#pragma unroll
                for (int m = 0; m < 4; ++m) {
                    const f32x4 v0 = acc[ai][bj][m][0], v1 = acc[ai][bj][m][1];
                    u32x4 w; w.x = cvt_pk_bf16(v0[0], v0[1]); w.y = cvt_pk_bf16(v0[2], v0[3]); w.z = cvt_pk_bf16(v1[0], v1[1]); w.w = cvt_pk_bf16(v1[2], v1[3]);
                    *(u32x4*)(mix + (size_t)(row0 + ai * 128 + m * 16) * 1024 + col0 + bj * 128) = w;
                }
    }
};
struct EpiGateUp {
    static constexpr bool PERM = true, BIAS_INIT = true;
    unsigned char* act; const float* bias; unsigned* rdy;
    __device__ __forceinline__ f32x4 bias4(const pg8::Unit& un, int bj, int n, int wc, int fq) const { return *(const f32x4*)(bias + (size_t)un.e * 2048 + bj * 1024 + un.pn * 128 + wc * 32 + 8 * fq + 4 * n); }
    __device__ __forceinline__ void operator()(f32x4 (&acc)[2][2][4][2], const pg8::Unit& un, int wr, int wc, int fr, int fq) const {
        const int row0 = un.pm * 256 + wr * 64 + fr, col0 = un.pn * 128 + wc * 32 + 8 * fq;
#pragma unroll
        for (int ai = 0; ai < 2; ++ai)
#pragma unroll
            for (int m = 0; m < 4; ++m) {
                float o[8];
#pragma unroll
                for (int n = 0; n < 2; ++n) {
                    const f32x4 gt = acc[ai][0][m][n], up = acc[ai][1][m][n];
#pragma unroll
                    for (int j = 0; j < 4; ++j) {
                        const float gg = __builtin_amdgcn_fmed3f(gt[j], -INFINITY, 7.0f), uu = __builtin_amdgcn_fmed3f(up[j], -7.0f, 7.0f);
                        const float sig = __builtin_amdgcn_rcpf(1.0f + __builtin_amdgcn_exp2f(-1.702f * 1.4426950408889634f * gg));
                        o[4 * n + j] = (uu * 8.0f + 8.0f) * gg * sig;
                    }
                }
                u32x2 w; w.x = pk4_fp8(o[0], o[1], o[2], o[3]); w.y = pk4_fp8(o[4], o[5], o[6], o[7]);
                const unsigned dofs = (unsigned)((row0 + ai * 128 + m * 16) * 1024 + col0);
                if (un.pm < 32) asm volatile("global_store_dwordx2 %0, %1, %2 sc1" :: "v"(dofs), "v"(w), "s"(act) : "memory");
                else *(u32x2*)(act + dofs) = w;
            }
        if (un.pm < 32) {
            asm volatile("s_waitcnt vmcnt(0)" ::: "memory");
            if ((threadIdx.x & 63) == 0) __hip_atomic_fetch_add(rdy + un.pm, 1u, __ATOMIC_RELAXED, __HIP_MEMORY_SCOPE_AGENT);
        }
    }
};
struct EpiDown {
    static constexpr bool PERM = true, BIAS_INIT = false;
    unsigned char* y; const float* bias;
    __device__ __forceinline__ f32x4 bias4(const pg8::Unit& un, int bj, int n, int wc, int fq) const { return *(const f32x4*)(bias + (size_t)un.e * 1024 + un.pn * 256 + bj * 128 + wc * 32 + 8 * fq + 4 * n); }
    __device__ __forceinline__ void operator()(f32x4 (&acc)[2][2][4][2], const pg8::Unit& un, int wr, int wc, int fr, int fq) const {
        const int row0 = un.pm * 256 + wr * 64 + fr, col0 = un.pn * 256 + wc * 32 + 8 * fq;
        const float* bp = bias + (size_t)un.e * 1024 + col0;
#pragma unroll
        for (int bj = 0; bj < 2; ++bj) {
            const f32x4 b0 = *(const f32x4*)(bp + bj * 128) * 64.0f, b1 = *(const f32x4*)(bp + bj * 128 + 4) * 64.0f;
#pragma unroll
            for (int ai = 0; ai < 2; ++ai)
#pragma unroll
                for (int m = 0; m < 4; ++m) {
                    const f32x4 v0 = acc[ai][bj][m][0] * 64.0f + b0, v1 = acc[ai][bj][m][1] * 64.0f + b1;
#define CL8(x) __builtin_amdgcn_fmed3f((x), -448.f, 448.f)
                    u32x2 w; w.x = pk4_fp8(CL8(v0[0]), CL8(v0[1]), CL8(v0[2]), CL8(v0[3])); w.y = pk4_fp8(CL8(v1[0]), CL8(v1[1]), CL8(v1[2]), CL8(v1[3]));
#undef CL8
                    *(u32x2*)(y + (size_t)(row0 + ai * 128 + m * 16) * 1024 + col0 + bj * 128) = w;
                }
        }
    }
};

struct Args { const void* in[18]; float* out; unsigned char* ws; int ph_lo, ph_hi; };
struct Frame {
    LAS unsigned char* lds; int tid, lane, wave, G, bid;
    const float *x, *ln_in_g, *ln_in_b, *w_in, *w_pool, *pool_scale, *w_out, *ln1_g, *ln1_b, *w_router, *b_router, *w_gu, *b_gu, *w_dn, *b_dn, *ln2_g, *ln2_b;
    const int* positions; float* out; unsigned char* ws; unsigned* ctl;
};

typedef const Args __attribute__((address_space(4))) * KArgP;
__device__ __forceinline__ void frame_refresh(Frame& F) {
    KArgP ap = (KArgP)__builtin_amdgcn_kernarg_segment_ptr(); asm volatile("" : "+s"(ap));
    int t_ = threadIdx.x; asm volatile("" : "+v"(t_)); F.tid = t_; F.lane = t_ & 63;
    F.x = (const float*)ap->in[0]; F.positions = (const int*)ap->in[1]; F.ln_in_g = (const float*)ap->in[2]; F.ln_in_b = (const float*)ap->in[3];
    F.w_in = (const float*)ap->in[4]; F.w_pool = (const float*)ap->in[5]; F.pool_scale = (const float*)ap->in[6]; F.w_out = (const float*)ap->in[7];
    F.ln1_g = (const float*)ap->in[8]; F.ln1_b = (const float*)ap->in[9]; F.w_router = (const float*)ap->in[10]; F.b_router = (const float*)ap->in[11];
    F.w_gu = (const float*)ap->in[12]; F.b_gu = (const float*)ap->in[13]; F.w_dn = (const float*)ap->in[14]; F.b_dn = (const float*)ap->in[15];
    F.ln2_g = (const float*)ap->in[16]; F.ln2_b = (const float*)ap->in[17];
    F.out = ap->out; F.ws = ap->ws; F.ctl = (unsigned*)(ap->ws + WS_CTL);
}
struct TrItem { const float* src; unsigned char* dst; int ldw, ldt, fp8; };
__device__ __forceinline__ TrItem mk_item(const float* W, unsigned char* WT, int ldw, int k0, int n0, int ldt, int drow0, int fp8) {
    TrItem t; t.src = W + (size_t)k0 * ldw + n0; t.dst = WT + ((size_t)drow0 * ldt + k0) * (fp8 ? 1 : 2); t.ldw = ldw; t.ldt = ldt; t.fp8 = fp8; return t;
}
__device__ __forceinline__ void tr_load(const TrItem& t, float (&tmp)[32], int lane) {
    if (t.fp8) {
        const float* p = t.src + (size_t)(lane >> 3) * t.ldw + (lane & 7) * 4;
#pragma unroll
        for (int j = 0; j < 8; ++j) { const f32x4 v = __builtin_nontemporal_load((const f32x4*)(p + (size_t)(8 * j) * t.ldw)); tmp[4 * j] = v.x; tmp[4 * j + 1] = v.y; tmp[4 * j + 2] = v.z; tmp[4 * j + 3] = v.w; }
    } else {
        const float* p = t.src + (size_t)(lane >> 5) * t.ldw + (lane & 31);
#pragma unroll
        for (int i = 0; i < 32; ++i) tmp[i] = __builtin_nontemporal_load(p + (size_t)(2 * i) * t.ldw);
    }
}
__device__ __forceinline__ void tr_store(const TrItem& t, const float (&tmp)[32], LAS float* scr, int lane) {
    if (t.fp8) {
#pragma unroll
        for (int j = 0; j < 8; ++j) *(LAS f32x4*)(scr + (8 * j + (lane >> 3)) * 32 + (lane & 7) * 4) = (f32x4){tmp[4 * j], tmp[4 * j + 1], tmp[4 * j + 2], tmp[4 * j + 3]};
        LDS_WAIT();
        const int n = lane >> 1, kb = 32 * (lane & 1); const LAS float* sp = scr + kb * 32 + n;
        unsigned o[8];
#pragma unroll
        for (int q = 0; q < 8; ++q) { float v[4];
#pragma unroll
            for (int j = 0; j < 4; ++j) v[j] = __builtin_amdgcn_fmed3f(sp[(4 * q + j) * 32] * 64.0f, -448.f, 448.f);
            o[q] = pk4_fp8(v[0], v[1], v[2], v[3]); }
        unsigned char* dp = t.dst + (size_t)n * 1024 + kb;
        *(u32x4*)dp = (u32x4){o[0], o[1], o[2], o[3]}; *(u32x4*)(dp + 16) = (u32x4){o[4], o[5], o[6], o[7]};
    } else {
#pragma unroll
        for (int i = 0; i < 32; ++i) { const int kk = 2 * i + (lane >> 5); scr[kk * 33 + (lane & 31)] = tmp[i]; }
        LDS_WAIT();
        const int c = lane & 7;
#pragma unroll
        for (int j = 0; j < 4; ++j) { const int n = (lane >> 3) + 8 * j; const LAS float* sp = scr + (8 * c) * 33 + n;
            u32x4 o; o.x = cvt_pk_bf16(sp[0 * 33], sp[1 * 33]); o.y = cvt_pk_bf16(sp[2 * 33], sp[3 * 33]); o.z = cvt_pk_bf16(sp[4 * 33], sp[5 * 33]); o.w = cvt_pk_bf16(sp[6 * 33], sp[7 * 33]);
            *(u32x4*)(t.dst + ((size_t)n * t.ldt + 8 * c) * 2) = o; }
    }
    LDS_WAIT();
}
__device__ __forceinline__ TrItem moe_item(Frame& F, int r) {
    constexpr int I_GU = NE * 16 * 64;
    if (r < I_GU) { const int e = r / 1024, rr = r % 1024, kb = rr / 64, nb = rr % 64, n0 = 32 * nb, bj = n0 / 1024, rem = n0 % 1024, pn = rem / 128, j0 = rem % 128;
        return mk_item(F.w_gu + (size_t)e * 1024 * 2048, F.ws + WS_BTGU + (size_t)e * 2048 * 1024, 2048, 64 * kb, n0, 1024, pn * 256 + bj * 128 + j0, 1); }
    r -= I_GU; const int e = r / 512, rr = r % 512, kb = rr / 32, nb = rr % 32;
    return mk_item(F.w_dn + (size_t)e * 1024 * 1024, F.ws + WS_BTDN + (size_t)e * 1024 * 1024, 1024, 64 * kb, 32 * nb, 1024, 32 * nb, 1);
}
__device__ __forceinline__ void convert_range(Frame& F, int first, int n, int widx, int nw) {
    LAS float* scr = (LAS float*)(F.lds + F.wave * 16384);
    int base = 2 * widx; if (base >= n) return;
    float va[32], vb[32], vc[32], vd[32];
    TrItem ta = moe_item(F, first + base), tb = moe_item(F, first + base + 1);
    tr_load(ta, va, F.lane); tr_load(tb, vb, F.lane);
    for (;;) {
        const int nb = base + 2 * nw; const bool more = nb < n;
        const TrItem tc = moe_item(F, first + (more ? nb : base)), td = moe_item(F, first + (more ? nb : base) + 1);
        if (more) { tr_load(tc, vc, F.lane); tr_load(td, vd, F.lane); }
        tr_store(ta, va, scr, F.lane); tr_store(tb, vb, scr, F.lane);
        if (!more) break;
        const int nb2 = nb + 2 * nw; const bool more2 = nb2 < n;
        ta = moe_item(F, first + (more2 ? nb2 : nb)); tb = moe_item(F, first + (more2 ? nb2 : nb) + 1);
        if (more2) { tr_load(ta, va, F.lane); tr_load(tb, vb, F.lane); }
        tr_store(tc, vc, scr, F.lane); tr_store(td, vd, scr, F.lane);
        if (!more2) break;
        base = nb2;
    }
}
__device__ __forceinline__ void cvq_pull(Frame& F, unsigned* head, int first, int npairs) {
    LAS float* scr = (LAS float*)(F.lds + F.wave * 16384);
    for (;;) {
        unsigned c = 0; if (F.lane == 0) c = __hip_atomic_fetch_add(head, 1u, __ATOMIC_RELAXED, __HIP_MEMORY_SCOPE_AGENT);
        c = (unsigned)__builtin_amdgcn_readfirstlane((int)c);
        if (c >= (unsigned)npairs) break;
        const int r = 2 * (first + (int)c);
        const TrItem ta = moe_item(F, r), tb = moe_item(F, r + 1);
        float va[32], vb[32];
        tr_load(ta, va, F.lane); tr_load(tb, vb, F.lane);
        tr_store(ta, va, scr, F.lane); tr_store(tb, vb, scr, F.lane);
    }
}
__constant__ double ROPE_QK_FREQ[16] = {1.0, 0.44036660267178046, 0.19392274474868576, 0.08539710028576561, 0.03760603093086393, 0.016560440080994446, 0.007292664737217109, 0.003211445994752591,
    0.001414213562373095, 0.000622772421914596, 0.0002742481756762073, 0.00012076973741146504, 5.318295896944988e-05, 2.341999896140934e-05, 1.031338537721246e-05, 4.5416704806078695e-06};
__constant__ double ROPE_IX_FREQ[8] = {1.0, 0.19392274474868576, 0.03760603093086393, 0.007292664737217109, 0.001414213562373095, 0.0002742481756762073, 5.318295896944988e-05, 1.031338537721246e-05};

__device__ __forceinline__ void p0_prologue(Frame& F) {
    LAS float* scr = (LAS float*)(F.lds + F.wave * 16384);
    const int gw = F.bid * 8 + F.wave, NGW = F.G * 8;
    const int gt = F.bid * NTHREADS + F.tid, NGT = F.G * NTHREADS;
    bf16_t* BtIn = (bf16_t*)(F.ws + WS_BTIN); bf16_t* BtOut = (bf16_t*)(F.ws + WS_BTOUT);
    bf16_t* WpT = (bf16_t*)(F.ws + WS_WPT);
    constexpr int I_IN = 16 * 66, I_OUT = 16 * 32, I_POOL = 8, I_MOE = NE * 16 * 64 + NE * 16 * 32;
    constexpr int NSMALL = I_IN + I_OUT + I_POOL, NITEMS = NSMALL + (I_MOE - CV_HIDDEN);
    auto decode = [&](int it) -> TrItem {
        int r = it;
        if (r < I_IN) { const int kb = r / 66, nb = r % 66;
            if (nb >= 8 && nb < 48) return mk_item(F.w_in, F.ws + WS_BTIN8, INW, 64 * kb, 32 * nb, 1024, 32 * nb, 1);
            return mk_item(F.w_in, (unsigned char*)BtIn, INW, 64 * kb, 32 * nb, 1024, 32 * nb, 0); } r -= I_IN;
        if (r < I_OUT) { const int kb = r / 32, nb = r % 32; return mk_item(F.w_out, (unsigned char*)BtOut, 1024, 64 * kb, 32 * nb, 1024, 32 * nb, 0); } r -= I_OUT;
        if (r < I_POOL) { const int g = r / 2, nb = r % 2; return mk_item(F.w_pool + g * 4096, (unsigned char*)(WpT + g * 4096), 64, 0, 32 * nb, 64, 32 * nb, 0); } r -= I_POOL;
        return moe_item(F, CV_HIDDEN + r);
    };
    for (int it = gw; it < NITEMS; it += 2 * NGW) {
        const bool two = (it + NGW < NITEMS);
        const TrItem ta = decode(it), tb = decode(two ? it + NGW : it);
        float va[32], vb[32];
        tr_load(ta, va, F.lane); if (two) tr_load(tb, vb, F.lane);
        tr_store(ta, va, scr, F.lane); if (two) tr_store(tb, vb, scr, F.lane);
    }
    for (int i = gt; i < 192 * 1024; i += NGT) { const int n = 2112 + i / 1024, k = i % 1024; const float v = (n < INW) ? F.w_in[(size_t)k * INW + n] : 0.f;
        BtIn[(size_t)n * 1024 + k] = (bf16_t)(cvt_pk_bf16(v, 0.f) & 0xffffu); }
    { float* wrA = (float*)(F.ws + WS_WRA);
      for (int i = gt; i < 32768; i += NGT) { const int ii = i & 3, e = (i >> 2) & 31, kh = (i >> 7) & 1, c = i >> 8; wrA[i] = F.w_router[(8 * c + 4 * kh + ii) * 32 + e]; } }
    { float* rq = (float*)(F.ws + WS_ROPEQK); float* ri = (float*)(F.ws + WS_ROPEIX);
      for (int i = gt; i < T * 24; i += NGT) { const int tok = i / 24, j = i % 24; const double pos = (double)F.positions[tok];
          const double inv = (j < 16) ? ROPE_QK_FREQ[j] : ROPE_IX_FREQ[j - 16];
          double rev = pos * inv * 0.15915494309189535; rev -= __builtin_floor(rev);
          const float c = __builtin_amdgcn_cosf((float)rev), s = __builtin_amdgcn_sinf((float)rev);
          if (j < 16) { rq[(size_t)tok * 32 + j] = c; rq[(size_t)tok * 32 + 16 + j] = s; } else { ri[(size_t)tok * 16 + (j - 16)] = c; ri[(size_t)tok * 16 + 8 + (j - 16)] = s; } } }
    if (F.bid == 0 && F.tid < 64) { F.ctl[CW_CNT + F.tid] = 0u; if (F.tid == 0) F.ctl[CW_ATTQ] = 0u; }
    { bf16_t* hA = (bf16_t*)(F.ws + WS_HA); float* stats = (float*)(F.ws + WS_STATS);
      f32x4 gv[4], bv[4];
#pragma unroll
      for (int j = 0; j < 4; ++j) { gv[j] = ((const f32x4*)F.ln_in_g)[F.lane + 64 * j]; bv[j] = ((const f32x4*)F.ln_in_b)[F.lane + 64 * j]; }
      f32x4 nx[4];
      if (gw < T) { const f32x4* xr = (const f32x4*)(F.x + (size_t)gw * 1024) + F.lane;
#pragma unroll
          for (int j = 0; j < 4; ++j) nx[j] = __builtin_nontemporal_load(xr + 64 * j); }
      for (int m = gw; m < T; m += NGW) {
          f32x4 v[4]; float s = 0.f;
#pragma unroll
          for (int j = 0; j < 4; ++j) { v[j] = nx[j]; s += (v[j].x + v[j].y) + (v[j].z + v[j].w); }
          if (m + NGW < T) { const f32x4* xr = (const f32x4*)(F.x + (size_t)(m + NGW) * 1024) + F.lane;
#pragma unroll
              for (int j = 0; j < 4; ++j) nx[j] = __builtin_nontemporal_load(xr + 64 * j); }
          const float mean = wave_sum(s) * (1.f / 1024.f); float s2 = 0.f;
#pragma unroll
          for (int j = 0; j < 4; ++j) { v[j] = v[j] - mean; s2 += (v[j].x * v[j].x + v[j].y * v[j].y) + (v[j].z * v[j].z + v[j].w * v[j].w); }
          const float rstd = 1.f / sqrtf(wave_sum(s2) * (1.f / 1024.f) + LN_EPS);
          u32x2* o8 = (u32x2*)(hA + (size_t)m * 1024) + F.lane; unsigned* q8 = (unsigned*)(F.ws + WS_HA8 + (size_t)m * 1024) + F.lane;
#pragma unroll
          for (int j = 0; j < 4; ++j) { const f32x4 h = v[j] * rstd * gv[j] + bv[j]; u32x2 w; w.x = cvt_pk_bf16(h.x, h.y); w.y = cvt_pk_bf16(h.z, h.w); o8[64 * j] = w; q8[64 * j] = pk4_fp8(h.x, h.y, h.z, h.w); }
          if (F.lane == 0) { stats[(size_t)m * 2] = mean; stats[(size_t)m * 2 + 1] = rstd; }
      } }
}

__device__ __forceinline__ void p2_pool(Frame& F) {
    const bf16_t* U = (const bf16_t*)(F.ws + WS_U); const bf16_t* WpT = (const bf16_t*)(F.ws + WS_WPT); bf16_t* cat = (bf16_t*)(F.ws + WS_CAT);
    LAS bf16_t* dl = (LAS bf16_t*)F.lds;
    LAS bf16_t* ul = (LAS bf16_t*)(F.lds + 33792);
    for (int tile = F.bid; tile < T / 64; tile += F.G) {
        const int t0 = tile * 64, pos0 = t0 % SEQ;
        __syncthreads();
        for (int i = F.tid; i < 79 * 32; i += NTHREADS) { const int r = i >> 5, c8 = i & 31; u32x4 v = {0u, 0u, 0u, 0u};
            if (pos0 + r - 15 >= 0) v = *(const u32x4*)(U + (size_t)(t0 + r - 15) * 256 + c8 * 8);
            *(LAS u32x4*)(ul + r * 256 + c8 * 8) = v; }
        __syncthreads();
        { const int c = F.tid & 255, half = F.tid >> 8, w = 2 << (c >> 6);
          const int ts = half * 32; float sum = 0.f;
          for (int d = 1; d < w; ++d) sum += __uint_as_float((unsigned)ul[(15 + ts - d) * 256 + c] << 16);
#pragma unroll 4
          for (int tt = 0; tt < 32; ++tt) { const int tl = ts + tt, p = pos0 + tl; const float cur = __uint_as_float((unsigned)ul[(15 + tl) * 256 + c] << 16);
              sum += cur; const int cnt = (p + 1 < w) ? (p + 1) : w;
              const float diff = sum / (float)cnt - cur;
              dl[tl * 264 + c] = (bf16_t)(cvt_pk_bf16(diff, 0.f) & 0xffffu);
              sum -= __uint_as_float((unsigned)ul[(15 + tl - (w - 1)) * 256 + c] << 16); } }
        __syncthreads();
        { const int g = F.wave & 3, th = F.wave >> 2, r32 = F.lane & 31, hi = F.lane >> 5;
          f32x16 c0 = {}, c1 = {};
#pragma unroll
          for (int s = 0; s < 4; ++s) {
              const bf16x8 a = *(const LAS bf16x8*)(dl + (th * 32 + r32) * 264 + g * 64 + 16 * s + 8 * hi);
              const bf16x8 b0 = *(const bf16x8*)(WpT + (size_t)g * 4096 + (size_t)r32 * 64 + 16 * s + 8 * hi);
              const bf16x8 b1 = *(const bf16x8*)(WpT + (size_t)g * 4096 + (size_t)(32 + r32) * 64 + 16 * s + 8 * hi);
              c0 = __builtin_amdgcn_mfma_f32_32x32x16_bf16(a, b0, c0, 0, 0, 0);
              c1 = __builtin_amdgcn_mfma_f32_32x32x16_bf16(a, b1, c1, 0, 0, 0); }
          const float ps0 = F.pool_scale[g * 64 + r32], ps1 = F.pool_scale[g * 64 + 32 + r32];
#pragma unroll
          for (int r = 0; r < 16; ++r) { const int tok = t0 + th * 32 + crow(r, hi);
              cat[(size_t)tok * 1024 + g * 64 + r32] = (bf16_t)(cvt_pk_bf16(c0[r] * ps0, 0.f) & 0xffffu);
              cat[(size_t)tok * 1024 + g * 64 + 32 + r32] = (bf16_t)(cvt_pk_bf16(c1[r] * ps1, 0.f) & 0xffffu); } }
    }
    __syncthreads();
}

constexpr int IDX_RING_OFF = 0, IDX_SLOT = 32768;
constexpr int IDX_HIST_OFF = 3 * IDX_SLOT;
constexpr int IDX_RES_OFF = IDX_HIST_OFF + 24576;
__device__ __forceinline__ void hist_find16(const LAS unsigned* hist, int li, unsigned need, unsigned& bsel, unsigned& above) {
    const u32x4 h0 = *(const LAS u32x4*)(hist + 4 * li);
    const unsigned c[8] = {h0.x & 0xffffu, h0.x >> 16, h0.y & 0xffffu, h0.y >> 16, h0.z & 0xffffu, h0.z >> 16, h0.w & 0xffffu, h0.w >> 16};
    unsigned s = 0;
#pragma unroll
    for (int k = 0; k < 8; ++k) s += c[k];
    unsigned S = s;
#pragma unroll
    for (int d = 1; d < 32; d <<= 1) { const unsigned o = __shfl_down(S, d, 32); if (li + d < 32) S += o; }
    const unsigned excl = S - s;
    unsigned b = 0xffffffffu, ab = 0;
    if (excl < need && need <= S) { unsigned cum = excl; bool found = false;
#pragma unroll
        for (int k = 7; k >= 0; --k) { if (!found && cum + c[k] >= need) { b = 8 * li + k; ab = cum; found = true; } if (!found) cum += c[k]; } }
    const unsigned long long bal = __ballot(b != 0xffffffffu);
    const unsigned halfmask = (unsigned)((threadIdx.x & 32) ? (bal >> 32) : (bal & 0xffffffffull));
    const int src = (halfmask ? (__ffs(halfmask) - 1) : 0) + (threadIdx.x & 32);
    bsel = __shfl(b, src, 64); above = __shfl(ab, src, 64);
    if (!halfmask) { bsel = 0; above = 0; }
}
template <int J> __device__ __forceinline__ void wlane(unsigned& m, unsigned v) { asm volatile("v_writelane_b32 %0, %1, %2" : "+v"(m) : "s"(v), "n"(J)); }
template <int J> __device__ __forceinline__ void mask_emit_step(const unsigned (&k0)[32], const unsigned (&k1)[32], unsigned T0, unsigned T1, int kh, int ntiles, unsigned& m0, unsigned& m1, unsigned& m2, unsigned& m3) {
    if (2 * J + kh < ntiles) {
        const unsigned long long ba = __ballot(k0[J] >= T0), bc = __ballot(k1[J] >= T1);
        wlane<J>(m0, (unsigned)ba); wlane<J>(m2, (unsigned)(ba >> 32)); wlane<J>(m1, (unsigned)bc); wlane<J>(m3, (unsigned)(bc >> 32));
    }
}
template <int... Js> __device__ __forceinline__ void mask_emit(std::integer_sequence<int, Js...>, const unsigned (&k0)[32], const unsigned (&k1)[32], unsigned T0, unsigned T1, int kh, int ntiles, unsigned& m0, unsigned& m1, unsigned& m2, unsigned& m3) {
    (mask_emit_step<Js>(k0, k1, T0, T1, kh, ntiles, m0, m1, m2, m3), ...);
}
__device__ __forceinline__ void p2_indexer_unit(Frame& F, int b, int qb) {
    const bf16_t* IQ = (const bf16_t*)(F.ws + WS_IQ); const bf16_t* IK = (const bf16_t*)(F.ws + WS_IK); const float* IW = (const float*)(F.ws + WS_IW);
    unsigned* MASK = (unsigned*)(F.ws + WS_MASK);
    const int qg = F.wave & 3, kh = F.wave >> 2;
    LAS unsigned* hist = (LAS unsigned*)(F.lds + IDX_HIST_OFF) + qg * 4 * 384;
    LAS float* mm = (LAS float*)(F.lds + IDX_RES_OFF);
    const int lane = F.lane, r32 = lane & 31, hi = lane >> 5;
    const int p0 = qb * 16 + qg * 4;
    const int tq0 = b * SEQ + p0;
    const int ntiles = (qb >> 1) + 1;
    const int nch = (ntiles + 7) >> 3;
    const char* ikb = (const char*)(IK + (size_t)b * SEQ * 64);
    unsigned dsrc[4];
#pragma unroll
    for (int i = 0; i < 4; ++i) { const int row = F.wave * 32 + i * 8 + (lane >> 3), pos = lane & 7; dsrc[i] = (unsigned)(row * 128 + ((pos ^ ((row >> 1) & 7)) << 4)); }
#define IDX_ISSUE(ch) do { _Pragma("unroll") for (int i_ = 0; i_ < 4; ++i_) \
        __builtin_amdgcn_global_load_lds((const unsigned*)(ikb + (size_t)(ch) * 32768 + dsrc[i_]), (LAS unsigned*)(F.lds + IDX_RING_OFF + ((ch) % 3) * IDX_SLOT + F.wave * 4096 + i_ * 1024), 16, 0, 0); } while (0)
    bf16x8 af[4];
    { const int i = r32, qi = 2 * ((i >> 2) & 1) + (i >> 4), hd = (i & 3) + 4 * ((i >> 3) & 1);
#pragma unroll
      for (int s = 0; s < 4; ++s) af[s] = *(const bf16x8*)(IQ + (size_t)(tq0 + qi) * 512 + hd * 64 + 16 * s + 8 * hi); }
    float wA[8], wB[8];
#pragma unroll
    for (int r = 0; r < 8; ++r) { const int hd = (r & 3) + 4 * (r >> 2); wA[r] = IW[(size_t)(tq0 + 2 * hi) * 8 + hd] * W_SCALE; wB[r] = IW[(size_t)(tq0 + 2 * hi + 1) * 8 + hd] * W_SCALE; }
    __builtin_amdgcn_s_barrier();
    asm volatile("" ::: "memory");
    IDX_ISSUE(0); if (nch > 1) IDX_ISSUE(1);
#pragma unroll
    for (int i = 0; i < 3; ++i) *(LAS u32x4*)(F.lds + IDX_HIST_OFF + (i * 512 + F.tid) * 16) = (u32x4){0u, 0u, 0u, 0u};
    const int limA = p0 + 2 * hi - 32 * (ntiles - 1), limB = limA + 1;
    float sc0[32], sc1[32];
#pragma unroll
    for (int j = 0; j < 32; ++j) { sc0[j] = -INFINITY; sc1[j] = -INFINITY; }
    float mx0 = -INFINITY, mn0 = INFINITY, mx1 = -INFINITY, mn1 = INFINITY;
    const int frag_off = r32 * 128;
    const int fx = (r32 >> 1) & 7;
#pragma unroll
    for (int ch = 0; ch < 8; ++ch) {
        if (ch < nch) {
            if (ch + 1 < nch) asm volatile("s_waitcnt vmcnt(4)" ::: "memory"); else asm volatile("s_waitcnt vmcnt(0)" ::: "memory");
            __builtin_amdgcn_s_barrier();
            asm volatile("" ::: "memory");
            if (ch + 2 < nch) IDX_ISSUE(ch + 2);
            const LAS char* slot = (const LAS char*)(F.lds + IDX_RING_OFF + (ch % 3) * IDX_SLOT);
#pragma unroll
            for (int j4 = 0; j4 < 4; ++j4) {
                const int jl = 2 * j4 + kh, j = ch * 8 + jl, idx = ch * 4 + j4;
                if (j < ntiles) {
                    f32x16 acc = {};
#pragma unroll
                    for (int s = 0; s < 4; ++s) { const bf16x8 bfr = *(const LAS bf16x8*)(slot + jl * 4096 + frag_off + (((2 * s + hi) ^ fx) << 4));
                        acc = __builtin_amdgcn_mfma_f32_32x32x16_bf16(af[s], bfr, acc, 0, 0, 0); }
                    float s0 = 0.f, s1 = 0.f;
#pragma unroll
                    for (int r = 0; r < 8; ++r) {
                        const int ia = __float_as_int(acc[r]), ib = __float_as_int(acc[8 + r]);
                        s0 = fmaf(wA[r], __int_as_float(ia > 0 ? ia : 0), s0); s1 = fmaf(wB[r], __int_as_float(ib > 0 ? ib : 0), s1); }
                    if (j == ntiles - 1) {
                        mn0 = fminf(mn0, (r32 > limA) ? INFINITY : s0); mn1 = fminf(mn1, (r32 > limB) ? INFINITY : s1);
                        s0 = (r32 > limA) ? -INFINITY : s0; s1 = (r32 > limB) ? -INFINITY : s1;
                    } else { mn0 = fminf(mn0, s0); mn1 = fminf(mn1, s1); }
                    mx0 = fmaxf(mx0, s0); mx1 = fmaxf(mx1, s1);
                    sc0[idx] = s0; sc1[idx] = s1;
                }
            }
        }
    }
#undef IDX_ISSUE
#pragma unroll
    for (int d = 1; d < 32; d <<= 1) { mx0 = fmaxf(mx0, __shfl_xor(mx0, d)); mx1 = fmaxf(mx1, __shfl_xor(mx1, d)); mn0 = fminf(mn0, __shfl_xor(mn0, d)); mn1 = fminf(mn1, __shfl_xor(mn1, d)); }
    if (r32 == 0) { LAS float* w = mm + ((qg * 2 + kh) * 4 + 2 * hi) * 2; w[0] = mx0; w[1] = mn0; w[2] = mx1; w[3] = mn1; }
    __syncthreads();
    { const LAS float* w = mm + ((qg * 2 + (kh ^ 1)) * 4 + 2 * hi) * 2; mx0 = fmaxf(mx0, w[0]); mn0 = fminf(mn0, w[1]); mx1 = fmaxf(mx1, w[2]); mn1 = fminf(mn1, w[3]); }
    const float scl0 = (mx0 > mn0) ? (16777212.0f / (mx0 - mn0)) : 0.f, scl1 = (mx1 > mn1) ? (16777212.0f / (mx1 - mn1)) : 0.f;
    const float off0 = 1.5f - mn0 * scl0, off1 = 1.5f - mn1 * scl1;
    unsigned k0[32], k1[32];
#pragma unroll
    for (int j = 0; j < 32; ++j) { k0[j] = (unsigned)fmaf(sc0[j], scl0, off0); k1[j] = (unsigned)fmaf(sc1[j], scl1, off1); }
    unsigned T0 = 1u, T1 = 1u;
#ifndef NO_SELECT
    if (qb >= 16) {
        LAS unsigned* hA = hist + (2 * hi) * 384; LAS unsigned* hB = hist + (2 * hi + 1) * 384;
        unsigned pre0 = 0, pre1 = 0, need0 = 256, need1 = 256;
#pragma unroll
        for (int lvl = 0; lvl < 3; ++lvl) {
            const int sh = 16 - 8 * lvl;
#pragma unroll
            for (int j = 0; j < 32; ++j) {
                if (2 * j + kh < ntiles) {
                    const unsigned ka = k0[j], kc = k1[j];
                    if (lvl == 0 || (ka >> (sh + 8)) == pre0) { const unsigned bn = (ka >> sh) & 255u; (void)__hip_atomic_fetch_add(hA + lvl * 128 + (bn >> 1), 1u << ((bn & 1u) << 4), __ATOMIC_RELAXED, __HIP_MEMORY_SCOPE_WORKGROUP); }
                    if (lvl == 0 || (kc >> (sh + 8)) == pre1) { const unsigned bn = (kc >> sh) & 255u; (void)__hip_atomic_fetch_add(hB + lvl * 128 + (bn >> 1), 1u << ((bn & 1u) << 4), __ATOMIC_RELAXED, __HIP_MEMORY_SCOPE_WORKGROUP); }
                }
            }
            __syncthreads();
            unsigned b0, a0, b1, a1;
            hist_find16(hA + lvl * 128, r32, need0, b0, a0);
            hist_find16(hB + lvl * 128, r32, need1, b1, a1);
            pre0 = (pre0 << 8) | b0; need0 -= a0;
            pre1 = (pre1 << 8) | b1; need1 -= a1;
        }
        T0 = pre0 > 1u ? pre0 : 1u; T1 = pre1 > 1u ? pre1 : 1u;
    }
#endif
    unsigned m0 = 0, m1 = 0, m2 = 0, m3 = 0;
    mask_emit(std::make_integer_sequence<int, 32>{}, k0, k1, T0, T1, kh, ntiles, m0, m1, m2, m3);
    if (lane < 32) { const int w = 2 * lane + kh;
        MASK[(size_t)(tq0 + 0) * 64 + w] = m0; MASK[(size_t)(tq0 + 1) * 64 + w] = m1; MASK[(size_t)(tq0 + 2) * 64 + w] = m2; MASK[(size_t)(tq0 + 3) * 64 + w] = m3; }
}
__device__ __forceinline__ void p2_indexer(Frame& F) {
    for (int pi = F.bid; pi < 512; pi += F.G) { const int b = pi >> 6, x = pi & 63;
        p2_indexer_unit(F, b, 127 - x);
        p2_indexer_unit(F, b, x); }
    __syncthreads();
}

namespace att {
constexpr int D = 128, NW = 8, QBLK = 32, KVBLK = 64;
constexpr float SCALE = 0.088388347648318440f;
constexpr float THR = 5.f;
constexpr int LDQ = 768, LDK = 256, LDO = 1024;
constexpr size_t SHM_V = KVBLK * D, SHM_K = KVBLK * D, SHM_ATTN = 2 * SHM_V + 2 * SHM_K + NW * 64 * 4;
#define KSWZ(row, colB) ((row) * 256 + ((colB) ^ (((row) & 7) << 4)))
#define SBAR() __builtin_amdgcn_sched_barrier(0)
__device__ __forceinline__ void apply_mask(f32x16& p0, f32x16& p1, u32x2 mk, int hi) {
    const int ml = (int)(mk.x >> (4 * hi)), mh = (int)(mk.y >> (4 * hi));
#pragma unroll
    for (int r = 0; r < 16; ++r) { const int cr = (r & 3) + 8 * (r >> 2);
        const unsigned t0 = (unsigned)__builtin_amdgcn_sbfe(ml, cr, 1), t1 = (unsigned)__builtin_amdgcn_sbfe(mh, cr, 1);
        p0[r] = __uint_as_float((__float_as_uint(p0[r]) & t0) | (0xff800000u & ~t0));
        p1[r] = __uint_as_float((__float_as_uint(p1[r]) & t1) | (0xff800000u & ~t1)); }
}
__device__ __forceinline__ void partialSM(f32x16& p0, f32x16& p1, float& m_reg, float& mn, float& alpha) {
    constexpr float C = SCALE * 1.4426950408889634f;
    float pmax = p0[0];
#pragma unroll
    for (int r = 1; r < 16; ++r) pmax = fmaxf(pmax, p0[r]);
#pragma unroll
    for (int r = 0; r < 16; ++r) pmax = fmaxf(pmax, p1[r]);
    { auto rr = __builtin_amdgcn_permlane32_swap(__float_as_uint(pmax), __float_as_uint(pmax), false, false);
      pmax = fmaxf(__uint_as_float(rr[0]), __uint_as_float(rr[1])); }
    if (__builtin_expect(__all(pmax - m_reg <= THR / SCALE), 1)) { mn = m_reg; alpha = 1.f; }
    else { mn = fmaxf(m_reg, pmax); alpha = __builtin_amdgcn_exp2f((m_reg - mn) * C); m_reg = mn; }
    const float mnC = -mn * C;
#pragma unroll
    for (int r = 0; r < 16; ++r) p0[r] = fmaf(p0[r], C, mnC);
#pragma unroll
    for (int r = 0; r < 16; ++r) p1[r] = fmaf(p1[r], C, mnC);
#pragma unroll
    for (int r = 0; r < 16; ++r) p0[r] = __builtin_amdgcn_exp2f(p0[r]);
}
typedef int v8i32a __attribute__((ext_vector_type(8)));
typedef int v4i32a __attribute__((ext_vector_type(4)));
__device__ __forceinline__ void finishSM(f32x16& p0, f32x16& p1, float alpha, float& l_reg, v8i32a& pf) {
#pragma unroll
    for (int r = 0; r < 16; ++r) p1[r] = __builtin_amdgcn_exp2f(p1[r]);
    float ps = 0;
#pragma unroll
    for (int r = 0; r < 16; ++r) ps += p0[r];
#pragma unroll
    for (int r = 0; r < 16; ++r) ps += p1[r];
    { auto rr = __builtin_amdgcn_permlane32_swap(__float_as_uint(ps), __float_as_uint(ps), false, false);
      ps = __uint_as_float(rr[0]) + __uint_as_float(rr[1]); }
    l_reg = l_reg * alpha + ps;
#pragma unroll
    for (int i = 0; i < 4; ++i) { pf[i] = (int)pk4_fp8(p0[4 * i], p0[4 * i + 1], p0[4 * i + 2], p0[4 * i + 3]); pf[4 + i] = (int)pk4_fp8(p1[4 * i], p1[4 * i + 1], p1[4 * i + 2], p1[4 * i + 3]); }
}
__device__ __forceinline__ void qkt(f32x16& p0, f32x16& p1, const LAS char* Ks, const v8i32a* qr, int r32, int hi) {
    p0 = f32x16{}; p1 = f32x16{};
    const int fx = (r32 >> 1) & 7;
#pragma unroll
    for (int s2 = 0; s2 < 2; ++s2) { const int c0 = 4 * s2 + 2 * hi;
        const v4i32a a0l = *reinterpret_cast<const LAS v4i32a*>(Ks + r32 * 128 + ((c0 ^ fx) << 4)), a0h = *reinterpret_cast<const LAS v4i32a*>(Ks + r32 * 128 + (((c0 + 1) ^ fx) << 4));
        const v4i32a a1l = *reinterpret_cast<const LAS v4i32a*>(Ks + (32 + r32) * 128 + ((c0 ^ fx) << 4)), a1h = *reinterpret_cast<const LAS v4i32a*>(Ks + (32 + r32) * 128 + (((c0 + 1) ^ fx) << 4));
        p0 = __builtin_amdgcn_mfma_scale_f32_32x32x64_f8f6f4(__builtin_shufflevector(a0l, a0h, 0, 1, 2, 3, 4, 5, 6, 7), qr[s2], p0, 0, 0, 0, 0x7f7f7f7f, 0, 0x7f7f7f7f);
        p1 = __builtin_amdgcn_mfma_scale_f32_32x32x64_f8f6f4(__builtin_shufflevector(a1l, a1h, 0, 1, 2, 3, 4, 5, 6, 7), qr[s2], p1, 0, 0, 0, 0x7f7f7f7f, 0, 0x7f7f7f7f); }
}
__device__ __forceinline__ void pv_d0(f32x16* o, const LAS char* Vs, v8i32a pf, int r32, int hi) {
    const int fx = (r32 >> 2) & 3;
#pragma unroll
    for (int d0 = 0; d0 < 4; ++d0) { const LAS char* rowp = Vs + (32 * d0 + r32) * 64;
        const v4i32a lo = *reinterpret_cast<const LAS v4i32a*>(rowp + (((2 * hi) ^ fx) << 4)), hh = *reinterpret_cast<const LAS v4i32a*>(rowp + (((2 * hi + 1) ^ fx) << 4));
        o[d0] = __builtin_amdgcn_mfma_scale_f32_32x32x64_f8f6f4(pf, __builtin_shufflevector(lo, hh, 0, 1, 2, 3, 4, 5, 6, 7), o[d0], 0, 0, 0, 0x7f7f7f7f, 0, 0x7f7f7f7f); }
}
__device__ __forceinline__ void attn_body(const unsigned char* __restrict__ Qb, const unsigned char* __restrict__ Kh, const unsigned char* __restrict__ Vh, bf16_t* __restrict__ Ob, const unsigned* __restrict__ Mb, int NT, LAS char* lds) {
    const int tid = threadIdx.x, wid = tid >> 6, lane = tid & 63, r32 = lane & 31, hi = lane >> 5;
    LAS char* V_lds = lds; LAS char* K_lds = lds + 2 * SHM_V;
    LAS float* ws = (LAS float*)(lds + 2 * SHM_V + 2 * SHM_K) + wid * 64; LAS float* li_l = ws; LAS float* al_l = ws + 32;
    float m_reg = -1e30f, l_reg = 0; f32x16 o[4] = {}; v8i32a qr[2];
    const unsigned char* Qw = Qb + (long)(wid * QBLK + r32) * LDQ + hi * 32;
#pragma unroll
    for (int s2 = 0; s2 < 2; ++s2) { const v4i32a ql = *reinterpret_cast<const v4i32a*>(Qw + s2 * 64), qh = *reinterpret_cast<const v4i32a*>(Qw + s2 * 64 + 16); qr[s2] = __builtin_shufflevector(ql, qh, 0, 1, 2, 3, 4, 5, 6, 7); }
    const int krow = tid >> 3, kdst = krow * 128 + (((tid & 7) ^ ((krow >> 1) & 7)) << 4);
    const unsigned mofs = (unsigned)(wid * QBLK + r32) * 256u;
#define Mw_(j) (*(const u32x2*)((const char*)Mb + (mofs + 8u * (unsigned)(j))))
    const int vdst = (tid >> 2) * 64 + (((tid & 3) ^ ((tid >> 4) & 3)) << 4);
    const LAS char* vb0 = V_lds;
    struct { v4i32a vs, ks; } sr_[2];
#define SLOAD(i, k0) do { sr_[i].vs = *(const v4i32a*)(Vh + (long)((k0) >> 6) * 8192 + tid * 16); \
    sr_[i].ks = *(const v4i32a*)(Kh + (long)((k0) + krow) * LDK + (tid & 7) * 16); } while (0)
#define SWRITE(b, i) do { *(LAS v4i32a*)(V_lds + (b) * SHM_V + vdst) = sr_[i].vs;          \
    *(LAS v4i32a*)(K_lds + (b) * SHM_K + kdst) = sr_[i].ks; } while (0)
#define SWAIT() asm volatile("s_waitcnt vmcnt(3)" ::: "memory")
#define RESC(a) do { if (__any((a) < 1.f)) { if (hi == 0) al_l[r32] = (a); asm volatile("s_waitcnt lgkmcnt(0)" ::: "memory"); \
    _Pragma("unroll") for (int d = 0; d < 4; ++d) _Pragma("unroll") for (int r = 0; r < 16; ++r) o[d][r] *= al_l[crow(r, hi)]; } } while (0)
    f32x16 pA0, pA1, pB0, pB1; float mnA, mnB, alA, alB; v8i32a pf;
    u32x2 mkA = Mw_(0), mkB = Mw_(1);
    constexpr int SE = 0, SO = 1;
    const int jmax = NT - 4 + (__builtin_amdgcn_readfirstlane(wid) >> 1);
#define VAL(t) ((t) <= jmax)
    SLOAD(SE, 0); asm volatile("s_waitcnt vmcnt(0)" ::: "memory"); SWRITE(0, SE); __syncthreads();
    qkt(pA0, pA1, K_lds, qr, r32, hi); apply_mask(pA0, pA1, mkA, hi); partialSM(pA0, pA1, m_reg, mnA, alA); mkA = Mw_(2);
    SLOAD(SO, KVBLK); if (2 < NT) SLOAD(SE, 2 * KVBLK);
    SWAIT(); SWRITE(1, SO); __syncthreads();
    for (int j = 1; j + 1 < NT; j += 2) {
        SBAR(); if (VAL(j)) qkt(pB0, pB1, K_lds + SHM_K, qr, r32, hi);
        if (VAL(j - 1)) finishSM(pA0, pA1, alA, l_reg, pf); SBAR();
        SLOAD(SO, (j + 2) * KVBLK); SBAR();
        if (VAL(j - 1)) pv_d0(o, vb0, pf, r32, hi);
        alB = 1.f; if (VAL(j)) { apply_mask(pB0, pB1, mkB, hi); partialSM(pB0, pB1, m_reg, mnB, alB); } mkB = Mw_((j + 2 < NT) ? (j + 2) : j);
        __syncthreads(); SWAIT(); SWRITE(0, SE);
        RESC(alB); __syncthreads();
        SBAR(); if (VAL(j + 1)) qkt(pA0, pA1, K_lds, qr, r32, hi);
        if (VAL(j)) finishSM(pB0, pB1, alB, l_reg, pf); SBAR();
        if (j + 3 < NT) SLOAD(SE, (j + 3) * KVBLK); SBAR();
        if (VAL(j)) pv_d0(o, vb0 + SHM_V, pf, r32, hi);
        alA = 1.f; if (VAL(j + 1)) { apply_mask(pA0, pA1, mkA, hi); partialSM(pA0, pA1, m_reg, mnA, alA); } mkA = Mw_((j + 3 < NT) ? (j + 3) : (j + 1));
        __syncthreads(); SWAIT(); SWRITE(1, SO);
        RESC(alA); __syncthreads();
    }
    SBAR(); if (VAL(NT - 1)) qkt(pB0, pB1, K_lds + SHM_K, qr, r32, hi);
    if (VAL(NT - 2)) finishSM(pA0, pA1, alA, l_reg, pf); SBAR();
    if (VAL(NT - 2)) pv_d0(o, vb0, pf, r32, hi);
    alB = 1.f; if (VAL(NT - 1)) { apply_mask(pB0, pB1, mkB, hi); partialSM(pB0, pB1, m_reg, mnB, alB); }
    __syncthreads(); RESC(alB);
    if (VAL(NT - 1)) { finishSM(pB0, pB1, alB, l_reg, pf); SBAR();
        pv_d0(o, vb0 + SHM_V, pf, r32, hi); }
#undef VAL
    if (hi == 0) li_l[r32] = l_reg; asm volatile("s_waitcnt lgkmcnt(0)" ::: "memory");
    float rli[16];
#pragma unroll
    for (int r = 0; r < 16; ++r) rli[r] = __builtin_amdgcn_rcpf(li_l[crow(r, hi)]);
    bf16_t* Ow = Ob + (long)(wid * QBLK) * LDO;
#pragma unroll
    for (int r = 0; r < 16; ++r) { const int orow = crow(r, hi);
#pragma unroll
        for (int d0 = 0; d0 < 4; ++d0) Ow[(long)orow * LDO + d0 * 32 + r32] = (bf16_t)(cvt_pk_bf16(o[d0][r] * rli[r], 0.f) & 0xffffu); }
#undef SLOAD
#undef SWRITE
#undef SWAIT
#undef RESC
#undef Mw_
}
}

__device__ __forceinline__ void p3_attention(Frame& F) {
    const bf16_t* Q = (const bf16_t*)(F.ws + WS_Q); const bf16_t* K = (const bf16_t*)(F.ws + WS_K); const bf16_t* V = (const bf16_t*)(F.ws + WS_V);
    bf16_t* cat = (bf16_t*)(F.ws + WS_CAT); const unsigned* MASK = (const unsigned*)(F.ws + WS_MASK);
    const int j = F.bid;
    if (F.G == 256 && j >= 216) {
        convert_range(F, 2 * CV_PAIRS1, 2 * CV_PAIRS3, (j - 216) * 8 + F.wave, 40 * 8);
        return;
    }
    int qbs[2], phs[2], nu = 2;
    if (F.G != 256) { nu = 0; }
    else if (j < 48) { qbs[0] = 7; phs[0] = (j % 8) * 6 + j / 8; nu = 1; qbs[1] = 0; phs[1] = 0; }
    else if (j < 96) { const int jl = j - 48; qbs[0] = 6; phs[0] = (jl % 8) * 6 + jl / 8; qbs[1] = 0; phs[1] = phs[0]; }
    else if (j < 144) { const int jl = j - 96; qbs[0] = 5; phs[0] = (jl % 8) * 6 + jl / 8; qbs[1] = 1; phs[1] = phs[0]; }
    else if (j < 192) { const int jl = j - 144; qbs[0] = 4; phs[0] = (jl % 8) * 6 + jl / 8; qbs[1] = 2; phs[1] = phs[0]; }
    else { const int jl = j - 192; qbs[0] = 3; phs[0] = (jl % 8) * 6 + 2 * (jl / 8); qbs[1] = 3; phs[1] = phs[0] + 1; }
    for (int ui = 0; ui < nu; ++ui) {
        __syncthreads();
        const int qb = qbs[ui], b = phs[ui] / 6, h = phs[ui] % 6, g = h / 3;
        const size_t row0 = (size_t)b * SEQ + (size_t)qb * 256;
        att::attn_body((const unsigned char*)Q + row0 * 768 + h * 128, (const unsigned char*)K + (size_t)b * SEQ * 256 + g * 128, (const unsigned char*)V + (size_t)(b * 2 + g) * 32 * 8192, cat + row0 * 1024 + 256 + h * 128, MASK + row0 * 64, 4 * (qb + 1), (LAS char*)F.lds);
    }
    __syncthreads();
}

__device__ __forceinline__ void p5_ln1_router(Frame& F) {
    const bf16_t* MIX = (const bf16_t*)(F.ws + WS_MIX); const bf16_t* HA = (const bf16_t*)(F.ws + WS_HA);
    bf16_t* H1R = (bf16_t*)(F.ws + WS_H1F); unsigned char* H1Q = F.ws + WS_H1B; const float* wrA = (const float*)(F.ws + WS_WRA);
    unsigned* INV = (unsigned*)(F.ws + WS_INV); unsigned* TOKEP = (unsigned*)(F.ws + WS_TOKEP); float* TOKG = (float*)(F.ws + WS_TOKG);
    LAS float* tile = (LAS float*)F.lds;
    LAS float* part = (LAS float*)F.lds;
    LAS float* logit = (LAS float*)(F.lds + 36864);
    LAS int* sel_e = (LAS int*)(F.lds + MISC_OFF + 2048);
    LAS float* sel_g = (LAS float*)(F.lds + MISC_OFF + 3072);
    LAS int* sel_p = (LAS int*)(F.lds + MISC_OFF + 4096);
    LAS unsigned* lcnt = (LAS unsigned*)(F.lds + MISC_OFF + 5120);
    LAS int* ebase = (LAS int*)(F.lds + MISC_OFF + 5376);
    const int lane = F.lane, r32 = lane & 31, hi = lane >> 5;
    for (int blk = F.bid; blk < T / 64; blk += F.G) {
        const int t0 = blk * 64;
        if (F.tid < 32) lcnt[F.tid] = 0u;
        for (int pass = 0; pass < 2; ++pass) {
            __syncthreads();
            { f32x4 g1[4], b1[4];
#pragma unroll
              for (int j = 0; j < 4; ++j) { g1[j] = ((const f32x4*)F.ln1_g)[lane + 64 * j]; b1[j] = ((const f32x4*)F.ln1_b)[lane + 64 * j]; }
#pragma unroll
              for (int rb = 0; rb < 4; rb += 2) {
              u32x2 xv[2][4]; u32x2 mv[2][4];
#pragma unroll
              for (int rr = 0; rr < 2; ++rr) { const int m = t0 + pass * 32 + F.wave * 4 + rb + rr;
#pragma unroll
                  for (int j = 0; j < 4; ++j) { xv[rr][j] = ((const u32x2*)(HA + (size_t)m * 1024))[lane + 64 * j]; mv[rr][j] = ((const u32x2*)(MIX + (size_t)m * 1024))[lane + 64 * j]; } }
#pragma unroll
              for (int rr = 0; rr < 2; ++rr) { const int tl = F.wave * 4 + rb + rr, m = t0 + pass * 32 + tl;
                  f32x4 v[4]; float s = 0.f;
#pragma unroll
                  for (int j = 0; j < 4; ++j) { const u32x2 hw = xv[rr][j]; const f32x4 h = {bf16_lo(hw.x), bf16_hi(hw.x), bf16_lo(hw.y), bf16_hi(hw.y)};
                      const u32x2 w = mv[rr][j]; const f32x4 mx = {bf16_lo(w.x), bf16_hi(w.x), bf16_lo(w.y), bf16_hi(w.y)};
                      v[j] = ALPHA * h + mx; s += (v[j].x + v[j].y) + (v[j].z + v[j].w); }
                  const float mean = wave_sum(s) * (1.f / 1024.f); float s2 = 0.f;
#pragma unroll
                  for (int j = 0; j < 4; ++j) { v[j] = v[j] - mean; s2 += (v[j].x * v[j].x + v[j].y * v[j].y) + (v[j].z * v[j].z + v[j].w * v[j].w); }
                  const float rstd = 1.f / sqrtf(wave_sum(s2) * (1.f / 1024.f) + LN_EPS);
                  u32x2* of = (u32x2*)(H1R + (size_t)m * 1024) + lane; unsigned* ob = (unsigned*)(H1Q + (size_t)m * 1024) + lane;
#pragma unroll
                  for (int j = 0; j < 4; ++j) { const f32x4 h = v[j] * rstd * g1[j] + b1[j]; { u32x2 hw; hw.x = cvt_pk_bf16(h.x, h.y); hw.y = cvt_pk_bf16(h.z, h.w); of[64 * j] = hw; } ob[64 * j] = pk4_fp8(h.x, h.y, h.z, h.w);
                      *(LAS f32x4*)(tile + tl * 1024 + (((lane + 64 * j) ^ (tl & 15)) << 2)) = h; } } } }
            f32x4 a4[16];
#pragma unroll
            for (int i = 0; i < 16; ++i) a4[i] = *(const f32x4*)(wrA + (size_t)(((F.wave * 16 + i) * 2 + hi) * 32 + r32) * 4);
            __syncthreads();
            f32x16 acc = {};
#pragma unroll
            for (int i = 0; i < 16; ++i) { const int c = F.wave * 16 + i;
                const f32x4 b4 = *(const LAS f32x4*)(tile + r32 * 1024 + (((2 * c + hi) ^ (r32 & 15)) << 2));
                acc = __builtin_amdgcn_mfma_f32_32x32x2f32(a4[i].x, b4.x, acc, 0, 0, 0);
                acc = __builtin_amdgcn_mfma_f32_32x32x2f32(a4[i].y, b4.y, acc, 0, 0, 0);
                acc = __builtin_amdgcn_mfma_f32_32x32x2f32(a4[i].z, b4.z, acc, 0, 0, 0);
                acc = __builtin_amdgcn_mfma_f32_32x32x2f32(a4[i].w, b4.w, acc, 0, 0, 0); }
            __syncthreads();
#pragma unroll
            for (int r = 0; r < 16; ++r) part[(F.wave * 32 + r32) * 33 + crow(r, hi)] = acc[r];
            __syncthreads();
#pragma unroll
            for (int q = 0; q < 2; ++q) { const int o = F.tid * 2 + q, tok = o >> 5, e = o & 31; float sm = F.b_router[e];
#pragma unroll
                for (int kq = 0; kq < 8; ++kq) sm += part[(kq * 32 + tok) * 33 + e];
                logit[tok * 33 + e] = sm; }
            __syncthreads();
            if (F.tid < 32) {
                float bv_[4] = {-INFINITY, -INFINITY, -INFINITY, -INFINITY}; int bi[4] = {0, 0, 0, 0};
#pragma unroll
                for (int e = 0; e < 32; ++e) { const float v = logit[F.tid * 33 + e];
                    if (v > bv_[3]) { bv_[3] = v; bi[3] = e;
                        if (bv_[3] > bv_[2]) { float tv = bv_[2]; bv_[2] = bv_[3]; bv_[3] = tv; int ti = bi[2]; bi[2] = bi[3]; bi[3] = ti;
                            if (bv_[2] > bv_[1]) { tv = bv_[1]; bv_[1] = bv_[2]; bv_[2] = tv; ti = bi[1]; bi[1] = bi[2]; bi[2] = ti;
                                if (bv_[1] > bv_[0]) { tv = bv_[0]; bv_[0] = bv_[1]; bv_[1] = tv; ti = bi[0]; bi[0] = bi[1]; bi[1] = ti; } } } } }
                float ex[4], se = 0.f;
#pragma unroll
                for (int j = 0; j < 4; ++j) { ex[j] = __expf(bv_[j] - bv_[0]); se += ex[j]; }
#pragma unroll
                for (int j = 0; j < 4; ++j) { sel_g[(pass * 32 + F.tid) * 4 + j] = ex[j] / se; sel_e[(pass * 32 + F.tid) * 4 + j] = bi[j]; }
            }
        }
        __syncthreads();
        if (F.tid < 256) sel_p[F.tid] = (int)__hip_atomic_fetch_add(lcnt + sel_e[F.tid], 1u, __ATOMIC_RELAXED, __HIP_MEMORY_SCOPE_WORKGROUP);
        __syncthreads();
        if (F.tid < 32) { const unsigned c = lcnt[F.tid]; int base = 0; if (c > 0) base = (int)__hip_atomic_fetch_add(F.ctl + CW_CNT + F.tid, c, __ATOMIC_RELAXED, __HIP_MEMORY_SCOPE_AGENT); ebase[F.tid] = base; }
        __syncthreads();
        if (F.tid < 256) { const int tok = t0 + (F.tid >> 2), e = sel_e[F.tid], p = ebase[e] + sel_p[F.tid];
            INV[(size_t)e * CAP + p] = (unsigned)tok; TOKEP[(size_t)tok * 4 + (F.tid & 3)] = ((unsigned)e << 16) | (unsigned)p; TOKG[(size_t)tok * 4 + (F.tid & 3)] = sel_g[F.tid]; }
        __syncthreads();
    }
}

__device__ __forceinline__ void moe_tables(Frame& F, LAS int* tstart) {
    __syncthreads();
    if (F.tid < 64) {
        const unsigned c = (F.tid < NE) ? __hip_atomic_load(F.ctl + CW_CNT + (F.tid & 31), __ATOMIC_RELAXED, __HIP_MEMORY_SCOPE_AGENT) : 0u;
        const int nt = (int)((c + 255u) >> 8); int incl = nt;
#pragma unroll
        for (int d = 1; d < 32; d <<= 1) { const int o = __shfl_up(incl, d, 64); if ((int)F.tid >= d) incl += o; }
        if (F.tid < NE) { tstart[F.tid] = incl - nt; tstart[40 + F.tid] = (int)c; }
        if (F.tid == NE - 1) tstart[NE] = incl; }
    __syncthreads();
}

__device__ __forceinline__ float fp8_to_f32(unsigned w, int byte) {
    if (byte == 0) return __builtin_amdgcn_cvt_f32_fp8(w, 0); if (byte == 1) return __builtin_amdgcn_cvt_f32_fp8(w, 1); if (byte == 2) return __builtin_amdgcn_cvt_f32_fp8(w, 2); return __builtin_amdgcn_cvt_f32_fp8(w, 3);
}
__device__ __forceinline__ void p8_final(Frame& F, LAS int* tstart) {
    const bf16_t* H1R = (const bf16_t*)(F.ws + WS_H1F); const unsigned* TOKEP = (const unsigned*)(F.ws + WS_TOKEP); const float* TOKG = (const float*)(F.ws + WS_TOKG);
    const unsigned char* Y = F.ws + WS_Y;
    const int gw = F.bid * 8 + F.wave, NGW = F.G * 8;
    f32x4 gv[4], bv[4];
#pragma unroll
    for (int j = 0; j < 4; ++j) { gv[j] = ((const f32x4*)F.ln2_g)[F.lane + 64 * j]; bv[j] = ((const f32x4*)F.ln2_b)[F.lane + 64 * j]; }
    unsigned tk = 0; float tg = 0.f;
    { const int m = gw + (F.lane >> 2) * NGW; if (F.lane < 32 && m < T) { tk = TOKEP[(size_t)m * 4 + (F.lane & 3)]; tg = TOKG[(size_t)m * 4 + (F.lane & 3)] * (1.0f / 64.0f); } }
    u32x2 hwA[4], hwB[4]; unsigned ywA[4][4], ywB[4][4];
#define P8_LOAD(k, hw, yw) do { const int m_ = gw + (k) * NGW; if (m_ < T) { const u32x2* xr_ = (const u32x2*)(H1R + (size_t)m_ * 1024) + F.lane; \
        _Pragma("unroll") for (int j = 0; j < 4; ++j) hw[j] = xr_[64 * j]; \
        _Pragma("unroll") for (int q = 0; q < 4; ++q) { const unsigned ep_ = (unsigned)__builtin_amdgcn_readlane((int)tk, (k) * 4 + q); \
            const size_t slot_ = (size_t)tstart[ep_ >> 16] * 256 + (ep_ & 0xffffu); const unsigned* yr_ = (const unsigned*)(Y + slot_ * 1024) + F.lane; \
            _Pragma("unroll") for (int j = 0; j < 4; ++j) yw[q][j] = yr_[64 * j]; } } } while (0)
#define P8_ROW(k, hw, yw) do { const int m_ = gw + (k) * NGW; if (m_ < T) { f32x4 v[4]; float gt[4]; \
        _Pragma("unroll") for (int q = 0; q < 4; ++q) gt[q] = __builtin_bit_cast(float, __builtin_amdgcn_readlane(__builtin_bit_cast(int, tg), (k) * 4 + q)); \
        _Pragma("unroll") for (int j = 0; j < 4; ++j) { v[j] = (f32x4){ALPHA * bf16_lo(hw[j].x), ALPHA * bf16_hi(hw[j].x), ALPHA * bf16_lo(hw[j].y), ALPHA * bf16_hi(hw[j].y)}; \
            _Pragma("unroll") for (int q = 0; q < 4; ++q) { const unsigned w = yw[q][j]; \
                v[j].x += gt[q] * fp8_to_f32(w, 0); v[j].y += gt[q] * fp8_to_f32(w, 1); v[j].z += gt[q] * fp8_to_f32(w, 2); v[j].w += gt[q] * fp8_to_f32(w, 3); } } \
        float s_ = 0.f; _Pragma("unroll") for (int j = 0; j < 4; ++j) s_ += (v[j].x + v[j].y) + (v[j].z + v[j].w); \
        const float mean_ = wave_sum(s_) * (1.f / 1024.f); float s2_ = 0.f; \
        _Pragma("unroll") for (int j = 0; j < 4; ++j) { v[j] = v[j] - mean_; s2_ += (v[j].x * v[j].x + v[j].y * v[j].y) + (v[j].z * v[j].z + v[j].w * v[j].w); } \
        const float rstd_ = 1.f / sqrtf(wave_sum(s2_) * (1.f / 1024.f) + LN_EPS); \
        f32x4* orow_ = (f32x4*)(F.out + (size_t)m_ * 1024) + F.lane; \
        _Pragma("unroll") for (int j = 0; j < 4; ++j) orow_[64 * j] = v[j] * rstd_ * gv[j] + bv[j]; } } while (0)
    P8_LOAD(0, hwA, ywA);
    P8_LOAD(1, hwB, ywB); P8_ROW(0, hwA, ywA);
    P8_LOAD(2, hwA, ywA); P8_ROW(1, hwB, ywB);
    P8_LOAD(3, hwB, ywB); P8_ROW(2, hwA, ywA);
    P8_LOAD(4, hwA, ywA); P8_ROW(3, hwB, ywB);
    P8_LOAD(5, hwB, ywB); P8_ROW(4, hwA, ywA);
    P8_LOAD(6, hwA, ywA); P8_ROW(5, hwB, ywB);
    P8_LOAD(7, hwB, ywB); P8_ROW(6, hwA, ywA);
    P8_ROW(7, hwB, ywB);
#undef P8_LOAD
#undef P8_ROW
}

__global__ void __launch_bounds__(NTHREADS, 2) mk_fwd(Args args) {
    extern __shared__ __attribute__((aligned(16))) unsigned char lds_raw[];
    Frame F;
    F.lds = (LAS unsigned char*)lds_raw;
    F.tid = threadIdx.x; F.lane = F.tid & 63; F.wave = __builtin_amdgcn_readfirstlane(F.tid >> 6); F.G = gridDim.x; F.bid = blockIdx.x;
    frame_refresh(F);
    volatile LAS unsigned* misc = (volatile LAS unsigned*)(F.lds + MISC_OFF);
    LAS int* tstart = (LAS int*)(F.lds + MISC_OFF + 256);
    LAS int* toktab = (LAS int*)(F.lds + MISC_OFF + 1024);
    if (F.tid < 4) misc[F.tid] = 0u;
    __syncthreads();
    const int lo = args.ph_lo, hi = args.ph_hi;
    XcdBarrier bar; bar.bar = F.ctl; bar.x = 0; bar.st = misc;
    if (hi - lo > 1) bar = xcd_barrier_post(F.ctl, misc);
#define IN(k) (lo <= (k) && (k) < hi)
#ifdef ONLY
#define PH_ON(k) ((k) == ONLY)
#else
#define PH_ON(k) true
#endif
#define SEAM(k) do { if (IN(k) && IN((k) + 1)) xcd_barrier(bar); frame_refresh(F); } while (0)

    if (PH_ON(0) && IN(0)) { p0_prologue(F); } SEAM(0);
    if (PH_ON(1) && IN(1)) {
        EpiInProj E{(bf16_t*)(F.ws + WS_U), (bf16_t*)(F.ws + WS_Q), (bf16_t*)(F.ws + WS_K), (bf16_t*)(F.ws + WS_V), (bf16_t*)(F.ws + WS_IQ), (bf16_t*)(F.ws + WS_IK), (float*)(F.ws + WS_IW),
                    (const float*)(F.ws + WS_ROPEQK), (const float*)(F.ws + WS_ROPEIX)};
        { pg8::StaticSched S{T / 256, 5, F.G, F.bid, 1, 1};
          pg8::gemm_phase<EpiInProj, pg8::StaticSched, true, 0x79797979, 0x7f7f7f7f>(F.lds, (const char*)(F.ws + WS_HA8), (const char*)(F.ws + WS_BTIN8), S, E); }
        { pg8::StaticSched S{T / 256, 4, F.G, F.bid, 0, 5};
          pg8::gemm_phase<EpiInProj, pg8::StaticSched>(F.lds, (const char*)(F.ws + WS_HA), (const char*)(F.ws + WS_BTIN), S, E); }
        if (F.bid >= 64) {
            convert_range(F, 0, 2 * CV_PAIRS1, (F.bid - 64) * 8 + F.wave, (F.G - 64) * 8); }
    } SEAM(1);
    if (PH_ON(2) && IN(2)) {
#ifndef NO_POOL
 p2_pool(F);
#endif
 p2_indexer(F); } SEAM(2);
    if (PH_ON(3) && IN(3)) { p3_attention(F); } SEAM(3);
    if (PH_ON(4) && IN(4)) {
        pg8::StaticSched S{T / 256, 4, F.G, F.bid, 0, 0};
        EpiMix E{(bf16_t*)(F.ws + WS_MIX)};
        pg8::gemm_phase<EpiMix, pg8::StaticSched>(F.lds, (const char*)(F.ws + WS_CAT), (const char*)(F.ws + WS_BTOUT), S, E);
    } SEAM(4);
    if (PH_ON(5) && IN(5)) { p5_ln1_router(F); } SEAM(5);
    if (PH_ON(6) && IN(6)) {
        moe_tables(F, tstart);
        const int ntl = tstart[NE];
        pg8::MoeSched<true> S{ntl, 8, F.G, F.bid, 2048, tstart, toktab, 0};
        { const unsigned* INV = (const unsigned*)(F.ws + WS_INV); pg8::Unit u; unsigned tk[10];
#pragma unroll
          for (int i = 0; i < 10; ++i) { tk[i] = 0u; if (S.next(i, u) && F.tid < 256) { const int p = (u.pm - tstart[u.e]) * 256 + F.tid; const int cnt = tstart[40 + u.e];
                  tk[i] = INV[(size_t)u.e * CAP + (p < cnt ? p : 0)]; } }
#pragma unroll
          for (int i = 0; i < 10; ++i) if (F.tid < 256) toktab[i * 256 + F.tid] = (int)tk[i];
          __syncthreads(); }
        EpiGateUp E{F.ws + WS_ACT, F.b_gu, F.ctl + CW_ACTRDY};
#ifndef NO_GU
        pg8::gemm_phase<EpiGateUp, pg8::MoeSched<true>, true, 0x79797979, 0x7f7f7f7f>(F.lds, (const char*)(F.ws + WS_H1B), (const char*)(F.ws + WS_BTGU), S, E);
#endif
        { const int nwg6 = 8 * ntl, rounds6 = (nwg6 + F.G - 1) / F.G, nidle = rounds6 * F.G - nwg6, cfirst = nwg6 - (rounds6 - 1) * F.G;
          int early = ((nidle < 128 ? nidle : 128) / 32) * 32; if (rounds6 < 9 || ntl < 32) early = 0;
          const int rank = F.bid - cfirst;
#ifndef NO_EARLY
          if (rank >= 0 && rank < early) {
              pg8::MoeSched<false> S7{early / 4, 4, F.G, rank, 1024, tstart, toktab, 0};
              pg8::Unit u; S7.next(0, u);
              if (F.tid < 64) {
                  unsigned* cp = F.ctl + CW_ACTRDY + u.pm; unsigned sp = 0;
                  while ((unsigned)__builtin_amdgcn_readfirstlane((int)__hip_atomic_load(cp, __ATOMIC_RELAXED, __HIP_MEMORY_SCOPE_AGENT)) < 64u) {
                      __builtin_amdgcn_s_sleep(2); if (++sp > (1u << 20)) { if (F.tid == 0) __hip_atomic_store(F.ctl + CW_TMO2, 1u, __ATOMIC_RELAXED, __HIP_MEMORY_SCOPE_AGENT); break; } }
                  __builtin_amdgcn_fence(__ATOMIC_ACQUIRE, "agent");
                  asm volatile("s_waitcnt vmcnt(0)" ::: "memory"); }
              __syncthreads();
              EpiDown E7{F.ws + WS_Y, F.b_dn};
              pg8::gemm_phase<EpiDown, pg8::MoeSched<false>, true, 0x79797979, 0x7c7c7c7c>(F.lds, (const char*)(F.ws + WS_ACT), (const char*)(F.ws + WS_BTDN), S7, E7);
          }
#endif
          (void)rank; (void)early; }
    } SEAM(6);
    if (PH_ON(7) && IN(7)) {
        moe_tables(F, tstart);
        const int ntl = tstart[NE];
        const int nwg6 = 8 * ntl, rounds6 = (nwg6 + F.G - 1) / F.G, nidle = rounds6 * F.G - nwg6;
        int early = ((nidle < 128 ? nidle : 128) / 32) * 32; if (rounds6 < 9 || ntl < 32) early = 0;
        pg8::MoeSched<false> S{ntl, 4, F.G, F.bid, 1024, tstart, toktab, early};
        EpiDown E{F.ws + WS_Y, F.b_dn};
        pg8::gemm_phase<EpiDown, pg8::MoeSched<false>, true, 0x79797979, 0x7c7c7c7c>(F.lds, (const char*)(F.ws + WS_ACT), (const char*)(F.ws + WS_BTDN), S, E);
    } SEAM(7);
    if (PH_ON(8) && IN(8)) { moe_tables(F, tstart); p8_final(F, tstart); }
#undef IN
#undef SEAM
}

extern "C" void kernel_launch(void* const* d_in, const int* in_sizes, int n_in, void* d_out, int out_size, void* d_ws, size_t ws_size, hipStream_t stream) {
    static int grid = 0;
    if (grid == 0) {
        if (n_in != 18 || in_sizes[0] != T * DM || out_size != T * DM || ws_size < WS_END) {
            fprintf(stderr, "kernel_launch: shape mismatch (n_in %d, in0 %d, out %d, ws %zu, need %zu)\n", n_in, n_in > 0 ? in_sizes[0] : -1, out_size, ws_size, (size_t)WS_END); grid = -1; return; }
        int dev = 0, cus = 0, per_cu = 0;
        if (hipGetDevice(&dev) != hipSuccess || hipDeviceGetAttribute(&cus, hipDeviceAttributeMultiprocessorCount, dev) != hipSuccess) { grid = -1; return; }
        if (hipFuncSetAttribute((const void*)mk_fwd, hipFuncAttributeMaxDynamicSharedMemorySize, LDS_BYTES) != hipSuccess) { fprintf(stderr, "kernel_launch: hipFuncSetAttribute failed\n"); grid = -1; return; }
        if (hipOccupancyMaxActiveBlocksPerMultiprocessor(&per_cu, (const void*)mk_fwd, NTHREADS, LDS_BYTES) != hipSuccess || per_cu < 1) {
            fprintf(stderr, "kernel_launch: occupancy query reports %d workgroups per CU\n", per_cu); }
        (void)hipGetLastError();
        grid = cus;
        if (grid != 256) { fprintf(stderr, "kernel_launch: built for a 256-CU device (static work deals), found %d CUs\n", cus); grid = -1; return; }
    }
    if (grid < 0) return;
    (void)hipMemsetAsync((char*)d_ws + WS_CTL, 0, CTL_BYTES, stream);
    Args a{};
    for (int i = 0; i < 18; ++i) a.in[i] = d_in[i];
    a.out = (float*)d_out; a.ws = (unsigned char*)d_ws;
#if MK_N_LAUNCHES == 1
    a.ph_lo = 0; a.ph_hi = NPH;
    hipLaunchKernelGGL(mk_fwd, dim3(grid), dim3(NTHREADS), LDS_BYTES, stream, a);
#else
    for (int p = 0; p < NPH; ++p) { a.ph_lo = p; a.ph_hi = p + 1; hipLaunchKernelGGL(mk_fwd, dim3(grid), dim3(NTHREADS), LDS_BYTES, stream, a);
#ifdef PROBE_DUP
        if (p == PROBE_DUP) { if (p == 3 || p == 5) (void)hipMemsetAsync((char*)d_ws + WS_CTL + 4096 * 4, 0, 1024, stream); hipLaunchKernelGGL(mk_fwd, dim3(grid), dim3(NTHREADS), LDS_BYTES, stream, a); }
#endif
    }
#endif
    const hipError_t le = hipPeekAtLastError();
    if (le != hipSuccess) fprintf(stderr, "kernel_launch: launch failed: %s\n", hipGetErrorName(le));
}
```

```cpp
#include <hip/hip_runtime.h>
#include <cstdio>
#include <cstdint>
#include <utility>

#define LAS __attribute__((address_space(3)))
typedef unsigned short bf16_t;
typedef short bf16x8 __attribute__((ext_vector_type(8)));
typedef short s16x4 __attribute__((ext_vector_type(4)));
typedef float f32x2 __attribute__((ext_vector_type(2)));
typedef float f32x4 __attribute__((ext_vector_type(4)));
typedef float f32x16 __attribute__((ext_vector_type(16)));
typedef unsigned u32x2 __attribute__((ext_vector_type(2)));
typedef unsigned u32x4 __attribute__((ext_vector_type(4)));

#ifndef MK_N_LAUNCHES
#define MK_N_LAUNCHES 1
#endif

constexpr int T = 16384, DM = 1024, SEQ = 2048, NBATCH = 8;
constexpr int INW = 2120, INP = 2304;
constexpr int NE = 32, CAP = 16384, MAXT = 288;
constexpr int NPH = 9;
constexpr float ALPHA = 1.189207115002721f;
constexpr float LN_EPS = 1e-5f;
constexpr float W_SCALE = 0.04419417382415922f;
constexpr int NTHREADS = 512;
constexpr int LDS_BYTES = 163840;
constexpr int EPI_OFF = 147456;
constexpr int MISC_OFF = 131072;

constexpr size_t al256(size_t x) { return (x + 255) / 256 * 256; }
constexpr size_t WS_CTL = 0;
constexpr size_t CTL_BYTES = 65536;
constexpr size_t WS_BTIN = WS_CTL + CTL_BYTES;
constexpr size_t WS_BTOUT = WS_BTIN + al256((size_t)INP * 1024 * 2);
constexpr size_t WS_BTGU = WS_BTOUT + al256((size_t)1024 * 1024 * 2);
constexpr size_t WS_BTDN = WS_BTGU + al256((size_t)NE * 2048 * 1024 * 2);
constexpr size_t WS_WPT = WS_BTDN + al256((size_t)NE * 1024 * 1024 * 2);
constexpr size_t WS_WRA = WS_WPT + al256((size_t)4 * 64 * 64 * 2);
constexpr size_t WS_HA = WS_WRA + al256((size_t)1024 * 32 * 4);
constexpr size_t WS_STATS = WS_HA + al256((size_t)T * 1024 * 2);
constexpr size_t WS_ROPEQK = WS_STATS + al256((size_t)T * 2 * 4);
constexpr size_t WS_ROPEIX = WS_ROPEQK + al256((size_t)T * 32 * 4);
constexpr size_t WS_U = WS_ROPEIX + al256((size_t)T * 16 * 4);
constexpr size_t WS_Q = WS_U + al256((size_t)T * 256 * 2);
constexpr size_t WS_K = WS_Q + al256((size_t)T * 768 * 2);
constexpr size_t WS_V = WS_K + al256((size_t)T * 256 * 2);
constexpr size_t WS_IQ = WS_V + al256((size_t)T * 256 * 2);
constexpr size_t WS_IK = WS_IQ + al256((size_t)T * 512 * 2);
constexpr size_t WS_IW = WS_IK + al256((size_t)T * 64 * 2);
constexpr size_t WS_MASK = WS_IW + al256((size_t)T * 8 * 4);
constexpr size_t WS_CAT = WS_MASK + al256((size_t)T * 64 * 4);
constexpr size_t WS_H1F = WS_CAT + al256((size_t)T * 1024 * 2);
constexpr size_t WS_H1B = WS_H1F + al256((size_t)T * 1024 * 4);
constexpr size_t WS_INV = WS_H1B + al256((size_t)T * 1024 * 2);
constexpr size_t WS_TOKEP = WS_INV + al256((size_t)NE * CAP * 4);
constexpr size_t WS_TOKG = WS_TOKEP + al256((size_t)T * 4 * 4);
constexpr size_t WS_ACT = WS_TOKG + al256((size_t)T * 4 * 4);
constexpr size_t WS_Y = WS_ACT + al256((size_t)MAXT * 256 * 1024 * 2);
constexpr size_t WS_MIX = WS_Y + al256((size_t)MAXT * 256 * 1024 * 2);
constexpr size_t WS_HA8 = WS_MIX + al256((size_t)T * 1024 * 2);
constexpr size_t WS_BTIN8 = WS_HA8 + al256((size_t)T * 1024);
constexpr size_t WS_END = WS_BTIN8 + al256((size_t)1536 * 1024);
constexpr int CW_CNT = 4096;
constexpr int CW_ATTQ = 4224;
constexpr int CW_CVQ1 = 4288, CW_CVQ3 = 4352, CW_ACTRDY = 4608;
constexpr int CW_TMO2 = 4480;
constexpr int CV_PAIRS1 = 3072, CV_PAIRS3 = 3072, CV_HIDDEN = 2 * (CV_PAIRS1 + CV_PAIRS3);

#define XB_TMO      128
#define XB_XCNT(j)  (256  + 64 * (j))
#define XB_XSUB(j)  (1280 + 64 * (j))
#define XB_XGEN(j)  (2304 + 64 * (j))
#define XB_TOP      3328
#define XB_TOPGEN   3392
#define XCD_BAR_WORDS 3456
#define XB_SPIN_CAP (1u << 18)
__device__ __forceinline__ unsigned xb_ld(unsigned* p)              { return __hip_atomic_load(p, __ATOMIC_RELAXED, __HIP_MEMORY_SCOPE_AGENT); }
__device__ __forceinline__ unsigned xb_add(unsigned* p, unsigned v) { return __hip_atomic_fetch_add(p, v, __ATOMIC_RELAXED, __HIP_MEMORY_SCOPE_AGENT); }
__device__ __forceinline__ unsigned xb_xcc_id() { return (unsigned)__builtin_amdgcn_s_getreg((3 << 11) | 20) & 0xFu; }
#define XB_SPIN(cond, bar) do { unsigned _sp = 0; while (cond) { __builtin_amdgcn_s_sleep(1); \
    if ((++_sp & 255u) == 0u) { if (xb_ld(&(bar)[XB_TMO])) break; if (_sp > XB_SPIN_CAP) { atomicAdd(&(bar)[XB_TMO], 1u); break; } } } } while (0)
struct XcdBarrier { unsigned* bar; unsigned x; volatile LAS unsigned* st; };
__device__ __forceinline__ XcdBarrier xcd_barrier_post(unsigned* bar, volatile LAS unsigned* st) {
    XcdBarrier b; b.bar = bar; b.x = xb_xcc_id(); b.st = st;
    if (threadIdx.x == 0) (void)xb_add(&bar[XB_XCNT(b.x)], 1u);
    return b;
}
__device__ __forceinline__ void xcd_barrier_complete(unsigned* bar, unsigned x, unsigned& nloc, unsigned& nx) {
    const unsigned G = gridDim.x * gridDim.y * gridDim.z;
    unsigned sum, cnt, mine, sp = 0u;
    for (;;) {
        sum = 0u; cnt = 0u; mine = 0u;
#pragma unroll
        for (unsigned j = 0; j < 16; ++j) { const unsigned c = xb_ld(&bar[XB_XCNT(j)]); sum += c; cnt += (c > 0u) ? 1u : 0u; mine = (j == x) ? c : mine; }
        if (sum == G) break;
        __builtin_amdgcn_s_sleep(1);
        if ((++sp & 255u) == 0u) { if (xb_ld(&bar[XB_TMO])) break; if (sp > XB_SPIN_CAP) { atomicAdd(&bar[XB_TMO], 1u); break; } }
    }
    nloc = mine > 0u ? mine : 1u; nx = cnt > 0u ? cnt : 1u;
}
__device__ __forceinline__ void xcd_barrier(const XcdBarrier& b) {
    asm volatile("s_waitcnt vmcnt(0)" ::: "memory");
    __syncthreads();
    if (threadIdx.x == 0) {
        unsigned* bar = b.bar;
        __builtin_amdgcn_s_waitcnt(0);
        unsigned nloc = b.st[0], nx = b.st[1];
        if (nloc == 0u) { xcd_barrier_complete(bar, b.x, nloc, nx); b.st[0] = nloc; b.st[1] = nx; }
        const unsigned old = xb_add(&bar[XB_XSUB(b.x)], 1u);
        const unsigned gen = old / nloc;
        if (old + 1u == (gen + 1u) * nloc) {
            __builtin_amdgcn_fence(__ATOMIC_RELEASE, "agent");
            asm volatile("s_waitcnt vmcnt(0)" ::: "memory");
            const unsigned og = xb_add(&bar[XB_TOP], 1u);
            const unsigned tg = og / nx;
            if (og + 1u == (tg + 1u) * nx) xb_add(&bar[XB_TOPGEN], 1u);
            else XB_SPIN(xb_ld(&bar[XB_TOPGEN]) == tg, bar);
            __builtin_amdgcn_fence(__ATOMIC_ACQUIRE, "agent");
            xb_add(&bar[XB_XGEN(b.x)], 1u);
            asm volatile("s_waitcnt vmcnt(0)" ::: "memory");
        } else {
            XB_SPIN(xb_ld(&bar[XB_XGEN(b.x)]) == gen, bar);
            __builtin_amdgcn_fence(__ATOMIC_ACQUIRE, "agent");
            asm volatile("s_waitcnt vmcnt(0)" ::: "memory");
        }
    }
    __syncthreads();
}

__device__ __forceinline__ unsigned cvt_pk_bf16(float lo, float hi) { unsigned r; asm volatile("v_cvt_pk_bf16_f32 %0, %1, %2" : "=v"(r) : "v"(lo), "v"(hi)); return r; }
__device__ __forceinline__ unsigned pk4_fp8(float a, float b, float c, float d) { int w = __builtin_amdgcn_cvt_pk_fp8_f32(a, b, 0, false); w = __builtin_amdgcn_cvt_pk_fp8_f32(c, d, w, true); return (unsigned)w; }
__device__ __forceinline__ float bf16_lo(unsigned w) { return __uint_as_float(w << 16); }
__device__ __forceinline__ float bf16_hi(unsigned w) { return __uint_as_float(w & 0xffff0000u); }
template <int CTRL> __device__ __forceinline__ float dpp_f(float v) { return __builtin_bit_cast(float, __builtin_amdgcn_update_dpp(0, __builtin_bit_cast(int, v), CTRL, 0xf, 0xf, true)); }
__device__ __forceinline__ float wave_sum(float v) {
    v += dpp_f<0xB1>(v);
    v += dpp_f<0x4E>(v);
    v += dpp_f<0x141>(v);
    v += dpp_f<0x140>(v);
    const int vi = __builtin_bit_cast(int, v);
    const float r0 = __builtin_bit_cast(float, __builtin_amdgcn_readlane(vi, 0)), r1 = __builtin_bit_cast(float, __builtin_amdgcn_readlane(vi, 16));
    const float r2 = __builtin_bit_cast(float, __builtin_amdgcn_readlane(vi, 32)), r3 = __builtin_bit_cast(float, __builtin_amdgcn_readlane(vi, 48));
    return (r0 + r1) + (r2 + r3);
}
#define LDS_WAIT() asm volatile("s_waitcnt lgkmcnt(0)" ::: "memory")
#define VM_WAIT()  asm volatile("s_waitcnt vmcnt(0)" ::: "memory")
__device__ __forceinline__ int crow(int r, int hi) { return (r & 3) + 8 * (r >> 2) + 4 * hi; }

namespace pg8 {
constexpr int BM = 256, BK = 64, HALF = 128, HTB = HALF * BK * 2, STAGE_BYTES = 8 * HTB, NXCD = 8, WGM = 4, KD = 1024;
__device__ __forceinline__ int lds_byte(int r, int c) { const int st = (r >> 4) * 2 + (c >> 5), rr = r & 15, cc = c & 31, ob = rr * 64 + cc * 2; return st * 1024 + (ob ^ (((ob >> 9) & 1) << 5)); }
__device__ __forceinline__ void stage_rc(int b, int& R, int& C) { const int st = b / 1024, sb = b % 1024, swz = sb ^ (((sb >> 9) & 1) << 5); R = (st >> 1) * 16 + swz / 64; C = (st & 1) * 32 + (swz % 64) / 2; }
__device__ __forceinline__ int perm32(int rho) { const int n = rho >> 4, i = rho & 15; return 8 * (i >> 2) + 4 * n + (i & 3); }

struct Unit { int pm, pn, e, idx; };

__device__ __forceinline__ void order_decode(int wgid, int nM, int nN, int& pm, int& pn) {
    const int nig = WGM * nN, gid = wgid / nig, fm = gid * WGM, gsz = (nM - fm) < WGM ? (nM - fm) : WGM;
    pm = fm + ((wgid % nig) % gsz); pn = (wgid % nig) / gsz;
}
__device__ __forceinline__ bool order_next(int i, int G, int c, int nM, int nN, int& pm, int& pn, int woff = 0) {
    const int nwg = nM * nN - woff; const long L = (long)i * G + c; if (L >= nwg) return false;
    int wgid = (int)L; { const int q = nwg / NXCD, r = nwg % NXCD, xcd = wgid % NXCD, off = wgid / NXCD; wgid = (xcd < r ? xcd * (q + 1) : r * (q + 1) + (xcd - r) * q) + off; }
    order_decode(wgid + woff, nM, nN, pm, pn); return true;
}
struct StaticSched {
    int nM, nN, G, c, t0, toff;
    __device__ __forceinline__ bool next(int i, Unit& u) const { u.idx = i; const bool ok = order_next(i, G, c, nM, nN, u.pm, u.pn); u.e = (u.pn == 0) ? t0 : u.pn + toff; return ok; }
    __device__ __forceinline__ int a_row(const Unit& u, int h, int R) const { return u.pm * BM + h * HALF + R; }
    __device__ __forceinline__ int b_row(const Unit& u) const { return u.e * BM; }
};
template <bool GATHER> struct MoeSched {
    int nM, nN, G, c; int brows;
    const LAS int* tstart; const LAS int* toktab; int woff;
    __device__ __forceinline__ bool next(int i, Unit& u) const {
        u.idx = i;
        if (!order_next(i, G, c, nM, nN, u.pm, u.pn, woff)) return false;
        int e = 0;
#pragma unroll
        for (int k = 1; k < NE; ++k) e += (u.pm >= tstart[k]) ? 1 : 0;
        u.e = e; return true;
    }
    __device__ __forceinline__ int a_row(const Unit& u, int h, int R) const { if constexpr (GATHER) return toktab[u.idx * 256 + h * HALF + R]; else return u.pm * BM + h * HALF + R; }
    __device__ __forceinline__ int b_row(const Unit& u) const { return u.e * brows + u.pn * BM; }
};

typedef int v8i32 __attribute__((ext_vector_type(8)));
typedef int v4i32 __attribute__((ext_vector_type(4)));
__device__ __forceinline__ const char* uni_ptr(const char* p) { const unsigned long long v = (unsigned long long)p;
    const unsigned lo = (unsigned)__builtin_amdgcn_readfirstlane((int)(unsigned)v), hi = (unsigned)__builtin_amdgcn_readfirstlane((int)(unsigned)(v >> 32));
    return (const char*)(((unsigned long long)hi << 32) | lo); }
__device__ __forceinline__ v8i32 cat8(bf16x8 a, bf16x8 b) { const v4i32 x = __builtin_bit_cast(v4i32, a), y = __builtin_bit_cast(v4i32, b); return __builtin_shufflevector(x, y, 0, 1, 2, 3, 4, 5, 6, 7); }
template <class Epi, class Sched, bool FP8 = false, int SW = 0x7f7f7f7f, int SA = 0x7f7f7f7f>
__device__ __forceinline__ void gemm_phase(LAS unsigned char* lds, const char* Abase, const char* Bbase, const Sched& S, const Epi& E) {
    const int tid = threadIdx.x, wid = __builtin_amdgcn_readfirstlane(tid >> 6), lane = tid & 63, wr = wid >> 2, wc = wid & 3, fr = lane & 15, fq = lane >> 4;
    constexpr int ROWB = FP8 ? KD : 2 * KD, nt = ROWB / 128;
    int RA[2], CA[2]; unsigned voffB[2];
#pragma unroll
    for (int i = 0; i < 2; ++i) { int R, C; stage_rc(tid * 16 + i * 8192, R, C); const int Rb = Epi::PERM ? ((R & ~31) + perm32(R & 31)) : R;
        RA[i] = R; CA[i] = C * 2; voffB[i] = (unsigned)(Rb * ROWB + C * 2); }
    const size_t kstep = (size_t)(BK * 2);
    const size_t hstep = (size_t)HALF * ROWB;
    const unsigned ldsw = (unsigned)wid * 1024u;
    const int aoff = lds_byte(wr * 64 + fr, fq * 8), boff = lds_byte(wc * 32 + fr, fq * 8);
#define PG8_SA(b, h) (((b) * 2 + (h)) * HTB)
#define PG8_SB(b, h) ((4 + (b) * 2 + (h)) * HTB)
#define PG8_STAGE(bufoff, gbase, voff) do { const char* _gb = uni_ptr((const char*)(gbase)); _Pragma("unroll") for (int _i = 0; _i < 2; ++_i) \
        { unsigned _v = (voff)[_i]; asm volatile("" : "+v"(_v)); __builtin_amdgcn_global_load_lds((const unsigned*)(_gb + _v), (LAS unsigned*)(lds + (bufoff) + ldsw + _i * 8192), 16, 0, 0); } } while (0)
#define PG8_LDA(dst, b, h) do { _Pragma("unroll") for (int m = 0; m < 4; ++m) _Pragma("unroll") for (int k = 0; k < 2; ++k) dst[m][k] = *(const LAS bf16x8*)(lds + PG8_SA(b, h) + aoff + m * 2048 + k * 1024); } while (0)
#define PG8_LDB(dst, b, h) do { _Pragma("unroll") for (int n = 0; n < 2; ++n) _Pragma("unroll") for (int k = 0; k < 2; ++k) dst[n][k] = *(const LAS bf16x8*)(lds + PG8_SB(b, h) + boff + n * 2048 + k * 1024); } while (0)
#define PG8_MMA(ai, bj, At, Bt) do { __builtin_amdgcn_s_setprio(1); if constexpr (FP8) { _Pragma("unroll") for (int m = 0; m < 4; ++m) _Pragma("unroll") for (int n = 0; n < 2; ++n) \
        acc[ai][bj][m][n] = __builtin_amdgcn_mfma_scale_f32_16x16x128_f8f6f4(cat8(Bt[n][0], Bt[n][1]), cat8(At[m][0], At[m][1]), acc[ai][bj][m][n], 0, 0, 0, SW, 0, SA); } \
        else { _Pragma("unroll") for (int m = 0; m < 4; ++m) _Pragma("unroll") for (int n = 0; n < 2; ++n) _Pragma("unroll") for (int k = 0; k < 2; ++k) \
        acc[ai][bj][m][n] = __builtin_amdgcn_mfma_f32_16x16x32_bf16(Bt[n][k], At[m][k], acc[ai][bj][m][n], 0, 0, 0); } __builtin_amdgcn_s_setprio(0); } while (0)
#define PG8_WAIT_V(n) asm volatile("s_waitcnt vmcnt(" #n ")" ::: "memory")
#define PG8_WAIT_L(n) asm volatile("s_waitcnt lgkmcnt(" #n ")" ::: "memory")
#define PG8_BAR __builtin_amdgcn_s_barrier()
#define PG8_SCHED __builtin_amdgcn_sched_barrier(0)
    Unit cur, nxt; int ui = 0;
    if (!S.next(0, cur)) return;
    f32x4 acc[2][2][4][2]; f32x4 bini[2][2];
#pragma unroll
    for (int b = 0; b < 2; ++b)
#pragma unroll
        for (int n = 0; n < 2; ++n) bini[b][n] = Epi::BIAS_INIT ? E.bias4(cur, b, n, wc, fq) : (f32x4){0.f, 0.f, 0.f, 0.f};
#pragma unroll
    for (int a = 0; a < 2; ++a)
#pragma unroll
        for (int b = 0; b < 2; ++b)
#pragma unroll
            for (int m = 0; m < 4; ++m)
#pragma unroll
                for (int n = 0; n < 2; ++n) acc[a][b][m][n] = bini[b][n];
    bf16x8 At[4][2], B0[2][2], B1[2][2];
    unsigned oA[2][2];
#pragma unroll
    for (int h = 0; h < 2; ++h)
#pragma unroll
        for (int i = 0; i < 2; ++i) oA[h][i] = (unsigned)(S.a_row(cur, h, RA[i]) * ROWB + CA[i]);
    const char* cB = Bbase + (size_t)S.b_row(cur) * ROWB;
    const char* cA = Abase;
    PG8_STAGE(PG8_SB(0, 0), cB, voffB); PG8_STAGE(PG8_SA(0, 0), cA, oA[0]); PG8_STAGE(PG8_SB(0, 1), cB + hstep, voffB); PG8_STAGE(PG8_SA(0, 1), cA, oA[1]);
    if (wr == 1) PG8_BAR;
    PG8_WAIT_V(4); PG8_BAR;
    PG8_STAGE(PG8_SB(1, 0), cB + kstep, voffB); PG8_STAGE(PG8_SA(1, 0), cA + kstep, oA[0]); PG8_STAGE(PG8_SB(1, 1), cB + hstep + kstep, voffB);
    PG8_WAIT_V(6); PG8_BAR;
    for (;;) {
        const bool has_next = S.next(ui + 1, nxt);
        const char* nB = has_next ? Bbase + (size_t)S.b_row(nxt) * ROWB : cB;
        for (int t = 0; t < nt; t += 2) {
            const bool last = (t == nt - 2);
            const char* a1 = cA + (size_t)(t + 1) * kstep;
            const char* a2 = last ? cA : cA + (size_t)(t + 2) * kstep; const char* b2 = last ? nB : cB + (size_t)(t + 2) * kstep;
            const char* a3 = a2 + kstep; const char* b3 = b2 + kstep;
            PG8_LDB(B0, 0, 0); PG8_SCHED; PG8_LDA(At, 0, 0); PG8_STAGE(PG8_SA(1, 1), a1, oA[1]);
            if (last && has_next) {
#pragma unroll
                for (int h = 0; h < 2; ++h)
#pragma unroll
                    for (int i = 0; i < 2; ++i) oA[h][i] = (unsigned)(S.a_row(nxt, h, RA[i]) * ROWB + CA[i]);
            }
            PG8_WAIT_L(8); PG8_BAR; PG8_WAIT_L(0); PG8_MMA(0, 0, At, B0); PG8_BAR; PG8_SCHED;
            PG8_LDB(B1, 0, 1); PG8_STAGE(PG8_SB(0, 0), b2, voffB);
            PG8_BAR; PG8_WAIT_L(0); PG8_MMA(0, 1, At, B1); PG8_BAR;
            PG8_LDA(At, 0, 1); PG8_STAGE(PG8_SA(0, 0), a2, oA[0]);
            PG8_BAR; PG8_WAIT_L(0); PG8_MMA(1, 0, At, B0); PG8_BAR; PG8_SCHED;
            PG8_STAGE(PG8_SB(0, 1), b2 + hstep, voffB);
            PG8_WAIT_V(6); PG8_BAR; PG8_MMA(1, 1, At, B1); PG8_BAR;
            PG8_LDB(B0, 1, 0); PG8_SCHED; PG8_LDA(At, 1, 0); PG8_STAGE(PG8_SA(0, 1), a2, oA[1]);
            PG8_WAIT_L(8); PG8_BAR; PG8_WAIT_L(0); PG8_MMA(0, 0, At, B0); PG8_BAR; PG8_SCHED;
            PG8_LDB(B1, 1, 1); PG8_STAGE(PG8_SB(1, 0), b3, voffB);
            PG8_BAR; PG8_WAIT_L(0); PG8_MMA(0, 1, At, B1); PG8_BAR;
            PG8_LDA(At, 1, 1); PG8_STAGE(PG8_SA(1, 0), a3, oA[0]);
            PG8_BAR; PG8_WAIT_L(0); PG8_MMA(1, 0, At, B0); PG8_BAR; PG8_SCHED;
            PG8_STAGE(PG8_SB(1, 1), b3 + hstep, voffB);
            PG8_WAIT_V(6); PG8_BAR; PG8_MMA(1, 1, At, B1); PG8_BAR;
        }
        int l2 = threadIdx.x & 63; asm volatile("" : "+v"(l2));
        const int fr2 = l2 & 15, fq2 = l2 >> 4;
        if (Epi::BIAS_INIT && has_next) {
#pragma unroll
            for (int b = 0; b < 2; ++b)
#pragma unroll
                for (int n = 0; n < 2; ++n) bini[b][n] = E.bias4(nxt, b, n, wc, fq2);
        }
        E(acc, cur, wr, wc, fr2, fq2);
        if (!has_next) break;
#pragma unroll
        for (int a = 0; a < 2; ++a)
#pragma unroll
            for (int b = 0; b < 2; ++b)
#pragma unroll
                for (int m = 0; m < 4; ++m)
#pragma unroll
                    for (int n = 0; n < 2; ++n) acc[a][b][m][n] = bini[b][n];
        cur = nxt; cB = nB; ++ui;
    }
    PG8_WAIT_V(0);
    if (wr == 0) PG8_BAR;
    PG8_BAR;
#undef PG8_SA
#undef PG8_SB
#undef PG8_STAGE
#undef PG8_LDA
#undef PG8_LDB
#undef PG8_MMA
#undef PG8_WAIT_V
#undef PG8_WAIT_L
#undef PG8_BAR
#undef PG8_SCHED
}
}

struct EpiInProj {
    static constexpr bool PERM = true, BIAS_INIT = false;
    bf16_t *u, *q, *k, *v, *iq, *ik; float* iw; const float* ropeQK; const float* ropeIX;
    __device__ __forceinline__ f32x4 bias4(const pg8::Unit&, int, int, int, int) const { return (f32x4){0.f, 0.f, 0.f, 0.f}; }
    __device__ __forceinline__ void operator()(f32x4 (&acc)[2][2][4][2], const pg8::Unit& un, int wr, int wc, int fr, int fq) const {
        const int lane = threadIdx.x & 63;
#pragma unroll
        for (int bj = 0; bj < 2; ++bj) {
            const int gc = un.e * 256 + bj * 128;
            bf16_t* dst; unsigned char* dst8 = nullptr; int ld; int kind = 0; bool f8 = false;
            const int cin = wc * 32 + 8 * fq;
            if (gc < 256) { dst = u + gc + cin; ld = 256; }
            else if (gc < 1024) { dst8 = (unsigned char*)q + (gc - 256) + cin; dst = q; ld = 768; kind = (wc == 0) ? 1 : 0; f8 = true; }
            else if (gc < 1280) { dst8 = (unsigned char*)k + (gc - 1024) + cin; dst = k; ld = 256; kind = (wc == 0) ? 1 : 0; f8 = true; }
            else if (gc < 1536) {
#pragma unroll
                for (int ai = 0; ai < 2; ++ai)
#pragma unroll
                    for (int m = 0; m < 4; ++m) { const int row = un.pm * 256 + ai * 128 + wr * 64 + m * 16 + fr;
                        const int bb = row >> 11, key = row & 2047, kp = key & 63, pos = 32 * ((kp >> 2) & 1) + 16 * (kp >> 5) + (kp & 3) + 4 * ((kp & 31) >> 3);
                        unsigned char* vp = (unsigned char*)v + ((size_t)((bb * 2 + bj) * 32 + (key >> 6))) * 8192 + (size_t)cin * 64 + pos;
                        const f32x4 v0 = acc[ai][bj][m][0], v1 = acc[ai][bj][m][1];
                        const unsigned w0 = pk4_fp8(v0[0], v0[1], v0[2], v0[3]), w1 = pk4_fp8(v1[0], v1[1], v1[2], v1[3]);
#pragma unroll
                        for (int i = 0; i < 4; ++i) { vp[i * 64] = (unsigned char)(w0 >> (8 * i)); vp[(4 + i) * 64] = (unsigned char)(w1 >> (8 * i)); } }
                continue; }
            else if (gc < 2048) { dst = iq + (gc - 1536) + cin; ld = 512; kind = ((wc & 1) == 0) ? 2 : 0; }
            else if (gc == 2048) { if (wc >= 2) { if (wc == 2 && fq == 0) {
#pragma unroll
                        for (int ai = 0; ai < 2; ++ai)
#pragma unroll
                            for (int m = 0; m < 4; ++m) { const int row = un.pm * 256 + ai * 128 + wr * 64 + m * 16 + fr;
                                *(f32x4*)(iw + (size_t)row * 8) = acc[ai][bj][m][0]; *(f32x4*)(iw + (size_t)row * 8 + 4) = acc[ai][bj][m][1]; } }
                    continue; }
                dst = ik + cin; ld = 64; kind = (wc == 0) ? 2 : 0; }
            else continue;
#pragma unroll
            for (int ai = 0; ai < 2; ++ai)
#pragma unroll
                for (int m = 0; m < 4; ++m) {
                    const int row = un.pm * 256 + ai * 128 + wr * 64 + m * 16 + fr;
                    f32x4 v0 = acc[ai][bj][m][0], v1 = acc[ai][bj][m][1];
                    if (kind == 1) {
                        const float* rp = ropeQK + (size_t)row * 32 + 8 * (fq & 1);
                        const f32x4 c0 = *(const f32x4*)rp, c1 = *(const f32x4*)(rp + 4), s0 = *(const f32x4*)(rp + 16), s1 = *(const f32x4*)(rp + 20);
                        f32x4 p0, p1;
#pragma unroll
                        for (int j = 0; j < 4; ++j) { p0[j] = __shfl_xor(v0[j], 32); p1[j] = __shfl_xor(v1[j], 32); }
                        const float sg = (fq < 2) ? -1.f : 1.f;
                        v0 = v0 * c0 + sg * (p0 * s0); v1 = v1 * c1 + sg * (p1 * s1);
                    } else if (kind == 2) {
                        const float* rp = ropeIX + (size_t)row * 16;
                        const f32x4 c0 = *(const f32x4*)rp, c1 = *(const f32x4*)(rp + 4), s0 = *(const f32x4*)(rp + 8), s1 = *(const f32x4*)(rp + 12);
                        f32x4 p0, p1;
#pragma unroll
                        for (int j = 0; j < 4; ++j) { p0[j] = __shfl_xor(v0[j], 16); p1[j] = __shfl_xor(v1[j], 16); }
                        if (fq < 2) { const float sg = (fq == 0) ? -1.f : 1.f; v0 = v0 * c0 + sg * (p0 * s0); v1 = v1 * c1 + sg * (p1 * s1); }
                    }
                    if (f8) { u32x2 w8; w8.x = pk4_fp8(v0[0], v0[1], v0[2], v0[3]); w8.y = pk4_fp8(v1[0], v1[1], v1[2], v1[3]); *(u32x2*)(dst8 + (size_t)row * ld) = w8; }
                    else {
                    u32x4 w; w.x = cvt_pk_bf16(v0[0], v0[1]); w.y = cvt_pk_bf16(v0[2], v0[3]); w.z = cvt_pk_bf16(v1[0], v1[1]); w.w = cvt_pk_bf16(v1[2], v1[3]);
                    *(u32x4*)(dst + (size_t)row * ld) = w;
                    }
                }
        }
        (void)lane;
    }
};
struct EpiMix {
    static constexpr bool PERM = true, BIAS_INIT = false;
    bf16_t* mix;
    __device__ __forceinline__ f32x4 bias4(const pg8::Unit&, int, int, int, int) const { return (f32x4){0.f, 0.f, 0.f, 0.f}; }
    __device__ __forceinline__ void operator()(f32x4 (&acc)[2][2][4][2], const pg8::Unit& un, int wr, int wc, int fr, int fq) const {
        const int row0 = un.pm * 256 + wr * 64 + fr, col0 = un.pn * 256 + wc * 32 + 8 * fq;
#pragma unroll
        for (int bj = 0; bj < 2; ++bj)
#pragma unroll
            for (int ai = 0; ai < 2; ++ai)
#pragma unroll
                for (int m = 0; m < 4; ++m) {
                    const f32x4 v0 = acc[ai][bj][m][0], v1 = acc[ai][bj][m][1];
                    u32x4 w; w.x = cvt_pk_bf16(v0[0], v0[1]); w.y = cvt_pk_bf16(v0[2], v0[3]); w.z = cvt_pk_bf16(v1[0], v1[1]); w.w = cvt_pk_bf16(v1[2], v1[3]);
                    *(u32x4*)(mix + (size_t)(row0 + ai * 128 + m * 16) * 1024 + col0 + bj * 128) = w;
                }
    }
};
struct EpiGateUp {
    static constexpr bool PERM = true, BIAS_INIT = true;
    unsigned char* act; const float* bias; unsigned* rdy; LAS unsigned char* stg;
    __device__ __forceinline__ f32x4 bias4(const pg8::Unit& un, int bj, int n, int wc, int fq) const { return *(const f32x4*)(bias + (size_t)un.e * 2048 + bj * 1024 + un.pn * 128 + wc * 32 + 8 * fq + 4 * n); }
    __device__ __forceinline__ void operator()(f32x4 (&acc)[2][2][4][2], const pg8::Unit& un, int wr, int wc, int fr, int fq) const {
        const int lane = fq * 16 + fr, rr = lane >> 1, hf = lane & 1;
        const unsigned dbase = (unsigned)((un.pm * 256 + wr * 64 + (rr & 15)) * 1024 + un.pn * 128 + wc * 32 + hf * 16);
        LAS unsigned char* wp = stg + fr * 48 + fq * 8; const LAS unsigned char* rp = stg + rr * 48 + hf * 16;
#pragma unroll
        for (int ai = 0; ai < 2; ++ai)
#pragma unroll
            for (int mp = 0; mp < 2; ++mp) {
#pragma unroll
                for (int mm = 0; mm < 2; ++mm) { const int m = mp * 2 + mm;
                    float o[8];
#pragma unroll
                    for (int n = 0; n < 2; ++n) {
                        const f32x4 gt = acc[ai][0][m][n], up = acc[ai][1][m][n];
#pragma unroll
                        for (int j = 0; j < 4; ++j) {
                            const float gg = __builtin_amdgcn_fmed3f(gt[j], -INFINITY, 7.0f), uu = __builtin_amdgcn_fmed3f(up[j], -7.0f, 7.0f);
                            const float sig = __builtin_amdgcn_rcpf(1.0f + __builtin_amdgcn_exp2f(-1.702f * 1.4426950408889634f * gg));
                            o[4 * n + j] = (uu * 8.0f + 8.0f) * gg * sig;
                        }
                    }
                    u32x2 w; w.x = pk4_fp8(o[0], o[1], o[2], o[3]); w.y = pk4_fp8(o[4], o[5], o[6], o[7]);
                    *(LAS u32x2*)(wp + mm * 768) = w; }
                const u32x4 v = *(const LAS u32x4*)rp;
                const unsigned dofs = dbase + (unsigned)((ai * 128 + mp * 32 + (rr >> 4) * 16) * 1024);
                if (un.pm < 32) asm volatile("global_store_dwordx4 %0, %1, %2 sc1" :: "v"(dofs), "v"(v), "s"(act) : "memory");
                else *(u32x4*)(act + dofs) = v;
            }
        if (un.pm < 32) {
            asm volatile("s_waitcnt vmcnt(0)" ::: "memory");
            if ((threadIdx.x & 63) == 0) __hip_atomic_fetch_add(rdy + un.pm, 1u, __ATOMIC_RELAXED, __HIP_MEMORY_SCOPE_AGENT);
        }
    }
};
struct EpiDown {
    static constexpr bool PERM = true, BIAS_INIT = false;
    unsigned char* y; const float* bias; LAS unsigned char* stg;
    __device__ __forceinline__ f32x4 bias4(const pg8::Unit& un, int bj, int n, int wc, int fq) const { return *(const f32x4*)(bias + (size_t)un.e * 1024 + un.pn * 256 + bj * 128 + wc * 32 + 8 * fq + 4 * n); }
    __device__ __forceinline__ void operator()(f32x4 (&acc)[2][2][4][2], const pg8::Unit& un, int wr, int wc, int fr, int fq) const {
        const int lane = fq * 16 + fr, rr = lane >> 2, pc = lane & 3;
        const float* bp = bias + (size_t)un.e * 1024 + un.pn * 256 + wc * 32 + 8 * fq;
        f32x4 bs[2][2];
#pragma unroll
        for (int bj = 0; bj < 2; ++bj) { bs[bj][0] = *(const f32x4*)(bp + bj * 128) * 64.0f; bs[bj][1] = *(const f32x4*)(bp + bj * 128 + 4) * 64.0f; }
        unsigned char* dp = y + (size_t)(un.pm * 256 + wr * 64 + rr) * 1024 + un.pn * 256 + (pc >> 1) * 128 + wc * 32 + (pc & 1) * 16;
        LAS unsigned char* wp = stg + fr * 80 + fq * 8; const LAS unsigned char* rp = stg + rr * 80 + pc * 16;
#pragma unroll
        for (int ai = 0; ai < 2; ++ai)
#pragma unroll
            for (int m = 0; m < 4; ++m) {
#pragma unroll
                for (int bj = 0; bj < 2; ++bj) {
                    const f32x4 v0 = acc[ai][bj][m][0] * 64.0f + bs[bj][0], v1 = acc[ai][bj][m][1] * 64.0f + bs[bj][1];
#define CL8(x) __builtin_amdgcn_fmed3f((x), -448.f, 448.f)
                    u32x2 w; w.x = pk4_fp8(CL8(v0[0]), CL8(v0[1]), CL8(v0[2]), CL8(v0[3])); w.y = pk4_fp8(CL8(v1[0]), CL8(v1[1]), CL8(v1[2]), CL8(v1[3]));
#undef CL8
                    *(LAS u32x2*)(wp + bj * 32) = w; }
                *(u32x4*)(dp + (size_t)(ai * 128 + m * 16) * 1024) = *(const LAS u32x4*)rp;
            }
    }
};

struct Args { const void* in[18]; float* out; unsigned char* ws; int ph_lo, ph_hi; };
struct Frame {
    LAS unsigned char* lds; int tid, lane, wave, G, bid;
    const float *x, *ln_in_g, *ln_in_b, *w_in, *w_pool, *pool_scale, *w_out, *ln1_g, *ln1_b, *w_router, *b_router, *w_gu, *b_gu, *w_dn, *b_dn, *ln2_g, *ln2_b;
    const int* positions; float* out; unsigned char* ws; unsigned* ctl;
};

typedef const Args __attribute__((address_space(4))) * KArgP;
__device__ __forceinline__ void frame_refresh(Frame& F) {
    KArgP ap = (KArgP)__builtin_amdgcn_kernarg_segment_ptr(); asm volatile("" : "+s"(ap));
    int t_ = threadIdx.x; asm volatile("" : "+v"(t_)); F.tid = t_; F.lane = t_ & 63;
    F.x = (const float*)ap->in[0]; F.positions = (const int*)ap->in[1]; F.ln_in_g = (const float*)ap->in[2]; F.ln_in_b = (const float*)ap->in[3];
    F.w_in = (const float*)ap->in[4]; F.w_pool = (const float*)ap->in[5]; F.pool_scale = (const float*)ap->in[6]; F.w_out = (const float*)ap->in[7];
    F.ln1_g = (const float*)ap->in[8]; F.ln1_b = (const float*)ap->in[9]; F.w_router = (const float*)ap->in[10]; F.b_router = (const float*)ap->in[11];
    F.w_gu = (const float*)ap->in[12]; F.b_gu = (const float*)ap->in[13]; F.w_dn = (const float*)ap->in[14]; F.b_dn = (const float*)ap->in[15];
    F.ln2_g = (const float*)ap->in[16]; F.ln2_b = (const float*)ap->in[17];
    F.out = ap->out; F.ws = ap->ws; F.ctl = (unsigned*)(ap->ws + WS_CTL);
}
struct TrItem { const float* src; unsigned char* dst; int ldw, ldt, fp8; };
__device__ __forceinline__ TrItem mk_item(const float* W, unsigned char* WT, int ldw, int k0, int n0, int ldt, int drow0, int fp8) {
    TrItem t; t.src = W + (size_t)k0 * ldw + n0; t.dst = WT + ((size_t)drow0 * ldt + k0) * (fp8 ? 1 : 2); t.ldw = ldw; t.ldt = ldt; t.fp8 = fp8; return t;
}
__device__ __forceinline__ void tr_load(const TrItem& t, float (&tmp)[32], int lane) {
    if (t.fp8) {
        const float* p = t.src + (size_t)(lane >> 3) * t.ldw + (lane & 7) * 4;
#pragma unroll
        for (int j = 0; j < 8; ++j) { const f32x4 v = __builtin_nontemporal_load((const f32x4*)(p + (size_t)(8 * j) * t.ldw)); tmp[4 * j] = v.x; tmp[4 * j + 1] = v.y; tmp[4 * j + 2] = v.z; tmp[4 * j + 3] = v.w; }
    } else {
        const float* p = t.src + (size_t)(lane >> 5) * t.ldw + (lane & 31);
#pragma unroll
        for (int i = 0; i < 32; ++i) tmp[i] = __builtin_nontemporal_load(p + (size_t)(2 * i) * t.ldw);
    }
}
__device__ __forceinline__ void tr_store(const TrItem& t, const float (&tmp)[32], LAS float* scr, int lane) {
    if (t.fp8) {
#pragma unroll
        for (int j = 0; j < 8; ++j) *(LAS f32x4*)(scr + (8 * j + (lane >> 3)) * 32 + (lane & 7) * 4) = (f32x4){tmp[4 * j], tmp[4 * j + 1], tmp[4 * j + 2], tmp[4 * j + 3]};
        LDS_WAIT();
        const int n = lane >> 1, kb = 32 * (lane & 1); const LAS float* sp = scr + kb * 32 + n;
        unsigned o[8];
#pragma unroll
        for (int q = 0; q < 8; ++q) { float v[4];
#pragma unroll
            for (int j = 0; j < 4; ++j) v[j] = __builtin_amdgcn_fmed3f(sp[(4 * q + j) * 32] * 64.0f, -448.f, 448.f);
            o[q] = pk4_fp8(v[0], v[1], v[2], v[3]); }
        unsigned char* dp = t.dst + (size_t)n * 1024 + kb;
        *(u32x4*)dp = (u32x4){o[0], o[1], o[2], o[3]}; *(u32x4*)(dp + 16) = (u32x4){o[4], o[5], o[6], o[7]};
    } else {
#pragma unroll
        for (int i = 0; i < 32; ++i) { const int kk = 2 * i + (lane >> 5); scr[kk * 33 + (lane & 31)] = tmp[i]; }
        LDS_WAIT();
        const int c = lane & 7;
#pragma unroll
        for (int j = 0; j < 4; ++j) { const int n = (lane >> 3) + 8 * j; const LAS float* sp = scr + (8 * c) * 33 + n;
            u32x4 o; o.x = cvt_pk_bf16(sp[0 * 33], sp[1 * 33]); o.y = cvt_pk_bf16(sp[2 * 33], sp[3 * 33]); o.z = cvt_pk_bf16(sp[4 * 33], sp[5 * 33]); o.w = cvt_pk_bf16(sp[6 * 33], sp[7 * 33]);
            *(u32x4*)(t.dst + ((size_t)n * t.ldt + 8 * c) * 2) = o; }
    }
    LDS_WAIT();
}
__device__ __forceinline__ TrItem moe_item(Frame& F, int r) {
    constexpr int I_GU = NE * 16 * 64;
    if (r < I_GU) { const int e = r / 1024, rr = r % 1024, kb = rr / 64, nb = rr % 64, n0 = 32 * nb, bj = n0 / 1024, rem = n0 % 1024, pn = rem / 128, j0 = rem % 128;
        return mk_item(F.w_gu + (size_t)e * 1024 * 2048, F.ws + WS_BTGU + (size_t)e * 2048 * 1024, 2048, 64 * kb, n0, 1024, pn * 256 + bj * 128 + j0, 1); }
    r -= I_GU; const int e = r / 512, rr = r % 512, kb = rr / 32, nb = rr % 32;
    return mk_item(F.w_dn + (size_t)e * 1024 * 1024, F.ws + WS_BTDN + (size_t)e * 1024 * 1024, 1024, 64 * kb, 32 * nb, 1024, 32 * nb, 1);
}
__device__ __forceinline__ void convert_range(Frame& F, int first, int n, int widx, int nw) {
    LAS float* scr = (LAS float*)(F.lds + F.wave * 16384);
    int base = 2 * widx; if (base >= n) return;
    float va[32], vb[32], vc[32], vd[32];
    TrItem ta = moe_item(F, first + base), tb = moe_item(F, first + base + 1);
    tr_load(ta, va, F.lane); tr_load(tb, vb, F.lane);
    for (;;) {
        const int nb = base + 2 * nw; const bool more = nb < n;
        const TrItem tc = moe_item(F, first + (more ? nb : base)), td = moe_item(F, first + (more ? nb : base) + 1);
        if (more) { tr_load(tc, vc, F.lane); tr_load(td, vd, F.lane); }
        tr_store(ta, va, scr, F.lane); tr_store(tb, vb, scr, F.lane);
        if (!more) break;
        const int nb2 = nb + 2 * nw; const bool more2 = nb2 < n;
        ta = moe_item(F, first + (more2 ? nb2 : nb)); tb = moe_item(F, first + (more2 ? nb2 : nb) + 1);
        if (more2) { tr_load(ta, va, F.lane); tr_load(tb, vb, F.lane); }
        tr_store(tc, vc, scr, F.lane); tr_store(td, vd, scr, F.lane);
        if (!more2) break;
        base = nb2;
    }
}
__device__ __forceinline__ void cvq_pull(Frame& F, unsigned* head, int first, int npairs) {
    LAS float* scr = (LAS float*)(F.lds + F.wave * 16384);
    for (;;) {
        unsigned c = 0; if (F.lane == 0) c = __hip_atomic_fetch_add(head, 1u, __ATOMIC_RELAXED, __HIP_MEMORY_SCOPE_AGENT);
        c = (unsigned)__builtin_amdgcn_readfirstlane((int)c);
        if (c >= (unsigned)npairs) break;
        const int r = 2 * (first + (int)c);
        const TrItem ta = moe_item(F, r), tb = moe_item(F, r + 1);
        float va[32], vb[32];
        tr_load(ta, va, F.lane); tr_load(tb, vb, F.lane);
        tr_store(ta, va, scr, F.lane); tr_store(tb, vb, scr, F.lane);
    }
}
__constant__ double ROPE_QK_FREQ[16] = {1.0, 0.44036660267178046, 0.19392274474868576, 0.08539710028576561, 0.03760603093086393, 0.016560440080994446, 0.007292664737217109, 0.003211445994752591,
    0.001414213562373095, 0.000622772421914596, 0.0002742481756762073, 0.00012076973741146504, 5.318295896944988e-05, 2.341999896140934e-05, 1.031338537721246e-05, 4.5416704806078695e-06};
__constant__ double ROPE_IX_FREQ[8] = {1.0, 0.19392274474868576, 0.03760603093086393, 0.007292664737217109, 0.001414213562373095, 0.0002742481756762073, 5.318295896944988e-05, 1.031338537721246e-05};

__device__ __forceinline__ void p0_prologue(Frame& F) {
    LAS float* scr = (LAS float*)(F.lds + F.wave * 16384);
    const int gw = F.bid * 8 + F.wave, NGW = F.G * 8;
    const int gt = F.bid * NTHREADS + F.tid, NGT = F.G * NTHREADS;
    bf16_t* BtIn = (bf16_t*)(F.ws + WS_BTIN); bf16_t* BtOut = (bf16_t*)(F.ws + WS_BTOUT);
    bf16_t* WpT = (bf16_t*)(F.ws + WS_WPT);
    constexpr int I_IN = 16 * 66, I_OUT = 16 * 32, I_POOL = 8, I_MOE = NE * 16 * 64 + NE * 16 * 32;
    constexpr int NSMALL = I_IN + I_OUT + I_POOL, NITEMS = NSMALL + (I_MOE - CV_HIDDEN);
    auto decode = [&](int it) -> TrItem {
        int r = it;
        if (r < I_IN) { const int kb = r / 66, nb = r % 66;
            if (nb >= 8 && nb < 48) return mk_item(F.w_in, F.ws + WS_BTIN8, INW, 64 * kb, 32 * nb, 1024, 32 * nb, 1);
            return mk_item(F.w_in, (unsigned char*)BtIn, INW, 64 * kb, 32 * nb, 1024, 32 * nb, 0); } r -= I_IN;
        if (r < I_OUT) { const int kb = r / 32, nb = r % 32; return mk_item(F.w_out, (unsigned char*)BtOut, 1024, 64 * kb, 32 * nb, 1024, 32 * nb, 0); } r -= I_OUT;
        if (r < I_POOL) { const int g = r / 2, nb = r % 2; return mk_item(F.w_pool + g * 4096, (unsigned char*)(WpT + g * 4096), 64, 0, 32 * nb, 64, 32 * nb, 0); } r -= I_POOL;
        return moe_item(F, CV_HIDDEN + r);
    };
    for (int it = gw; it < NITEMS; it += 2 * NGW) {
        const bool two = (it + NGW < NITEMS);
        const TrItem ta = decode(it), tb = decode(two ? it + NGW : it);
        float va[32], vb[32];
        tr_load(ta, va, F.lane); if (two) tr_load(tb, vb, F.lane);
        tr_store(ta, va, scr, F.lane); if (two) tr_store(tb, vb, scr, F.lane);
    }
    for (int i = gt; i < 192 * 1024; i += NGT) { const int n = 2112 + i / 1024, k = i % 1024; const float v = (n < INW) ? F.w_in[(size_t)k * INW + n] : 0.f;
        BtIn[(size_t)n * 1024 + k] = (bf16_t)(cvt_pk_bf16(v, 0.f) & 0xffffu); }
    { float* wrA = (float*)(F.ws + WS_WRA);
      for (int i = gt; i < 32768; i += NGT) { const int ii = i & 3, e = (i >> 2) & 31, kh = (i >> 7) & 1, c = i >> 8; wrA[i] = F.w_router[(8 * c + 4 * kh + ii) * 32 + e]; } }
    { float* rq = (float*)(F.ws + WS_ROPEQK); float* ri = (float*)(F.ws + WS_ROPEIX);
      for (int i = gt; i < T * 24; i += NGT) { const int tok = i / 24, j = i % 24; const double pos = (double)F.positions[tok];
          const double inv = (j < 16) ? ROPE_QK_FREQ[j] : ROPE_IX_FREQ[j - 16];
          double rev = pos * inv * 0.15915494309189535; rev -= __builtin_floor(rev);
          const float c = __builtin_amdgcn_cosf((float)rev), s = __builtin_amdgcn_sinf((float)rev);
          if (j < 16) { rq[(size_t)tok * 32 + j] = c; rq[(size_t)tok * 32 + 16 + j] = s; } else { ri[(size_t)tok * 16 + (j - 16)] = c; ri[(size_t)tok * 16 + 8 + (j - 16)] = s; } } }
    if (F.bid == 0 && F.tid < 64) { F.ctl[CW_CNT + F.tid] = 0u; if (F.tid == 0) F.ctl[CW_ATTQ] = 0u; }
    { bf16_t* hA = (bf16_t*)(F.ws + WS_HA); float* stats = (float*)(F.ws + WS_STATS);
      f32x4 gv[4], bv[4];
#pragma unroll
      for (int j = 0; j < 4; ++j) { gv[j] = ((const f32x4*)F.ln_in_g)[F.lane + 64 * j]; bv[j] = ((const f32x4*)F.ln_in_b)[F.lane + 64 * j]; }
      f32x4 nx[4];
      if (gw < T) { const f32x4* xr = (const f32x4*)(F.x + (size_t)gw * 1024) + F.lane;
#pragma unroll
          for (int j = 0; j < 4; ++j) nx[j] = __builtin_nontemporal_load(xr + 64 * j); }
      for (int m = gw; m < T; m += NGW) {
          f32x4 v[4]; float s = 0.f;
#pragma unroll
          for (int j = 0; j < 4; ++j) { v[j] = nx[j]; s += (v[j].x + v[j].y) + (v[j].z + v[j].w); }
          if (m + NGW < T) { const f32x4* xr = (const f32x4*)(F.x + (size_t)(m + NGW) * 1024) + F.lane;
#pragma unroll
              for (int j = 0; j < 4; ++j) nx[j] = __builtin_nontemporal_load(xr + 64 * j); }
          const float mean = wave_sum(s) * (1.f / 1024.f); float s2 = 0.f;
#pragma unroll
          for (int j = 0; j < 4; ++j) { v[j] = v[j] - mean; s2 += (v[j].x * v[j].x + v[j].y * v[j].y) + (v[j].z * v[j].z + v[j].w * v[j].w); }
          const float rstd = 1.f / sqrtf(wave_sum(s2) * (1.f / 1024.f) + LN_EPS);
          u32x2* o8 = (u32x2*)(hA + (size_t)m * 1024) + F.lane; unsigned* q8 = (unsigned*)(F.ws + WS_HA8 + (size_t)m * 1024) + F.lane;
#pragma unroll
          for (int j = 0; j < 4; ++j) { const f32x4 h = v[j] * rstd * gv[j] + bv[j]; u32x2 w; w.x = cvt_pk_bf16(h.x, h.y); w.y = cvt_pk_bf16(h.z, h.w); o8[64 * j] = w; q8[64 * j] = pk4_fp8(h.x, h.y, h.z, h.w); }
          if (F.lane == 0) { stats[(size_t)m * 2] = mean; stats[(size_t)m * 2 + 1] = rstd; }
      } }
}

__device__ __forceinline__ void p2_pool(Frame& F) {
    const bf16_t* U = (const bf16_t*)(F.ws + WS_U); const bf16_t* WpT = (const bf16_t*)(F.ws + WS_WPT); bf16_t* cat = (bf16_t*)(F.ws + WS_CAT);
    LAS bf16_t* dl = (LAS bf16_t*)F.lds;
    LAS bf16_t* ul = (LAS bf16_t*)(F.lds + 33792);
    for (int tile = F.bid; tile < T / 64; tile += F.G) {
        const int t0 = tile * 64, pos0 = t0 % SEQ;
        __syncthreads();
        for (int i = F.tid; i < 79 * 32; i += NTHREADS) { const int r = i >> 5, c8 = i & 31; u32x4 v = {0u, 0u, 0u, 0u};
            if (pos0 + r - 15 >= 0) v = *(const u32x4*)(U + (size_t)(t0 + r - 15) * 256 + c8 * 8);
            *(LAS u32x4*)(ul + r * 256 + c8 * 8) = v; }
        __syncthreads();
        { const int c = F.tid & 255, half = F.tid >> 8, w = 2 << (c >> 6);
          const int ts = half * 32; float sum = 0.f;
          for (int d = 1; d < w; ++d) sum += __uint_as_float((unsigned)ul[(15 + ts - d) * 256 + c] << 16);
#pragma unroll 4
          for (int tt = 0; tt < 32; ++tt) { const int tl = ts + tt, p = pos0 + tl; const float cur = __uint_as_float((unsigned)ul[(15 + tl) * 256 + c] << 16);
              sum += cur; const int cnt = (p + 1 < w) ? (p + 1) : w;
              const float diff = sum / (float)cnt - cur;
              dl[tl * 264 + c] = (bf16_t)(cvt_pk_bf16(diff, 0.f) & 0xffffu);
              sum -= __uint_as_float((unsigned)ul[(15 + tl - (w - 1)) * 256 + c] << 16); } }
        __syncthreads();
        { const int g = F.wave & 3, th = F.wave >> 2, r32 = F.lane & 31, hi = F.lane >> 5;
          f32x16 c0 = {}, c1 = {};
#pragma unroll
          for (int s = 0; s < 4; ++s) {
              const bf16x8 a = *(const LAS bf16x8*)(dl + (th * 32 + r32) * 264 + g * 64 + 16 * s + 8 * hi);
              const bf16x8 b0 = *(const bf16x8*)(WpT + (size_t)g * 4096 + (size_t)r32 * 64 + 16 * s + 8 * hi);
              const bf16x8 b1 = *(const bf16x8*)(WpT + (size_t)g * 4096 + (size_t)(32 + r32) * 64 + 16 * s + 8 * hi);
              c0 = __builtin_amdgcn_mfma_f32_32x32x16_bf16(a, b0, c0, 0, 0, 0);
              c1 = __builtin_amdgcn_mfma_f32_32x32x16_bf16(a, b1, c1, 0, 0, 0); }
          const float ps0 = F.pool_scale[g * 64 + r32], ps1 = F.pool_scale[g * 64 + 32 + r32];
#pragma unroll
          for (int r = 0; r < 16; ++r) { const int tok = t0 + th * 32 + crow(r, hi);
              cat[(size_t)tok * 1024 + g * 64 + r32] = (bf16_t)(cvt_pk_bf16(c0[r] * ps0, 0.f) & 0xffffu);
              cat[(size_t)tok * 1024 + g * 64 + 32 + r32] = (bf16_t)(cvt_pk_bf16(c1[r] * ps1, 0.f) & 0xffffu); } }
    }
    __syncthreads();
}

constexpr int IDX_RING_OFF = 0, IDX_SLOT = 32768;
constexpr int IDX_HIST_OFF = 3 * IDX_SLOT;
constexpr int IDX_RES_OFF = IDX_HIST_OFF + 24576;
__device__ __forceinline__ void hist_find16(const LAS unsigned* hist, int li, unsigned need, unsigned& bsel, unsigned& above) {
    const u32x4 h0 = *(const LAS u32x4*)(hist + 4 * li);
    const unsigned c[8] = {h0.x & 0xffffu, h0.x >> 16, h0.y & 0xffffu, h0.y >> 16, h0.z & 0xffffu, h0.z >> 16, h0.w & 0xffffu, h0.w >> 16};
    unsigned s = 0;
#pragma unroll
    for (int k = 0; k < 8; ++k) s += c[k];
    unsigned S = s;
#pragma unroll
    for (int d = 1; d < 32; d <<= 1) { const unsigned o = __shfl_down(S, d, 32); if (li + d < 32) S += o; }
    const unsigned excl = S - s;
    unsigned b = 0xffffffffu, ab = 0;
    if (excl < need && need <= S) { unsigned cum = excl; bool found = false;
#pragma unroll
        for (int k = 7; k >= 0; --k) { if (!found && cum + c[k] >= need) { b = 8 * li + k; ab = cum; found = true; } if (!found) cum += c[k]; } }
    const unsigned long long bal = __ballot(b != 0xffffffffu);
    const unsigned halfmask = (unsigned)((threadIdx.x & 32) ? (bal >> 32) : (bal & 0xffffffffull));
    const int src = (halfmask ? (__ffs(halfmask) - 1) : 0) + (threadIdx.x & 32);
    bsel = __shfl(b, src, 64); above = __shfl(ab, src, 64);
    if (!halfmask) { bsel = 0; above = 0; }
}
template <int J> __device__ __forceinline__ void wlane(unsigned& m, unsigned v) { asm volatile("v_writelane_b32 %0, %1, %2" : "+v"(m) : "s"(v), "n"(J)); }
template <int J> __device__ __forceinline__ void mask_emit_step(const unsigned (&k0)[32], const unsigned (&k1)[32], unsigned T0, unsigned T1, int kh, int ntiles, unsigned& m0, unsigned& m1, unsigned& m2, unsigned& m3) {
    if (2 * J + kh < ntiles) {
        const unsigned long long ba = __ballot(k0[J] >= T0), bc = __ballot(k1[J] >= T1);
        wlane<J>(m0, (unsigned)ba); wlane<J>(m2, (unsigned)(ba >> 32)); wlane<J>(m1, (unsigned)bc); wlane<J>(m3, (unsigned)(bc >> 32));
    }
}
template <int... Js> __device__ __forceinline__ void mask_emit(std::integer_sequence<int, Js...>, const unsigned (&k0)[32], const unsigned (&k1)[32], unsigned T0, unsigned T1, int kh, int ntiles, unsigned& m0, unsigned& m1, unsigned& m2, unsigned& m3) {
    (mask_emit_step<Js>(k0, k1, T0, T1, kh, ntiles, m0, m1, m2, m3), ...);
}
__device__ __forceinline__ void p2_indexer_unit(Frame& F, int b, int qb) {
    const bf16_t* IQ = (const bf16_t*)(F.ws + WS_IQ); const bf16_t* IK = (const bf16_t*)(F.ws + WS_IK); const float* IW = (const float*)(F.ws + WS_IW);
    unsigned* MASK = (unsigned*)(F.ws + WS_MASK);
    const int qg = F.wave & 3, kh = F.wave >> 2;
    LAS unsigned* hist = (LAS unsigned*)(F.lds + IDX_HIST_OFF) + qg * 4 * 384;
    LAS float* mm = (LAS float*)(F.lds + IDX_RES_OFF);
    const int lane = F.lane, r32 = lane & 31, hi = lane >> 5;
    const int p0 = qb * 16 + qg * 4;
    const int tq0 = b * SEQ + p0;
    const int ntiles = (qb >> 1) + 1;
    const int nch = (ntiles + 7) >> 3;
    const char* ikb = (const char*)(IK + (size_t)b * SEQ * 64);
    unsigned dsrc[4];
#pragma unroll
    for (int i = 0; i < 4; ++i) { const int row = F.wave * 32 + i * 8 + (lane >> 3), pos = lane & 7; dsrc[i] = (unsigned)(row * 128 + ((pos ^ ((row >> 1) & 7)) << 4)); }
#define IDX_ISSUE(ch) do { _Pragma("unroll") for (int i_ = 0; i_ < 4; ++i_) \
        __builtin_amdgcn_global_load_lds((const unsigned*)(ikb + (size_t)(ch) * 32768 + dsrc[i_]), (LAS unsigned*)(F.lds + IDX_RING_OFF + ((ch) % 3) * IDX_SLOT + F.wave * 4096 + i_ * 1024), 16, 0, 0); } while (0)
    bf16x8 af[4];
    { const int i = r32, qi = 2 * ((i >> 2) & 1) + (i >> 4), hd = (i & 3) + 4 * ((i >> 3) & 1);
#pragma unroll
      for (int s = 0; s < 4; ++s) af[s] = *(const bf16x8*)(IQ + (size_t)(tq0 + qi) * 512 + hd * 64 + 16 * s + 8 * hi); }
    float wA[8], wB[8];
#pragma unroll
    for (int r = 0; r < 8; ++r) { const int hd = (r & 3) + 4 * (r >> 2); wA[r] = IW[(size_t)(tq0 + 2 * hi) * 8 + hd] * W_SCALE; wB[r] = IW[(size_t)(tq0 + 2 * hi + 1) * 8 + hd] * W_SCALE; }
    __builtin_amdgcn_s_barrier();
    asm volatile("" ::: "memory");
    IDX_ISSUE(0); if (nch > 1) IDX_ISSUE(1);
#pragma unroll
    for (int i = 0; i < 3; ++i) *(LAS u32x4*)(F.lds + IDX_HIST_OFF + (i * 512 + F.tid) * 16) = (u32x4){0u, 0u, 0u, 0u};
    const int limA = p0 + 2 * hi - 32 * (ntiles - 1), limB = limA + 1;
    float sc0[32], sc1[32];
#pragma unroll
    for (int j = 0; j < 32; ++j) { sc0[j] = -INFINITY; sc1[j] = -INFINITY; }
    float mx0 = -INFINITY, mn0 = INFINITY, mx1 = -INFINITY, mn1 = INFINITY;
    const int frag_off = r32 * 128;
    const int fx = (r32 >> 1) & 7;
#pragma unroll
    for (int ch = 0; ch < 8; ++ch) {
        if (ch < nch) {
            if (ch + 1 < nch) asm volatile("s_waitcnt vmcnt(4)" ::: "memory"); else asm volatile("s_waitcnt vmcnt(0)" ::: "memory");
            __builtin_amdgcn_s_barrier();
            asm volatile("" ::: "memory");
            if (ch + 2 < nch) IDX_ISSUE(ch + 2);
            const LAS char* slot = (const LAS char*)(F.lds + IDX_RING_OFF + (ch % 3) * IDX_SLOT);
#pragma unroll
            for (int j4 = 0; j4 < 4; ++j4) {
                const int jl = 2 * j4 + kh, j = ch * 8 + jl, idx = ch * 4 + j4;
                if (j < ntiles) {
                    f32x16 acc = {};
#pragma unroll
                    for (int s = 0; s < 4; ++s) { const bf16x8 bfr = *(const LAS bf16x8*)(slot + jl * 4096 + frag_off + (((2 * s + hi) ^ fx) << 4));
                        acc = __builtin_amdgcn_mfma_f32_32x32x16_bf16(af[s], bfr, acc, 0, 0, 0); }
                    float s0 = 0.f, s1 = 0.f;
#pragma unroll
                    for (int r = 0; r < 8; ++r) {
                        const int ia = __float_as_int(acc[r]), ib = __float_as_int(acc[8 + r]);
                        s0 = fmaf(wA[r], __int_as_float(ia > 0 ? ia : 0), s0); s1 = fmaf(wB[r], __int_as_float(ib > 0 ? ib : 0), s1); }
                    if (j == ntiles - 1) {
                        mn0 = fminf(mn0, (r32 > limA) ? INFINITY : s0); mn1 = fminf(mn1, (r32 > limB) ? INFINITY : s1);
                        s0 = (r32 > limA) ? -INFINITY : s0; s1 = (r32 > limB) ? -INFINITY : s1;
                    } else { mn0 = fminf(mn0, s0); mn1 = fminf(mn1, s1); }
                    mx0 = fmaxf(mx0, s0); mx1 = fmaxf(mx1, s1);
                    sc0[idx] = s0; sc1[idx] = s1;
                }
            }
        }
    }
#undef IDX_ISSUE
#pragma unroll
    for (int d = 1; d < 32; d <<= 1) { mx0 = fmaxf(mx0, __shfl_xor(mx0, d)); mx1 = fmaxf(mx1, __shfl_xor(mx1, d)); mn0 = fminf(mn0, __shfl_xor(mn0, d)); mn1 = fminf(mn1, __shfl_xor(mn1, d)); }
    if (r32 == 0) { LAS float* w = mm + ((qg * 2 + kh) * 4 + 2 * hi) * 2; w[0] = mx0; w[1] = mn0; w[2] = mx1; w[3] = mn1; }
    __syncthreads();
    { const LAS float* w = mm + ((qg * 2 + (kh ^ 1)) * 4 + 2 * hi) * 2; mx0 = fmaxf(mx0, w[0]); mn0 = fminf(mn0, w[1]); mx1 = fmaxf(mx1, w[2]); mn1 = fminf(mn1, w[3]); }
    const float scl0 = (mx0 > mn0) ? (16777212.0f / (mx0 - mn0)) : 0.f, scl1 = (mx1 > mn1) ? (16777212.0f / (mx1 - mn1)) : 0.f;
    const float off0 = 1.5f - mn0 * scl0, off1 = 1.5f - mn1 * scl1;
    unsigned k0[32], k1[32];
#pragma unroll
    for (int j = 0; j < 32; ++j) { k0[j] = (unsigned)fmaf(sc0[j], scl0, off0); k1[j] = (unsigned)fmaf(sc1[j], scl1, off1); }
    unsigned T0 = 1u, T1 = 1u;
#ifndef NO_SELECT
    if (qb >= 16) {
        LAS unsigned* hA = hist + (2 * hi) * 384; LAS unsigned* hB = hist + (2 * hi + 1) * 384;
        unsigned pre0 = 0, pre1 = 0, need0 = 256, need1 = 256;
#pragma unroll
        for (int lvl = 0; lvl < 3; ++lvl) {
            const int sh = 16 - 8 * lvl;
#pragma unroll
            for (int j = 0; j < 32; ++j) {
                if (2 * j + kh < ntiles) {
                    const unsigned ka = k0[j], kc = k1[j];
                    if (lvl == 0 || (ka >> (sh + 8)) == pre0) { const unsigned bn = (ka >> sh) & 255u; (void)__hip_atomic_fetch_add(hA + lvl * 128 + (bn >> 1), 1u << ((bn & 1u) << 4), __ATOMIC_RELAXED, __HIP_MEMORY_SCOPE_WORKGROUP); }
                    if (lvl == 0 || (kc >> (sh + 8)) == pre1) { const unsigned bn = (kc >> sh) & 255u; (void)__hip_atomic_fetch_add(hB + lvl * 128 + (bn >> 1), 1u << ((bn & 1u) << 4), __ATOMIC_RELAXED, __HIP_MEMORY_SCOPE_WORKGROUP); }
                }
            }
            __syncthreads();
            unsigned b0, a0, b1, a1;
            hist_find16(hA + lvl * 128, r32, need0, b0, a0);
            hist_find16(hB + lvl * 128, r32, need1, b1, a1);
            pre0 = (pre0 << 8) | b0; need0 -= a0;
            pre1 = (pre1 << 8) | b1; need1 -= a1;
        }
        T0 = pre0 > 1u ? pre0 : 1u; T1 = pre1 > 1u ? pre1 : 1u;
    }
#endif
    unsigned m0 = 0, m1 = 0, m2 = 0, m3 = 0;
    mask_emit(std::make_integer_sequence<int, 32>{}, k0, k1, T0, T1, kh, ntiles, m0, m1, m2, m3);
    if (lane < 32) { const int w = 2 * lane + kh;
        MASK[(size_t)(tq0 + 0) * 64 + w] = m0; MASK[(size_t)(tq0 + 1) * 64 + w] = m1; MASK[(size_t)(tq0 + 2) * 64 + w] = m2; MASK[(size_t)(tq0 + 3) * 64 + w] = m3; }
}
__device__ __forceinline__ void p2_indexer(Frame& F) {
    for (int pi = F.bid; pi < 512; pi += F.G) { const int b = pi >> 6, x = pi & 63;
        p2_indexer_unit(F, b, 127 - x);
        p2_indexer_unit(F, b, x); }
    __syncthreads();
}

namespace att {
constexpr int D = 128, NW = 8, QBLK = 32, KVBLK = 64;
constexpr float SCALE = 0.088388347648318440f;
constexpr float THR = 5.f;
constexpr int LDQ = 768, LDK = 256, LDO = 1024;
constexpr size_t SHM_V = KVBLK * D, SHM_K = KVBLK * D, SHM_ATTN = 2 * SHM_V + 2 * SHM_K + NW * 64 * 4;
#define KSWZ(row, colB) ((row) * 256 + ((colB) ^ (((row) & 7) << 4)))
#define SBAR() __builtin_amdgcn_sched_barrier(0)
__device__ __forceinline__ void apply_mask(f32x16& p0, f32x16& p1, u32x2 mk, int hi) {
    const int ml = (int)(mk.x >> (4 * hi)), mh = (int)(mk.y >> (4 * hi));
#pragma unroll
    for (int r = 0; r < 16; ++r) { const int cr = (r & 3) + 8 * (r >> 2);
        const unsigned t0 = (unsigned)__builtin_amdgcn_sbfe(ml, cr, 1), t1 = (unsigned)__builtin_amdgcn_sbfe(mh, cr, 1);
        p0[r] = __uint_as_float((__float_as_uint(p0[r]) & t0) | (0xff800000u & ~t0));
        p1[r] = __uint_as_float((__float_as_uint(p1[r]) & t1) | (0xff800000u & ~t1)); }
}
__device__ __forceinline__ void partialSM(f32x16& p0, f32x16& p1, float& m_reg, float& mn, float& alpha) {
    constexpr float C = SCALE * 1.4426950408889634f;
    float pmax = p0[0];
#pragma unroll
    for (int r = 1; r < 16; ++r) pmax = fmaxf(pmax, p0[r]);
#pragma unroll
    for (int r = 0; r < 16; ++r) pmax = fmaxf(pmax, p1[r]);
    { auto rr = __builtin_amdgcn_permlane32_swap(__float_as_uint(pmax), __float_as_uint(pmax), false, false);
      pmax = fmaxf(__uint_as_float(rr[0]), __uint_as_float(rr[1])); }
    if (__builtin_expect(__all(pmax - m_reg <= THR / SCALE), 1)) { mn = m_reg; alpha = 1.f; }
    else { mn = fmaxf(m_reg, pmax); alpha = __builtin_amdgcn_exp2f((m_reg - mn) * C); m_reg = mn; }
    const float mnC = -mn * C;
#pragma unroll
    for (int r = 0; r < 16; ++r) p0[r] = fmaf(p0[r], C, mnC);
#pragma unroll
    for (int r = 0; r < 16; ++r) p1[r] = fmaf(p1[r], C, mnC);
#pragma unroll
    for (int r = 0; r < 16; ++r) p0[r] = __builtin_amdgcn_exp2f(p0[r]);
}
typedef int v8i32a __attribute__((ext_vector_type(8)));
typedef int v4i32a __attribute__((ext_vector_type(4)));
__device__ __forceinline__ void finishSM(f32x16& p0, f32x16& p1, float alpha, float& l_reg, v8i32a& pf) {
#pragma unroll
    for (int r = 0; r < 16; ++r) p1[r] = __builtin_amdgcn_exp2f(p1[r]);
    float ps = 0;
#pragma unroll
    for (int r = 0; r < 16; ++r) ps += p0[r];
#pragma unroll
    for (int r = 0; r < 16; ++r) ps += p1[r];
    { auto rr = __builtin_amdgcn_permlane32_swap(__float_as_uint(ps), __float_as_uint(ps), false, false);
      ps = __uint_as_float(rr[0]) + __uint_as_float(rr[1]); }
    l_reg = l_reg * alpha + ps;
#pragma unroll
    for (int i = 0; i < 4; ++i) { pf[i] = (int)pk4_fp8(p0[4 * i], p0[4 * i + 1], p0[4 * i + 2], p0[4 * i + 3]); pf[4 + i] = (int)pk4_fp8(p1[4 * i], p1[4 * i + 1], p1[4 * i + 2], p1[4 * i + 3]); }
}
__device__ __forceinline__ void qkt(f32x16& p0, f32x16& p1, const LAS char* Ks, const v8i32a* qr, int r32, int hi) {
    p0 = f32x16{}; p1 = f32x16{};
    const int fx = (r32 >> 1) & 7;
#pragma unroll
    for (int s2 = 0; s2 < 2; ++s2) { const int c0 = 4 * s2 + 2 * hi;
        const v4i32a a0l = *reinterpret_cast<const LAS v4i32a*>(Ks + r32 * 128 + ((c0 ^ fx) << 4)), a0h = *reinterpret_cast<const LAS v4i32a*>(Ks + r32 * 128 + (((c0 + 1) ^ fx) << 4));
        const v4i32a a1l = *reinterpret_cast<const LAS v4i32a*>(Ks + (32 + r32) * 128 + ((c0 ^ fx) << 4)), a1h = *reinterpret_cast<const LAS v4i32a*>(Ks + (32 + r32) * 128 + (((c0 + 1) ^ fx) << 4));
        p0 = __builtin_amdgcn_mfma_scale_f32_32x32x64_f8f6f4(__builtin_shufflevector(a0l, a0h, 0, 1, 2, 3, 4, 5, 6, 7), qr[s2], p0, 0, 0, 0, 0x7f7f7f7f, 0, 0x7f7f7f7f);
        p1 = __builtin_amdgcn_mfma_scale_f32_32x32x64_f8f6f4(__builtin_shufflevector(a1l, a1h, 0, 1, 2, 3, 4, 5, 6, 7), qr[s2], p1, 0, 0, 0, 0x7f7f7f7f, 0, 0x7f7f7f7f); }
}
__device__ __forceinline__ void pv_d0(f32x16* o, const LAS char* Vs, v8i32a pf, int r32, int hi) {
    const int fx = (r32 >> 2) & 3;
#pragma unroll
    for (int d0 = 0; d0 < 4; ++d0) { const LAS char* rowp = Vs + (32 * d0 + r32) * 64;
        const v4i32a lo = *reinterpret_cast<const LAS v4i32a*>(rowp + (((2 * hi) ^ fx) << 4)), hh = *reinterpret_cast<const LAS v4i32a*>(rowp + (((2 * hi + 1) ^ fx) << 4));
        o[d0] = __builtin_amdgcn_mfma_scale_f32_32x32x64_f8f6f4(pf, __builtin_shufflevector(lo, hh, 0, 1, 2, 3, 4, 5, 6, 7), o[d0], 0, 0, 0, 0x7f7f7f7f, 0, 0x7f7f7f7f); }
}
__device__ __forceinline__ void attn_body(const unsigned char* __restrict__ Qb, const unsigned char* __restrict__ Kh, const unsigned char* __restrict__ Vh, bf16_t* __restrict__ Ob, const unsigned* __restrict__ Mb, int NT, LAS char* lds) {
    const int tid = threadIdx.x, wid = tid >> 6, lane = tid & 63, r32 = lane & 31, hi = lane >> 5;
    LAS char* V_lds = lds; LAS char* K_lds = lds + 2 * SHM_V;
    LAS float* ws = (LAS float*)(lds + 2 * SHM_V + 2 * SHM_K) + wid * 64; LAS float* li_l = ws; LAS float* al_l = ws + 32;
    float m_reg = -1e30f, l_reg = 0; f32x16 o[4] = {}; v8i32a qr[2];
    const unsigned char* Qw = Qb + (long)(wid * QBLK + r32) * LDQ + hi * 32;
#pragma unroll
    for (int s2 = 0; s2 < 2; ++s2) { const v4i32a ql = *reinterpret_cast<const v4i32a*>(Qw + s2 * 64), qh = *reinterpret_cast<const v4i32a*>(Qw + s2 * 64 + 16); qr[s2] = __builtin_shufflevector(ql, qh, 0, 1, 2, 3, 4, 5, 6, 7); }
    const int krow = tid >> 3, kdst = krow * 128 + (((tid & 7) ^ ((krow >> 1) & 7)) << 4);
    const unsigned mofs = (unsigned)(wid * QBLK + r32) * 256u;
#define Mw_(j) (*(const u32x2*)((const char*)Mb + (mofs + 8u * (unsigned)(j))))
    const int vdst = (tid >> 2) * 64 + (((tid & 3) ^ ((tid >> 4) & 3)) << 4);
    const LAS char* vb0 = V_lds;
    struct { v4i32a vs, ks; } sr_[2];
#define SLOAD(i, k0) do { sr_[i].vs = *(const v4i32a*)(Vh + (long)((k0) >> 6) * 8192 + tid * 16); \
    sr_[i].ks = *(const v4i32a*)(Kh + (long)((k0) + krow) * LDK + (tid & 7) * 16); } while (0)
#define SWRITE(b, i) do { *(LAS v4i32a*)(V_lds + (b) * SHM_V + vdst) = sr_[i].vs;          \
    *(LAS v4i32a*)(K_lds + (b) * SHM_K + kdst) = sr_[i].ks; } while (0)
#define SWAIT() asm volatile("s_waitcnt vmcnt(3)" ::: "memory")
#define RESC(a) do { if (__any((a) < 1.f)) { if (hi == 0) al_l[r32] = (a); asm volatile("s_waitcnt lgkmcnt(0)" ::: "memory"); \
    _Pragma("unroll") for (int d = 0; d < 4; ++d) _Pragma("unroll") for (int r = 0; r < 16; ++r) o[d][r] *= al_l[crow(r, hi)]; } } while (0)
    f32x16 pA0, pA1, pB0, pB1; float mnA, mnB, alA, alB; v8i32a pf;
    u32x2 mkA = Mw_(0), mkB = Mw_(1);
    constexpr int SE = 0, SO = 1;
    const int jmax = NT - 4 + (__builtin_amdgcn_readfirstlane(wid) >> 1);
#define VAL(t) ((t) <= jmax)
    SLOAD(SE, 0); asm volatile("s_waitcnt vmcnt(0)" ::: "memory"); SWRITE(0, SE); __syncthreads();
    qkt(pA0, pA1, K_lds, qr, r32, hi); apply_mask(pA0, pA1, mkA, hi); partialSM(pA0, pA1, m_reg, mnA, alA); mkA = Mw_(2);
    SLOAD(SO, KVBLK); if (2 < NT) SLOAD(SE, 2 * KVBLK);
    SWAIT(); SWRITE(1, SO); __syncthreads();
    for (int j = 1; j + 1 < NT; j += 2) {
        SBAR(); if (VAL(j)) qkt(pB0, pB1, K_lds + SHM_K, qr, r32, hi);
        if (VAL(j - 1)) finishSM(pA0, pA1, alA, l_reg, pf); SBAR();
        SLOAD(SO, (j + 2) * KVBLK); SBAR();
        if (VAL(j - 1)) pv_d0(o, vb0, pf, r32, hi);
        alB = 1.f; if (VAL(j)) { apply_mask(pB0, pB1, mkB, hi); partialSM(pB0, pB1, m_reg, mnB, alB); } mkB = Mw_((j + 2 < NT) ? (j + 2) : j);
        __syncthreads(); SWAIT(); SWRITE(0, SE);
        RESC(alB); __syncthreads();
        SBAR(); if (VAL(j + 1)) qkt(pA0, pA1, K_lds, qr, r32, hi);
        if (VAL(j)) finishSM(pB0, pB1, alB, l_reg, pf); SBAR();
        if (j + 3 < NT) SLOAD(SE, (j + 3) * KVBLK); SBAR();
        if (VAL(j)) pv_d0(o, vb0 + SHM_V, pf, r32, hi);
        alA = 1.f; if (VAL(j + 1)) { apply_mask(pA0, pA1, mkA, hi); partialSM(pA0, pA1, m_reg, mnA, alA); } mkA = Mw_((j + 3 < NT) ? (j + 3) : (j + 1));
        __syncthreads(); SWAIT(); SWRITE(1, SO);
        RESC(alA); __syncthreads();
    }
    SBAR(); if (VAL(NT - 1)) qkt(pB0, pB1, K_lds + SHM_K, qr, r32, hi);
    if (VAL(NT - 2)) finishSM(pA0, pA1, alA, l_reg, pf); SBAR();
    if (VAL(NT - 2)) pv_d0(o, vb0, pf, r32, hi);
    alB = 1.f; if (VAL(NT - 1)) { apply_mask(pB0, pB1, mkB, hi); partialSM(pB0, pB1, m_reg, mnB, alB); }
    __syncthreads(); RESC(alB);
    if (VAL(NT - 1)) { finishSM(pB0, pB1, alB, l_reg, pf); SBAR();
        pv_d0(o, vb0 + SHM_V, pf, r32, hi); }
#undef VAL
    if (hi == 0) li_l[r32] = l_reg; asm volatile("s_waitcnt lgkmcnt(0)" ::: "memory");
    float rli[16];
#pragma unroll
    for (int r = 0; r < 16; ++r) rli[r] = __builtin_amdgcn_rcpf(li_l[crow(r, hi)]);
    bf16_t* Ow = Ob + (long)(wid * QBLK) * LDO;
#pragma unroll
    for (int r = 0; r < 16; ++r) { const int orow = crow(r, hi);
#pragma unroll
        for (int d0 = 0; d0 < 4; ++d0) Ow[(long)orow * LDO + d0 * 32 + r32] = (bf16_t)(cvt_pk_bf16(o[d0][r] * rli[r], 0.f) & 0xffffu); }
#undef SLOAD
#undef SWRITE
#undef SWAIT
#undef RESC
#undef Mw_
}
}

__device__ __forceinline__ void p3_attention(Frame& F) {
    const bf16_t* Q = (const bf16_t*)(F.ws + WS_Q); const bf16_t* K = (const bf16_t*)(F.ws + WS_K); const bf16_t* V = (const bf16_t*)(F.ws + WS_V);
    bf16_t* cat = (bf16_t*)(F.ws + WS_CAT); const unsigned* MASK = (const unsigned*)(F.ws + WS_MASK);
    const int j = F.bid;
    if (F.G == 256 && j >= 216) {
        convert_range(F, 2 * CV_PAIRS1, 2 * CV_PAIRS3, (j - 216) * 8 + F.wave, 40 * 8);
        return;
    }
    int qbs[2], phs[2], nu = 2;
    if (F.G != 256) { nu = 0; }
    else if (j < 48) { qbs[0] = 7; phs[0] = (j % 8) * 6 + j / 8; nu = 1; qbs[1] = 0; phs[1] = 0; }
    else if (j < 96) { const int jl = j - 48; qbs[0] = 6; phs[0] = (jl % 8) * 6 + jl / 8; qbs[1] = 0; phs[1] = phs[0]; }
    else if (j < 144) { const int jl = j - 96; qbs[0] = 5; phs[0] = (jl % 8) * 6 + jl / 8; qbs[1] = 1; phs[1] = phs[0]; }
    else if (j < 192) { const int jl = j - 144; qbs[0] = 4; phs[0] = (jl % 8) * 6 + jl / 8; qbs[1] = 2; phs[1] = phs[0]; }
    else { const int jl = j - 192; qbs[0] = 3; phs[0] = (jl % 8) * 6 + 2 * (jl / 8); qbs[1] = 3; phs[1] = phs[0] + 1; }
    for (int ui = 0; ui < nu; ++ui) {
        __syncthreads();
        const int qb = qbs[ui], b = phs[ui] / 6, h = phs[ui] % 6, g = h / 3;
        const size_t row0 = (size_t)b * SEQ + (size_t)qb * 256;
        att::attn_body((const unsigned char*)Q + row0 * 768 + h * 128, (const unsigned char*)K + (size_t)b * SEQ * 256 + g * 128, (const unsigned char*)V + (size_t)(b * 2 + g) * 32 * 8192, cat + row0 * 1024 + 256 + h * 128, MASK + row0 * 64, 4 * (qb + 1), (LAS char*)F.lds);
    }
    __syncthreads();
}

__device__ __forceinline__ void p5_ln1_router(Frame& F) {
    const bf16_t* MIX = (const bf16_t*)(F.ws + WS_MIX); const bf16_t* HA = (const bf16_t*)(F.ws + WS_HA);
    bf16_t* H1R = (bf16_t*)(F.ws + WS_H1F); unsigned char* H1Q = F.ws + WS_H1B; const float* wrA = (const float*)(F.ws + WS_WRA);
    unsigned* INV = (unsigned*)(F.ws + WS_INV); unsigned* TOKEP = (unsigned*)(F.ws + WS_TOKEP); float* TOKG = (float*)(F.ws + WS_TOKG);
    LAS float* tile = (LAS float*)F.lds;
    LAS float* part = (LAS float*)F.lds;
    LAS float* logit = (LAS float*)(F.lds + 36864);
    LAS int* sel_e = (LAS int*)(F.lds + MISC_OFF + 2048);
    LAS float* sel_g = (LAS float*)(F.lds + MISC_OFF + 3072);
    LAS int* sel_p = (LAS int*)(F.lds + MISC_OFF + 4096);
    LAS unsigned* lcnt = (LAS unsigned*)(F.lds + MISC_OFF + 5120);
    LAS int* ebase = (LAS int*)(F.lds + MISC_OFF + 5376);
    const int lane = F.lane, r32 = lane & 31, hi = lane >> 5;
    for (int blk = F.bid; blk < T / 64; blk += F.G) {
        const int t0 = blk * 64;
        if (F.tid < 32) lcnt[F.tid] = 0u;
        for (int pass = 0; pass < 2; ++pass) {
            __syncthreads();
            { f32x4 g1[4], b1[4];
#pragma unroll
              for (int j = 0; j < 4; ++j) { g1[j] = ((const f32x4*)F.ln1_g)[lane + 64 * j]; b1[j] = ((const f32x4*)F.ln1_b)[lane + 64 * j]; }
#pragma unroll
              for (int rb = 0; rb < 4; rb += 2) {
              u32x2 xv[2][4]; u32x2 mv[2][4];
#pragma unroll
              for (int rr = 0; rr < 2; ++rr) { const int m = t0 + pass * 32 + F.wave * 4 + rb + rr;
#pragma unroll
                  for (int j = 0; j < 4; ++j) { xv[rr][j] = ((const u32x2*)(HA + (size_t)m * 1024))[lane + 64 * j]; mv[rr][j] = ((const u32x2*)(MIX + (size_t)m * 1024))[lane + 64 * j]; } }
#pragma unroll
              for (int rr = 0; rr < 2; ++rr) { const int tl = F.wave * 4 + rb + rr, m = t0 + pass * 32 + tl;
                  f32x4 v[4]; float s = 0.f;
#pragma unroll
                  for (int j = 0; j < 4; ++j) { const u32x2 hw = xv[rr][j]; const f32x4 h = {bf16_lo(hw.x), bf16_hi(hw.x), bf16_lo(hw.y), bf16_hi(hw.y)};
                      const u32x2 w = mv[rr][j]; const f32x4 mx = {bf16_lo(w.x), bf16_hi(w.x), bf16_lo(w.y), bf16_hi(w.y)};
                      v[j] = ALPHA * h + mx; s += (v[j].x + v[j].y) + (v[j].z + v[j].w); }
                  const float mean = wave_sum(s) * (1.f / 1024.f); float s2 = 0.f;
#pragma unroll
                  for (int j = 0; j < 4; ++j) { v[j] = v[j] - mean; s2 += (v[j].x * v[j].x + v[j].y * v[j].y) + (v[j].z * v[j].z + v[j].w * v[j].w); }
                  const float rstd = 1.f / sqrtf(wave_sum(s2) * (1.f / 1024.f) + LN_EPS);
                  u32x2* of = (u32x2*)(H1R + (size_t)m * 1024) + lane; unsigned* ob = (unsigned*)(H1Q + (size_t)m * 1024) + lane;
#pragma unroll
                  for (int j = 0; j < 4; ++j) { const f32x4 h = v[j] * rstd * g1[j] + b1[j]; { u32x2 hw; hw.x = cvt_pk_bf16(h.x, h.y); hw.y = cvt_pk_bf16(h.z, h.w); of[64 * j] = hw; } ob[64 * j] = pk4_fp8(h.x, h.y, h.z, h.w);
                      *(LAS f32x4*)(tile + tl * 1024 + (((lane + 64 * j) ^ (tl & 15)) << 2)) = h; } } } }
            f32x4 a4[16];
#pragma unroll
            for (int i = 0; i < 16; ++i) a4[i] = *(const f32x4*)(wrA + (size_t)(((F.wave * 16 + i) * 2 + hi) * 32 + r32) * 4);
            __syncthreads();
            f32x16 acc = {};
#pragma unroll
            for (int i = 0; i < 16; ++i) { const int c = F.wave * 16 + i;
                const f32x4 b4 = *(const LAS f32x4*)(tile + r32 * 1024 + (((2 * c + hi) ^ (r32 & 15)) << 2));
                acc = __builtin_amdgcn_mfma_f32_32x32x2f32(a4[i].x, b4.x, acc, 0, 0, 0);
                acc = __builtin_amdgcn_mfma_f32_32x32x2f32(a4[i].y, b4.y, acc, 0, 0, 0);
                acc = __builtin_amdgcn_mfma_f32_32x32x2f32(a4[i].z, b4.z, acc, 0, 0, 0);
                acc = __builtin_amdgcn_mfma_f32_32x32x2f32(a4[i].w, b4.w, acc, 0, 0, 0); }
            __syncthreads();
#pragma unroll
            for (int r = 0; r < 16; ++r) part[(F.wave * 32 + r32) * 33 + crow(r, hi)] = acc[r];
            __syncthreads();
#pragma unroll
            for (int q = 0; q < 2; ++q) { const int o = F.tid * 2 + q, tok = o >> 5, e = o & 31; float sm = F.b_router[e];
#pragma unroll
                for (int kq = 0; kq < 8; ++kq) sm += part[(kq * 32 + tok) * 33 + e];
                logit[tok * 33 + e] = sm; }
            __syncthreads();
            if (F.tid < 32) {
                float bv_[4] = {-INFINITY, -INFINITY, -INFINITY, -INFINITY}; int bi[4] = {0, 0, 0, 0};
#pragma unroll
                for (int e = 0; e < 32; ++e) { const float v = logit[F.tid * 33 + e];
                    if (v > bv_[3]) { bv_[3] = v; bi[3] = e;
                        if (bv_[3] > bv_[2]) { float tv = bv_[2]; bv_[2] = bv_[3]; bv_[3] = tv; int ti = bi[2]; bi[2] = bi[3]; bi[3] = ti;
                            if (bv_[2] > bv_[1]) { tv = bv_[1]; bv_[1] = bv_[2]; bv_[2] = tv; ti = bi[1]; bi[1] = bi[2]; bi[2] = ti;
                                if (bv_[1] > bv_[0]) { tv = bv_[0]; bv_[0] = bv_[1]; bv_[1] = tv; ti = bi[0]; bi[0] = bi[1]; bi[1] = ti; } } } } }
                float ex[4], se = 0.f;
#pragma unroll
                for (int j = 0; j < 4; ++j) { ex[j] = __expf(bv_[j] - bv_[0]); se += ex[j]; }
#pragma unroll
                for (int j = 0; j < 4; ++j) { sel_g[(pass * 32 + F.tid) * 4 + j] = ex[j] / se; sel_e[(pass * 32 + F.tid) * 4 + j] = bi[j]; }
            }
        }
        __syncthreads();
        if (F.tid < 256) sel_p[F.tid] = (int)__hip_atomic_fetch_add(lcnt + sel_e[F.tid], 1u, __ATOMIC_RELAXED, __HIP_MEMORY_SCOPE_WORKGROUP);
        __syncthreads();
        if (F.tid < 32) { const unsigned c = lcnt[F.tid]; int base = 0; if (c > 0) base = (int)__hip_atomic_fetch_add(F.ctl + CW_CNT + F.tid, c, __ATOMIC_RELAXED, __HIP_MEMORY_SCOPE_AGENT); ebase[F.tid] = base; }
        __syncthreads();
        if (F.tid < 256) { const int tok = t0 + (F.tid >> 2), e = sel_e[F.tid], p = ebase[e] + sel_p[F.tid];
            INV[(size_t)e * CAP + p] = (unsigned)tok; TOKEP[(size_t)tok * 4 + (F.tid & 3)] = ((unsigned)e << 16) | (unsigned)p; TOKG[(size_t)tok * 4 + (F.tid & 3)] = sel_g[F.tid]; }
        __syncthreads();
    }
}

__device__ __forceinline__ void moe_tables(Frame& F, LAS int* tstart) {
    __syncthreads();
    if (F.tid < 64) {
        const unsigned c = (F.tid < NE) ? __hip_atomic_load(F.ctl + CW_CNT + (F.tid & 31), __ATOMIC_RELAXED, __HIP_MEMORY_SCOPE_AGENT) : 0u;
        const int nt = (int)((c + 255u) >> 8); int incl = nt;
#pragma unroll
        for (int d = 1; d < 32; d <<= 1) { const int o = __shfl_up(incl, d, 64); if ((int)F.tid >= d) incl += o; }
        if (F.tid < NE) { tstart[F.tid] = incl - nt; tstart[40 + F.tid] = (int)c; }
        if (F.tid == NE - 1) tstart[NE] = incl; }
    __syncthreads();
}

__device__ __forceinline__ float fp8_to_f32(unsigned w, int byte) {
    if (byte == 0) return __builtin_amdgcn_cvt_f32_fp8(w, 0); if (byte == 1) return __builtin_amdgcn_cvt_f32_fp8(w, 1); if (byte == 2) return __builtin_amdgcn_cvt_f32_fp8(w, 2); return __builtin_amdgcn_cvt_f32_fp8(w, 3);
}
__device__ __forceinline__ void p8_final(Frame& F, LAS int* tstart) {
    const bf16_t* H1R = (const bf16_t*)(F.ws + WS_H1F); const unsigned* TOKEP = (const unsigned*)(F.ws + WS_TOKEP); const float* TOKG = (const float*)(F.ws + WS_TOKG);
    const unsigned char* Y = F.ws + WS_Y;
    const int gw = F.bid * 8 + F.wave, NGW = F.G * 8;
    f32x4 gv[4], bv[4];
#pragma unroll
    for (int j = 0; j < 4; ++j) { gv[j] = ((const f32x4*)F.ln2_g)[F.lane + 64 * j]; bv[j] = ((const f32x4*)F.ln2_b)[F.lane + 64 * j]; }
    unsigned tk = 0; float tg = 0.f;
    { const int m = gw + (F.lane >> 2) * NGW; if (F.lane < 32 && m < T) { tk = TOKEP[(size_t)m * 4 + (F.lane & 3)]; tg = TOKG[(size_t)m * 4 + (F.lane & 3)] * (1.0f / 64.0f); } }
    u32x2 hwA[4], hwB[4]; unsigned ywA[4][4], ywB[4][4];
#define P8_LOAD(k, hw, yw) do { const int m_ = gw + (k) * NGW; if (m_ < T) { const u32x2* xr_ = (const u32x2*)(H1R + (size_t)m_ * 1024) + F.lane; \
        _Pragma("unroll") for (int j = 0; j < 4; ++j) hw[j] = xr_[64 * j]; \
        _Pragma("unroll") for (int q = 0; q < 4; ++q) { const unsigned ep_ = (unsigned)__builtin_amdgcn_readlane((int)tk, (k) * 4 + q); \
            const size_t slot_ = (size_t)tstart[ep_ >> 16] * 256 + (ep_ & 0xffffu); const unsigned* yr_ = (const unsigned*)(Y + slot_ * 1024) + F.lane; \
            _Pragma("unroll") for (int j = 0; j < 4; ++j) yw[q][j] = yr_[64 * j]; } } } while (0)
#define P8_ROW(k, hw, yw) do { const int m_ = gw + (k) * NGW; if (m_ < T) { f32x4 v[4]; float gt[4]; \
        _Pragma("unroll") for (int q = 0; q < 4; ++q) gt[q] = __builtin_bit_cast(float, __builtin_amdgcn_readlane(__builtin_bit_cast(int, tg), (k) * 4 + q)); \
        _Pragma("unroll") for (int j = 0; j < 4; ++j) { v[j] = (f32x4){ALPHA * bf16_lo(hw[j].x), ALPHA * bf16_hi(hw[j].x), ALPHA * bf16_lo(hw[j].y), ALPHA * bf16_hi(hw[j].y)}; \
            _Pragma("unroll") for (int q = 0; q < 4; ++q) { const unsigned w = yw[q][j]; \
                v[j].x += gt[q] * fp8_to_f32(w, 0); v[j].y += gt[q] * fp8_to_f32(w, 1); v[j].z += gt[q] * fp8_to_f32(w, 2); v[j].w += gt[q] * fp8_to_f32(w, 3); } } \
        float s_ = 0.f; _Pragma("unroll") for (int j = 0; j < 4; ++j) s_ += (v[j].x + v[j].y) + (v[j].z + v[j].w); \
        const float mean_ = wave_sum(s_) * (1.f / 1024.f); float s2_ = 0.f; \
        _Pragma("unroll") for (int j = 0; j < 4; ++j) { v[j] = v[j] - mean_; s2_ += (v[j].x * v[j].x + v[j].y * v[j].y) + (v[j].z * v[j].z + v[j].w * v[j].w); } \
        const float rstd_ = 1.f / sqrtf(wave_sum(s2_) * (1.f / 1024.f) + LN_EPS); \
        f32x4* orow_ = (f32x4*)(F.out + (size_t)m_ * 1024) + F.lane; \
        _Pragma("unroll") for (int j = 0; j < 4; ++j) orow_[64 * j] = v[j] * rstd_ * gv[j] + bv[j]; } } while (0)
    P8_LOAD(0, hwA, ywA);
    P8_LOAD(1, hwB, ywB); P8_ROW(0, hwA, ywA);
    P8_LOAD(2, hwA, ywA); P8_ROW(1, hwB, ywB);
    P8_LOAD(3, hwB, ywB); P8_ROW(2, hwA, ywA);
    P8_LOAD(4, hwA, ywA); P8_ROW(3, hwB, ywB);
    P8_LOAD(5, hwB, ywB); P8_ROW(4, hwA, ywA);
    P8_LOAD(6, hwA, ywA); P8_ROW(5, hwB, ywB);
    P8_LOAD(7, hwB, ywB); P8_ROW(6, hwA, ywA);
    P8_ROW(7, hwB, ywB);
#undef P8_LOAD
#undef P8_ROW
}

__global__ void __launch_bounds__(NTHREADS, 2) mk_fwd(Args args) {
    extern __shared__ __attribute__((aligned(16))) unsigned char lds_raw[];
    Frame F;
    F.lds = (LAS unsigned char*)lds_raw;
    F.tid = threadIdx.x; F.lane = F.tid & 63; F.wave = __builtin_amdgcn_readfirstlane(F.tid >> 6); F.G = gridDim.x; F.bid = blockIdx.x;
    frame_refresh(F);
    volatile LAS unsigned* misc = (volatile LAS unsigned*)(F.lds + MISC_OFF);
    LAS int* tstart = (LAS int*)(F.lds + MISC_OFF + 256);
    LAS int* toktab = (LAS int*)(F.lds + MISC_OFF + 1024);
    if (F.tid < 4) misc[F.tid] = 0u;
    __syncthreads();
    const int lo = args.ph_lo, hi = args.ph_hi;
    XcdBarrier bar; bar.bar = F.ctl; bar.x = 0; bar.st = misc;
    if (hi - lo > 1) bar = xcd_barrier_post(F.ctl, misc);
#define IN(k) (lo <= (k) && (k) < hi)
#ifdef ONLY
#define PH_ON(k) ((k) == ONLY)
#else
#define PH_ON(k) true
#endif
#define SEAM(k) do { if (IN(k) && IN((k) + 1)) xcd_barrier(bar); frame_refresh(F); } while (0)

    if (PH_ON(0) && IN(0)) { p0_prologue(F); } SEAM(0);
    if (PH_ON(1) && IN(1)) {
        EpiInProj E{(bf16_t*)(F.ws + WS_U), (bf16_t*)(F.ws + WS_Q), (bf16_t*)(F.ws + WS_K), (bf16_t*)(F.ws + WS_V), (bf16_t*)(F.ws + WS_IQ), (bf16_t*)(F.ws + WS_IK), (float*)(F.ws + WS_IW),
                    (const float*)(F.ws + WS_ROPEQK), (const float*)(F.ws + WS_ROPEIX)};
        { pg8::StaticSched S{T / 256, 5, F.G, F.bid, 1, 1};
          pg8::gemm_phase<EpiInProj, pg8::StaticSched, true, 0x79797979, 0x7f7f7f7f>(F.lds, (const char*)(F.ws + WS_HA8), (const char*)(F.ws + WS_BTIN8), S, E); }
        { pg8::StaticSched S{T / 256, 4, F.G, F.bid, 0, 5};
          pg8::gemm_phase<EpiInProj, pg8::StaticSched>(F.lds, (const char*)(F.ws + WS_HA), (const char*)(F.ws + WS_BTIN), S, E); }
        if (F.bid >= 64) {
            convert_range(F, 0, 2 * CV_PAIRS1, (F.bid - 64) * 8 + F.wave, (F.G - 64) * 8); }
    } SEAM(1);
    if (PH_ON(2) && IN(2)) {
#ifndef NO_POOL
 p2_pool(F);
#endif
 p2_indexer(F); } SEAM(2);
    if (PH_ON(3) && IN(3)) { p3_attention(F); } SEAM(3);
    if (PH_ON(4) && IN(4)) {
        pg8::StaticSched S{T / 256, 4, F.G, F.bid, 0, 0};
        EpiMix E{(bf16_t*)(F.ws + WS_MIX)};
        pg8::gemm_phase<EpiMix, pg8::StaticSched>(F.lds, (const char*)(F.ws + WS_CAT), (const char*)(F.ws + WS_BTOUT), S, E);
    } SEAM(4);
    if (PH_ON(5) && IN(5)) { p5_ln1_router(F); } SEAM(5);
    if (PH_ON(6) && IN(6)) {
        moe_tables(F, tstart);
        const int ntl = tstart[NE];
        pg8::MoeSched<true> S{ntl, 8, F.G, F.bid, 2048, tstart, toktab, 0};
        { const unsigned* INV = (const unsigned*)(F.ws + WS_INV); pg8::Unit u; unsigned tk[10];
#pragma unroll
          for (int i = 0; i < 10; ++i) { tk[i] = 0u; if (S.next(i, u) && F.tid < 256) { const int p = (u.pm - tstart[u.e]) * 256 + F.tid; const int cnt = tstart[40 + u.e];
                  tk[i] = INV[(size_t)u.e * CAP + (p < cnt ? p : 0)]; } }
#pragma unroll
          for (int i = 0; i < 10; ++i) if (F.tid < 256) toktab[i * 256 + F.tid] = (int)tk[i];
          __syncthreads(); }
        EpiGateUp E{F.ws + WS_ACT, F.b_gu, F.ctl + CW_ACTRDY, F.lds + EPI_OFF + F.wave * 2048};
#ifndef NO_GU
        pg8::gemm_phase<EpiGateUp, pg8::MoeSched<true>, true, 0x79797979, 0x7f7f7f7f>(F.lds, (const char*)(F.ws + WS_H1B), (const char*)(F.ws + WS_BTGU), S, E);
#endif
        { const int nwg6 = 8 * ntl, rounds6 = (nwg6 + F.G - 1) / F.G, nidle = rounds6 * F.G - nwg6, cfirst = nwg6 - (rounds6 - 1) * F.G;
          int early = ((nidle < 128 ? nidle : 128) / 32) * 32; if (rounds6 < 9 || ntl < 32) early = 0;
          const int rank = F.bid - cfirst;
#ifndef NO_EARLY
          if (rank >= 0 && rank < early) {
              pg8::MoeSched<false> S7{early / 4, 4, F.G, rank, 1024, tstart, toktab, 0};
              pg8::Unit u; S7.next(0, u);
              if (F.tid < 64) {
                  unsigned* cp = F.ctl + CW_ACTRDY + u.pm; unsigned sp = 0;
                  while ((unsigned)__builtin_amdgcn_readfirstlane((int)__hip_atomic_load(cp, __ATOMIC_RELAXED, __HIP_MEMORY_SCOPE_AGENT)) < 64u) {
                      __builtin_amdgcn_s_sleep(2); if (++sp > (1u << 20)) { if (F.tid == 0) __hip_atomic_store(F.ctl + CW_TMO2, 1u, __ATOMIC_RELAXED, __HIP_MEMORY_SCOPE_AGENT); break; } }
                  __builtin_amdgcn_fence(__ATOMIC_ACQUIRE, "agent");
                  asm volatile("s_waitcnt vmcnt(0)" ::: "memory"); }
              __syncthreads();
              EpiDown E7{F.ws + WS_Y, F.b_dn, F.lds + EPI_OFF + F.wave * 2048};
              pg8::gemm_phase<EpiDown, pg8::MoeSched<false>, true, 0x79797979, 0x7c7c7c7c>(F.lds, (const char*)(F.ws + WS_ACT), (const char*)(F.ws + WS_BTDN), S7, E7);
          }
#endif
          (void)rank; (void)early; }
    } SEAM(6);
    if (PH_ON(7) && IN(7)) {
        moe_tables(F, tstart);
        const int ntl = tstart[NE];
        const int nwg6 = 8 * ntl, rounds6 = (nwg6 + F.G - 1) / F.G, nidle = rounds6 * F.G - nwg6;
        int early = ((nidle < 128 ? nidle : 128) / 32) * 32; if (rounds6 < 9 || ntl < 32) early = 0;
        pg8::MoeSched<false> S{ntl, 4, F.G, F.bid, 1024, tstart, toktab, early};
        EpiDown E{F.ws + WS_Y, F.b_dn, F.lds + EPI_OFF + F.wave * 2048};
        pg8::gemm_phase<EpiDown, pg8::MoeSched<false>, true, 0x79797979, 0x7c7c7c7c>(F.lds, (const char*)(F.ws + WS_ACT), (const char*)(F.ws + WS_BTDN), S, E);
    } SEAM(7);
    if (PH_ON(8) && IN(8)) { moe_tables(F, tstart); p8_final(F, tstart); }
#undef IN
#undef SEAM
}

extern "C" void kernel_launch(void* const* d_in, const int* in_sizes, int n_in, void* d_out, int out_size, void* d_ws, size_t ws_size, hipStream_t stream) {
    static int grid = 0;
    if (grid == 0) {
        if (n_in != 18 || in_sizes[0] != T * DM || out_size != T * DM || ws_size < WS_END) {
            fprintf(stderr, "kernel_launch: shape mismatch (n_in %d, in0 %d, out %d, ws %zu, need %zu)\n", n_in, n_in > 0 ? in_sizes[0] : -1, out_size, ws_size, (size_t)WS_END); grid = -1; return; }
        int dev = 0, cus = 0, per_cu = 0;
        if (hipGetDevice(&dev) != hipSuccess || hipDeviceGetAttribute(&cus, hipDeviceAttributeMultiprocessorCount, dev) != hipSuccess) { grid = -1; return; }
        if (hipFuncSetAttribute((const void*)mk_fwd, hipFuncAttributeMaxDynamicSharedMemorySize, LDS_BYTES) != hipSuccess) { fprintf(stderr, "kernel_launch: hipFuncSetAttribute failed\n"); grid = -1; return; }
        if (hipOccupancyMaxActiveBlocksPerMultiprocessor(&per_cu, (const void*)mk_fwd, NTHREADS, LDS_BYTES) != hipSuccess || per_cu < 1) {
            fprintf(stderr, "kernel_launch: occupancy query reports %d workgroups per CU\n", per_cu); }
        (void)hipGetLastError();
        grid = cus;
        if (grid != 256) { fprintf(stderr, "kernel_launch: built for a 256-CU device (static work deals), found %d CUs\n", cus); grid = -1; return; }
    }
    if (grid < 0) return;
    (void)hipMemsetAsync((char*)d_ws + WS_CTL, 0, CTL_BYTES, stream);
    Args a{};
    for (int i = 0; i < 18; ++i) a.in[i] = d_in[i];
    a.out = (float*)d_out; a.ws = (unsigned char*)d_ws;
#if MK_N_LAUNCHES == 1
    a.ph_lo = 0; a.ph_hi = NPH;
    hipLaunchKernelGGL(mk_fwd, dim3(grid), dim3(NTHREADS), LDS_BYTES, stream, a);
#else
    for (int p = 0; p < NPH; ++p) { a.ph_lo = p; a.ph_hi = p + 1; hipLaunchKernelGGL(mk_fwd, dim3(grid), dim3(NTHREADS), LDS_BYTES, stream, a);
#ifdef PROBE_DUP
        if (p == PROBE_DUP) { if (p == 3 || p == 5) (void)hipMemsetAsync((char*)d_ws + WS_CTL + 4096 * 4, 0, 1024, stream); hipLaunchKernelGGL(mk_fwd, dim3(grid), dim3(NTHREADS), LDS_BYTES, stream, a); }
#endif
    }
#endif
    const hipError_t le = hipPeekAtLastError();
    if (le != hipSuccess) fprintf(stderr, "kernel_launch: launch failed: %s\n", hipGetErrorName(le));
}
```
